# Optimizing an MI355X kernel written in HIP

```python
import math, functools
import jax, jax.numpy as jnp
from jax import lax
import numpy as np

D_MODEL = 1024
BATCH = 32
SEQ = 256
DEPTH = 2
DEC_BATCH = 8
DEC_SEQ = 2048
PAST_LEN = 512

GRID_W = 64
HEAD_DIM = 64
N_HEADS = D_MODEL // HEAD_DIM
DECAY_LORA = 64
A_LORA = 64
GATE_LORA = 128
D_FF = 2816
N_MIXERS = 2
N_RWKV_LAYERS = (DEPTH + 1) // 2
N_POOL_LAYERS = DEPTH // 2
POOL_WINDOWS = (2, 4, 8, 16)
N_POOL_GROUPS = 4
POOL_GC = D_MODEL // N_POOL_GROUPS
N_MOD = 9
RMS_EPS = 1e-6
GN_EPS = 64e-5

kernel_name = 'hybrid_rwkv7_pool_diffusion_step'


def rms_norm(x, g):
    xf = x.astype(jnp.float32)
    y = xf * lax.rsqrt(jnp.mean(xf * xf, axis=-1, keepdims=True) + RMS_EPS)
    return (y * g.astype(jnp.float32)).astype(x.dtype)


def premod(x, g_pre, shift, scale):
    return rms_norm(x, g_pre) * (1 + scale) + shift


def swiglu(h, w1, w3, w2):
    return (jax.nn.silu(h @ w1) * (h @ w3)) @ w2


def wkv_scan(S0, r, w, k, v, kk, a, reverse):
    seq = tuple(jnp.moveaxis(t.astype(jnp.float32), 1, 0) for t in (r, w, k, v, kk, a))

    def step(S, inp):
        r_t, w_t, k_t, v_t, kk_t, a_t = inp
        sa = jnp.einsum('bhij,bhj->bhi', S, -kk_t)
        S = (S * w_t[:, :, None, :]
             + sa[..., None] * (kk_t * a_t)[:, :, None, :]
             + v_t[..., None] * k_t[:, :, None, :])
        return S, jnp.einsum('bhij,bhj->bhi', S, r_t)

    S, ys = lax.scan(step, S0.astype(jnp.float32), seq, reverse=reverse)
    return jnp.moveaxis(ys, 0, 1), S


def head_group_norm(y, w, b):
    yf = y.astype(jnp.float32)
    mean = jnp.mean(yf, axis=-1, keepdims=True)
    var = jnp.mean(jnp.square(yf - mean), axis=-1, keepdims=True)
    yn = (yf - mean) * lax.rsqrt(var + GN_EPS)
    return yn.reshape(y.shape[0], y.shape[1], -1) * w + b


def rwkv_time_mix(h, S0f, S0b, mu, w_rkv, w0, w1, w2, a0, a1, a2, g1, g2, k_k, k_a, r_k, gn_w, gn_b, w_o):
    B, T, D = h.shape
    heads = lambda t: t.reshape(B, T, N_HEADS, HEAD_DIM)
    hp = jnp.pad(h, ((0, 0), (1, 1), (0, 0)))
    xx = 0.5 * (hp[:, :-2] + hp[:, 2:]) - h
    xs = h[None] + xx[None] * mu[:, None, None, :]
    xr, xw, xk, xv, xa, xg = xs[0], xs[1], xs[2], xs[3], xs[4], xs[5]
    rkv = jnp.einsum('nbtd,nde->nbte', jnp.stack([xr, xk, xv]), w_rkv)
    r, k, v = heads(rkv[0]), rkv[1], heads(rkv[2])
    g = jax.nn.sigmoid(xg @ g1) @ g2
    kk = heads(k * k_k).astype(jnp.float32)
    kk = kk / jnp.maximum(jnp.sqrt(jnp.sum(kk * kk, axis=-1, keepdims=True)), 1e-12)
    ys, bonuses, finals = [], [], []
    for d, S0 in enumerate((S0f, S0b)):
        wlog = -jax.nn.softplus(-(w0[d] + jnp.tanh(xw @ w1[d]) @ w2[d])) - 0.5
        decay = jnp.exp(-jnp.exp(wlog.astype(jnp.float32)))
        a = jax.nn.sigmoid(a0[d] + (xa @ a1[d]) @ a2[d])
        kd = heads(k * (1 + (a - 1) * k_a))
        y_d, S_d = wkv_scan(S0, r, heads(decay), kd, v, kk, heads(a), reverse=(d == 1))
        ys.append(y_d)
        bonuses.append(jnp.sum(r * kd * r_k, axis=-1, keepdims=True) * v)
        finals.append(S_d)
    y = head_group_norm(ys[0] + ys[1], gn_w, gn_b) + (bonuses[0] + bonuses[1]).reshape(B, T, D)
    out = (y.astype(h.dtype) * g) @ w_o
    return out, finals[0], finals[1]


def centred_box_mean(x, window, axis):
    L = x.shape[axis]
    cs = jnp.cumsum(x.astype(jnp.float32), axis=axis)
    pad_cfg = [(0, 0)] * x.ndim
    pad_cfg[axis] = (1, 0)
    cs = jnp.pad(cs, pad_cfg)
    t = jnp.arange(L)
    lo = jnp.clip(t - window // 2, 0, L)
    hi = jnp.clip(t + window - window // 2, 0, L)
    s = jnp.take(cs, hi, axis=axis) - jnp.take(cs, lo, axis=axis)
    cshape = [1] * x.ndim
    cshape[axis] = L
    cnt = (hi - lo).astype(jnp.float32).reshape(cshape)
    return (s / cnt).astype(x.dtype)


def pool_mix(h, pool_w, pool_scale, grid):
    B, T, D = h.shape
    if grid:
        rows = T // GRID_W
        hg = h.reshape(B, rows, GRID_W, D)
        axes = (1, 2)
    else:
        hg = h
        axes = (1,)
    outs = []
    for gi, win in enumerate(POOL_WINDOWS):
        part = hg[..., gi * POOL_GC:(gi + 1) * POOL_GC]
        m = part
        for ax in axes:
            m = centred_box_mean(m, win, ax)
        outs.append(m - part)
    dlt = jnp.stack(outs, axis=-2)
    y = jnp.einsum('...gc,gce->...ge', dlt, pool_w)
    return y.reshape(B, T, D) * pool_scale


def trunk(x, cond, S0f_all, S0b_all, grid, W):
    B = x.shape[0]
    finals_f, finals_b = [], []
    for i in range(DEPTH):
        mod = jax.nn.silu(cond) @ W['w_mod'][i] + W['b_mod'][i]
        m = jnp.split(mod[:, None, :], N_MOD, axis=-1)
        h = premod(x, W['norm_pre'][i, 0], m[0], m[1])
        f = swiglu(h, W['ffn_w1'][i, 0], W['ffn_w3'][i, 0], W['ffn_w2'][i, 0])
        x = x + 0.5 * m[2] * rms_norm(f, W['norm_post'][i, 0])
        h = premod(x, W['norm_pre'][i, 1], m[3], m[4])
        j = i // N_MIXERS
        if i % N_MIXERS == 0:
            if S0f_all is None:
                s0f = jnp.zeros((B, N_HEADS, HEAD_DIM, HEAD_DIM), jnp.float32)
                s0b = s0f
            else:
                s0f, s0b = S0f_all[:, j], S0b_all[:, j]
            out, sf, sb = rwkv_time_mix(
                h, s0f, s0b, W['rwkv_mu'][j], W['rwkv_w_rkv'][j], W['rwkv_w0'][j], W['rwkv_w1'][j],
                W['rwkv_w2'][j], W['rwkv_a0'][j], W['rwkv_a1'][j], W['rwkv_a2'][j], W['rwkv_g1'][j],
                W['rwkv_g2'][j], W['rwkv_k_k'][j], W['rwkv_k_a'][j], W['rwkv_r_k'][j], W['rwkv_gn_w'][j],
                W['rwkv_gn_b'][j], W['rwkv_w_o'][j])
            finals_f.append(sf.astype(x.dtype))
            finals_b.append(sb.astype(x.dtype))
        else:
            out = pool_mix(h, W['pool_w'][j], W['pool_scale'][j], grid)
        x = x + m[5] * rms_norm(out, W['norm_post'][i, 1])
        h = premod(x, W['norm_pre'][i, 2], m[6], m[7])
        f = swiglu(h, W['ffn_w1'][i, 1], W['ffn_w3'][i, 1], W['ffn_w2'][i, 1])
        x = x + 0.5 * m[8] * rms_norm(f, W['norm_post'][i, 2])
    return x, jnp.stack(finals_f, axis=1), jnp.stack(finals_b, axis=1)


def setup_inputs(seed: int = 0) -> dict:
    key = jax.random.key(seed)
    ks = jax.random.split(key, 40)
    D = D_MODEL
    NR, NP = N_RWKV_LAYERS, N_POOL_LAYERS

    def nrm(k, shape, scale):
        return jax.random.normal(k, shape, jnp.float32) * scale

    return {
        'x_prompt': nrm(ks[0], (BATCH, SEQ, D), 1.0),
        'x_sample': nrm(ks[1], (DEC_BATCH, DEC_SEQ, D), 1.0),
        'c': nrm(ks[2], (DEC_BATCH, D), 1.0),
        'state_ctx_fwd': nrm(ks[3], (DEC_BATCH, NR, N_HEADS, HEAD_DIM, HEAD_DIM), 0.5),
        'state_ctx_bwd': nrm(ks[4], (DEC_BATCH, NR, N_HEADS, HEAD_DIM, HEAD_DIM), 0.5),
        'c_ctx': nrm(ks[5], (D,), 1.0),
        'w_mod': nrm(ks[6], (DEPTH, D, N_MOD * D), 0.5 * D ** -0.5),
        'b_mod': nrm(ks[7], (DEPTH, N_MOD * D), 0.02),
        'norm_pre': 1.0 + nrm(ks[8], (DEPTH, 3, D), 0.02),
        'norm_post': 1.0 + nrm(ks[9], (DEPTH, 3, D), 0.02),
        'ffn_w1': nrm(ks[10], (DEPTH, 2, D, D_FF), D ** -0.5),
        'ffn_w3': nrm(ks[11], (DEPTH, 2, D, D_FF), D ** -0.5),
        'ffn_w2': nrm(ks[12], (DEPTH, 2, D_FF, D), D_FF ** -0.5),
        'rwkv_mu': jax.random.uniform(ks[13], (NR, 6, D), jnp.float32),
        'rwkv_w_rkv': nrm(ks[14], (NR, 3, D, D), D ** -0.5),
        'rwkv_w0': jnp.linspace(-6.0, -1.0, D, dtype=jnp.float32)[None, None, :] + nrm(ks[15], (NR, 2, D), 0.1),
        'rwkv_w1': nrm(ks[16], (NR, 2, D, DECAY_LORA), D ** -0.5),
        'rwkv_w2': nrm(ks[17], (NR, 2, DECAY_LORA, D), 0.1 * DECAY_LORA ** -0.5),
        'rwkv_a0': nrm(ks[18], (NR, 2, D), 0.1),
        'rwkv_a1': nrm(ks[19], (NR, 2, D, A_LORA), D ** -0.5),
        'rwkv_a2': nrm(ks[20], (NR, 2, A_LORA, D), A_LORA ** -0.5),
        'rwkv_g1': nrm(ks[21], (NR, D, GATE_LORA), D ** -0.5),
        'rwkv_g2': nrm(ks[22], (NR, GATE_LORA, D), GATE_LORA ** -0.5),
        'rwkv_k_k': 0.85 + nrm(ks[23], (NR, D), 0.02),
        'rwkv_k_a': 1.0 + nrm(ks[24], (NR, D), 0.02),
        'rwkv_r_k': nrm(ks[25], (NR, N_HEADS, HEAD_DIM), 0.1),
        'rwkv_gn_w': 1.0 + nrm(ks[26], (NR, D), 0.02),
        'rwkv_gn_b': nrm(ks[27], (NR, D), 0.02),
        'rwkv_w_o': nrm(ks[28], (NR, D, D), D ** -0.5),
        'pool_w': nrm(ks[29], (NP, N_POOL_GROUPS, POOL_GC, POOL_GC), POOL_GC ** -0.5),
        'pool_scale': 1.0 + nrm(ks[30], (NP, D), 0.1),
    }


def reference(x_prompt, x_sample, c, state_ctx_fwd, state_ctx_bwd, c_ctx, w_mod, b_mod, norm_pre, norm_post,
              ffn_w1, ffn_w3, ffn_w2, rwkv_mu, rwkv_w_rkv, rwkv_w0, rwkv_w1, rwkv_w2, rwkv_a0, rwkv_a1,
              rwkv_a2, rwkv_g1, rwkv_g2, rwkv_k_k, rwkv_k_a, rwkv_r_k, rwkv_gn_w, rwkv_gn_b, rwkv_w_o,
              pool_w, pool_scale):
    W = dict(w_mod=w_mod, b_mod=b_mod, norm_pre=norm_pre, norm_post=norm_post,
             ffn_w1=ffn_w1, ffn_w3=ffn_w3, ffn_w2=ffn_w2,
             rwkv_mu=rwkv_mu, rwkv_w_rkv=rwkv_w_rkv, rwkv_w0=rwkv_w0, rwkv_w1=rwkv_w1, rwkv_w2=rwkv_w2,
             rwkv_a0=rwkv_a0, rwkv_a1=rwkv_a1, rwkv_a2=rwkv_a2, rwkv_g1=rwkv_g1, rwkv_g2=rwkv_g2,
             rwkv_k_k=rwkv_k_k, rwkv_k_a=rwkv_k_a, rwkv_r_k=rwkv_r_k, rwkv_gn_w=rwkv_gn_w,
             rwkv_gn_b=rwkv_gn_b, rwkv_w_o=rwkv_w_o, pool_w=pool_w, pool_scale=pool_scale)
    y_prompt, new_state_ctx_fwd, new_state_ctx_bwd = trunk(x_prompt, c_ctx[None, :], None, None, False, W)
    y_sample, _, _ = trunk(x_sample, c, state_ctx_fwd, state_ctx_bwd, True, W)
    return (y_prompt, y_sample, new_state_ctx_fwd, new_state_ctx_bwd)
```

```cpp
#include <hip/hip_runtime.h>
#include <hip/hip_cooperative_groups.h>
namespace pg8 {
#define PG8_LAS __attribute__((address_space(3)))
typedef unsigned short bf16_t;
typedef short bf16x8 __attribute__((ext_vector_type(8)));
typedef float f32x4 __attribute__((ext_vector_type(4)));
typedef unsigned u32x4 __attribute__((ext_vector_type(4)));
constexpr int BM = 256, BK = 64, HALF = 128, HTB = HALF * BK * 2  , STAGE_BYTES = 8 * HTB, NXCD = 8, WGM = 8;

__host__ __device__ __forceinline__ int lds_byte(int r, int c) { const int st = (r >> 4) * 2 + (c >> 5), rr = r & 15, cc = c & 31, ob = rr * 64 + cc * 2; return st * 1024 + (ob ^ (((ob >> 9) & 1) << 5)); }
__host__ __device__ __forceinline__ void stage_rc(int b, int& R, int& C) { const int st = b / 1024, sb = b % 1024, swz = sb ^ (((sb >> 9) & 1) << 5); R = (st >> 1) * 16 + swz / 64; C = (st & 1) * 32 + (swz % 64) / 2; }
__host__ __device__ __forceinline__ int perm32(int rho) { const int n = rho >> 4, i = rho & 15; return 8 * (i >> 2) + 4 * n + (i & 3); }

struct Unit { int pm, pn; };
struct Gemm { const bf16_t* A; const bf16_t* Bt; int M, N, K; };

struct StaticOrder {
    int nM, nN, nwg, G, c;
    __host__ __device__ void init(int M, int N, int G_, int c_) { nM = M / BM; nN = N / BM; nwg = nM * nN; G = G_; c = c_; }
    __host__ __device__ bool next(int i, Unit& u) const {
        const long L = (long)i * G + c; if (L >= nwg) return false;
        int wgid = (int)L; { const int q = nwg / NXCD, r = nwg % NXCD, xcd = wgid % NXCD, off = wgid / NXCD; wgid = (xcd < r ? xcd * (q + 1) : r * (q + 1) + (xcd - r) * q) + off; }
        const int nig = WGM * nN, gid = wgid / nig, fm = gid * WGM, gsz = (nM - fm) < WGM ? (nM - fm) : WGM;
        u.pm = fm + ((wgid % nig) % gsz); u.pn = (wgid % nig) / gsz; return true;
    }
    __device__ __forceinline__ void a_ready(const Unit&) const {}
    __device__ __forceinline__ void done(const Unit&) const {}
};
__device__ __forceinline__ unsigned cvt_pk_bf16(float lo, float hi) { unsigned r; asm volatile("v_cvt_pk_bf16_f32 %0, %1, %2" : "=v"(r) : "v"(lo), "v"(hi)); return r; }
typedef float f32x2 __attribute__((ext_vector_type(2)));
__device__ __forceinline__ float fast_sigmoid(float x) { return __builtin_amdgcn_rcpf(1.0f + __expf(-x)); }
__device__ __forceinline__ float fast_tanh(float x) { return 1.0f - 2.0f * __builtin_amdgcn_rcpf(1.0f + __expf(2.0f * x)); }
struct EpiStore {
    static constexpr bool PERM = true, AFTER_DRAIN = false;
    bf16_t* O; int ldc;
    __device__ __forceinline__ void operator()(const f32x4 (&acc)[2][2][4][2], const Unit& u, int wr, int wc, int fr, int fq) const {
        const int row0 = u.pm * BM + wr * 64 + fr, col0 = u.pn * BM + wc * 32 + 8 * fq;
#pragma unroll
        for (int ai = 0; ai < 2; ++ai)
#pragma unroll
            for (int m = 0; m < 4; ++m) { bf16_t* rowp = O + (size_t)(row0 + ai * HALF + m * 16) * ldc + col0;
#pragma unroll
                for (int bj = 0; bj < 2; ++bj) { const f32x4 v0 = acc[ai][bj][m][0], v1 = acc[ai][bj][m][1];
                    u32x4 w; w.x = cvt_pk_bf16(v0[0], v0[1]); w.y = cvt_pk_bf16(v0[2], v0[3]); w.z = cvt_pk_bf16(v1[0], v1[1]); w.w = cvt_pk_bf16(v1[2], v1[3]);
                    *(u32x4*)(rowp + bj * HALF) = w; } }
    }
};
struct EpiSwiglu {
    static constexpr bool PERM = true, AFTER_DRAIN = false;
    bf16_t* O; int ldc;
    __device__ __forceinline__ void operator()(const f32x4 (&acc)[2][2][4][2], const Unit& u, int wr, int wc, int fr, int fq) const {
        const int row0 = u.pm * BM + wr * 64 + fr, col0 = u.pn * HALF + wc * 32 + 8 * fq;
#pragma unroll
        for (int ai = 0; ai < 2; ++ai)
#pragma unroll
            for (int m = 0; m < 4; ++m) { bf16_t* rowp = O + (size_t)(row0 + ai * HALF + m * 16) * ldc + col0;
                float o[8];
#pragma unroll
                for (int n = 0; n < 2; ++n)
#pragma unroll
                    for (int j = 0; j < 4; ++j) { const float a = acc[ai][0][m][n][j], b = acc[ai][1][m][n][j]; o[n * 4 + j] = a * fast_sigmoid(a) * b; }
                u32x4 w; w.x = cvt_pk_bf16(o[0], o[1]); w.y = cvt_pk_bf16(o[2], o[3]); w.z = cvt_pk_bf16(o[4], o[5]); w.w = cvt_pk_bf16(o[6], o[7]);
                *(u32x4*)rowp = w; }
    }
};
struct EpiRkv {
    static constexpr bool PERM = true, AFTER_DRAIN = false;
    bf16_t* O; size_t tstride; bf16_t* L;
    __device__ __forceinline__ void operator()(const f32x4 (&acc)[2][2][4][2], const Unit& u, int wr, int wc, int fr, int fq) const {
        const int row0 = u.pm * BM + wr * 64 + fr;
        if (u.pn < 12) {
            bf16_t* base = O + (size_t)(u.pn >> 2) * tstride; const int col0 = (u.pn & 3) * BM + wc * 32 + 8 * fq;
#pragma unroll
            for (int ai = 0; ai < 2; ++ai)
#pragma unroll
                for (int m = 0; m < 4; ++m) { bf16_t* rowp = base + (size_t)(row0 + ai * HALF + m * 16) * 1024 + col0;
#pragma unroll
                    for (int bj = 0; bj < 2; ++bj) { const f32x4 v0 = acc[ai][bj][m][0], v1 = acc[ai][bj][m][1];
                        u32x4 w; w.x = cvt_pk_bf16(v0[0], v0[1]); w.y = cvt_pk_bf16(v0[2], v0[3]); w.z = cvt_pk_bf16(v1[0], v1[1]); w.w = cvt_pk_bf16(v1[2], v1[3]);
                        *(u32x4*)(rowp + bj * HALF) = w; } }
        } else {
            const int t13 = (u.pn == 13); const int col0 = (u.pn - 12) * BM + wc * 32 + 8 * fq;
#pragma unroll
            for (int ai = 0; ai < 2; ++ai)
#pragma unroll
                for (int m = 0; m < 4; ++m) { bf16_t* rowp = L + (size_t)(row0 + ai * HALF + m * 16) * 384 + col0;
#pragma unroll
                    for (int bj = 0; bj < 2; ++bj) { if (t13 && bj == 1) continue;
                        float o[8];
#pragma unroll
                        for (int n = 0; n < 2; ++n)
#pragma unroll
                            for (int j = 0; j < 4; ++j) { const float a = acc[ai][bj][m][n][j]; o[n * 4 + j] = t13 ? fast_sigmoid(a) : (bj == 0 ? fast_tanh(a) : a); }
                        u32x4 w; w.x = cvt_pk_bf16(o[0], o[1]); w.y = cvt_pk_bf16(o[2], o[3]); w.z = cvt_pk_bf16(o[4], o[5]); w.w = cvt_pk_bf16(o[6], o[7]);
                        *(u32x4*)(rowp + bj * HALF) = w; } }
        }
    }
};

struct EpiAll {
    static constexpr bool PERM = true, AFTER_DRAIN = false;
    int kind; bf16_t* O; int ldc; bf16_t* L;
    __device__ __forceinline__ void operator()(const f32x4 (&acc)[2][2][4][2], const Unit& u, int wr, int wc, int fr, int fq) const {
        if (kind == 0) { EpiStore e{O, ldc}; e(acc, u, wr, wc, fr, fq); }
        else if (kind == 1) { EpiSwiglu e{O, ldc}; e(acc, u, wr, wc, fr, fq); }
        else { EpiRkv e{O, (size_t)24576 * 1024, L}; e(acc, u, wr, wc, fr, fq); }
    }
};
template <class Epi, class Sched, bool STAMP = false>
__device__ __forceinline__ void gemm_phase(PG8_LAS unsigned char* lds, const Gemm g, const Sched& S, const Epi& E, unsigned long long* stamps, const int tid_in) {
    const int tid = tid_in, wid = __builtin_amdgcn_readfirstlane(tid >> 6), lane = tid & 63, wr = wid >> 2, wc = wid & 3, fr = lane & 15, fq = lane >> 4;
    const int K = g.K, nt = K / BK;
    int ts_lo = 0, ts_hi = 0, nts = 0; const unsigned long long rt_entry = STAMP ? (unsigned long long)wall_clock64() : 0ull;
#define PG8_STAMP() do { if (STAMP && wid == 0 && nts < 64) { const unsigned long long _c = (unsigned long long)clock64(); \
        ts_lo = (lane == nts) ? (int)(unsigned)_c : ts_lo; ts_hi = (lane == nts) ? (int)(unsigned)(_c >> 32) : ts_hi; ++nts; } } while (0)
    PG8_STAMP();
    unsigned voffA[2], voffB[2];
#pragma unroll
    for (int i = 0; i < 2; ++i) { int R, C; stage_rc(tid * 16 + i * 8192, R, C); const int Rb = Epi::PERM ? ((R & ~31) + perm32(R & 31)) : R;
        voffA[i] = (unsigned)(R * K + C) * 2u; voffB[i] = (unsigned)(Rb * K + C) * 2u; }
    const size_t kstep = (size_t)(BK * 2);
    const size_t hstep = (size_t)HALF * K * 2;
    const size_t tstep = 2 * hstep;
    const unsigned ldsw = (unsigned)wid * 1024u;
    const int aoff = lds_byte(wr * 64 + fr, fq * 8), boff = lds_byte(wc * 32 + fr, fq * 8);
#define PG8_SA(b, h) (((b) * 2 + (h)) * HTB)
#define PG8_SB(b, h) ((4 + (b) * 2 + (h)) * HTB)
#define PG8_STAGE(bufoff, gbase, voff) do { _Pragma("unroll") for (int _i = 0; _i < 2; ++_i) \
        __builtin_amdgcn_global_load_lds((const unsigned*)((const char*)(gbase) + (voff)[_i]), (PG8_LAS unsigned*)(lds + (bufoff) + ldsw + _i * 8192), 16, 0, 0); } while (0)
#define PG8_LDA(dst, b, h) do { _Pragma("unroll") for (int m = 0; m < 4; ++m) _Pragma("unroll") for (int k = 0; k < 2; ++k) dst[m][k] = *(const PG8_LAS bf16x8*)(lds + PG8_SA(b, h) + aoff + m * 2048 + k * 1024); } while (0)
#define PG8_LDB(dst, b, h) do { _Pragma("unroll") for (int n = 0; n < 2; ++n) _Pragma("unroll") for (int k = 0; k < 2; ++k) dst[n][k] = *(const PG8_LAS bf16x8*)(lds + PG8_SB(b, h) + boff + n * 2048 + k * 1024); } while (0)
#define PG8_MMA(ai, bj, At, Bt) do { __builtin_amdgcn_s_setprio(1); _Pragma("unroll") for (int m = 0; m < 4; ++m) _Pragma("unroll") for (int n = 0; n < 2; ++n) _Pragma("unroll") for (int k = 0; k < 2; ++k) \
        acc[ai][bj][m][n] = __builtin_amdgcn_mfma_f32_16x16x32_bf16(Bt[n][k], At[m][k], acc[ai][bj][m][n], 0, 0, 0); __builtin_amdgcn_s_setprio(0); } while (0)
#define PG8_WAIT_V(n) asm volatile("s_waitcnt vmcnt(" #n ")" ::: "memory")
#define PG8_WAIT_L(n) asm volatile("s_waitcnt lgkmcnt(" #n ")" ::: "memory")
#define PG8_BAR __builtin_amdgcn_s_barrier()
#define PG8_SCHED __builtin_amdgcn_sched_barrier(0)
    Unit cur, nxt; int ui = 0;
    if (!S.next(0, cur)) return;
    f32x4 acc[2][2][4][2];
#pragma unroll
    for (int a = 0; a < 2; ++a)
#pragma unroll
        for (int b = 0; b < 2; ++b)
#pragma unroll
            for (int m = 0; m < 4; ++m)
#pragma unroll
                for (int n = 0; n < 2; ++n) acc[a][b][m][n] = (f32x4){0.f, 0.f, 0.f, 0.f};
    bf16x8 At[4][2], B0[2][2], B1[2][2];
    const char* cA = (const char*)g.A + (size_t)cur.pm * tstep; const char* cB = (const char*)g.Bt + (size_t)cur.pn * tstep;
    S.a_ready(cur);
    PG8_STAGE(PG8_SB(0, 0), cB, voffB); PG8_STAGE(PG8_SA(0, 0), cA, voffA); PG8_STAGE(PG8_SB(0, 1), cB + hstep, voffB); PG8_STAGE(PG8_SA(0, 1), cA + hstep, voffA);
    if (wr == 1) PG8_BAR;
    PG8_WAIT_V(4); PG8_BAR;
    PG8_STAGE(PG8_SB(1, 0), cB + kstep, voffB); PG8_STAGE(PG8_SA(1, 0), cA + kstep, voffA); PG8_STAGE(PG8_SB(1, 1), cB + hstep + kstep, voffB);
    PG8_WAIT_V(6); PG8_BAR;
    PG8_STAMP();
    for (;;) {
        const bool has_next = S.next(ui + 1, nxt);
        const char* nA = has_next ? (const char*)g.A + (size_t)nxt.pm * tstep : cA; const char* nB = has_next ? (const char*)g.Bt + (size_t)nxt.pn * tstep : cB;
        for (int t = 0; t < nt; t += 2) {
            const bool last = (t == nt - 2);
            const char* a1 = cA + (size_t)(t + 1) * kstep;
            const char* a2 = last ? nA : cA + (size_t)(t + 2) * kstep; const char* b2 = last ? nB : cB + (size_t)(t + 2) * kstep;
            const char* a3 = a2 + kstep; const char* b3 = b2 + kstep;
            if (last && has_next) S.a_ready(nxt);
            PG8_LDB(B0, 0, 0); PG8_SCHED; PG8_LDA(At, 0, 0); PG8_STAGE(PG8_SA(1, 1), a1 + hstep, voffA);
            PG8_WAIT_L(8); PG8_BAR; PG8_WAIT_L(0); PG8_MMA(0, 0, At, B0); PG8_BAR; PG8_SCHED;
            PG8_LDB(B1, 0, 1); PG8_STAGE(PG8_SB(0, 0), b2, voffB);
            PG8_BAR; PG8_WAIT_L(0); PG8_MMA(0, 1, At, B1); PG8_BAR;
            PG8_LDA(At, 0, 1); PG8_STAGE(PG8_SA(0, 0), a2, voffA);
            PG8_BAR; PG8_WAIT_L(0); PG8_MMA(1, 0, At, B0); PG8_BAR; PG8_SCHED;
            PG8_STAGE(PG8_SB(0, 1), b2 + hstep, voffB);
            PG8_WAIT_V(6); PG8_BAR; PG8_MMA(1, 1, At, B1); PG8_BAR;
            PG8_LDB(B0, 1, 0); PG8_SCHED; PG8_LDA(At, 1, 0); PG8_STAGE(PG8_SA(0, 1), a2 + hstep, voffA);
            PG8_WAIT_L(8); PG8_BAR; PG8_WAIT_L(0); PG8_MMA(0, 0, At, B0); PG8_BAR; PG8_SCHED;
            PG8_LDB(B1, 1, 1); PG8_STAGE(PG8_SB(1, 0), b3, voffB);
            PG8_BAR; PG8_WAIT_L(0); PG8_MMA(0, 1, At, B1); PG8_BAR;
            PG8_LDA(At, 1, 1); PG8_STAGE(PG8_SA(1, 0), a3, voffA);
            PG8_BAR; PG8_WAIT_L(0); PG8_MMA(1, 0, At, B0); PG8_BAR; PG8_SCHED;
            PG8_STAGE(PG8_SB(1, 1), b3 + hstep, voffB);
            PG8_WAIT_V(6); PG8_BAR; PG8_MMA(1, 1, At, B1); PG8_BAR;
        }
        PG8_STAMP();
        if constexpr (!Epi::AFTER_DRAIN) { E(acc, cur, wr, wc, fr, fq); S.done(cur); }
        PG8_STAMP();
        if (!has_next) break;
#pragma unroll
        for (int a = 0; a < 2; ++a)
#pragma unroll
            for (int b = 0; b < 2; ++b)
#pragma unroll
                for (int m = 0; m < 4; ++m)
#pragma unroll
                    for (int n = 0; n < 2; ++n) acc[a][b][m][n] = (f32x4){0.f, 0.f, 0.f, 0.f};
        cur = nxt; cA = nA; cB = nB; ++ui;
    }
    PG8_WAIT_V(0);
    if (wr == 0) PG8_BAR;
    PG8_BAR;
    if constexpr (Epi::AFTER_DRAIN) { E.fused(acc, cur, wr, wc, fr, fq, lds, wid, lane); S.done(cur); }
    PG8_STAMP();
    if (STAMP && wid == 0) { stamps[lane] = lane < nts ? (((unsigned long long)(unsigned)ts_hi << 32) | (unsigned)ts_lo) : 0ull;
        if (lane == 62) stamps[62] = rt_entry; if (lane == 63) stamps[63] = (unsigned long long)wall_clock64(); }
#undef PG8_STAMP
#undef PG8_SA
#undef PG8_SB
#undef PG8_STAGE
#undef PG8_LDA
#undef PG8_LDB
#undef PG8_MMA
#undef PG8_WAIT_V
#undef PG8_WAIT_L
#undef PG8_BAR
#undef PG8_SCHED
}
}

namespace cg = cooperative_groups;
using pg8::bf16_t; using pg8::bf16x8; using pg8::f32x4; using pg8::u32x4; using pg8::cvt_pk_bf16; using pg8::fast_sigmoid;
#define LAS __attribute__((address_space(3)))
typedef float f32x2 __attribute__((ext_vector_type(2)));
typedef unsigned u32x2 __attribute__((ext_vector_type(2)));

constexpr int D = 1024, DFF = 2816, MP = 8192, MS = 16384, MT = 24576;
constexpr int NIN = 31;
constexpr size_t R48 = (size_t)MT * 1024 * 2;
constexpr size_t OFF_A = 0, OFF_B = R48, OFF_C = 2 * R48, OFF_D = 3 * R48, OFF_E = 4 * R48;
constexpr size_t OFF_S = 5 * R48;
constexpr size_t OFF_W = OFF_S + (size_t)MT * 384 * 2;
constexpr size_t W_ELEMS = 9043968;
constexpr size_t OFF_MOD = OFF_W + W_ELEMS * 2;
constexpr size_t OFF_CBP = OFF_MOD + (size_t)9 * 2 * 9216 * 4;
constexpr size_t WS_NEED = OFF_CBP + (size_t)2 * MT * 64 * 4;
constexpr size_t W_W13 = 0, W_W2T = (size_t)5632 * 1024;
constexpr size_t W_BTP = 0, W_BTG = (size_t)3584 * 2048, W_WOT = W_BTG + (size_t)1024 * 384, W_W2L = W_WOT + (size_t)1024 * 1024, W_A2L = W_W2L + 131072;
constexpr float RMS_EPS = 1e-6f, GN_EPS = 64e-5f;

struct Tix { int tid, bid, gd; };
struct Params { const float* in[NIN]; float* out; unsigned char* ws; int pb, pe; };
typedef const Params __attribute__((address_space(4)))* CP;

__device__ __forceinline__ float bf2f(unsigned short b) { return __uint_as_float(((unsigned)b) << 16); }
__device__ __forceinline__ float bflo(unsigned w) { return __uint_as_float(w << 16); }
__device__ __forceinline__ float bfhi(unsigned w) { return __uint_as_float(w & 0xffff0000u); }
__device__ __forceinline__ float wave_sum(float v) {
#pragma unroll
    for (int o = 32; o >= 1; o >>= 1) v += __shfl_xor(v, o);
    return v;
}
template <int CTRL> __device__ __forceinline__ float dpp_f(float x) { return __builtin_bit_cast(float, __builtin_amdgcn_mov_dpp(__builtin_bit_cast(int, x), CTRL, 0xf, 0xf, true)); }
__device__ __forceinline__ float reduce8(float x) { x += dpp_f<0xB1>(x); x += dpp_f<0x4E>(x); x += dpp_f<0x141>(x); return x; }

struct ConvJob { const float* src; int K, N; bf16_t* dst; int dld, kofs, blk, blk_stride, row_off; const float* ksc; };
__device__ __forceinline__ void conv_job(const ConvJob j, LAS float* tile, int& rot, const Tix tx) {
    const int tid = tx.tid, G = tx.gd;
    const int tn = j.N >> 6, nt = (j.K >> 6) * tn;
    int t0 = (tx.bid - (rot % G) + G) % G;
    for (int t = t0; t < nt; t += G) {
        const int k0 = (t / tn) << 6, n0 = (t % tn) << 6;
        { const int r = tid >> 4, c4 = tid & 15;
#pragma unroll
          for (int it = 0; it < 2; ++it) { const int k = r + 32 * it; const float4 v = *(const float4*)(j.src + (size_t)(k0 + k) * j.N + n0 + 4 * c4);
              LAS float* tp = tile + k * 65 + 4 * c4; tp[0] = v.x; tp[1] = v.y; tp[2] = v.z; tp[3] = v.w; } }
        __syncthreads();
        { const int n = tid >> 3, kg = tid & 7; float v[8];
#pragma unroll
          for (int i = 0; i < 8; ++i) { v[i] = tile[(8 * kg + i) * 65 + n]; if (j.ksc) v[i] *= j.ksc[k0 + 8 * kg + i]; }
          u32x4 w; w.x = cvt_pk_bf16(v[0], v[1]); w.y = cvt_pk_bf16(v[2], v[3]); w.z = cvt_pk_bf16(v[4], v[5]); w.w = cvt_pk_bf16(v[6], v[7]);
          const int gn = n0 + n; const int drow = (gn / j.blk) * j.blk_stride + (gn % j.blk) + j.row_off;
          *(u32x4*)(j.dst + (size_t)drow * j.dld + j.kofs + k0 + 8 * kg) = w; }
        __syncthreads();
    }
    rot += nt;
}
__device__ void conv_ffn(CP p, int fi, LAS float* tile, const Tix tx) {
    bf16_t* W = (bf16_t*)(p->ws + OFF_W); int rot = 0;
    conv_job(ConvJob{p->in[10] + (size_t)fi * D * DFF, D, DFF, W + W_W13, 1024, 0, 128, 256, 0, nullptr}, tile, rot, tx);
    conv_job(ConvJob{p->in[11] + (size_t)fi * D * DFF, D, DFF, W + W_W13, 1024, 0, 128, 256, 128, nullptr}, tile, rot, tx);
    conv_job(ConvJob{p->in[12] + (size_t)fi * D * DFF, DFF, D, W + W_W2T, 2816, 0, 1024, 1024, 0, nullptr}, tile, rot, tx);
}
__device__ void conv_rwkv(CP p, LAS float* tile, const Tix tx) {
    bf16_t* W = (bf16_t*)(p->ws + OFF_W); int rot = 0;
    const float* mu = p->in[13];
    for (int half = 0; half < 2; ++half) {
        const int ko = half * 1024;
        for (int i = 0; i < 3; ++i) { const int mi = (i == 0) ? 0 : (i == 1 ? 2 : 3);
            conv_job(ConvJob{p->in[14] + (size_t)i * D * D, D, D, W + W_BTP, 2048, ko, 1024, 1024, i * 1024, half ? mu + mi * D : nullptr}, tile, rot, tx); }
        for (int d = 0; d < 2; ++d) {
            conv_job(ConvJob{p->in[16] + (size_t)d * D * 64, D, 64, W + W_BTP, 2048, ko, 64, 64, 3072 + 64 * d, half ? mu + 1 * D : nullptr}, tile, rot, tx);
            conv_job(ConvJob{p->in[19] + (size_t)d * D * 64, D, 64, W + W_BTP, 2048, ko, 64, 64, 3200 + 64 * d, half ? mu + 4 * D : nullptr}, tile, rot, tx); }
        conv_job(ConvJob{p->in[21], D, 128, W + W_BTP, 2048, ko, 128, 128, 3328, half ? mu + 5 * D : nullptr}, tile, rot, tx);
    }
    conv_job(ConvJob{p->in[22], 128, D, W + W_BTG, 384, 256, 1024, 1024, 0, nullptr}, tile, rot, tx);
    for (int idx = tx.bid * 512 + tx.tid; idx < 1024 * 32; idx += tx.gd * 512) { const int n = idx >> 5, k8 = idx & 31; *(u32x4*)(W + W_BTG + (size_t)n * 384 + 8 * k8) = (u32x4){0u, 0u, 0u, 0u}; }
    conv_job(ConvJob{p->in[28], D, D, W + W_WOT, 1024, 0, 1024, 1024, 0, nullptr}, tile, rot, tx);
    for (int d = 0; d < 2; ++d) {
        conv_job(ConvJob{p->in[17] + (size_t)d * 64 * D, 64, D, W + W_W2L + (size_t)d * 65536, 64, 0, 1024, 1024, 0, nullptr}, tile, rot, tx);
        conv_job(ConvJob{p->in[20] + (size_t)d * 64 * D, 64, D, W + W_A2L + (size_t)d * 65536, 64, 0, 1024, 1024, 0, nullptr}, tile, rot, tx); }
}
__device__ void conv_pool(CP p, const Tix tx) {
    bf16_t* W = (bf16_t*)(p->ws + OFF_W); const float* pw = p->in[29]; const float* ps = p->in[30];
    for (int idx = tx.bid * 512 + tx.tid; idx < 1024 * 128; idx += tx.gd * 512) {
        const int k8 = idx >> 10, n = idx & 1023, g = n >> 8; u32x4 w = (u32x4){0u, 0u, 0u, 0u};
        if ((k8 >> 5) == g) { const float s = ps[n]; float v[8];
#pragma unroll
            for (int i = 0; i < 8; ++i) v[i] = pw[((size_t)g * 256 + ((8 * k8 + i) & 255)) * 256 + (n & 255)] * s;
            w.x = cvt_pk_bf16(v[0], v[1]); w.y = cvt_pk_bf16(v[2], v[3]); w.z = cvt_pk_bf16(v[4], v[5]); w.w = cvt_pk_bf16(v[6], v[7]); }
        *(u32x4*)(W + (size_t)n * 1024 + 8 * k8) = w; }
}

__device__ void mod_phase(CP p, LAS float* lf, const Tix tx) {
    LAS float* sc = lf; LAS float* red = lf + 9216;
    const int tid = tx.tid;
    if (tx.bid >= 288) return;
    for (int o = tid; o < 9216; o += 512) { const int c = o >> 10, k = o & 1023; const float v = (c == 0) ? p->in[5][k] : p->in[2][(c - 1) * 1024 + k]; sc[o] = v * fast_sigmoid(v); }
    __syncthreads();
    float* mod = (float*)(p->ws + OFF_MOD);
    for (int item = tx.bid; item < 288; item += tx.gd) {
        const int i = item / 144, n0 = (item % 144) * 64, col = tid & 63, ks = tid >> 6;
        float acc[9];
#pragma unroll
        for (int c = 0; c < 9; ++c) acc[c] = 0.f;
        const float* wp = p->in[6] + ((size_t)i * 1024 + ks * 128) * 9216 + n0 + col;
#pragma unroll 8
        for (int k = 0; k < 128; ++k) { const float w = wp[(size_t)k * 9216];
#pragma unroll
            for (int c = 0; c < 9; ++c) acc[c] += sc[c * 1024 + ks * 128 + k] * w; }
#pragma unroll
        for (int c = 0; c < 9; ++c) red[(ks * 9 + c) * 64 + col] = acc[c];
        __syncthreads();
        for (int o = tid; o < 576; o += 512) { const int c = o >> 6, cl = o & 63; float s = p->in[7][i * 9216 + n0 + cl];
#pragma unroll
            for (int k2 = 0; k2 < 8; ++k2) s += red[(k2 * 9 + c) * 64 + cl];
            mod[((size_t)c * 2 + i) * 9216 + n0 + cl] = s; }
        __syncthreads();
    }
}

struct RowCfg {
    int src_input;
    int pending;
    int lg, gidx; float coef; const float* npost;
    int has_next;
    int lh, shidx, scidx; const float* npre;
    int write_x;
};
__device__ __forceinline__ const float* xrow_in(CP p, int m) { return m < MP ? p->in[0] + (size_t)m * D : p->in[1] + (size_t)(m - MP) * D; }
__device__ __forceinline__ int cond_of(int m) { return m < MP ? 0 : 1 + ((m - MP) >> 11); }
__device__ __forceinline__ void row_update(CP p, const RowCfg& c, int m, int lane, f32x4 (&x)[4]) {
    const float* xr = c.src_input ? xrow_in(p, m) : p->out + (size_t)m * D;
    const float* mod = (const float*)(p->ws + OFF_MOD);
    const int cd = cond_of(m);
#pragma unroll
    for (int q = 0; q < 4; ++q) x[q] = *(const f32x4*)(xr + 4 * lane + 256 * q);
    if (c.pending) {
        const bf16_t* fr = (const bf16_t*)(p->ws + OFF_E) + (size_t)m * D; f32x4 f[4]; float ss = 0.f;
#pragma unroll
        for (int q = 0; q < 4; ++q) { const u32x2 w = *(const u32x2*)(fr + 4 * lane + 256 * q); f[q] = (f32x4){bflo(w.x), bfhi(w.x), bflo(w.y), bfhi(w.y)};
            ss += f[q][0] * f[q][0] + f[q][1] * f[q][1] + f[q][2] * f[q][2] + f[q][3] * f[q][3]; }
        ss = wave_sum(ss); const float rs = rsqrtf(ss * (1.0f / 1024.0f) + RMS_EPS) * c.coef;
        const float* gate = mod + ((size_t)(cd * 2 + c.lg) * 9 + c.gidx) * D;
#pragma unroll
        for (int q = 0; q < 4; ++q) { const f32x4 g = *(const f32x4*)(gate + 4 * lane + 256 * q), np = *(const f32x4*)(c.npost + 4 * lane + 256 * q); x[q] += g * (f[q] * np) * rs; }
    }
}
__device__ __forceinline__ void row_premod(CP p, const RowCfg& c, int m, int lane, const f32x4 (&x)[4], f32x4 (&h)[4]) {
    const float* mod = (const float*)(p->ws + OFF_MOD);
    const int cd = cond_of(m);
    float ss = 0.f;
#pragma unroll
    for (int q = 0; q < 4; ++q) ss += x[q][0] * x[q][0] + x[q][1] * x[q][1] + x[q][2] * x[q][2] + x[q][3] * x[q][3];
    ss = wave_sum(ss); const float rs = rsqrtf(ss * (1.0f / 1024.0f) + RMS_EPS);
    const float* sh = mod + ((size_t)(cd * 2 + c.lh) * 9 + c.shidx) * D; const float* scl = mod + ((size_t)(cd * 2 + c.lh) * 9 + c.scidx) * D;
#pragma unroll
    for (int q = 0; q < 4; ++q) { const f32x4 g = *(const f32x4*)(c.npre + 4 * lane + 256 * q), s1 = *(const f32x4*)(scl + 4 * lane + 256 * q), s0 = *(const f32x4*)(sh + 4 * lane + 256 * q);
        h[q] = (x[q] * rs * g) * (1.0f + s1) + s0; }
}
__device__ __forceinline__ void store_bf16_row(bf16_t* dst, int lane, const f32x4 (&h)[4]) {
#pragma unroll
    for (int q = 0; q < 4; ++q) { u32x2 w; w.x = cvt_pk_bf16(h[q][0], h[q][1]); w.y = cvt_pk_bf16(h[q][2], h[q][3]); *(u32x2*)(dst + 4 * lane + 256 * q) = w; }
}
__device__ void rowpass_simple(CP p, const RowCfg c, const Tix tx) {
    const int lane = tx.tid & 63, wid = tx.tid >> 6, nw = tx.gd * 8;
    bf16_t* hdst = (bf16_t*)(p->ws + OFF_A);
    for (int m = tx.bid * 8 + wid; m < MT; m += nw) {
        f32x4 x[4]; row_update(p, c, m, lane, x);
        if (c.write_x) {
#pragma unroll
            for (int q = 0; q < 4; ++q) *(f32x4*)(p->out + (size_t)m * D + 4 * lane + 256 * q) = x[q]; }
        if (c.has_next) { f32x4 h[4]; row_premod(p, c, m, lane, x, h); store_bf16_row(hdst + (size_t)m * D, lane, h); }
    }
}
__device__ void rowpass_shift(CP p, const RowCfg c, const Tix tx) {
    const int lane = tx.tid & 63, wid = tx.tid >> 6, nw = tx.gd * 8;
    bf16_t* adst = (bf16_t*)(p->ws + OFF_A);
    for (int m = tx.bid * 8 + wid; m < MT; m += nw) {
        const int T = m < MP ? 256 : 2048, t = m < MP ? (m & 255) : ((m - MP) & 2047);
        f32x4 x[4], h[4], hs[4];
        row_update(p, c, m, lane, x);
#pragma unroll
        for (int q = 0; q < 4; ++q) *(f32x4*)(p->out + (size_t)m * D + 4 * lane + 256 * q) = x[q];
        row_premod(p, c, m, lane, x, h);
#pragma unroll
        for (int q = 0; q < 4; ++q) hs[q] = (f32x4){0.f, 0.f, 0.f, 0.f};
        if (t > 0) { f32x4 xn[4], hn[4]; row_update(p, c, m - 1, lane, xn); row_premod(p, c, m - 1, lane, xn, hn);
#pragma unroll
            for (int q = 0; q < 4; ++q) hs[q] += hn[q]; }
        if (t < T - 1) { f32x4 xn[4], hn[4]; row_update(p, c, m + 1, lane, xn); row_premod(p, c, m + 1, lane, xn, hn);
#pragma unroll
            for (int q = 0; q < 4; ++q) hs[q] += hn[q]; }
#pragma unroll
        for (int q = 0; q < 4; ++q) hs[q] = 0.5f * hs[q] - h[q];
        store_bf16_row(adst + (size_t)m * 2048, lane, h);
        store_bf16_row(adst + (size_t)m * 2048 + 1024, lane, hs);
    }
}
__device__ void rowpass_gn(CP p, const Tix tx) {
    const int lane = tx.tid & 63, wid = tx.tid >> 6, nw = tx.gd * 8;
    const bf16_t* yf = (const bf16_t*)(p->ws + OFF_A); const bf16_t* yb = (const bf16_t*)(p->ws + OFF_B);
    const bf16_t* gb = (const bf16_t*)(p->ws + OFF_C); const bf16_t* vb = (const bf16_t*)(p->ws + OFF_E);
    bf16_t* ob = (bf16_t*)(p->ws + OFF_D); const float* cbp = (const float*)(p->ws + OFF_CBP);
    const float* gnw = p->in[26]; const float* gnb = p->in[27];
    for (int m = tx.bid * 8 + wid; m < MT; m += nw) {
        f32x4 o[4];
#pragma unroll
        for (int q = 0; q < 4; ++q) {
            const int col = 4 * lane + 256 * q, hd = 4 * q + (lane >> 4);
            const u32x2 a = *(const u32x2*)(yf + (size_t)m * D + col), b = *(const u32x2*)(yb + (size_t)m * D + col);
            f32x4 y = (f32x4){bflo(a.x) + bflo(b.x), bfhi(a.x) + bfhi(b.x), bflo(a.y) + bflo(b.y), bfhi(a.y) + bfhi(b.y)};
            float s = y[0] + y[1] + y[2] + y[3];
            s += __shfl_xor(s, 1); s += __shfl_xor(s, 2); s += __shfl_xor(s, 4); s += __shfl_xor(s, 8);
            const float mean = s * (1.0f / 64.0f); const f32x4 dv = y - mean;
            float vs = dv[0] * dv[0] + dv[1] * dv[1] + dv[2] * dv[2] + dv[3] * dv[3];
            vs += __shfl_xor(vs, 1); vs += __shfl_xor(vs, 2); vs += __shfl_xor(vs, 4); vs += __shfl_xor(vs, 8);
            const float rstd = rsqrtf(vs * (1.0f / 64.0f) + GN_EPS);
            const f32x4 c0 = *(const f32x4*)(cbp + ((size_t)m * 16 + hd) * 4), c1 = *(const f32x4*)(cbp + ((size_t)(MT + m) * 16 + hd) * 4);
            const float cb = (c0[0] + c0[1] + c0[2] + c0[3]) + (c1[0] + c1[1] + c1[2] + c1[3]);
            const u32x2 vw = *(const u32x2*)(vb + (size_t)m * D + col), gw = *(const u32x2*)(gb + (size_t)m * D + col);
            const f32x4 v = (f32x4){bflo(vw.x), bfhi(vw.x), bflo(vw.y), bfhi(vw.y)}, g = (f32x4){bflo(gw.x), bfhi(gw.x), bflo(gw.y), bfhi(gw.y)};
            const f32x4 w = *(const f32x4*)(gnw + col), bb = *(const f32x4*)(gnb + col);
            o[q] = (dv * rstd * w + bb + cb * v) * g;
        }
        store_bf16_row(ob + (size_t)m * D, lane, o);
    }
}

__device__ void pool_pass(CP p, int pass, const Tix tx) {
    const bf16_t* h = (const bf16_t*)(p->ws + OFF_A); float* t1 = (float*)(p->ws + OFF_B); bf16_t* dl = (bf16_t*)(p->ws + OFF_D);
    const int total = MT * 128;
    for (int idx = tx.bid * 512 + tx.tid; idx < total; idx += tx.gd * 512) {
        const int m = idx >> 7, cg8 = idx & 127, ch = 8 * cg8, win = 2 << (cg8 >> 5), hw = win >> 1;
        float acc[8];
#pragma unroll
        for (int i = 0; i < 8; ++i) acc[i] = 0.f;
        if (m < MP) {
            if (pass != 0) continue;
            const int t = m & 255, mb = m - t; const int lo = max(t - hw, 0), hi = min(t + hw, 256);
            for (int tt = lo; tt < hi; ++tt) { const u32x4 w = *(const u32x4*)(h + (size_t)(mb + tt) * D + ch);
                acc[0] += bflo(w.x); acc[1] += bfhi(w.x); acc[2] += bflo(w.y); acc[3] += bfhi(w.y); acc[4] += bflo(w.z); acc[5] += bfhi(w.z); acc[6] += bflo(w.w); acc[7] += bfhi(w.w); }
            const float inv = 1.0f / (float)(hi - lo); const u32x4 w = *(const u32x4*)(h + (size_t)m * D + ch);
            u32x4 o; o.x = cvt_pk_bf16(acc[0] * inv - bflo(w.x), acc[1] * inv - bfhi(w.x)); o.y = cvt_pk_bf16(acc[2] * inv - bflo(w.y), acc[3] * inv - bfhi(w.y));
            o.z = cvt_pk_bf16(acc[4] * inv - bflo(w.z), acc[5] * inv - bfhi(w.z)); o.w = cvt_pk_bf16(acc[6] * inv - bflo(w.w), acc[7] * inv - bfhi(w.w));
            *(u32x4*)(dl + (size_t)m * D + ch) = o;
        } else {
            const int ms = m - MP, pos = ms & 2047, r = pos >> 6, cc = pos & 63, sb = ms - pos;
            if (pass == 0) {
                const int lo = max(r - hw, 0), hi = min(r + hw, 32);
                for (int rr = lo; rr < hi; ++rr) { const u32x4 w = *(const u32x4*)(h + (size_t)(MP + sb + rr * 64 + cc) * D + ch);
                    acc[0] += bflo(w.x); acc[1] += bfhi(w.x); acc[2] += bflo(w.y); acc[3] += bfhi(w.y); acc[4] += bflo(w.z); acc[5] += bfhi(w.z); acc[6] += bflo(w.w); acc[7] += bfhi(w.w); }
                const float inv = 1.0f / (float)(hi - lo);
                *(f32x4*)(t1 + (size_t)ms * D + ch) = (f32x4){acc[0] * inv, acc[1] * inv, acc[2] * inv, acc[3] * inv};
                *(f32x4*)(t1 + (size_t)ms * D + ch + 4) = (f32x4){acc[4] * inv, acc[5] * inv, acc[6] * inv, acc[7] * inv};
            } else {
                const int lo = max(cc - hw, 0), hi = min(cc + hw, 64);
                for (int c2 = lo; c2 < hi; ++c2) { const float* tp = t1 + (size_t)(sb + r * 64 + c2) * D + ch; const f32x4 a = *(const f32x4*)tp, b = *(const f32x4*)(tp + 4);
                    acc[0] += a[0]; acc[1] += a[1]; acc[2] += a[2]; acc[3] += a[3]; acc[4] += b[0]; acc[5] += b[1]; acc[6] += b[2]; acc[7] += b[3]; }
                const float inv = 1.0f / (float)(hi - lo); const u32x4 w = *(const u32x4*)(h + (size_t)m * D + ch);
                u32x4 o; o.x = cvt_pk_bf16(acc[0] * inv - bflo(w.x), acc[1] * inv - bfhi(w.x)); o.y = cvt_pk_bf16(acc[2] * inv - bflo(w.y), acc[3] * inv - bfhi(w.y));
                o.z = cvt_pk_bf16(acc[4] * inv - bflo(w.z), acc[5] * inv - bfhi(w.z)); o.w = cvt_pk_bf16(acc[6] * inv - bflo(w.w), acc[7] * inv - bfhi(w.w));
                *(u32x4*)(dl + (size_t)m * D + ch) = o;
            }
        }
    }
}

constexpr int SST = 388;
constexpr int SBUF = 16 * SST;
__device__ void scan_phase(CP p, LAS float* lf, const Tix tx) {
    const int tid = tx.tid, lane = tid & 63, wid = tid >> 6, grp = wid >> 2, q = wid & 3;
    const int l15 = lane & 15, quad = lane >> 4, rl = lane >> 3, cg8 = lane & 7, i0 = 16 * q + 2 * rl;
    const bf16_t* rb = (const bf16_t*)(p->ws + OFF_C); const bf16_t* kb = (const bf16_t*)(p->ws + OFF_D); const bf16_t* vb = (const bf16_t*)(p->ws + OFF_E);
    const bf16_t* lb = (const bf16_t*)(p->ws + OFF_S);
    const bf16_t* W = (const bf16_t*)(p->ws + OFF_W);
    bf16_t* yout = (bf16_t*)(p->ws + OFF_A);
    float* cbp = (float*)(p->ws + OFF_CBP);
    const int tch = grp == 0 ? 128 : 16, nsub = grp == 0 ? 1 : 4;
    for (int it = tx.bid; it < 256; it += tx.gd) {
        float S0[8], S1[8];
        bf16x8 W2f[2], A2f[2]; f32x4 cw0, ca0, ckk, cka, crk; f32x4 kn[4];
#pragma unroll
        for (int i = 0; i < 8; ++i) { S0[i] = 0.f; S1[i] = 0.f; }
        W2f[0] = W2f[1] = A2f[0] = A2f[1] = (bf16x8){0, 0, 0, 0, 0, 0, 0, 0};
        cw0 = ca0 = ckk = cka = crk = (f32x4){0.f, 0.f, 0.f, 0.f}; kn[0] = kn[1] = kn[2] = kn[3] = (f32x4){0.f, 0.f, 0.f, 0.f};
        for (int c = -1; c < 128; ++c) {
            const int cn = c + 1; const int subn = cn / tch, ccn = cn % tch; const bool actn = (cn < 128) && (subn < nsub);
            u32x2 pr = (u32x2){0u, 0u}, pk = pr, pv = pr; u32x4 pkf0 = (u32x4){0u, 0u, 0u, 0u}, pkf1 = pkf0; bf16x8 plw0 = (bf16x8){0, 0, 0, 0, 0, 0, 0, 0}, plw1 = plw0, pla0 = plw0, pla1 = plw0;
            int mn = 0, dn = 0, hhn = 0;
            if (actn) {
                const int pid = grp == 0 ? it : 4 * it + subn; dn = pid & 1; hhn = (pid >> 1) & 15; const int b = pid >> 5;
                const int T = grp == 0 ? 2048 : 256, mb = grp == 0 ? MP + b * 2048 : b * 256;
                const int pos = ccn * 16 + l15; mn = mb + (dn == 0 ? pos : T - 1 - pos);
                const int col4 = 64 * hhn + 16 * q + 4 * quad;
                pr = *(const u32x2*)(rb + (size_t)mn * D + col4); pk = *(const u32x2*)(kb + (size_t)mn * D + col4); pv = *(const u32x2*)(vb + (size_t)mn * D + col4);
                pkf0 = *(const u32x4*)(kb + (size_t)mn * D + 64 * hhn + 16 * quad); pkf1 = *(const u32x4*)(kb + (size_t)mn * D + 64 * hhn + 16 * quad + 8);
                plw0 = *(const bf16x8*)(lb + (size_t)mn * 384 + dn * 64 + 8 * quad); plw1 = *(const bf16x8*)(lb + (size_t)mn * 384 + dn * 64 + 32 + 8 * quad);
                pla0 = *(const bf16x8*)(lb + (size_t)mn * 384 + 128 + dn * 64 + 8 * quad); pla1 = *(const bf16x8*)(lb + (size_t)mn * 384 + 128 + dn * 64 + 32 + 8 * quad);
                if (ccn == 0) {
                    const bf16_t* w2r = W + W_W2L + ((size_t)dn * 1024 + 64 * hhn + 16 * q + l15) * 64 + 8 * quad;
                    const bf16_t* a2r = W + W_A2L + ((size_t)dn * 1024 + 64 * hhn + 16 * q + l15) * 64 + 8 * quad;
                    W2f[0] = *(const bf16x8*)w2r; W2f[1] = *(const bf16x8*)(w2r + 32); A2f[0] = *(const bf16x8*)a2r; A2f[1] = *(const bf16x8*)(a2r + 32);
                    cw0 = *(const f32x4*)(p->in[15] + dn * D + col4); ca0 = *(const f32x4*)(p->in[18] + dn * D + col4);
                    ckk = *(const f32x4*)(p->in[23] + col4); cka = *(const f32x4*)(p->in[24] + col4); crk = *(const f32x4*)(p->in[25] + col4);
#pragma unroll
                    for (int i = 0; i < 4; ++i) kn[i] = *(const f32x4*)(p->in[23] + 64 * hhn + 16 * quad + 4 * i);
                }
            }
            const int sub = c < 0 ? 0 : c / tch, cc = c < 0 ? 0 : c % tch; const bool act = (c >= 0) && (sub < nsub);
            if (act) {
                const int pid = grp == 0 ? it : 4 * it + sub; const int d = pid & 1, hh = (pid >> 1) & 15, b = pid >> 5;
                const int T = grp == 0 ? 2048 : 256, mb = grp == 0 ? MP + b * 2048 : b * 256;
                if (cc == 0) {
                    if (grp == 0) { const float* s0 = (d == 0 ? p->in[3] : p->in[4]) + ((size_t)(b * 16 + hh) * 64 + i0) * 64 + 8 * cg8;
                        const f32x4 a0 = *(const f32x4*)s0, a1 = *(const f32x4*)(s0 + 4), b0 = *(const f32x4*)(s0 + 64), b1 = *(const f32x4*)(s0 + 68);
#pragma unroll
                        for (int i = 0; i < 4; ++i) { S0[i] = a0[i]; S0[4 + i] = a1[i]; S1[i] = b0[i]; S1[4 + i] = b1[i]; } }
                    else {
#pragma unroll
                        for (int i = 0; i < 8; ++i) { S0[i] = 0.f; S1[i] = 0.f; } }
                }
                const LAS float* bp0 = lf + (grp * 2 + (c & 1)) * SBUF;
                bf16_t* yo = yout + (size_t)d * MT * D + 64 * hh + i0;
#pragma unroll 4
                for (int s = 0; s < 16; ++s) {
                    const LAS float* bp = bp0 + s * SST + 8 * cg8;
                    const f32x4 kk0 = *(const LAS f32x4*)(bp), kk1 = *(const LAS f32x4*)(bp + 4);
                    const f32x4 w0 = *(const LAS f32x4*)(bp + 64), w1 = *(const LAS f32x4*)(bp + 68);
                    const f32x4 b0 = *(const LAS f32x4*)(bp + 128), b1 = *(const LAS f32x4*)(bp + 132);
                    const f32x4 d0 = *(const LAS f32x4*)(bp + 192), d1 = *(const LAS f32x4*)(bp + 196);
                    const f32x4 r0 = *(const LAS f32x4*)(bp + 256), r1 = *(const LAS f32x4*)(bp + 260);
                    const f32x2 vv = *(const LAS f32x2*)(bp0 + s * SST + 320 + i0);
                    float kkv[8] = {kk0[0], kk0[1], kk0[2], kk0[3], kk1[0], kk1[1], kk1[2], kk1[3]};
                    float wv[8] = {w0[0], w0[1], w0[2], w0[3], w1[0], w1[1], w1[2], w1[3]};
                    float bv[8] = {b0[0], b0[1], b0[2], b0[3], b1[0], b1[1], b1[2], b1[3]};
                    float dv[8] = {d0[0], d0[1], d0[2], d0[3], d1[0], d1[1], d1[2], d1[3]};
                    float rv[8] = {r0[0], r0[1], r0[2], r0[3], r1[0], r1[1], r1[2], r1[3]};
                    float sa0 = 0.f, sa1 = 0.f;
#pragma unroll
                    for (int i = 0; i < 8; ++i) { sa0 += S0[i] * kkv[i]; sa1 += S1[i] * kkv[i]; }
                    sa0 = -reduce8(sa0); sa1 = -reduce8(sa1);
                    float y0 = 0.f, y1 = 0.f;
#pragma unroll
                    for (int i = 0; i < 8; ++i) {
                        S0[i] = S0[i] * wv[i] + sa0 * bv[i] + vv.x * dv[i];
                        S1[i] = S1[i] * wv[i] + sa1 * bv[i] + vv.y * dv[i];
                        y0 += S0[i] * rv[i]; y1 += S1[i] * rv[i]; }
                    y0 = reduce8(y0); y1 = reduce8(y1);
                    const int pos = cc * 16 + s; const int m = mb + (d == 0 ? pos : T - 1 - pos);
                    if (cg8 == 0) *(unsigned*)(yo + (size_t)m * D) = cvt_pk_bf16(y0, y1);
                }
                if (grp == 1 && cc == tch - 1) {
                    float* sf = p->out + (size_t)MT * D + (size_t)d * (32 * 16 * 4096) + ((size_t)(b * 16 + hh) * 64 + i0) * 64 + 8 * cg8;
                    *(f32x4*)sf = (f32x4){S0[0], S0[1], S0[2], S0[3]}; *(f32x4*)(sf + 4) = (f32x4){S0[4], S0[5], S0[6], S0[7]};
                    *(f32x4*)(sf + 64) = (f32x4){S1[0], S1[1], S1[2], S1[3]}; *(f32x4*)(sf + 68) = (f32x4){S1[4], S1[5], S1[6], S1[7]};
                }
            }
            if (actn) {
                f32x4 aw = (f32x4){0.f, 0.f, 0.f, 0.f}, aa = aw;
                aw = __builtin_amdgcn_mfma_f32_16x16x32_bf16(W2f[0], plw0, aw, 0, 0, 0); aw = __builtin_amdgcn_mfma_f32_16x16x32_bf16(W2f[1], plw1, aw, 0, 0, 0);
                aa = __builtin_amdgcn_mfma_f32_16x16x32_bf16(A2f[0], pla0, aa, 0, 0, 0); aa = __builtin_amdgcn_mfma_f32_16x16x32_bf16(A2f[1], pla1, aa, 0, 0, 0);
                float ssq = 0.f;
                { const unsigned kw[8] = {pkf0.x, pkf0.y, pkf0.z, pkf0.w, pkf1.x, pkf1.y, pkf1.z, pkf1.w};
#pragma unroll
                  for (int i = 0; i < 8; ++i) { const float a = bflo(kw[i]) * kn[i >> 1][(i & 1) * 2], b2 = bfhi(kw[i]) * kn[i >> 1][(i & 1) * 2 + 1]; ssq += a * a + b2 * b2; } }
                ssq += __shfl_xor(ssq, 16); ssq += __shfl_xor(ssq, 32);
                const float rn = 1.0f / fmaxf(sqrtf(ssq), 1e-12f);
                const f32x4 r4 = (f32x4){bflo(pr.x), bfhi(pr.x), bflo(pr.y), bfhi(pr.y)}, k4 = (f32x4){bflo(pk.x), bfhi(pk.x), bflo(pk.y), bfhi(pk.y)}, v4 = (f32x4){bflo(pv.x), bfhi(pv.x), bflo(pv.y), bfhi(pv.y)};
                f32x4 w4, a4, kk4, b4, kd4; float cbs = 0.f;
#pragma unroll
                for (int j = 0; j < 4; ++j) {
                    const float e = 0.60653066f * fast_sigmoid(cw0[j] + aw[j]); w4[j] = __expf(-e);
                    a4[j] = fast_sigmoid(ca0[j] + aa[j]);
                    kk4[j] = k4[j] * ckk[j] * rn; b4[j] = kk4[j] * a4[j]; kd4[j] = k4[j] * (1.0f + (a4[j] - 1.0f) * cka[j]);
                    cbs += r4[j] * kd4[j] * crk[j]; }
                LAS float* wp = lf + (grp * 2 + (cn & 1)) * SBUF + l15 * SST + 16 * q + 4 * quad;
                *(LAS f32x4*)(wp) = kk4; *(LAS f32x4*)(wp + 64) = w4; *(LAS f32x4*)(wp + 128) = b4; *(LAS f32x4*)(wp + 192) = kd4; *(LAS f32x4*)(wp + 256) = r4; *(LAS f32x4*)(wp + 320) = v4;
                cbs += __shfl_xor(cbs, 16); cbs += __shfl_xor(cbs, 32);
                if (quad == 0) cbp[(((size_t)dn * MT + mn) * 16 + hhn) * 4 + q] = cbs;
            }
            __syncthreads();
        }
    }
}

constexpr int NPHASE = 24;
#ifndef ONLYMASK
#define ONLYMASK 0x1ff
#endif
#define EN(k) ((ONLYMASK >> (k)) & 1)
constexpr int LDS_BYTES = 131072;
__global__ void __launch_bounds__(512, 2) mega(Params kp) {
    extern __shared__ __attribute__((aligned(16))) unsigned char shm[];
    PG8_LAS unsigned char* lds = (PG8_LAS unsigned char*)shm;
    LAS float* lf = (LAS float*)shm;
    cg::grid_group grid = cg::this_grid();
    const int pb = kp.pb, pe = kp.pe;
#pragma unroll 1
    for (int ph = pb; ph < pe; ++ph) {
        CP p = (CP)__builtin_amdgcn_kernarg_segment_ptr();
        asm volatile("" : "+s"(p));
        Tix tx; { int t_ = threadIdx.x, b_ = blockIdx.x, g_ = gridDim.x; asm volatile("" : "+v"(t_)); asm volatile("" : "+s"(b_), "+s"(g_)); tx.tid = t_; tx.bid = b_; tx.gd = g_; }
        bf16_t* rA = (bf16_t*)(p->ws + OFF_A); bf16_t* rB = (bf16_t*)(p->ws + OFF_B); bf16_t* rC = (bf16_t*)(p->ws + OFF_C); bf16_t* rD = (bf16_t*)(p->ws + OFF_D); bf16_t* rE = (bf16_t*)(p->ws + OFF_E);
        bf16_t* rS = (bf16_t*)(p->ws + OFF_S); bf16_t* W = (bf16_t*)(p->ws + OFF_W);
        const float* npre = p->in[8]; const float* npost = p->in[9];
        int kind = 0;
        RowCfg rc{}; int conv = -1;
        const bf16_t* gA = nullptr; const bf16_t* gB = nullptr; bf16_t* gO = nullptr; int gN = 0, gK = 0, pool_pass_id = 0;
        switch (ph) {
            case 0: kind = 0; break;
            case 1: kind = 1; rc = RowCfg{1, 0, 0, 0, 0.f, npost, 1, 0, 0, 1, npre + 0 * D, 0}; break;
            case 2: case 11: case 14: case 21: kind = 2; break;
            case 3: case 12: case 15: case 22: kind = 3; gA = rB; gB = W + W_W2T; gO = rE; gN = 1024; gK = 2816; break;
            case 4: kind = 4; rc = RowCfg{1, 1, 0, 2, 0.5f, npost + 0 * D, 1, 0, 3, 4, npre + 1 * D, 1}; conv = 4; break;
            case 5: kind = 5; break;
            case 6: kind = 6; break;
            case 7: kind = 3; gA = rS; gB = W + W_BTG; gO = rC; gN = 1024; gK = 384; break;
            case 8: kind = 7; break;
            case 9: kind = 3; gA = rD; gB = W + W_WOT; gO = rE; gN = 1024; gK = 1024; break;
            case 10: kind = 1; rc = RowCfg{0, 1, 0, 5, 1.0f, npost + 1 * D, 1, 0, 6, 7, npre + 2 * D, 1}; conv = 1; break;
            case 13: kind = 1; rc = RowCfg{0, 1, 0, 8, 0.5f, npost + 2 * D, 1, 1, 0, 1, npre + 3 * D, 1}; conv = 2; break;
            case 16: kind = 1; rc = RowCfg{0, 1, 1, 2, 0.5f, npost + 3 * D, 1, 1, 3, 4, npre + 4 * D, 1}; conv = 5; break;
            case 17: kind = 8; pool_pass_id = 0; break;
            case 18: kind = 8; pool_pass_id = 1; break;
            case 19: kind = 3; gA = rD; gB = W; gO = rE; gN = 1024; gK = 1024; break;
            case 20: kind = 1; rc = RowCfg{0, 1, 1, 5, 1.0f, npost + 4 * D, 1, 1, 6, 7, npre + 5 * D, 1}; conv = 3; break;
            case 23: kind = 1; rc = RowCfg{0, 1, 1, 8, 0.5f, npost + 5 * D, 0, 0, 0, 0, npre, 1}; break;
            default: break;
        }
        if (EN(0) && kind == 0) { mod_phase(p, lf, tx); __syncthreads(); conv_ffn(p, 0, lf + 16384, tx); }
        else if (EN(1) && kind == 1) { rowpass_simple(p, rc, tx); if (conv >= 0 && conv < 4) conv_ffn(p, conv, lf, tx); else if (conv == 5) conv_pool(p, tx); }
        else if (EN(4) && kind == 4) { rowpass_shift(p, rc, tx); conv_rwkv(p, lf, tx); }
        else if (EN(2) && (kind == 2 || kind == 3 || kind == 5)) {
            if (kind == 2) { gA = rA; gB = W + W_W13; gO = rB; gN = 5632; gK = 1024; } else if (kind == 5) { gA = rA; gB = W + W_BTP; gO = rC; gN = 3584; gK = 2048; }
            pg8::Gemm g{gA, gB, MT, gN, gK}; pg8::StaticOrder S; S.init(MT, gN, tx.gd, tx.bid); pg8::EpiAll E{kind == 3 ? 0 : (kind == 2 ? 1 : 2), gO, kind == 2 ? DFF : 1024, rS};
            pg8::gemm_phase<pg8::EpiAll, pg8::StaticOrder, false>(lds, g, S, E, nullptr, tx.tid); }
        else if (EN(6) && kind == 6) scan_phase(p, lf, tx);
        else if (EN(7) && kind == 7) rowpass_gn(p, tx);
        else if (EN(8) && kind == 8) pool_pass(p, pool_pass_id, tx);
        if (ph + 1 < pe) grid.sync();
    }
}

#include <cstdio>
#ifndef USE_COOP
#define USE_COOP 1
#endif
extern "C" void kernel_launch(void* const* d_in, const int* in_sizes, int n_in, void* d_out, int out_size, void* d_ws, size_t ws_size, hipStream_t stream) {
    static int grid = 0;
    if (grid == 0) {
        if (n_in != NIN || ws_size < WS_NEED) { fprintf(stderr, "kernel_launch: n_in %d ws %zu (need %zu)\n", n_in, ws_size, (size_t)WS_NEED); grid = -1; return; }
        int dev = 0, cus = 0, per_cu = 0;
        hipGetDevice(&dev); hipDeviceGetAttribute(&cus, hipDeviceAttributeMultiprocessorCount, dev);
        if (hipFuncSetAttribute((const void*)mega, hipFuncAttributeMaxDynamicSharedMemorySize, LDS_BYTES) != hipSuccess) { fprintf(stderr, "kernel_launch: hipFuncSetAttribute failed\n"); grid = -1; return; }
        if (hipOccupancyMaxActiveBlocksPerMultiprocessor(&per_cu, (const void*)mega, 512, LDS_BYTES) != hipSuccess || per_cu < 1) { fprintf(stderr, "kernel_launch: occupancy query says %d\n", per_cu); per_cu = 1; }
        (void)hipGetLastError();
        grid = cus * 1;
        if (grid <= 0) grid = 256;
    }
    if (grid < 0) return;
    Params p{};
    for (int i = 0; i < NIN; ++i) p.in[i] = (const float*)d_in[i];
    p.out = (float*)d_out; p.ws = (unsigned char*)d_ws;
#if USE_COOP
    p.pb = 0; p.pe = NPHASE;
    void* args[] = {&p};
    hipError_t e = hipLaunchCooperativeKernel((const void*)mega, dim3(grid), dim3(512), args, LDS_BYTES, stream);
    if (e != hipSuccess) fprintf(stderr, "cooperative launch failed: %s (grid %d)\n", hipGetErrorString(e), grid);
#else
    for (int ph = 0; ph < NPHASE; ++ph) { p.pb = ph; p.pe = ph + 1; hipLaunchKernelGGL(mega, dim3(grid), dim3(512), LDS_BYTES, stream, p); }
#endif
}
```

```cpp
#include <hip/hip_runtime.h>
#include <hip/hip_cooperative_groups.h>
namespace pg8 {
#define PG8_LAS __attribute__((address_space(3)))
typedef unsigned short bf16_t;
typedef short bf16x8 __attribute__((ext_vector_type(8)));
typedef float f32x4 __attribute__((ext_vector_type(4)));
typedef unsigned u32x4 __attribute__((ext_vector_type(4)));
constexpr int BM = 256, BK = 64, HALF = 128, HTB = HALF * BK * 2  , STAGE_BYTES = 8 * HTB, NXCD = 8, WGM = 8;

__host__ __device__ __forceinline__ int lds_byte(int r, int c) { const int st = (r >> 4) * 2 + (c >> 5), rr = r & 15, cc = c & 31, ob = rr * 64 + cc * 2; return st * 1024 + (ob ^ (((ob >> 9) & 1) << 5)); }
__host__ __device__ __forceinline__ void stage_rc(int b, int& R, int& C) { const int st = b / 1024, sb = b % 1024, swz = sb ^ (((sb >> 9) & 1) << 5); R = (st >> 1) * 16 + swz / 64; C = (st & 1) * 32 + (swz % 64) / 2; }
__host__ __device__ __forceinline__ int perm32(int rho) { const int n = rho >> 4, i = rho & 15; return 8 * (i >> 2) + 4 * n + (i & 3); }

struct Unit { int pm, pn, part; };
struct Gemm { const bf16_t* A; const bf16_t* Bt; int M, N, K; };

struct StaticOrder {
    int nM, nN, nwg, G, c;
    __host__ __device__ void init(int M, int N, int G_, int c_) { nM = M / BM; nN = N / BM; nwg = nM * nN; G = G_; c = c_; }
    __host__ __device__ bool next(int i, Unit& u) const {
        const long L = (long)i * G + c; if (L >= nwg) return false;
        int wgid = (int)L; { const int q = nwg / NXCD, r = nwg % NXCD, xcd = wgid % NXCD, off = wgid / NXCD; wgid = (xcd < r ? xcd * (q + 1) : r * (q + 1) + (xcd - r) * q) + off; }
        const int nig = WGM * nN, gid = wgid / nig, fm = gid * WGM, gsz = (nM - fm) < WGM ? (nM - fm) : WGM;
        u.pm = fm + ((wgid % nig) % gsz); u.pn = (wgid % nig) / gsz; u.part = 0; return true;
    }
    __device__ __forceinline__ void a_ready(const Unit&) const {}
    __device__ __forceinline__ void done(const Unit&) const {}
};
struct FwdOrder {
    StaticOrder so; int mode;
    __host__ __device__ void init(int M, int N, int K, int G_, int c_, int mode_) { so.init(M, N, G_, c_); mode = mode_; }
    __host__ __device__ bool next(int i, Unit& u) const {
        if (mode == 0) return so.next(i, u);
        if (i >= 2) return false;
        const int w = (so.c & 7) * 32 + (so.c >> 3);
        if (i == 0) { u.pm = w >> 2; u.pn = w & 3; u.part = 0; }
        else { u.pm = 64 + (w >> 3); u.pn = (w >> 1) & 3; u.part = 1 + (w & 1); }
        return true;
    }
    __device__ __forceinline__ void a_ready(const Unit&) const {}
    __device__ __forceinline__ void done(const Unit&) const {}
};
__device__ __forceinline__ unsigned cvt_pk_bf16(float lo, float hi) { unsigned r; asm volatile("v_cvt_pk_bf16_f32 %0, %1, %2" : "=v"(r) : "v"(lo), "v"(hi)); return r; }
typedef float f32x2 __attribute__((ext_vector_type(2)));
__device__ __forceinline__ float fast_sigmoid(float x) { return __builtin_amdgcn_rcpf(1.0f + __expf(-x)); }
__device__ __forceinline__ float fast_tanh(float x) { return 1.0f - 2.0f * __builtin_amdgcn_rcpf(1.0f + __expf(2.0f * x)); }
struct EpiStore {
    static constexpr bool PERM = true, AFTER_DRAIN = false;
    bf16_t* O; int ldc;
    __device__ __forceinline__ void operator()(const f32x4 (&acc)[2][2][4][2], const Unit& u, int wr, int wc, int fr, int fq) const {
        const int row0 = u.pm * BM + wr * 64 + fr, col0 = u.pn * BM + wc * 32 + 8 * fq;
#pragma unroll
        for (int ai = 0; ai < 2; ++ai)
#pragma unroll
            for (int m = 0; m < 4; ++m) { bf16_t* rowp = O + (size_t)(row0 + ai * HALF + m * 16) * ldc + col0;
#pragma unroll
                for (int bj = 0; bj < 2; ++bj) { const f32x4 v0 = acc[ai][bj][m][0], v1 = acc[ai][bj][m][1];
                    u32x4 w; w.x = cvt_pk_bf16(v0[0], v0[1]); w.y = cvt_pk_bf16(v0[2], v0[3]); w.z = cvt_pk_bf16(v1[0], v1[1]); w.w = cvt_pk_bf16(v1[2], v1[3]);
                    *(u32x4*)(rowp + bj * HALF) = w; } }
    }
};
struct EpiSwiglu {
    static constexpr bool PERM = true, AFTER_DRAIN = false;
    bf16_t* O; int ldc;
    __device__ __forceinline__ void operator()(const f32x4 (&acc)[2][2][4][2], const Unit& u, int wr, int wc, int fr, int fq) const {
        const int row0 = u.pm * BM + wr * 64 + fr, col0 = u.pn * HALF + wc * 32 + 8 * fq;
#pragma unroll
        for (int ai = 0; ai < 2; ++ai)
#pragma unroll
            for (int m = 0; m < 4; ++m) { bf16_t* rowp = O + (size_t)(row0 + ai * HALF + m * 16) * ldc + col0;
                float o[8];
#pragma unroll
                for (int n = 0; n < 2; ++n)
#pragma unroll
                    for (int j = 0; j < 4; ++j) { const float a = acc[ai][0][m][n][j], b = acc[ai][1][m][n][j]; o[n * 4 + j] = a * fast_sigmoid(a) * b; }
                u32x4 w; w.x = cvt_pk_bf16(o[0], o[1]); w.y = cvt_pk_bf16(o[2], o[3]); w.z = cvt_pk_bf16(o[4], o[5]); w.w = cvt_pk_bf16(o[6], o[7]);
                *(u32x4*)rowp = w; }
    }
};
struct EpiRkv {
    static constexpr bool PERM = true, AFTER_DRAIN = false;
    bf16_t* O; size_t tstride; bf16_t* L;
    __device__ __forceinline__ void operator()(const f32x4 (&acc)[2][2][4][2], const Unit& u, int wr, int wc, int fr, int fq) const {
        const int row0 = u.pm * BM + wr * 64 + fr;
        if (u.pn < 12) {
            bf16_t* base = O + (size_t)(u.pn >> 2) * tstride; const int col0 = (u.pn & 3) * BM + wc * 32 + 8 * fq;
#pragma unroll
            for (int ai = 0; ai < 2; ++ai)
#pragma unroll
                for (int m = 0; m < 4; ++m) { bf16_t* rowp = base + (size_t)(row0 + ai * HALF + m * 16) * 1024 + col0;
#pragma unroll
                    for (int bj = 0; bj < 2; ++bj) { const f32x4 v0 = acc[ai][bj][m][0], v1 = acc[ai][bj][m][1];
                        u32x4 w; w.x = cvt_pk_bf16(v0[0], v0[1]); w.y = cvt_pk_bf16(v0[2], v0[3]); w.z = cvt_pk_bf16(v1[0], v1[1]); w.w = cvt_pk_bf16(v1[2], v1[3]);
                        *(u32x4*)(rowp + bj * HALF) = w; } }
        } else {
            const int t13 = (u.pn == 13); const int col0 = (u.pn - 12) * BM + wc * 32 + 8 * fq;
#pragma unroll
            for (int ai = 0; ai < 2; ++ai)
#pragma unroll
                for (int m = 0; m < 4; ++m) { bf16_t* rowp = L + (size_t)(row0 + ai * HALF + m * 16) * 384 + col0;
#pragma unroll
                    for (int bj = 0; bj < 2; ++bj) { if (t13 && bj == 1) continue;
                        float o[8];
#pragma unroll
                        for (int n = 0; n < 2; ++n)
#pragma unroll
                            for (int j = 0; j < 4; ++j) { const float a = acc[ai][bj][m][n][j]; o[n * 4 + j] = t13 ? fast_sigmoid(a) : (bj == 0 ? fast_tanh(a) : a); }
                        u32x4 w; w.x = cvt_pk_bf16(o[0], o[1]); w.y = cvt_pk_bf16(o[2], o[3]); w.z = cvt_pk_bf16(o[4], o[5]); w.w = cvt_pk_bf16(o[6], o[7]);
                        *(u32x4*)(rowp + bj * HALF) = w; } }
        }
    }
};

struct EpiAll {
    static constexpr bool PERM = true, AFTER_DRAIN = false;
    int kind; bf16_t* O; int ldc; bf16_t* L; bf16_t* O2;
    __device__ __forceinline__ void operator()(const f32x4 (&acc)[2][2][4][2], const Unit& u, int wr, int wc, int fr, int fq) const {
        if (kind == 0) { EpiStore e{u.part == 2 ? O2 : O, ldc}; e(acc, u, wr, wc, fr, fq); }
        else if (kind == 1) { EpiSwiglu e{O, ldc}; e(acc, u, wr, wc, fr, fq); }
        else if (kind == 2) { EpiRkv e{O, (size_t)24576 * 1024, L}; e(acc, u, wr, wc, fr, fq); }
    }
};
template <class Epi, class Sched, bool STAMP = false>
__device__ __forceinline__ void gemm_phase(PG8_LAS unsigned char* lds, const Gemm g, const Sched& S, const Epi& E, unsigned long long* stamps, const int tid_in) {
    const int tid = tid_in, wid = __builtin_amdgcn_readfirstlane(tid >> 6), lane = tid & 63, wr = wid >> 2, wc = wid & 3, fr = lane & 15, fq = lane >> 4;
    const int K = g.K; int nt = K / BK;
    int ts_lo = 0, ts_hi = 0, nts = 0; const unsigned long long rt_entry = STAMP ? (unsigned long long)wall_clock64() : 0ull;
#define PG8_STAMP() do { if (STAMP && wid == 0 && nts < 64) { const unsigned long long _c = (unsigned long long)clock64(); \
        ts_lo = (lane == nts) ? (int)(unsigned)_c : ts_lo; ts_hi = (lane == nts) ? (int)(unsigned)(_c >> 32) : ts_hi; ++nts; } } while (0)
    PG8_STAMP();
    unsigned voffA[2], voffB[2];
#pragma unroll
    for (int i = 0; i < 2; ++i) { int R, C; stage_rc(tid * 16 + i * 8192, R, C); const int Rb = Epi::PERM ? ((R & ~31) + perm32(R & 31)) : R;
        voffA[i] = (unsigned)(R * K + C) * 2u; voffB[i] = (unsigned)(Rb * K + C) * 2u; }
    const size_t kstep = (size_t)(BK * 2);
    const size_t hstep = (size_t)HALF * K * 2;
    const size_t tstep = 2 * hstep;
    const unsigned ldsw = (unsigned)wid * 1024u;
    const int aoff = lds_byte(wr * 64 + fr, fq * 8), boff = lds_byte(wc * 32 + fr, fq * 8);
#define PG8_SA(b, h) (((b) * 2 + (h)) * HTB)
#define PG8_SB(b, h) ((4 + (b) * 2 + (h)) * HTB)
#define PG8_STAGE(bufoff, gbase, voff) do { _Pragma("unroll") for (int _i = 0; _i < 2; ++_i) \
        __builtin_amdgcn_global_load_lds((const unsigned*)((const char*)(gbase) + (voff)[_i]), (PG8_LAS unsigned*)(lds + (bufoff) + ldsw + _i * 8192), 16, 0, 0); } while (0)
#define PG8_LDA(dst, b, h) do { _Pragma("unroll") for (int m = 0; m < 4; ++m) _Pragma("unroll") for (int k = 0; k < 2; ++k) dst[m][k] = *(const PG8_LAS bf16x8*)(lds + PG8_SA(b, h) + aoff + m * 2048 + k * 1024); } while (0)
#define PG8_LDB(dst, b, h) do { _Pragma("unroll") for (int n = 0; n < 2; ++n) _Pragma("unroll") for (int k = 0; k < 2; ++k) dst[n][k] = *(const PG8_LAS bf16x8*)(lds + PG8_SB(b, h) + boff + n * 2048 + k * 1024); } while (0)
#define PG8_MMA(ai, bj, At, Bt) do { __builtin_amdgcn_s_setprio(1); _Pragma("unroll") for (int m = 0; m < 4; ++m) _Pragma("unroll") for (int n = 0; n < 2; ++n) _Pragma("unroll") for (int k = 0; k < 2; ++k) \
        acc[ai][bj][m][n] = __builtin_amdgcn_mfma_f32_16x16x32_bf16(Bt[n][k], At[m][k], acc[ai][bj][m][n], 0, 0, 0); __builtin_amdgcn_s_setprio(0); } while (0)
#define PG8_WAIT_V(n) asm volatile("s_waitcnt vmcnt(" #n ")" ::: "memory")
#define PG8_WAIT_L(n) asm volatile("s_waitcnt lgkmcnt(" #n ")" ::: "memory")
#define PG8_BAR __builtin_amdgcn_s_barrier()
#define PG8_SCHED __builtin_amdgcn_sched_barrier(0)
    Unit cur, nxt; int ui = 0;
    if (!S.next(0, cur)) return;
    f32x4 acc[2][2][4][2];
#pragma unroll
    for (int a = 0; a < 2; ++a)
#pragma unroll
        for (int b = 0; b < 2; ++b)
#pragma unroll
            for (int m = 0; m < 4; ++m)
#pragma unroll
                for (int n = 0; n < 2; ++n) acc[a][b][m][n] = (f32x4){0.f, 0.f, 0.f, 0.f};
    bf16x8 At[4][2], B0[2][2], B1[2][2];
    const char* cA = (const char*)g.A + (size_t)cur.pm * tstep + (cur.part == 2 ? (size_t)K : (size_t)0); const char* cB = (const char*)g.Bt + (size_t)cur.pn * tstep + (cur.part == 2 ? (size_t)K : (size_t)0);
    nt = cur.part ? K / (2 * BK) : K / BK;
    S.a_ready(cur);
    PG8_STAGE(PG8_SB(0, 0), cB, voffB); PG8_STAGE(PG8_SA(0, 0), cA, voffA); PG8_STAGE(PG8_SB(0, 1), cB + hstep, voffB); PG8_STAGE(PG8_SA(0, 1), cA + hstep, voffA);
    if (wr == 1) PG8_BAR;
    PG8_WAIT_V(4); PG8_BAR;
    PG8_STAGE(PG8_SB(1, 0), cB + kstep, voffB); PG8_STAGE(PG8_SA(1, 0), cA + kstep, voffA); PG8_STAGE(PG8_SB(1, 1), cB + hstep + kstep, voffB);
    PG8_WAIT_V(6); PG8_BAR;
    PG8_STAMP();
    for (;;) {
        const bool has_next = S.next(ui + 1, nxt);
        const char* nA = has_next ? (const char*)g.A + (size_t)nxt.pm * tstep + (nxt.part == 2 ? (size_t)K : (size_t)0) : cA; const char* nB = has_next ? (const char*)g.Bt + (size_t)nxt.pn * tstep + (nxt.part == 2 ? (size_t)K : (size_t)0) : cB;
        for (int t = 0; t < nt; t += 2) {
            const bool last = (t == nt - 2);
            const char* a1 = cA + (size_t)(t + 1) * kstep;
            const char* a2 = last ? nA : cA + (size_t)(t + 2) * kstep; const char* b2 = last ? nB : cB + (size_t)(t + 2) * kstep;
            const char* a3 = a2 + kstep; const char* b3 = b2 + kstep;
            if (last && has_next) S.a_ready(nxt);
            PG8_LDB(B0, 0, 0); PG8_SCHED; PG8_LDA(At, 0, 0); PG8_STAGE(PG8_SA(1, 1), a1 + hstep, voffA);
            PG8_WAIT_L(8); PG8_BAR; PG8_WAIT_L(0); PG8_MMA(0, 0, At, B0); PG8_BAR; PG8_SCHED;
            PG8_LDB(B1, 0, 1); PG8_STAGE(PG8_SB(0, 0), b2, voffB);
            PG8_BAR; PG8_WAIT_L(0); PG8_MMA(0, 1, At, B1); PG8_BAR;
            PG8_LDA(At, 0, 1); PG8_STAGE(PG8_SA(0, 0), a2, voffA);
            PG8_BAR; PG8_WAIT_L(0); PG8_MMA(1, 0, At, B0); PG8_BAR; PG8_SCHED;
            PG8_STAGE(PG8_SB(0, 1), b2 + hstep, voffB);
            PG8_WAIT_V(6); PG8_BAR; PG8_MMA(1, 1, At, B1); PG8_BAR;
            PG8_LDB(B0, 1, 0); PG8_SCHED; PG8_LDA(At, 1, 0); PG8_STAGE(PG8_SA(0, 1), a2 + hstep, voffA);
            PG8_WAIT_L(8); PG8_BAR; PG8_WAIT_L(0); PG8_MMA(0, 0, At, B0); PG8_BAR; PG8_SCHED;
            PG8_LDB(B1, 1, 1); PG8_STAGE(PG8_SB(1, 0), b3, voffB);
            PG8_BAR; PG8_WAIT_L(0); PG8_MMA(0, 1, At, B1); PG8_BAR;
            PG8_LDA(At, 1, 1); PG8_STAGE(PG8_SA(1, 0), a3, voffA);
            PG8_BAR; PG8_WAIT_L(0); PG8_MMA(1, 0, At, B0); PG8_BAR; PG8_SCHED;
            PG8_STAGE(PG8_SB(1, 1), b3 + hstep, voffB);
            PG8_WAIT_V(6); PG8_BAR; PG8_MMA(1, 1, At, B1); PG8_BAR;
        }
        PG8_STAMP();
        if constexpr (!Epi::AFTER_DRAIN) { E(acc, cur, wr, wc, fr, fq); S.done(cur); }
        PG8_STAMP();
        if (!has_next) break;
#pragma unroll
        for (int a = 0; a < 2; ++a)
#pragma unroll
            for (int b = 0; b < 2; ++b)
#pragma unroll
                for (int m = 0; m < 4; ++m)
#pragma unroll
                    for (int n = 0; n < 2; ++n) acc[a][b][m][n] = (f32x4){0.f, 0.f, 0.f, 0.f};
        cur = nxt; cA = nA; cB = nB; ++ui; nt = cur.part ? K / (2 * BK) : K / BK;
    }
    PG8_WAIT_V(0);
    if (wr == 0) PG8_BAR;
    PG8_BAR;
    if constexpr (Epi::AFTER_DRAIN) { E.fused(acc, cur, wr, wc, fr, fq, lds, wid, lane); S.done(cur); }
    PG8_STAMP();
    if (STAMP && wid == 0) { stamps[lane] = lane < nts ? (((unsigned long long)(unsigned)ts_hi << 32) | (unsigned)ts_lo) : 0ull;
        if (lane == 62) stamps[62] = rt_entry; if (lane == 63) stamps[63] = (unsigned long long)wall_clock64(); }
#undef PG8_STAMP
#undef PG8_SA
#undef PG8_SB
#undef PG8_STAGE
#undef PG8_LDA
#undef PG8_LDB
#undef PG8_MMA
#undef PG8_WAIT_V
#undef PG8_WAIT_L
#undef PG8_BAR
#undef PG8_SCHED
}
}

namespace cg = cooperative_groups;
using pg8::bf16_t; using pg8::bf16x8; using pg8::f32x4; using pg8::u32x4; using pg8::cvt_pk_bf16; using pg8::fast_sigmoid;
#define LAS __attribute__((address_space(3)))
typedef float f32x2 __attribute__((ext_vector_type(2)));
typedef unsigned u32x2 __attribute__((ext_vector_type(2)));

constexpr int D = 1024, DFF = 2816, MP = 8192, MS = 16384, MT = 24576;
constexpr int NIN = 31;
constexpr size_t R48 = (size_t)MT * 1024 * 2;
constexpr size_t OFF_A = 0, OFF_B = R48, OFF_C = 2 * R48, OFF_D = 3 * R48, OFF_E = 4 * R48;
constexpr size_t OFF_S = 5 * R48;
constexpr size_t OFF_W = OFF_S + (size_t)MT * 384 * 2;
constexpr size_t W_ELEMS = 9043968;
constexpr size_t OFF_MOD = OFF_W + W_ELEMS * 2;
constexpr size_t OFF_CBP = OFF_MOD + (size_t)9 * 2 * 9216 * 4;
constexpr size_t OFF_BAR = OFF_CBP + (size_t)2 * MT * 64 * 4;
constexpr size_t OFF_W2 = OFF_BAR + 16384;
constexpr size_t OFF_FB = OFF_W2 + W_ELEMS * 2;
constexpr size_t WS_NEED = OFF_FB + (size_t)8192 * 1024 * 2;
constexpr size_t W_W13 = 0, W_W2T = (size_t)5632 * 1024;
constexpr size_t W_BTP = 0, W_BTG = (size_t)3584 * 2048, W_WOT = W_BTG + (size_t)1024 * 384, W_W2L = W_WOT + (size_t)1024 * 1024, W_A2L = W_W2L + 131072;
constexpr float RMS_EPS = 1e-6f, GN_EPS = 64e-5f;

struct Tix { int tid, bid, gd; };
struct Params { const float* in[NIN]; float* out; unsigned char* ws; int pb, pe; };
typedef const Params __attribute__((address_space(4)))* CP;

__device__ __forceinline__ float bf2f(unsigned short b) { return __uint_as_float(((unsigned)b) << 16); }
__device__ __forceinline__ float bflo(unsigned w) { return __uint_as_float(w << 16); }
__device__ __forceinline__ float bfhi(unsigned w) { return __uint_as_float(w & 0xffff0000u); }
template <int CTRL> __device__ __forceinline__ float dpp_f(float x) { return __builtin_bit_cast(float, __builtin_amdgcn_mov_dpp(__builtin_bit_cast(int, x), CTRL, 0xf, 0xf, true)); }
__device__ __forceinline__ float row16_sum(float v) { v += dpp_f<0xB1>(v); v += dpp_f<0x4E>(v); v += dpp_f<0x141>(v); v += dpp_f<0x128>(v); return v; }
__device__ __forceinline__ float wave_sum(float v) {
    v = row16_sum(v);
    auto s1 = __builtin_amdgcn_permlane16_swap(__float_as_uint(v), __float_as_uint(v), false, false); v = __uint_as_float(s1[0]) + __uint_as_float(s1[1]);
    auto s2 = __builtin_amdgcn_permlane32_swap(__float_as_uint(v), __float_as_uint(v), false, false); v = __uint_as_float(s2[0]) + __uint_as_float(s2[1]);
    return v;
}
__device__ __forceinline__ float reduce8(float x) { x += dpp_f<0xB1>(x); x += dpp_f<0x4E>(x); x += dpp_f<0x141>(x); return x; }

struct ConvJob { const float* src; int K, N; bf16_t* dst; int dld, kofs, blk, blk_stride, row_off; const float* ksc; };
__device__ __forceinline__ void conv_job(const ConvJob j, LAS float* tile, int& rot, const Tix tx) {
    const int tid = tx.tid, G = tx.gd;
    const int tn = j.N >> 6, nt = (j.K >> 6) * tn;
    int t0 = (tx.bid - (rot % G) + G) % G;
    for (int t = t0; t < nt; t += G) {
        const int k0 = (t / tn) << 6, n0 = (t % tn) << 6;
        { const int r = tid >> 4, c4 = tid & 15;
#pragma unroll
          for (int it = 0; it < 2; ++it) { const int k = r + 32 * it; const float4 v = *(const float4*)(j.src + (size_t)(k0 + k) * j.N + n0 + 4 * c4);
              LAS float* tp = tile + k * 65 + 4 * c4; tp[0] = v.x; tp[1] = v.y; tp[2] = v.z; tp[3] = v.w; } }
        __syncthreads();
        { const int n = tid >> 3, kg = tid & 7; float v[8];
#pragma unroll
          for (int i = 0; i < 8; ++i) { v[i] = tile[(8 * kg + i) * 65 + n]; if (j.ksc) v[i] *= j.ksc[k0 + 8 * kg + i]; }
          u32x4 w; w.x = cvt_pk_bf16(v[0], v[1]); w.y = cvt_pk_bf16(v[2], v[3]); w.z = cvt_pk_bf16(v[4], v[5]); w.w = cvt_pk_bf16(v[6], v[7]);
          const int gn = n0 + n; const int drow = (gn / j.blk) * j.blk_stride + (gn % j.blk) + j.row_off;
          *(u32x4*)(j.dst + (size_t)drow * j.dld + j.kofs + k0 + 8 * kg) = w; }
        __syncthreads();
    }
    rot += nt;
}
__device__ void conv_ffn(CP p, bf16_t* W, int fi, LAS float* tile, const Tix tx) {
    int rot = 0;
    conv_job(ConvJob{p->in[10] + (size_t)fi * D * DFF, D, DFF, W + W_W13, 1024, 0, 128, 256, 0, nullptr}, tile, rot, tx);
    conv_job(ConvJob{p->in[11] + (size_t)fi * D * DFF, D, DFF, W + W_W13, 1024, 0, 128, 256, 128, nullptr}, tile, rot, tx);
    conv_job(ConvJob{p->in[12] + (size_t)fi * D * DFF, DFF, D, W + W_W2T, 2816, 0, 1024, 1024, 0, nullptr}, tile, rot, tx);
}
__device__ void conv_rwkv(CP p, bf16_t* W, LAS float* tile, const Tix tx) {
    int rot = 0;
    const float* mu = p->in[13];
    for (int half = 0; half < 2; ++half) {
        const int ko = half * 1024;
        for (int i = 0; i < 3; ++i) { const int mi = (i == 0) ? 0 : (i == 1 ? 2 : 3);
            conv_job(ConvJob{p->in[14] + (size_t)i * D * D, D, D, W + W_BTP, 2048, ko, 1024, 1024, i * 1024, half ? mu + mi * D : nullptr}, tile, rot, tx); }
        for (int d = 0; d < 2; ++d) {
            conv_job(ConvJob{p->in[16] + (size_t)d * D * 64, D, 64, W + W_BTP, 2048, ko, 64, 64, 3072 + 64 * d, half ? mu + 1 * D : nullptr}, tile, rot, tx);
            conv_job(ConvJob{p->in[19] + (size_t)d * D * 64, D, 64, W + W_BTP, 2048, ko, 64, 64, 3200 + 64 * d, half ? mu + 4 * D : nullptr}, tile, rot, tx); }
        conv_job(ConvJob{p->in[21], D, 128, W + W_BTP, 2048, ko, 128, 128, 3328, half ? mu + 5 * D : nullptr}, tile, rot, tx);
    }
    conv_job(ConvJob{p->in[22], 128, D, W + W_BTG, 384, 256, 1024, 1024, 0, nullptr}, tile, rot, tx);
    for (int idx = tx.bid * 512 + tx.tid; idx < 1024 * 32; idx += tx.gd * 512) { const int n = idx >> 5, k8 = idx & 31; *(u32x4*)(W + W_BTG + (size_t)n * 384 + 8 * k8) = (u32x4){0u, 0u, 0u, 0u}; }
    conv_job(ConvJob{p->in[28], D, D, W + W_WOT, 1024, 0, 1024, 1024, 0, nullptr}, tile, rot, tx);
    for (int d = 0; d < 2; ++d) {
        conv_job(ConvJob{p->in[17] + (size_t)d * 64 * D, 64, D, W + W_W2L + (size_t)d * 65536, 64, 0, 1024, 1024, 0, nullptr}, tile, rot, tx);
        conv_job(ConvJob{p->in[20] + (size_t)d * 64 * D, 64, D, W + W_A2L + (size_t)d * 65536, 64, 0, 1024, 1024, 0, nullptr}, tile, rot, tx); }
}
__device__ void conv_pool(CP p, bf16_t* W, const Tix tx) {
    const float* pw = p->in[29]; const float* ps = p->in[30];
    for (int idx = tx.bid * 512 + tx.tid; idx < 1024 * 128; idx += tx.gd * 512) {
        const int k8 = idx >> 10, n = idx & 1023, g = n >> 8; u32x4 w = (u32x4){0u, 0u, 0u, 0u};
        if ((k8 >> 5) == g) { const float s = ps[n]; float v[8];
#pragma unroll
            for (int i = 0; i < 8; ++i) v[i] = pw[((size_t)g * 256 + ((8 * k8 + i) & 255)) * 256 + (n & 255)] * s;
            w.x = cvt_pk_bf16(v[0], v[1]); w.y = cvt_pk_bf16(v[2], v[3]); w.z = cvt_pk_bf16(v[4], v[5]); w.w = cvt_pk_bf16(v[6], v[7]); }
        *(u32x4*)(W + (size_t)n * 1024 + 8 * k8) = w; }
}

__device__ void mod_phase(CP p, LAS float* lf, const Tix tx) {
    LAS float* sc = lf; LAS float* red = lf + 9216;
    const int tid = tx.tid;
    if (tx.bid >= 288) return;
    for (int o = tid; o < 9216; o += 512) { const int c = o >> 10, k = o & 1023; const float v = (c == 0) ? p->in[5][k] : p->in[2][(c - 1) * 1024 + k]; sc[o] = v * fast_sigmoid(v); }
    __syncthreads();
    float* mod = (float*)(p->ws + OFF_MOD);
    for (int item = tx.bid; item < 288; item += tx.gd) {
        const int i = item / 144, n0 = (item % 144) * 64, col = tid & 63, ks = tid >> 6;
        float acc[9];
#pragma unroll
        for (int c = 0; c < 9; ++c) acc[c] = 0.f;
        const float* wp = p->in[6] + ((size_t)i * 1024 + ks * 128) * 9216 + n0 + col;
#pragma unroll 8
        for (int k = 0; k < 128; ++k) { const float w = wp[(size_t)k * 9216];
#pragma unroll
            for (int c = 0; c < 9; ++c) acc[c] += sc[c * 1024 + ks * 128 + k] * w; }
#pragma unroll
        for (int c = 0; c < 9; ++c) red[(ks * 9 + c) * 64 + col] = acc[c];
        __syncthreads();
        for (int o = tid; o < 576; o += 512) { const int c = o >> 6, cl = o & 63; float s = p->in[7][i * 9216 + n0 + cl];
#pragma unroll
            for (int k2 = 0; k2 < 8; ++k2) s += red[(k2 * 9 + c) * 64 + cl];
            mod[((size_t)c * 2 + i) * 9216 + n0 + cl] = s; }
        __syncthreads();
    }
}

struct RowCfg {
    int src_input;
    int pending;
    int lg, gidx; float coef; const float* npost;
    int has_next;
    int lh, shidx, scidx; const float* npre;
    int write_x;
    int fsplit;
};
__device__ __forceinline__ const float* xrow_in(CP p, int m) { return m < MP ? p->in[0] + (size_t)m * D : p->in[1] + (size_t)(m - MP) * D; }
__device__ __forceinline__ int cond_of(int m) { return m < MP ? 0 : 1 + ((m - MP) >> 11); }
__device__ __forceinline__ void row_update(CP p, const RowCfg& c, int m, int lane, f32x4 (&x)[4]) {
    const float* xr = c.src_input ? xrow_in(p, m) : p->out + (size_t)m * D;
    const float* mod = (const float*)(p->ws + OFF_MOD);
    const int cd = cond_of(m);
#pragma unroll
    for (int q = 0; q < 4; ++q) x[q] = *(const f32x4*)(xr + 4 * lane + 256 * q);
    if (c.pending) {
        const bf16_t* fr = (const bf16_t*)(p->ws + OFF_E) + (size_t)m * D; f32x4 f[4]; float ss = 0.f;
#pragma unroll
        for (int q = 0; q < 4; ++q) { const u32x2 w = *(const u32x2*)(fr + 4 * lane + 256 * q); f[q] = (f32x4){bflo(w.x), bfhi(w.x), bflo(w.y), bfhi(w.y)}; }
        if (c.fsplit && m >= 16384) {
            const bf16_t* fr2 = (const bf16_t*)(p->ws + OFF_FB) + (size_t)(m - 16384) * D;
#pragma unroll
            for (int q = 0; q < 4; ++q) { const u32x2 w = *(const u32x2*)(fr2 + 4 * lane + 256 * q); f[q] += (f32x4){bflo(w.x), bfhi(w.x), bflo(w.y), bfhi(w.y)}; } }
#pragma unroll
        for (int q = 0; q < 4; ++q) ss += f[q][0] * f[q][0] + f[q][1] * f[q][1] + f[q][2] * f[q][2] + f[q][3] * f[q][3];
        ss = wave_sum(ss); const float rs = rsqrtf(ss * (1.0f / 1024.0f) + RMS_EPS) * c.coef;
        const float* gate = mod + ((size_t)(cd * 2 + c.lg) * 9 + c.gidx) * D;
#pragma unroll
        for (int q = 0; q < 4; ++q) { const f32x4 g = *(const f32x4*)(gate + 4 * lane + 256 * q), np = *(const f32x4*)(c.npost + 4 * lane + 256 * q); x[q] += g * (f[q] * np) * rs; }
    }
}
__device__ __forceinline__ void row_premod(CP p, const RowCfg& c, int m, int lane, const f32x4 (&x)[4], f32x4 (&h)[4]) {
    const float* mod = (const float*)(p->ws + OFF_MOD);
    const int cd = cond_of(m);
    float ss = 0.f;
#pragma unroll
    for (int q = 0; q < 4; ++q) ss += x[q][0] * x[q][0] + x[q][1] * x[q][1] + x[q][2] * x[q][2] + x[q][3] * x[q][3];
    ss = wave_sum(ss); const float rs = rsqrtf(ss * (1.0f / 1024.0f) + RMS_EPS);
    const float* sh = mod + ((size_t)(cd * 2 + c.lh) * 9 + c.shidx) * D; const float* scl = mod + ((size_t)(cd * 2 + c.lh) * 9 + c.scidx) * D;
#pragma unroll
    for (int q = 0; q < 4; ++q) { const f32x4 g = *(const f32x4*)(c.npre + 4 * lane + 256 * q), s1 = *(const f32x4*)(scl + 4 * lane + 256 * q), s0 = *(const f32x4*)(sh + 4 * lane + 256 * q);
        h[q] = (x[q] * rs * g) * (1.0f + s1) + s0; }
}
__device__ __forceinline__ void store_bf16_row(bf16_t* dst, int lane, const f32x4 (&h)[4]) {
#pragma unroll
    for (int q = 0; q < 4; ++q) { u32x2 w; w.x = cvt_pk_bf16(h[q][0], h[q][1]); w.y = cvt_pk_bf16(h[q][2], h[q][3]); *(u32x2*)(dst + 4 * lane + 256 * q) = w; }
}
__device__ void rowpass_simple(CP p, const RowCfg c, const Tix tx) {
    const int lane = tx.tid & 63, wid = tx.tid >> 6, nw = tx.gd * 8;
    bf16_t* hdst = (bf16_t*)(p->ws + OFF_A);
    for (int m = tx.bid * 8 + wid; m < MT; m += nw) {
        f32x4 x[4]; row_update(p, c, m, lane, x);
        if (c.write_x) {
#pragma unroll
            for (int q = 0; q < 4; ++q) *(f32x4*)(p->out + (size_t)m * D + 4 * lane + 256 * q) = x[q]; }
        if (c.has_next) { f32x4 h[4]; row_premod(p, c, m, lane, x, h); store_bf16_row(hdst + (size_t)m * D, lane, h); }
    }
}
__device__ void rowpass_shift(CP p, const RowCfg c, LAS float* lf, const Tix tx) {
    const int lane = tx.tid & 63, wid = tx.tid >> 6;
    bf16_t* adst = (bf16_t*)(p->ws + OFF_A);
    for (int blk = tx.bid; blk < MT / 6; blk += tx.gd) {
        const int m = blk * 6 - 1 + wid;
        f32x4 x[4], h[4];
#pragma unroll
        for (int q = 0; q < 4; ++q) { x[q] = (f32x4){0.f, 0.f, 0.f, 0.f}; h[q] = x[q]; }
        if (m >= 0 && m < MT) {
            row_update(p, c, m, lane, x); row_premod(p, c, m, lane, x, h);
#pragma unroll
            for (int q = 0; q < 4; ++q) *(LAS f32x4*)(lf + wid * 1024 + 4 * lane + 256 * q) = h[q];
        }
        __syncthreads();
        if (wid >= 1 && wid <= 6) {
            const int T = m < MP ? 256 : 2048, t = m < MP ? (m & 255) : ((m - MP) & 2047);
#pragma unroll
            for (int q = 0; q < 4; ++q) *(f32x4*)(p->out + (size_t)m * D + 4 * lane + 256 * q) = x[q];
            f32x4 hs[4];
#pragma unroll
            for (int q = 0; q < 4; ++q) { hs[q] = (f32x4){0.f, 0.f, 0.f, 0.f};
                if (t > 0) hs[q] += *(const LAS f32x4*)(lf + (wid - 1) * 1024 + 4 * lane + 256 * q);
                if (t < T - 1) hs[q] += *(const LAS f32x4*)(lf + (wid + 1) * 1024 + 4 * lane + 256 * q);
                hs[q] = 0.5f * hs[q] - h[q]; }
            store_bf16_row(adst + (size_t)m * 2048, lane, h);
            store_bf16_row(adst + (size_t)m * 2048 + 1024, lane, hs);
        }
        __syncthreads();
    }
}
__device__ void rowpass_gn(CP p, const Tix tx) {
    const int lane = tx.tid & 63, wid = tx.tid >> 6, nw = tx.gd * 8;
    const bf16_t* yf = (const bf16_t*)(p->ws + OFF_A); const bf16_t* yb = (const bf16_t*)(p->ws + OFF_B);
    const bf16_t* gb = (const bf16_t*)(p->ws + OFF_C); const bf16_t* vb = (const bf16_t*)(p->ws + OFF_E);
    bf16_t* ob = (bf16_t*)(p->ws + OFF_D); const float* cbp = (const float*)(p->ws + OFF_CBP);
    const float* gnw = p->in[26]; const float* gnb = p->in[27];
    for (int m = tx.bid * 8 + wid; m < MT; m += nw) {
        f32x4 o[4];
#pragma unroll
        for (int q = 0; q < 4; ++q) {
            const int col = 4 * lane + 256 * q, hd = 4 * q + (lane >> 4);
            const u32x2 a = *(const u32x2*)(yf + (size_t)m * D + col), b = *(const u32x2*)(yb + (size_t)m * D + col);
            f32x4 y = (f32x4){bflo(a.x) + bflo(b.x), bfhi(a.x) + bfhi(b.x), bflo(a.y) + bflo(b.y), bfhi(a.y) + bfhi(b.y)};
            float s = y[0] + y[1] + y[2] + y[3];
            s = row16_sum(s);
            const float mean = s * (1.0f / 64.0f); const f32x4 dv = y - mean;
            float vs = dv[0] * dv[0] + dv[1] * dv[1] + dv[2] * dv[2] + dv[3] * dv[3];
            vs = row16_sum(vs);
            const float rstd = rsqrtf(vs * (1.0f / 64.0f) + GN_EPS);
            const f32x4 c0 = *(const f32x4*)(cbp + ((size_t)m * 16 + hd) * 4), c1 = *(const f32x4*)(cbp + ((size_t)(MT + m) * 16 + hd) * 4);
            const float cb = (c0[0] + c0[1] + c0[2] + c0[3]) + (c1[0] + c1[1] + c1[2] + c1[3]);
            const u32x2 vw = *(const u32x2*)(vb + (size_t)m * D + col), gw = *(const u32x2*)(gb + (size_t)m * D + col);
            const f32x4 v = (f32x4){bflo(vw.x), bfhi(vw.x), bflo(vw.y), bfhi(vw.y)}, g = (f32x4){bflo(gw.x), bfhi(gw.x), bflo(gw.y), bfhi(gw.y)};
            const f32x4 w = *(const f32x4*)(gnw + col), bb = *(const f32x4*)(gnb + col);
            o[q] = (dv * rstd * w + bb + cb * v) * g;
        }
        store_bf16_row(ob + (size_t)m * D, lane, o);
    }
}

__device__ __forceinline__ void pool_acc(float (&acc)[8], const u32x4 w, const float wt) {
    acc[0] += wt * bflo(w.x); acc[1] += wt * bfhi(w.x); acc[2] += wt * bflo(w.y); acc[3] += wt * bfhi(w.y); acc[4] += wt * bflo(w.z); acc[5] += wt * bfhi(w.z); acc[6] += wt * bflo(w.w); acc[7] += wt * bfhi(w.w);
}
template <int WIN> __device__ __forceinline__ void pool_unit(CP p, const int pass, const int pair, const int gi, const int lane) {
    constexpr int HW = WIN / 2;
    const bf16_t* h = (const bf16_t*)(p->ws + OFF_A); bf16_t* t1 = (bf16_t*)(p->ws + OFF_B); bf16_t* dl = (bf16_t*)(p->ws + OFF_D);
    const int m = 2 * pair + (lane >> 5), ch = gi * 256 + 8 * (lane & 31);
    float acc[8];
#pragma unroll
    for (int i = 0; i < 8; ++i) acc[i] = 0.f;
    if (m < MP) {
        if (pass != 0) return;
        const int t = m & 255, mb = m - t;
        u32x4 w[WIN];
#pragma unroll
        for (int k = 0; k < WIN; ++k) { const int tt = t - HW + k; const int tc = min(max(tt, 0), 255); w[k] = *(const u32x4*)(h + (size_t)(mb + tc) * D + ch); }
#pragma unroll
        for (int k = 0; k < WIN; ++k) { const int tt = t - HW + k; pool_acc(acc, w[k], (tt >= 0 && tt < 256) ? 1.0f : 0.0f); }
        const float inv = __builtin_amdgcn_rcpf((float)(min(t + HW, 256) - max(t - HW, 0))); const u32x4 c = w[HW];
        u32x4 o; o.x = cvt_pk_bf16(acc[0] * inv - bflo(c.x), acc[1] * inv - bfhi(c.x)); o.y = cvt_pk_bf16(acc[2] * inv - bflo(c.y), acc[3] * inv - bfhi(c.y));
        o.z = cvt_pk_bf16(acc[4] * inv - bflo(c.z), acc[5] * inv - bfhi(c.z)); o.w = cvt_pk_bf16(acc[6] * inv - bflo(c.w), acc[7] * inv - bfhi(c.w));
        *(u32x4*)(dl + (size_t)m * D + ch) = o;
    } else {
        const int ms = m - MP, pos = ms & 2047, r = pos >> 6, cc = pos & 63, sb = ms - pos;
        if (pass == 0) {
            u32x4 w[WIN];
#pragma unroll
            for (int k = 0; k < WIN; ++k) { const int rr = r - HW + k; const int rc = min(max(rr, 0), 31); w[k] = *(const u32x4*)(h + (size_t)(MP + sb + rc * 64 + cc) * D + ch); }
#pragma unroll
            for (int k = 0; k < WIN; ++k) { const int rr = r - HW + k; pool_acc(acc, w[k], (rr >= 0 && rr < 32) ? 1.0f : 0.0f); }
            const float inv = __builtin_amdgcn_rcpf((float)(min(r + HW, 32) - max(r - HW, 0)));
            u32x4 o; o.x = cvt_pk_bf16(acc[0] * inv, acc[1] * inv); o.y = cvt_pk_bf16(acc[2] * inv, acc[3] * inv); o.z = cvt_pk_bf16(acc[4] * inv, acc[5] * inv); o.w = cvt_pk_bf16(acc[6] * inv, acc[7] * inv);
            *(u32x4*)(t1 + (size_t)ms * D + ch) = o;
        } else {
            u32x4 w[WIN];
#pragma unroll
            for (int k = 0; k < WIN; ++k) { const int c2 = cc - HW + k; const int c3 = min(max(c2, 0), 63); w[k] = *(const u32x4*)(t1 + (size_t)(sb + r * 64 + c3) * D + ch); }
#pragma unroll
            for (int k = 0; k < WIN; ++k) { const int c2 = cc - HW + k; pool_acc(acc, w[k], (c2 >= 0 && c2 < 64) ? 1.0f : 0.0f); }
            const float inv = __builtin_amdgcn_rcpf((float)(min(cc + HW, 64) - max(cc - HW, 0))); const u32x4 c = *(const u32x4*)(h + (size_t)m * D + ch);
            u32x4 o; o.x = cvt_pk_bf16(acc[0] * inv - bflo(c.x), acc[1] * inv - bfhi(c.x)); o.y = cvt_pk_bf16(acc[2] * inv - bflo(c.y), acc[3] * inv - bfhi(c.y));
            o.z = cvt_pk_bf16(acc[4] * inv - bflo(c.z), acc[5] * inv - bfhi(c.z)); o.w = cvt_pk_bf16(acc[6] * inv - bflo(c.w), acc[7] * inv - bfhi(c.w));
            *(u32x4*)(dl + (size_t)m * D + ch) = o;
        }
    }
}
__device__ void pool_pass(CP p, int pass, const Tix tx) {
    const int lane = tx.tid & 63, wid = tx.tid >> 6;
    const int first = pass == 0 ? 0 : (MP / 2) * 4, total = (MT / 2) * 4;
    for (int u = first + tx.bid * 8 + wid; u < total; u += tx.gd * 8) {
        const int gi = u & 3, pair = u >> 2;
        if (gi == 0) pool_unit<2>(p, pass, pair, 0, lane); else if (gi == 1) pool_unit<4>(p, pass, pair, 1, lane);
        else if (gi == 2) pool_unit<8>(p, pass, pair, 2, lane); else pool_unit<16>(p, pass, pair, 3, lane);
    }
}

constexpr int SST = 324;
constexpr int SBUF = 16 * SST + 64;
template <int VAR> __device__ void scan_phase(CP p, const bf16_t* W, LAS float* lf, const Tix tx, const int skipmask) {
    const int tid = tx.tid, lane = tid & 63, wid = tid >> 6, grp = wid >> 2, q = wid & 3;
    const int l15 = lane & 15, quad = lane >> 4, rl = lane >> 3, cg8 = lane & 7, i0 = 16 * q + 2 * rl;
    const bf16_t* rb = (const bf16_t*)(p->ws + OFF_C); const bf16_t* kb = (const bf16_t*)(p->ws + OFF_D); const bf16_t* vb = (const bf16_t*)(p->ws + OFF_E);
    const bf16_t* lb = (const bf16_t*)(p->ws + OFF_S);
    bf16_t* yout = (bf16_t*)(p->ws + OFF_A);
    float* cbp = (float*)(p->ws + OFF_CBP);
    const int tch = grp == 0 ? 128 : 16, nsub = grp == 0 ? 1 : ((skipmask & 8) ? 0 : 4);
    for (int it = tx.bid; it < 256; it += tx.gd) {
        f32x2 Sa[4], Sb[4];
        bf16x8 W2f[2], A2f[2];
        LAS float* ystage = lf + 4 * SBUF + 8 * 144 + wid * 1024;
        LAS float* wcst = lf + 4 * SBUF + wid * 144;
#pragma unroll
        for (int i = 0; i < 4; ++i) { Sa[i] = (f32x2){0.f, 0.f}; Sb[i] = (f32x2){0.f, 0.f}; }
        W2f[0] = W2f[1] = A2f[0] = A2f[1] = (bf16x8){0, 0, 0, 0, 0, 0, 0, 0};
        for (int c = -1; c < 128; ++c) {
            const int cn = c + 1; const int subn = cn / tch, ccn = cn % tch; const bool actn = (cn < 128) && (subn < nsub);
            u32x2 pr = (u32x2){0u, 0u}, pk = pr, pv = pr; u32x4 pkf0 = (u32x4){0u, 0u, 0u, 0u}, pkf1 = pkf0; bf16x8 plw0 = (bf16x8){0, 0, 0, 0, 0, 0, 0, 0}, plw1 = plw0, pla0 = plw0, pla1 = plw0;
            int mn = 0, dn = 0, hhn = 0;
            if (actn && !(skipmask & 4)) {
                const int pid = grp == 0 ? it : 4 * it + subn; dn = pid & 1; hhn = (pid >> 1) & 15; const int b = pid >> 5;
                const int T = grp == 0 ? 2048 : 256, mb = grp == 0 ? MP + b * 2048 : b * 256;
                const int pos = ccn * 16 + l15; mn = mb + (dn == 0 ? pos : T - 1 - pos);
                const int col4 = 64 * hhn + 16 * q + 4 * quad;
                pr = *(const u32x2*)(rb + (size_t)mn * D + col4); pk = *(const u32x2*)(kb + (size_t)mn * D + col4); pv = *(const u32x2*)(vb + (size_t)mn * D + col4);
                pkf0 = *(const u32x4*)(kb + (size_t)mn * D + 64 * hhn + 16 * quad); pkf1 = *(const u32x4*)(kb + (size_t)mn * D + 64 * hhn + 16 * quad + 8);
                plw0 = *(const bf16x8*)(lb + (size_t)mn * 384 + dn * 64 + 8 * quad); plw1 = *(const bf16x8*)(lb + (size_t)mn * 384 + dn * 64 + 32 + 8 * quad);
                pla0 = *(const bf16x8*)(lb + (size_t)mn * 384 + 128 + dn * 64 + 8 * quad); pla1 = *(const bf16x8*)(lb + (size_t)mn * 384 + 128 + dn * 64 + 32 + 8 * quad);
                if (ccn == 0) {
                    const bf16_t* w2r = W + W_W2L + ((size_t)dn * 1024 + 64 * hhn + 16 * q + l15) * 64 + 8 * quad;
                    const bf16_t* a2r = W + W_A2L + ((size_t)dn * 1024 + 64 * hhn + 16 * q + l15) * 64 + 8 * quad;
                    W2f[0] = *(const bf16x8*)w2r; W2f[1] = *(const bf16x8*)(w2r + 32); A2f[0] = *(const bf16x8*)a2r; A2f[1] = *(const bf16x8*)(a2r + 32);
                    const int cw = 64 * hhn + 16 * q + l15;
                    if (lane < 16) { wcst[lane] = p->in[15][dn * D + cw]; wcst[16 + lane] = p->in[18][dn * D + cw]; wcst[32 + lane] = p->in[23][cw]; wcst[48 + lane] = p->in[24][cw]; wcst[64 + lane] = p->in[25][cw]; }
                    wcst[80 + lane] = p->in[23][64 * hhn + lane];
                }
            }
            const int sub = c < 0 ? 0 : c / tch, cc = c < 0 ? 0 : c % tch; const bool act = (c >= 0) && (sub < nsub);
            if (act && !(skipmask & 1)) {
                const int pid = grp == 0 ? it : 4 * it + sub; const int d = pid & 1, hh = (pid >> 1) & 15, b = pid >> 5;
                const int T = grp == 0 ? 2048 : 256, mb = grp == 0 ? MP + b * 2048 : b * 256;
                if (cc == 0) {
                    if (grp == 0) { const float* s0 = (d == 0 ? p->in[3] : p->in[4]) + ((size_t)(b * 16 + hh) * 64 + i0) * 64 + 8 * cg8;
                        const f32x4 a0 = *(const f32x4*)s0, a1 = *(const f32x4*)(s0 + 4), b0 = *(const f32x4*)(s0 + 64), b1 = *(const f32x4*)(s0 + 68);
                        Sa[0] = a0.lo; Sa[1] = a0.hi; Sa[2] = a1.lo; Sa[3] = a1.hi; Sb[0] = b0.lo; Sb[1] = b0.hi; Sb[2] = b1.lo; Sb[3] = b1.hi; }
                    else {
#pragma unroll
                        for (int i = 0; i < 4; ++i) { Sa[i] = (f32x2){0.f, 0.f}; Sb[i] = (f32x2){0.f, 0.f}; } }
                }
                const LAS float* bp0 = lf + (grp * 2 + (c & 1)) * SBUF;
                bf16_t* yo = yout + (size_t)d * MT * D + 64 * hh + i0;
                f32x4 nk0, nk1, nb0, nb1, nd0, nd1; f32x2 nv; f32x2 rp[4];
#define SCAN_LOAD_K(s_) do { const LAS float* bp_ = bp0 + (s_) * SST + 8 * cg8; nk0 = *(const LAS f32x4*)(bp_); nk1 = *(const LAS f32x4*)(bp_ + 4); } while (0)
#define SCAN_LOAD_R(s_) do { const LAS float* bp_ = bp0 + (s_) * SST + 8 * cg8; const f32x4 r0_ = *(const LAS f32x4*)(bp_ + 192), r1_ = *(const LAS f32x4*)(bp_ + 196); rp[0] = r0_.lo; rp[1] = r0_.hi; rp[2] = r1_.lo; rp[3] = r1_.hi; } while (0)
#define SCAN_LOAD_B(s_) do { const LAS float* bp_ = bp0 + (s_) * SST + 8 * cg8; nb0 = *(const LAS f32x4*)(bp_ + 64); nb1 = *(const LAS f32x4*)(bp_ + 68); \
                    nd0 = *(const LAS f32x4*)(bp_ + 128); nd1 = *(const LAS f32x4*)(bp_ + 132); nv = *(const LAS f32x2*)(bp0 + (s_) * SST + 256 + i0); } while (0)
                SCAN_LOAD_K(0); SCAN_LOAD_B(0);
#pragma unroll
                for (int i = 0; i < 4; ++i) rp[i] = (f32x2){0.f, 0.f};
#define SCAN_YFLUSH(b_) do { const LAS float* ys_ = ystage + cg8 * 128 + 16 * rl; const f32x4 q0_ = *(const LAS f32x4*)(ys_), q1_ = *(const LAS f32x4*)(ys_ + 4), q2_ = *(const LAS f32x4*)(ys_ + 8), q3_ = *(const LAS f32x4*)(ys_ + 12); \
                    const float ye_ = ((q0_[0] + q0_[2]) + (q1_[0] + q1_[2])) + ((q2_[0] + q2_[2]) + (q3_[0] + q3_[2])), yo_ = ((q0_[1] + q0_[3]) + (q1_[1] + q1_[3])) + ((q2_[1] + q2_[3]) + (q3_[1] + q3_[3])); \
                    const int pos_ = cc * 16 + 8 * (b_) + cg8; const int m_ = mb + (d == 0 ? pos_ : T - 1 - pos_); *(unsigned*)(yo + (size_t)m_ * D) = cvt_pk_bf16(ye_, yo_); } while (0)
#pragma unroll
                for (int s = 0; s < 16; ++s) {
                    const f32x2 kk[4] = {nk0.lo, nk0.hi, nk1.lo, nk1.hi};
                    f32x2 pa = Sa[0] * kk[0], pb = Sb[0] * kk[0], ya = Sa[0] * rp[0], yb = Sb[0] * rp[0];
#pragma unroll
                    for (int i = 1; i < 4; ++i) { pa = Sa[i] * kk[i] + pa; pb = Sb[i] * kk[i] + pb; ya = Sa[i] * rp[i] + ya; yb = Sb[i] * rp[i] + yb; }
                    if (s < 15 && !(VAR & 2)) SCAN_LOAD_K(s + 1);
                    if (!(VAR & 2)) SCAN_LOAD_R(s);
                    float sa0 = pa.x + pa.y, sa1 = pb.x + pb.y;
                    if (s > 0) *(LAS f32x2*)(ystage + ((s - 1) & 7) * 128 + 2 * lane) = (f32x2){ya.x + ya.y, yb.x + yb.y};
                    sa0 += dpp_f<0xB1>(sa0); sa1 += dpp_f<0xB1>(sa1);
                    sa0 += dpp_f<0x4E>(sa0); sa1 += dpp_f<0x4E>(sa1);
                    sa0 += dpp_f<0x141>(sa0); sa1 += dpp_f<0x141>(sa1);
                    const f32x2 bb[4] = {nb0.lo, nb0.hi, nb1.lo, nb1.hi}, dd[4] = {nd0.lo, nd0.hi, nd1.lo, nd1.hi};
                    const f32x2 n0 = (f32x2){-sa0, -sa0}, n1 = (f32x2){-sa1, -sa1}, v0 = (f32x2){nv.x, nv.x}, v1 = (f32x2){nv.y, nv.y};
#pragma unroll
                    for (int i = 0; i < 4; ++i) { Sa[i] = n0 * bb[i] + Sa[i]; Sb[i] = n1 * bb[i] + Sb[i]; Sa[i] = v0 * dd[i] + Sa[i]; Sb[i] = v1 * dd[i] + Sb[i]; }
                    if (s < 15 && !(VAR & 1)) SCAN_LOAD_B(s + 1);
                    if (s == 8) SCAN_YFLUSH(0);
                }
                {
                    f32x2 ya = Sa[0] * rp[0], yb = Sb[0] * rp[0];
#pragma unroll
                    for (int i = 1; i < 4; ++i) { ya = Sa[i] * rp[i] + ya; yb = Sb[i] * rp[i] + yb; }
                    *(LAS f32x2*)(ystage + 7 * 128 + 2 * lane) = (f32x2){ya.x + ya.y, yb.x + yb.y};
                    const f32x4 c0 = *(const LAS f32x4*)(bp0 + 16 * SST + 8 * cg8), c1 = *(const LAS f32x4*)(bp0 + 16 * SST + 8 * cg8 + 4);
                    Sa[0] *= c0.lo; Sa[1] *= c0.hi; Sa[2] *= c1.lo; Sa[3] *= c1.hi; Sb[0] *= c0.lo; Sb[1] *= c0.hi; Sb[2] *= c1.lo; Sb[3] *= c1.hi;
                    SCAN_YFLUSH(1);
                }
#undef SCAN_YFLUSH
#undef SCAN_LOAD_K
#undef SCAN_LOAD_R
#undef SCAN_LOAD_B
                if (grp == 1 && cc == tch - 1) {
                    float* sf = p->out + (size_t)MT * D + (size_t)d * (32 * 16 * 4096) + ((size_t)(b * 16 + hh) * 64 + i0) * 64 + 8 * cg8;
                    *(f32x4*)sf = (f32x4){Sa[0].x, Sa[0].y, Sa[1].x, Sa[1].y}; *(f32x4*)(sf + 4) = (f32x4){Sa[2].x, Sa[2].y, Sa[3].x, Sa[3].y};
                    *(f32x4*)(sf + 64) = (f32x4){Sb[0].x, Sb[0].y, Sb[1].x, Sb[1].y}; *(f32x4*)(sf + 68) = (f32x4){Sb[2].x, Sb[2].y, Sb[3].x, Sb[3].y};
                }
            }
            if (actn && !(skipmask & 2)) {
                f32x4 aw = (f32x4){0.f, 0.f, 0.f, 0.f}, aa = aw;
                aw = __builtin_amdgcn_mfma_f32_16x16x32_bf16(W2f[0], plw0, aw, 0, 0, 0); aw = __builtin_amdgcn_mfma_f32_16x16x32_bf16(W2f[1], plw1, aw, 0, 0, 0);
                aa = __builtin_amdgcn_mfma_f32_16x16x32_bf16(A2f[0], pla0, aa, 0, 0, 0); aa = __builtin_amdgcn_mfma_f32_16x16x32_bf16(A2f[1], pla1, aa, 0, 0, 0);
                const f32x4 cw0 = *(const LAS f32x4*)(wcst + 4 * quad), ca0 = *(const LAS f32x4*)(wcst + 16 + 4 * quad), ckk = *(const LAS f32x4*)(wcst + 32 + 4 * quad), cka = *(const LAS f32x4*)(wcst + 48 + 4 * quad), crk = *(const LAS f32x4*)(wcst + 64 + 4 * quad);
                f32x4 kn[4];
#pragma unroll
                for (int i = 0; i < 4; ++i) kn[i] = *(const LAS f32x4*)(wcst + 80 + 16 * quad + 4 * i);
                float ssq = 0.f;
                { const unsigned kw[8] = {pkf0.x, pkf0.y, pkf0.z, pkf0.w, pkf1.x, pkf1.y, pkf1.z, pkf1.w};
#pragma unroll
                  for (int i = 0; i < 8; ++i) { const float a = bflo(kw[i]) * kn[i >> 1][(i & 1) * 2], b2 = bfhi(kw[i]) * kn[i >> 1][(i & 1) * 2 + 1]; ssq += a * a + b2 * b2; } }
                { auto s1 = __builtin_amdgcn_permlane16_swap(__float_as_uint(ssq), __float_as_uint(ssq), false, false); ssq = __uint_as_float(s1[0]) + __uint_as_float(s1[1]);
                  auto s2 = __builtin_amdgcn_permlane32_swap(__float_as_uint(ssq), __float_as_uint(ssq), false, false); ssq = __uint_as_float(s2[0]) + __uint_as_float(s2[1]); }
                const float rn = fminf(__builtin_amdgcn_rsqf(ssq), 1e12f);
                const f32x4 r4 = (f32x4){bflo(pr.x), bfhi(pr.x), bflo(pr.y), bfhi(pr.y)}, k4 = (f32x4){bflo(pk.x), bfhi(pk.x), bflo(pk.y), bfhi(pk.y)}, v4 = (f32x4){bflo(pv.x), bfhi(pv.x), bflo(pv.y), bfhi(pv.y)};
                f32x4 e4, E4, kk4, b4, kd4, rh4, cs4; float cbs = 0.f;
#pragma unroll
                for (int j = 0; j < 4; ++j) { e4[j] = 0.60653066f * fast_sigmoid(cw0[j] + aw[j]);
                    float t = e4[j];
                    t += __builtin_bit_cast(float, __builtin_amdgcn_update_dpp(0, __builtin_bit_cast(int, t), 0x111, 0xf, 0xf, true));
                    t += __builtin_bit_cast(float, __builtin_amdgcn_update_dpp(0, __builtin_bit_cast(int, t), 0x112, 0xf, 0xf, true));
                    t += __builtin_bit_cast(float, __builtin_amdgcn_update_dpp(0, __builtin_bit_cast(int, t), 0x114, 0xf, 0xf, true));
                    t += __builtin_bit_cast(float, __builtin_amdgcn_update_dpp(0, __builtin_bit_cast(int, t), 0x118, 0xf, 0xf, true));
                    E4[j] = t; }
#pragma unroll
                for (int j = 0; j < 4; ++j) {
                    const float a = fast_sigmoid(ca0[j] + aa[j]);
                    const float kkn = k4[j] * ckk[j] * rn, bq = kkn * a, kd = k4[j] * (1.0f + (a - 1.0f) * cka[j]);
                    cbs += r4[j] * kd * crk[j];
                    const float cs = __expf(-E4[j]), cinv = __builtin_amdgcn_rcpf(cs);
                    const float cp = __builtin_bit_cast(float, __builtin_amdgcn_update_dpp(0x3f800000, __builtin_bit_cast(int, cs), 0x111, 0xf, 0xf, false));
                    kk4[j] = kkn * cp; b4[j] = bq * cinv; kd4[j] = kd * cinv; rh4[j] = r4[j] * cs; cs4[j] = cs; }
                LAS float* wb = lf + (grp * 2 + (cn & 1)) * SBUF;
                LAS float* wp = wb + l15 * SST + 16 * q + 4 * quad;
                *(LAS f32x4*)(wp) = kk4; *(LAS f32x4*)(wp + 64) = b4; *(LAS f32x4*)(wp + 128) = kd4; *(LAS f32x4*)(wp + 192) = rh4; *(LAS f32x4*)(wp + 256) = v4;
                if (l15 == 15) *(LAS f32x4*)(wb + 16 * SST + 16 * q + 4 * quad) = cs4;
                { auto s1 = __builtin_amdgcn_permlane16_swap(__float_as_uint(cbs), __float_as_uint(cbs), false, false); cbs = __uint_as_float(s1[0]) + __uint_as_float(s1[1]);
                  auto s2 = __builtin_amdgcn_permlane32_swap(__float_as_uint(cbs), __float_as_uint(cbs), false, false); cbs = __uint_as_float(s2[0]) + __uint_as_float(s2[1]); }
                if (quad == 0) cbp[(((size_t)dn * MT + mn) * 16 + hhn) * 4 + q] = cbs;
            }
            asm volatile("s_waitcnt lgkmcnt(0)" ::: "memory"); __builtin_amdgcn_s_barrier(); asm volatile("" ::: "memory");
        }
    }
}

#define XB_TMO      128
#define XB_XCNT(j)  (256  + 64 * (j))
#define XB_XSUB(j)  (1280 + 64 * (j))
#define XB_XGEN(j)  (2304 + 64 * (j))
#define XB_TOP      3328
#define XB_TOPGEN   3392
#define XCD_BAR_WORDS 3456
#define XB_SPIN_CAP (1u << 18)

__device__ __forceinline__ unsigned xb_ld(unsigned* p)              { return __hip_atomic_load(p, __ATOMIC_RELAXED, __HIP_MEMORY_SCOPE_AGENT); }
__device__ __forceinline__ unsigned xb_add(unsigned* p, unsigned v) { return __hip_atomic_fetch_add(p, v, __ATOMIC_RELAXED, __HIP_MEMORY_SCOPE_AGENT); }
__device__ __forceinline__ unsigned xb_xcc_id() { return (unsigned)__builtin_amdgcn_s_getreg((3 << 11) | 20) & 0xFu; }
#define XB_SPIN(cond, bar) do { unsigned _sp = 0; while (cond) { __builtin_amdgcn_s_sleep(1); \
    if ((++_sp & 255u) == 0u) { if (xb_ld(&(bar)[XB_TMO])) break; if (_sp > XB_SPIN_CAP) { atomicAdd(&(bar)[XB_TMO], 1u); break; } } } } while (0)

struct XcdBarrier {
    unsigned* bar; unsigned x;
    volatile LAS unsigned* st;
};

__device__ __forceinline__ XcdBarrier xcd_barrier_post(unsigned* bar, volatile LAS unsigned* st) {
    XcdBarrier b; b.bar = bar; b.x = xb_xcc_id(); b.st = st;
    if (threadIdx.x == 0) (void)xb_add(&bar[XB_XCNT(b.x)], 1u);
    return b;
}
__device__ __forceinline__ void xcd_barrier_complete(unsigned* bar, unsigned x, unsigned& nloc, unsigned& nx) {
    const unsigned G = gridDim.x * gridDim.y * gridDim.z;
    unsigned sum, cnt, mine, sp = 0u;
    for (;;) {
        sum = 0u; cnt = 0u; mine = 0u;
#pragma unroll
        for (unsigned j = 0; j < 16; ++j) { const unsigned c = xb_ld(&bar[XB_XCNT(j)]); sum += c; cnt += (c > 0u) ? 1u : 0u; mine = (j == x) ? c : mine; }
        if (sum == G) break;
        __builtin_amdgcn_s_sleep(1);
        if ((++sp & 255u) == 0u) { if (xb_ld(&bar[XB_TMO])) break; if (sp > XB_SPIN_CAP) { atomicAdd(&bar[XB_TMO], 1u); break; } }
    }
    nloc = mine > 0u ? mine : 1u; nx = cnt > 0u ? cnt : 1u;
}

__device__ __forceinline__ void xcd_barrier(const XcdBarrier& b) {
    asm volatile("s_waitcnt vmcnt(0)" ::: "memory");
    __syncthreads();
    if (threadIdx.x == 0) {
        unsigned* bar = b.bar;
        __builtin_amdgcn_s_waitcnt(0);
        unsigned nloc = b.st[0], nx = b.st[1];
        if (nloc == 0u) { xcd_barrier_complete(bar, b.x, nloc, nx); b.st[0] = nloc; b.st[1] = nx; }
        const unsigned old = xb_add(&bar[XB_XSUB(b.x)], 1u);
        const unsigned gen = old / nloc;
        if (old + 1u == (gen + 1u) * nloc) {
            __builtin_amdgcn_fence(__ATOMIC_RELEASE, "agent");
            asm volatile("s_waitcnt vmcnt(0)" ::: "memory");
            const unsigned og = xb_add(&bar[XB_TOP], 1u);
            const unsigned tg = og / nx;
            if (og + 1u == (tg + 1u) * nx) xb_add(&bar[XB_TOPGEN], 1u);
            else XB_SPIN(xb_ld(&bar[XB_TOPGEN]) == tg, bar);
            __builtin_amdgcn_fence(__ATOMIC_ACQUIRE, "agent");
            xb_add(&bar[XB_XGEN(b.x)], 1u);
            asm volatile("s_waitcnt vmcnt(0)" ::: "memory");
        } else {
            XB_SPIN(xb_ld(&bar[XB_XGEN(b.x)]) == gen, bar);
            __builtin_amdgcn_fence(__ATOMIC_ACQUIRE, "agent");
            asm volatile("s_waitcnt vmcnt(0)" ::: "memory");
        }
    }
    __syncthreads();
}


constexpr int NPHASE = 24;
#ifndef SPLITK
#define SPLITK 1
#endif
#ifndef ONLYMASK
#define ONLYMASK 0x1ff
#endif
#define EN(k) ((ONLYMASK >> (k)) & 1)
constexpr int LDS_BYTES = 131072 + 16;
__global__ void __launch_bounds__(512, 2) mega(Params kp) {
    extern __shared__ __attribute__((aligned(16))) unsigned char shm[];
    PG8_LAS unsigned char* lds = (PG8_LAS unsigned char*)shm;
    LAS float* lf = (LAS float*)shm;
    cg::grid_group grid = cg::this_grid();
    const int pb = kp.pb, pe = kp.pe;
    volatile LAS unsigned* xst = (volatile LAS unsigned*)(lds + 131072);
    if (threadIdx.x < 2) xst[threadIdx.x] = 0u;
    __syncthreads();
    XcdBarrier xb = xcd_barrier_post((unsigned*)(kp.ws + OFF_BAR), xst);
#ifdef PROBE_SYNC
#pragma unroll 1
    for (int i = 0; i < PROBE_SYNC; ++i) grid.sync();
#endif
#pragma unroll 1
    for (int ph = pb; ph < pe; ++ph) {
        CP p = (CP)__builtin_amdgcn_kernarg_segment_ptr();
        asm volatile("" : "+s"(p));
        Tix tx; { int t_ = threadIdx.x, b_ = blockIdx.x, g_ = gridDim.x; asm volatile("" : "+v"(t_)); asm volatile("" : "+s"(b_), "+s"(g_)); tx.tid = t_; tx.bid = b_; tx.gd = g_; }
        bf16_t* rA = (bf16_t*)(p->ws + OFF_A); bf16_t* rB = (bf16_t*)(p->ws + OFF_B); bf16_t* rC = (bf16_t*)(p->ws + OFF_C); bf16_t* rD = (bf16_t*)(p->ws + OFF_D); bf16_t* rE = (bf16_t*)(p->ws + OFF_E);
        bf16_t* rS = (bf16_t*)(p->ws + OFF_S);
        const int wsel = (ph <= 3) ? 0 : (ph <= 9) ? 1 : (ph <= 12) ? 0 : (ph <= 15) ? 1 : (ph <= 19) ? 0 : 1;
        bf16_t* W = (bf16_t*)(p->ws + (wsel ? OFF_W2 : OFF_W)); bf16_t* Wn = (bf16_t*)(p->ws + (wsel ? OFF_W : OFF_W2));
        const float* npre = p->in[8]; const float* npost = p->in[9];
        int kind = 0;
        RowCfg rc{}; int conv = -1;
        const bf16_t* gA = nullptr; const bf16_t* gB = nullptr; bf16_t* gO = nullptr; int gN = 0, gK = 0, pool_pass_id = 0;
        switch (ph) {
            case 0: kind = 0; break;
            case 1: kind = 1; rc = RowCfg{1, 0, 0, 0, 0.f, npost, 1, 0, 0, 1, npre + 0 * D, 0, SPLITK}; break;
            case 2: case 11: case 14: case 21: kind = 2; break;
            case 3: case 12: case 15: case 22: kind = 3; gA = rB; gB = W + W_W2T; gO = rE; gN = 1024; gK = 2816; conv = (ph == 3) ? 4 : (ph == 12) ? 2 : (ph == 15) ? 5 : -1; break;
            case 4: kind = 4; rc = RowCfg{1, 1, 0, 2, 0.5f, npost + 0 * D, 1, 0, 3, 4, npre + 1 * D, 1, SPLITK}; break;
            case 5: kind = 5; break;
            case 6: kind = 6; break;
            case 7: kind = 3; gA = rS; gB = W + W_BTG; gO = rC; gN = 1024; gK = 384; break;
            case 8: kind = 7; break;
            case 9: kind = 3; gA = rD; gB = W + W_WOT; gO = rE; gN = 1024; gK = 1024; conv = 1; break;
            case 10: kind = 1; rc = RowCfg{0, 1, 0, 5, 1.0f, npost + 1 * D, 1, 0, 6, 7, npre + 2 * D, 1, SPLITK}; break;
            case 13: kind = 1; rc = RowCfg{0, 1, 0, 8, 0.5f, npost + 2 * D, 1, 1, 0, 1, npre + 3 * D, 1, SPLITK}; break;
            case 16: kind = 1; rc = RowCfg{0, 1, 1, 2, 0.5f, npost + 3 * D, 1, 1, 3, 4, npre + 4 * D, 1, SPLITK}; break;
            case 17: kind = 8; pool_pass_id = 0; break;
            case 18: kind = 8; pool_pass_id = 1; break;
            case 19: kind = 3; gA = rD; gB = W; gO = rE; gN = 1024; gK = 1024; conv = 3; break;
            case 20: kind = 1; rc = RowCfg{0, 1, 1, 5, 1.0f, npost + 4 * D, 1, 1, 6, 7, npre + 5 * D, 1, SPLITK}; break;
            case 23: kind = 1; rc = RowCfg{0, 1, 1, 8, 0.5f, npost + 5 * D, 0, 0, 0, 0, npre, 1, SPLITK}; break;
            default: break;
        }
        rc.fsplit = (SPLITK && tx.gd == 256) ? 1 : 0;
#ifdef PROBE_PH
        const int reps = (ph == PROBE_PH) ? PROBE_N : 1;
#else
        const int reps = 1;
#endif
#pragma unroll 1
        for (int rep = 0; rep < reps; ++rep) {
        if (rep > 0) xcd_barrier(xb);
        asm volatile("" : "+v"(tx.tid)); asm volatile("" : "+s"(tx.bid), "+s"(tx.gd)); asm volatile("" : "+s"(p));
        if (EN(0) && kind == 0) { mod_phase(p, lf, tx); __syncthreads(); conv_ffn(p, W, 0, lf + 16384, tx); }
        else if (EN(1) && kind == 1) { rowpass_simple(p, rc, tx); }
        else if (EN(4) && kind == 4) { rowpass_shift(p, rc, lf, tx); }
        else if (EN(2) && (kind == 2 || kind == 3 || kind == 5)) {
            if (kind == 2) { gA = rA; gB = W + W_W13; gO = rB; gN = 5632; gK = 1024; } else if (kind == 5) { gA = rA; gB = W + W_BTP; gO = rC; gN = 3584; gK = 2048; }
            const int bal = (SPLITK && kind == 3 && gK >= 1024 && tx.gd == 256) ? 1 : 0;
            pg8::Gemm g{gA, gB, MT, gN, gK}; pg8::FwdOrder S; S.init(MT, gN, gK, tx.gd, tx.bid, bal);
            pg8::EpiAll E{kind == 3 ? 0 : (kind == 2 ? 1 : 2), gO, kind == 2 ? DFF : 1024, rS, (bf16_t*)(p->ws + OFF_FB) - (size_t)16384 * 1024};
#ifdef PROBE_NOEPI
            if (rep + 1 < reps) E.kind = 7;
#endif
            pg8::gemm_phase<pg8::EpiAll, pg8::FwdOrder, false>(lds, g, S, E, nullptr, tx.tid);
            if (conv >= 0) { const int half = bal ? 0 : (tx.gd >> 1); if (tx.bid >= half) { const Tix tv{tx.tid, tx.bid - half, tx.gd - half};
                if (conv < 4) conv_ffn(p, Wn, conv, lf, tv); else if (conv == 4) conv_rwkv(p, Wn, lf, tv); else conv_pool(p, Wn, tv); } } }
        else if (EN(6) && kind == 6) {
#ifdef PROBE_VAR
            if (rep + 1 < reps) scan_phase<PROBE_VAR>(p, W, lf, tx, 0); else scan_phase<0>(p, W, lf, tx, 0);
#elif defined(PROBE_MASK)
            scan_phase<0>(p, W, lf, tx, (rep + 1 < reps) ? PROBE_MASK : 0);
#else
            scan_phase<0>(p, W, lf, tx, 0);
#endif
        }
        else if (EN(7) && kind == 7) rowpass_gn(p, tx);
        else if (EN(8) && kind == 8) pool_pass(p, pool_pass_id, tx);
        }
        if (ph + 1 < pe) { if (pb > pe) grid.sync(); else xcd_barrier(xb); }
    }
}

#include <cstdio>
#ifndef USE_COOP
#define USE_COOP 1
#endif
extern "C" void kernel_launch(void* const* d_in, const int* in_sizes, int n_in, void* d_out, int out_size, void* d_ws, size_t ws_size, hipStream_t stream) {
    static int grid = 0;
    if (grid == 0) {
        if (n_in != NIN || ws_size < WS_NEED) { fprintf(stderr, "kernel_launch: n_in %d ws %zu (need %zu)\n", n_in, ws_size, (size_t)WS_NEED); grid = -1; return; }
        int dev = 0, cus = 0, per_cu = 0;
        hipGetDevice(&dev); hipDeviceGetAttribute(&cus, hipDeviceAttributeMultiprocessorCount, dev);
        if (hipFuncSetAttribute((const void*)mega, hipFuncAttributeMaxDynamicSharedMemorySize, LDS_BYTES) != hipSuccess) { fprintf(stderr, "kernel_launch: hipFuncSetAttribute failed\n"); grid = -1; return; }
        if (hipOccupancyMaxActiveBlocksPerMultiprocessor(&per_cu, (const void*)mega, 512, LDS_BYTES) != hipSuccess || per_cu < 1) { fprintf(stderr, "kernel_launch: occupancy query says %d\n", per_cu); per_cu = 1; }
        (void)hipGetLastError();
        grid = cus * 1;
        if (grid <= 0) grid = 256;
    }
    if (grid < 0) return;
    if (hipMemsetAsync((unsigned char*)d_ws + OFF_BAR, 0, 16384, stream) != hipSuccess) { fprintf(stderr, "kernel_launch: memset of the barrier words failed\n"); return; }
    Params p{};
    for (int i = 0; i < NIN; ++i) p.in[i] = (const float*)d_in[i];
    p.out = (float*)d_out; p.ws = (unsigned char*)d_ws;
#if USE_COOP
    p.pb = 0; p.pe = NPHASE;
    void* args[] = {&p};
    hipError_t e = hipLaunchCooperativeKernel((const void*)mega, dim3(grid), dim3(512), args, LDS_BYTES, stream);
    if (e != hipSuccess) fprintf(stderr, "cooperative launch failed: %s (grid %d)\n", hipGetErrorString(e), grid);
#else
    for (int ph = 0; ph < NPHASE; ++ph) { p.pb = ph; p.pe = ph + 1; hipLaunchKernelGGL(mega, dim3(grid), dim3(512), LDS_BYTES, stream, p); }
#endif
}
```

```cpp
#include <hip/hip_runtime.h>
#include <hip/hip_cooperative_groups.h>
namespace pg8 {
#define PG8_LAS __attribute__((address_space(3)))
typedef unsigned short bf16_t;
typedef short bf16x8 __attribute__((ext_vector_type(8)));
typedef float f32x4 __attribute__((ext_vector_type(4)));
typedef unsigned u32x4 __attribute__((ext_vector_type(4)));
constexpr int BM = 256, BK = 64, HALF = 128, HTB = HALF * BK * 2  , STAGE_BYTES = 8 * HTB, NXCD = 8, WGM = 8;

__host__ __device__ __forceinline__ int lds_byte(int r, int c) { const int st = (r >> 4) * 2 + (c >> 5), rr = r & 15, cc = c & 31, ob = rr * 64 + cc * 2; return st * 1024 + (ob ^ (((ob >> 9) & 1) << 5)); }
__host__ __device__ __forceinline__ void stage_rc(int b, int& R, int& C) { const int st = b / 1024, sb = b % 1024, swz = sb ^ (((sb >> 9) & 1) << 5); R = (st >> 1) * 16 + swz / 64; C = (st & 1) * 32 + (swz % 64) / 2; }
__host__ __device__ __forceinline__ int perm32(int rho) { const int n = rho >> 4, i = rho & 15; return 8 * (i >> 2) + 4 * n + (i & 3); }

struct Unit { int pm, pn, part; };
struct Gemm { const bf16_t* A; const bf16_t* Bt; int M, N, K; };

struct StaticOrder {
    int nM, nN, nwg, G, c;
    __host__ __device__ void init(int M, int N, int G_, int c_) { nM = M / BM; nN = N / BM; nwg = nM * nN; G = G_; c = c_; }
    __host__ __device__ bool next(int i, Unit& u) const {
        const long L = (long)i * G + c; if (L >= nwg) return false;
        int wgid = (int)L; { const int q = nwg / NXCD, r = nwg % NXCD, xcd = wgid % NXCD, off = wgid / NXCD; wgid = (xcd < r ? xcd * (q + 1) : r * (q + 1) + (xcd - r) * q) + off; }
        const int nig = WGM * nN, gid = wgid / nig, fm = gid * WGM, gsz = (nM - fm) < WGM ? (nM - fm) : WGM;
        u.pm = fm + ((wgid % nig) % gsz); u.pn = (wgid % nig) / gsz; u.part = 0; return true;
    }
    __device__ __forceinline__ void a_ready(const Unit&) const {}
    __device__ __forceinline__ void done(const Unit&) const {}
};
struct FwdOrder {
    StaticOrder so; int mode;
    __host__ __device__ void init(int M, int N, int K, int G_, int c_, int mode_) { so.init(M, N, G_, c_); mode = mode_; }
    __host__ __device__ bool next(int i, Unit& u) const {
        if (mode == 0) return so.next(i, u);
        if (i >= 2) return false;
        const int w = (so.c & 7) * 32 + (so.c >> 3);
        if (i == 0) { u.pm = w >> 2; u.pn = w & 3; u.part = 0; }
        else { u.pm = 64 + (w >> 3); u.pn = (w >> 1) & 3; u.part = 1 + (w & 1); }
        return true;
    }
    __device__ __forceinline__ void a_ready(const Unit&) const {}
    __device__ __forceinline__ void done(const Unit&) const {}
};
__device__ __forceinline__ unsigned cvt_pk_bf16(float lo, float hi) { unsigned r; asm volatile("v_cvt_pk_bf16_f32 %0, %1, %2" : "=v"(r) : "v"(lo), "v"(hi)); return r; }
typedef float f32x2 __attribute__((ext_vector_type(2)));
__device__ __forceinline__ float fast_sigmoid(float x) { return __builtin_amdgcn_rcpf(1.0f + __expf(-x)); }
__device__ __forceinline__ float fast_tanh(float x) { return 1.0f - 2.0f * __builtin_amdgcn_rcpf(1.0f + __expf(2.0f * x)); }
struct EpiStore {
    static constexpr bool PERM = true, AFTER_DRAIN = false;
    bf16_t* O; int ldc;
    __device__ __forceinline__ void operator()(const f32x4 (&acc)[2][2][4][2], const Unit& u, int wr, int wc, int fr, int fq) const {
        const int row0 = u.pm * BM + wr * 64 + fr, col0 = u.pn * BM + wc * 32 + 8 * fq;
#pragma unroll
        for (int ai = 0; ai < 2; ++ai)
#pragma unroll
            for (int m = 0; m < 4; ++m) { bf16_t* rowp = O + (size_t)(row0 + ai * HALF + m * 16) * ldc + col0;
#pragma unroll
                for (int bj = 0; bj < 2; ++bj) { const f32x4 v0 = acc[ai][bj][m][0], v1 = acc[ai][bj][m][1];
                    u32x4 w; w.x = cvt_pk_bf16(v0[0], v0[1]); w.y = cvt_pk_bf16(v0[2], v0[3]); w.z = cvt_pk_bf16(v1[0], v1[1]); w.w = cvt_pk_bf16(v1[2], v1[3]);
                    *(u32x4*)(rowp + bj * HALF) = w; } }
    }
};
struct EpiSwiglu {
    static constexpr bool PERM = true, AFTER_DRAIN = false;
    bf16_t* O; int ldc;
    __device__ __forceinline__ void operator()(const f32x4 (&acc)[2][2][4][2], const Unit& u, int wr, int wc, int fr, int fq) const {
        const int row0 = u.pm * BM + wr * 64 + fr, col0 = u.pn * HALF + wc * 32 + 8 * fq;
#pragma unroll
        for (int ai = 0; ai < 2; ++ai)
#pragma unroll
            for (int m = 0; m < 4; ++m) { bf16_t* rowp = O + (size_t)(row0 + ai * HALF + m * 16) * ldc + col0;
                float o[8];
#pragma unroll
                for (int n = 0; n < 2; ++n)
#pragma unroll
                    for (int j = 0; j < 4; ++j) { const float a = acc[ai][0][m][n][j], b = acc[ai][1][m][n][j]; o[n * 4 + j] = a * fast_sigmoid(a) * b; }
                u32x4 w; w.x = cvt_pk_bf16(o[0], o[1]); w.y = cvt_pk_bf16(o[2], o[3]); w.z = cvt_pk_bf16(o[4], o[5]); w.w = cvt_pk_bf16(o[6], o[7]);
                *(u32x4*)rowp = w; }
    }
};
struct EpiRkv {
    static constexpr bool PERM = true, AFTER_DRAIN = false;
    bf16_t* O; size_t tstride; bf16_t* L;
    __device__ __forceinline__ void operator()(const f32x4 (&acc)[2][2][4][2], const Unit& u, int wr, int wc, int fr, int fq) const {
        const int row0 = u.pm * BM + wr * 64 + fr;
        if (u.pn < 12) {
            bf16_t* base = O + (size_t)(u.pn >> 2) * tstride; const int col0 = (u.pn & 3) * BM + wc * 32 + 8 * fq;
#pragma unroll
            for (int ai = 0; ai < 2; ++ai)
#pragma unroll
                for (int m = 0; m < 4; ++m) { bf16_t* rowp = base + (size_t)(row0 + ai * HALF + m * 16) * 1024 + col0;
#pragma unroll
                    for (int bj = 0; bj < 2; ++bj) { const f32x4 v0 = acc[ai][bj][m][0], v1 = acc[ai][bj][m][1];
                        u32x4 w; w.x = cvt_pk_bf16(v0[0], v0[1]); w.y = cvt_pk_bf16(v0[2], v0[3]); w.z = cvt_pk_bf16(v1[0], v1[1]); w.w = cvt_pk_bf16(v1[2], v1[3]);
                        *(u32x4*)(rowp + bj * HALF) = w; } }
        } else {
            const int t13 = (u.pn == 13); const int col0 = (u.pn - 12) * BM + wc * 32 + 8 * fq;
#pragma unroll
            for (int ai = 0; ai < 2; ++ai)
#pragma unroll
                for (int m = 0; m < 4; ++m) { bf16_t* rowp = L + (size_t)(row0 + ai * HALF + m * 16) * 384 + col0;
#pragma unroll
                    for (int bj = 0; bj < 2; ++bj) { if (t13 && bj == 1) continue;
                        float o[8];
#pragma unroll
                        for (int n = 0; n < 2; ++n)
#pragma unroll
                            for (int j = 0; j < 4; ++j) { const float a = acc[ai][bj][m][n][j]; o[n * 4 + j] = t13 ? fast_sigmoid(a) : (bj == 0 ? fast_tanh(a) : a); }
                        u32x4 w; w.x = cvt_pk_bf16(o[0], o[1]); w.y = cvt_pk_bf16(o[2], o[3]); w.z = cvt_pk_bf16(o[4], o[5]); w.w = cvt_pk_bf16(o[6], o[7]);
                        *(u32x4*)(rowp + bj * HALF) = w; } }
        }
    }
};

struct EpiAll {
    static constexpr bool PERM = true, AFTER_DRAIN = false;
    int kind; bf16_t* O; int ldc; bf16_t* L; bf16_t* O2;
    __device__ __forceinline__ void operator()(const f32x4 (&acc)[2][2][4][2], const Unit& u, int wr, int wc, int fr, int fq) const {
        if (kind == 0) { EpiStore e{u.part == 2 ? O2 : O, ldc}; e(acc, u, wr, wc, fr, fq); }
        else if (kind == 1) { EpiSwiglu e{O, ldc}; e(acc, u, wr, wc, fr, fq); }
        else if (kind == 2) { EpiRkv e{O, (size_t)24576 * 1024, L}; e(acc, u, wr, wc, fr, fq); }
    }
};
template <class Epi, class Sched, bool STAMP = false>
__device__ __forceinline__ void gemm_phase(PG8_LAS unsigned char* lds, const Gemm g, const Sched& S, const Epi& E, unsigned long long* stamps, const int tid_in) {
    const int tid = tid_in, wid = __builtin_amdgcn_readfirstlane(tid >> 6), lane = tid & 63, wr = wid >> 2, wc = wid & 3, fr = lane & 15, fq = lane >> 4;
    const int K = g.K; int nt = K / BK;
    int ts_lo = 0, ts_hi = 0, nts = 0; const unsigned long long rt_entry = STAMP ? (unsigned long long)wall_clock64() : 0ull;
#define PG8_STAMP() do { if (STAMP && wid == 0 && nts < 64) { const unsigned long long _c = (unsigned long long)clock64(); \
        ts_lo = (lane == nts) ? (int)(unsigned)_c : ts_lo; ts_hi = (lane == nts) ? (int)(unsigned)(_c >> 32) : ts_hi; ++nts; } } while (0)
    PG8_STAMP();
    unsigned voffA[2], voffB[2];
#pragma unroll
    for (int i = 0; i < 2; ++i) { int R, C; stage_rc(tid * 16 + i * 8192, R, C); const int Rb = Epi::PERM ? ((R & ~31) + perm32(R & 31)) : R;
        voffA[i] = (unsigned)(R * K + C) * 2u; voffB[i] = (unsigned)(Rb * K + C) * 2u; }
    const size_t kstep = (size_t)(BK * 2);
    const size_t hstep = (size_t)HALF * K * 2;
    const size_t tstep = 2 * hstep;
    const unsigned ldsw = (unsigned)wid * 1024u;
    const int aoff = lds_byte(wr * 64 + fr, fq * 8), boff = lds_byte(wc * 32 + fr, fq * 8);
#define PG8_SA(b, h) (((b) * 2 + (h)) * HTB)
#define PG8_SB(b, h) ((4 + (b) * 2 + (h)) * HTB)
#define PG8_STAGE(bufoff, gbase, voff) do { _Pragma("unroll") for (int _i = 0; _i < 2; ++_i) \
        __builtin_amdgcn_global_load_lds((const unsigned*)((const char*)(gbase) + (voff)[_i]), (PG8_LAS unsigned*)(lds + (bufoff) + ldsw + _i * 8192), 16, 0, 0); } while (0)
#define PG8_LDA(dst, b, h) do { _Pragma("unroll") for (int m = 0; m < 4; ++m) _Pragma("unroll") for (int k = 0; k < 2; ++k) dst[m][k] = *(const PG8_LAS bf16x8*)(lds + PG8_SA(b, h) + aoff + m * 2048 + k * 1024); } while (0)
#define PG8_LDB(dst, b, h) do { _Pragma("unroll") for (int n = 0; n < 2; ++n) _Pragma("unroll") for (int k = 0; k < 2; ++k) dst[n][k] = *(const PG8_LAS bf16x8*)(lds + PG8_SB(b, h) + boff + n * 2048 + k * 1024); } while (0)
#define PG8_MMA(ai, bj, At, Bt) do { __builtin_amdgcn_s_setprio(1); _Pragma("unroll") for (int m = 0; m < 4; ++m) _Pragma("unroll") for (int n = 0; n < 2; ++n) _Pragma("unroll") for (int k = 0; k < 2; ++k) \
        acc[ai][bj][m][n] = __builtin_amdgcn_mfma_f32_16x16x32_bf16(Bt[n][k], At[m][k], acc[ai][bj][m][n], 0, 0, 0); __builtin_amdgcn_s_setprio(0); } while (0)
#define PG8_WAIT_V(n) asm volatile("s_waitcnt vmcnt(" #n ")" ::: "memory")
#define PG8_WAIT_L(n) asm volatile("s_waitcnt lgkmcnt(" #n ")" ::: "memory")
#define PG8_BAR __builtin_amdgcn_s_barrier()
#define PG8_SCHED __builtin_amdgcn_sched_barrier(0)
    Unit cur, nxt; int ui = 0;
    if (!S.next(0, cur)) return;
    f32x4 acc[2][2][4][2];
#pragma unroll
    for (int a = 0; a < 2; ++a)
#pragma unroll
        for (int b = 0; b < 2; ++b)
#pragma unroll
            for (int m = 0; m < 4; ++m)
#pragma unroll
                for (int n = 0; n < 2; ++n) acc[a][b][m][n] = (f32x4){0.f, 0.f, 0.f, 0.f};
    bf16x8 At[4][2], B0[2][2], B1[2][2];
    const char* cA = (const char*)g.A + (size_t)cur.pm * tstep + (cur.part == 2 ? (size_t)K : (size_t)0); const char* cB = (const char*)g.Bt + (size_t)cur.pn * tstep + (cur.part == 2 ? (size_t)K : (size_t)0);
    nt = cur.part ? K / (2 * BK) : K / BK;
    S.a_ready(cur);
    PG8_STAGE(PG8_SB(0, 0), cB, voffB); PG8_STAGE(PG8_SA(0, 0), cA, voffA); PG8_STAGE(PG8_SB(0, 1), cB + hstep, voffB); PG8_STAGE(PG8_SA(0, 1), cA + hstep, voffA);
    if (wr == 1) PG8_BAR;
    PG8_WAIT_V(4); PG8_BAR;
    PG8_STAGE(PG8_SB(1, 0), cB + kstep, voffB); PG8_STAGE(PG8_SA(1, 0), cA + kstep, voffA); PG8_STAGE(PG8_SB(1, 1), cB + hstep + kstep, voffB);
    PG8_WAIT_V(6); PG8_BAR;
    PG8_STAMP();
    for (;;) {
        const bool has_next = S.next(ui + 1, nxt);
        const char* nA = has_next ? (const char*)g.A + (size_t)nxt.pm * tstep + (nxt.part == 2 ? (size_t)K : (size_t)0) : cA; const char* nB = has_next ? (const char*)g.Bt + (size_t)nxt.pn * tstep + (nxt.part == 2 ? (size_t)K : (size_t)0) : cB;
        for (int t = 0; t < nt; t += 2) {
            const bool last = (t == nt - 2);
            const char* a1 = cA + (size_t)(t + 1) * kstep;
            const char* a2 = last ? nA : cA + (size_t)(t + 2) * kstep; const char* b2 = last ? nB : cB + (size_t)(t + 2) * kstep;
            const char* a3 = a2 + kstep; const char* b3 = b2 + kstep;
            if (last && has_next) S.a_ready(nxt);
            PG8_LDB(B0, 0, 0); PG8_SCHED; PG8_LDA(At, 0, 0); PG8_STAGE(PG8_SA(1, 1), a1 + hstep, voffA);
            PG8_WAIT_L(8); PG8_BAR; PG8_WAIT_L(0); PG8_MMA(0, 0, At, B0); PG8_BAR; PG8_SCHED;
            PG8_LDB(B1, 0, 1); PG8_STAGE(PG8_SB(0, 0), b2, voffB);
            PG8_BAR; PG8_WAIT_L(0); PG8_MMA(0, 1, At, B1); PG8_BAR;
            PG8_LDA(At, 0, 1); PG8_STAGE(PG8_SA(0, 0), a2, voffA);
            PG8_BAR; PG8_WAIT_L(0); PG8_MMA(1, 0, At, B0); PG8_BAR; PG8_SCHED;
            PG8_STAGE(PG8_SB(0, 1), b2 + hstep, voffB);
            PG8_WAIT_V(6); PG8_BAR; PG8_MMA(1, 1, At, B1); PG8_BAR;
            PG8_LDB(B0, 1, 0); PG8_SCHED; PG8_LDA(At, 1, 0); PG8_STAGE(PG8_SA(0, 1), a2 + hstep, voffA);
            PG8_WAIT_L(8); PG8_BAR; PG8_WAIT_L(0); PG8_MMA(0, 0, At, B0); PG8_BAR; PG8_SCHED;
            PG8_LDB(B1, 1, 1); PG8_STAGE(PG8_SB(1, 0), b3, voffB);
            PG8_BAR; PG8_WAIT_L(0); PG8_MMA(0, 1, At, B1); PG8_BAR;
            PG8_LDA(At, 1, 1); PG8_STAGE(PG8_SA(1, 0), a3, voffA);
            PG8_BAR; PG8_WAIT_L(0); PG8_MMA(1, 0, At, B0); PG8_BAR; PG8_SCHED;
            PG8_STAGE(PG8_SB(1, 1), b3 + hstep, voffB);
            PG8_WAIT_V(6); PG8_BAR; PG8_MMA(1, 1, At, B1); PG8_BAR;
        }
        PG8_STAMP();
        if constexpr (!Epi::AFTER_DRAIN) { E(acc, cur, wr, wc, fr, fq); S.done(cur); }
        PG8_STAMP();
        if (!has_next) break;
#pragma unroll
        for (int a = 0; a < 2; ++a)
#pragma unroll
            for (int b = 0; b < 2; ++b)
#pragma unroll
                for (int m = 0; m < 4; ++m)
#pragma unroll
                    for (int n = 0; n < 2; ++n) acc[a][b][m][n] = (f32x4){0.f, 0.f, 0.f, 0.f};
        cur = nxt; cA = nA; cB = nB; ++ui; nt = cur.part ? K / (2 * BK) : K / BK;
    }
    PG8_WAIT_V(0);
    if (wr == 0) PG8_BAR;
    PG8_BAR;
    if constexpr (Epi::AFTER_DRAIN) { E.fused(acc, cur, wr, wc, fr, fq, lds, wid, lane); S.done(cur); }
    PG8_STAMP();
    if (STAMP && wid == 0) { stamps[lane] = lane < nts ? (((unsigned long long)(unsigned)ts_hi << 32) | (unsigned)ts_lo) : 0ull;
        if (lane == 62) stamps[62] = rt_entry; if (lane == 63) stamps[63] = (unsigned long long)wall_clock64(); }
#undef PG8_STAMP
#undef PG8_SA
#undef PG8_SB
#undef PG8_STAGE
#undef PG8_LDA
#undef PG8_LDB
#undef PG8_MMA
#undef PG8_WAIT_V
#undef PG8_WAIT_L
#undef PG8_BAR
#undef PG8_SCHED
}
}

namespace cg = cooperative_groups;
using pg8::bf16_t; using pg8::bf16x8; using pg8::f32x4; using pg8::u32x4; using pg8::cvt_pk_bf16; using pg8::fast_sigmoid;
#define LAS __attribute__((address_space(3)))
typedef float f32x2 __attribute__((ext_vector_type(2)));
typedef unsigned u32x2 __attribute__((ext_vector_type(2)));

constexpr int D = 1024, DFF = 2816, MP = 8192, MS = 16384, MT = 24576;
constexpr int NIN = 31;
constexpr size_t R48 = (size_t)MT * 1024 * 2;
constexpr size_t OFF_A = 0, OFF_B = R48, OFF_C = 2 * R48, OFF_D = 3 * R48, OFF_E = 4 * R48;
constexpr size_t OFF_S = 5 * R48;
constexpr size_t OFF_W = OFF_S + (size_t)MT * 384 * 2;
constexpr size_t W_ELEMS = 9043968;
constexpr size_t OFF_MOD = OFF_W + W_ELEMS * 2;
constexpr size_t OFF_CBP = OFF_MOD + (size_t)9 * 2 * 9216 * 4;
constexpr size_t OFF_BAR = OFF_CBP + (size_t)2 * MT * 64 * 4;
constexpr size_t OFF_W2 = OFF_BAR + 16384;
constexpr size_t OFF_FB = OFF_W2 + W_ELEMS * 2;
constexpr size_t WS_NEED = OFF_FB + (size_t)8192 * 1024 * 2;
constexpr size_t W_W13 = 0, W_W2T = (size_t)5632 * 1024;
constexpr size_t W_BTP = 0, W_BTG = (size_t)3584 * 2048, W_WOT = W_BTG + (size_t)1024 * 384, W_W2L = W_WOT + (size_t)1024 * 1024, W_A2L = W_W2L + 131072;
constexpr float RMS_EPS = 1e-6f, GN_EPS = 64e-5f;

struct Tix { int tid, bid, gd; };
struct Params { const float* in[NIN]; float* out; unsigned char* ws; int pb, pe; };
typedef const Params __attribute__((address_space(4)))* CP;

__device__ __forceinline__ float bf2f(unsigned short b) { return __uint_as_float(((unsigned)b) << 16); }
__device__ __forceinline__ float bflo(unsigned w) { return __uint_as_float(w << 16); }
__device__ __forceinline__ float bfhi(unsigned w) { return __uint_as_float(w & 0xffff0000u); }
template <int CTRL> __device__ __forceinline__ float dpp_f(float x) { return __builtin_bit_cast(float, __builtin_amdgcn_mov_dpp(__builtin_bit_cast(int, x), CTRL, 0xf, 0xf, true)); }
__device__ __forceinline__ float row16_sum(float v) { v += dpp_f<0xB1>(v); v += dpp_f<0x4E>(v); v += dpp_f<0x141>(v); v += dpp_f<0x128>(v); return v; }
__device__ __forceinline__ float wave_sum(float v) {
    v = row16_sum(v);
    auto s1 = __builtin_amdgcn_permlane16_swap(__float_as_uint(v), __float_as_uint(v), false, false); v = __uint_as_float(s1[0]) + __uint_as_float(s1[1]);
    auto s2 = __builtin_amdgcn_permlane32_swap(__float_as_uint(v), __float_as_uint(v), false, false); v = __uint_as_float(s2[0]) + __uint_as_float(s2[1]);
    return v;
}
__device__ __forceinline__ float reduce8(float x) { x += dpp_f<0xB1>(x); x += dpp_f<0x4E>(x); x += dpp_f<0x141>(x); return x; }

struct ConvJob { const float* src; int K, N; bf16_t* dst; int dld, kofs, blk, blk_stride, row_off; const float* ksc; };
__device__ __forceinline__ void conv_job(const ConvJob j, LAS float* tile, int& rot, const Tix tx) {
    const int tid = tx.tid, G = tx.gd;
    const int tn = j.N >> 6, nt = (j.K >> 6) * tn;
    int t0 = (tx.bid - (rot % G) + G) % G;
    for (int t = t0; t < nt; t += G) {
        const int k0 = (t / tn) << 6, n0 = (t % tn) << 6;
        { const int r = tid >> 4, c4 = tid & 15;
#pragma unroll
          for (int it = 0; it < 2; ++it) { const int k = r + 32 * it; const float4 v = *(const float4*)(j.src + (size_t)(k0 + k) * j.N + n0 + 4 * c4);
              LAS float* tp = tile + k * 65 + 4 * c4; tp[0] = v.x; tp[1] = v.y; tp[2] = v.z; tp[3] = v.w; } }
        __syncthreads();
        { const int n = tid >> 3, kg = tid & 7; float v[8];
#pragma unroll
          for (int i = 0; i < 8; ++i) { v[i] = tile[(8 * kg + i) * 65 + n]; if (j.ksc) v[i] *= j.ksc[k0 + 8 * kg + i]; }
          u32x4 w; w.x = cvt_pk_bf16(v[0], v[1]); w.y = cvt_pk_bf16(v[2], v[3]); w.z = cvt_pk_bf16(v[4], v[5]); w.w = cvt_pk_bf16(v[6], v[7]);
          const int gn = n0 + n; const int drow = (gn / j.blk) * j.blk_stride + (gn % j.blk) + j.row_off;
          *(u32x4*)(j.dst + (size_t)drow * j.dld + j.kofs + k0 + 8 * kg) = w; }
        __syncthreads();
    }
    rot += nt;
}
__device__ void conv_ffn(CP p, bf16_t* W, int fi, LAS float* tile, const Tix tx) {
    int rot = 0;
    conv_job(ConvJob{p->in[10] + (size_t)fi * D * DFF, D, DFF, W + W_W13, 1024, 0, 128, 256, 0, nullptr}, tile, rot, tx);
    conv_job(ConvJob{p->in[11] + (size_t)fi * D * DFF, D, DFF, W + W_W13, 1024, 0, 128, 256, 128, nullptr}, tile, rot, tx);
    conv_job(ConvJob{p->in[12] + (size_t)fi * D * DFF, DFF, D, W + W_W2T, 2816, 0, 1024, 1024, 0, nullptr}, tile, rot, tx);
}
__device__ void conv_rwkv(CP p, bf16_t* W, LAS float* tile, const Tix tx) {
    int rot = 0;
    const float* mu = p->in[13];
    for (int half = 0; half < 2; ++half) {
        const int ko = half * 1024;
        for (int i = 0; i < 3; ++i) { const int mi = (i == 0) ? 0 : (i == 1 ? 2 : 3);
            conv_job(ConvJob{p->in[14] + (size_t)i * D * D, D, D, W + W_BTP, 2048, ko, 1024, 1024, i * 1024, half ? mu + mi * D : nullptr}, tile, rot, tx); }
        for (int d = 0; d < 2; ++d) {
            conv_job(ConvJob{p->in[16] + (size_t)d * D * 64, D, 64, W + W_BTP, 2048, ko, 64, 64, 3072 + 64 * d, half ? mu + 1 * D : nullptr}, tile, rot, tx);
            conv_job(ConvJob{p->in[19] + (size_t)d * D * 64, D, 64, W + W_BTP, 2048, ko, 64, 64, 3200 + 64 * d, half ? mu + 4 * D : nullptr}, tile, rot, tx); }
        conv_job(ConvJob{p->in[21], D, 128, W + W_BTP, 2048, ko, 128, 128, 3328, half ? mu + 5 * D : nullptr}, tile, rot, tx);
    }
    conv_job(ConvJob{p->in[22], 128, D, W + W_BTG, 384, 256, 1024, 1024, 0, nullptr}, tile, rot, tx);
    for (int idx = tx.bid * 512 + tx.tid; idx < 1024 * 32; idx += tx.gd * 512) { const int n = idx >> 5, k8 = idx & 31; *(u32x4*)(W + W_BTG + (size_t)n * 384 + 8 * k8) = (u32x4){0u, 0u, 0u, 0u}; }
    conv_job(ConvJob{p->in[28], D, D, W + W_WOT, 1024, 0, 1024, 1024, 0, nullptr}, tile, rot, tx);
    for (int d = 0; d < 2; ++d) {
        conv_job(ConvJob{p->in[17] + (size_t)d * 64 * D, 64, D, W + W_W2L + (size_t)d * 65536, 64, 0, 1024, 1024, 0, nullptr}, tile, rot, tx);
        conv_job(ConvJob{p->in[20] + (size_t)d * 64 * D, 64, D, W + W_A2L + (size_t)d * 65536, 64, 0, 1024, 1024, 0, nullptr}, tile, rot, tx); }
}
__device__ void conv_pool(CP p, bf16_t* W, const Tix tx) {
    const float* pw = p->in[29]; const float* ps = p->in[30];
    for (int idx = tx.bid * 512 + tx.tid; idx < 1024 * 128; idx += tx.gd * 512) {
        const int k8 = idx >> 10, n = idx & 1023, g = n >> 8; u32x4 w = (u32x4){0u, 0u, 0u, 0u};
        if ((k8 >> 5) == g) { const float s = ps[n]; float v[8];
#pragma unroll
            for (int i = 0; i < 8; ++i) v[i] = pw[((size_t)g * 256 + ((8 * k8 + i) & 255)) * 256 + (n & 255)] * s;
            w.x = cvt_pk_bf16(v[0], v[1]); w.y = cvt_pk_bf16(v[2], v[3]); w.z = cvt_pk_bf16(v[4], v[5]); w.w = cvt_pk_bf16(v[6], v[7]); }
        *(u32x4*)(W + (size_t)n * 1024 + 8 * k8) = w; }
}

__device__ void mod_phase(CP p, LAS float* lf, const Tix tx) {
    LAS float* sc = lf; LAS float* red = lf + 9216;
    const int tid = tx.tid;
    if (tx.bid >= 288) return;
    for (int o = tid; o < 9216; o += 512) { const int c = o >> 10, k = o & 1023; const float v = (c == 0) ? p->in[5][k] : p->in[2][(c - 1) * 1024 + k]; sc[o] = v * fast_sigmoid(v); }
    __syncthreads();
    float* mod = (float*)(p->ws + OFF_MOD);
    for (int item = tx.bid; item < 288; item += tx.gd) {
        const int i = item / 144, n0 = (item % 144) * 64, col = tid & 63, ks = tid >> 6;
        float acc[9];
#pragma unroll
        for (int c = 0; c < 9; ++c) acc[c] = 0.f;
        const float* wp = p->in[6] + ((size_t)i * 1024 + ks * 128) * 9216 + n0 + col;
#pragma unroll 8
        for (int k = 0; k < 128; ++k) { const float w = wp[(size_t)k * 9216];
#pragma unroll
            for (int c = 0; c < 9; ++c) acc[c] += sc[c * 1024 + ks * 128 + k] * w; }
#pragma unroll
        for (int c = 0; c < 9; ++c) red[(ks * 9 + c) * 64 + col] = acc[c];
        __syncthreads();
        for (int o = tid; o < 576; o += 512) { const int c = o >> 6, cl = o & 63; float s = p->in[7][i * 9216 + n0 + cl];
#pragma unroll
            for (int k2 = 0; k2 < 8; ++k2) s += red[(k2 * 9 + c) * 64 + cl];
            mod[((size_t)c * 2 + i) * 9216 + n0 + cl] = s; }
        __syncthreads();
    }
}

struct RowCfg {
    int src_input;
    int pending;
    int lg, gidx; float coef; const float* npost;
    int has_next;
    int lh, shidx, scidx; const float* npre;
    int write_x;
    int fsplit;
};
__device__ __forceinline__ const float* xrow_in(CP p, int m) { return m < MP ? p->in[0] + (size_t)m * D : p->in[1] + (size_t)(m - MP) * D; }
__device__ __forceinline__ int cond_of(int m) { return m < MP ? 0 : 1 + ((m - MP) >> 11); }
__device__ __forceinline__ void row_update(CP p, const RowCfg& c, int m, int lane, f32x4 (&x)[4]) {
    const float* xr = c.src_input ? xrow_in(p, m) : p->out + (size_t)m * D;
    const float* mod = (const float*)(p->ws + OFF_MOD);
    const int cd = cond_of(m);
#pragma unroll
    for (int q = 0; q < 4; ++q) x[q] = *(const f32x4*)(xr + 4 * lane + 256 * q);
    if (c.pending) {
        const bf16_t* fr = (const bf16_t*)(p->ws + OFF_E) + (size_t)m * D; f32x4 f[4]; float ss = 0.f;
#pragma unroll
        for (int q = 0; q < 4; ++q) { const u32x2 w = *(const u32x2*)(fr + 4 * lane + 256 * q); f[q] = (f32x4){bflo(w.x), bfhi(w.x), bflo(w.y), bfhi(w.y)}; }
        if (c.fsplit && m >= 16384) {
            const bf16_t* fr2 = (const bf16_t*)(p->ws + OFF_FB) + (size_t)(m - 16384) * D;
#pragma unroll
            for (int q = 0; q < 4; ++q) { const u32x2 w = *(const u32x2*)(fr2 + 4 * lane + 256 * q); f[q] += (f32x4){bflo(w.x), bfhi(w.x), bflo(w.y), bfhi(w.y)}; } }
#pragma unroll
        for (int q = 0; q < 4; ++q) ss += f[q][0] * f[q][0] + f[q][1] * f[q][1] + f[q][2] * f[q][2] + f[q][3] * f[q][3];
        ss = wave_sum(ss); const float rs = rsqrtf(ss * (1.0f / 1024.0f) + RMS_EPS) * c.coef;
        const float* gate = mod + ((size_t)(cd * 2 + c.lg) * 9 + c.gidx) * D;
#pragma unroll
        for (int q = 0; q < 4; ++q) { const f32x4 g = *(const f32x4*)(gate + 4 * lane + 256 * q), np = *(const f32x4*)(c.npost + 4 * lane + 256 * q); x[q] += g * (f[q] * np) * rs; }
    }
}
__device__ __forceinline__ void row_premod(CP p, const RowCfg& c, int m, int lane, const f32x4 (&x)[4], f32x4 (&h)[4]) {
    const float* mod = (const float*)(p->ws + OFF_MOD);
    const int cd = cond_of(m);
    float ss = 0.f;
#pragma unroll
    for (int q = 0; q < 4; ++q) ss += x[q][0] * x[q][0] + x[q][1] * x[q][1] + x[q][2] * x[q][2] + x[q][3] * x[q][3];
    ss = wave_sum(ss); const float rs = rsqrtf(ss * (1.0f / 1024.0f) + RMS_EPS);
    const float* sh = mod + ((size_t)(cd * 2 + c.lh) * 9 + c.shidx) * D; const float* scl = mod + ((size_t)(cd * 2 + c.lh) * 9 + c.scidx) * D;
#pragma unroll
    for (int q = 0; q < 4; ++q) { const f32x4 g = *(const f32x4*)(c.npre + 4 * lane + 256 * q), s1 = *(const f32x4*)(scl + 4 * lane + 256 * q), s0 = *(const f32x4*)(sh + 4 * lane + 256 * q);
        h[q] = (x[q] * rs * g) * (1.0f + s1) + s0; }
}
__device__ __forceinline__ void store_bf16_row(bf16_t* dst, int lane, const f32x4 (&h)[4]) {
#pragma unroll
    for (int q = 0; q < 4; ++q) { u32x2 w; w.x = cvt_pk_bf16(h[q][0], h[q][1]); w.y = cvt_pk_bf16(h[q][2], h[q][3]); *(u32x2*)(dst + 4 * lane + 256 * q) = w; }
}
__device__ void rowpass_simple(CP p, const RowCfg c, const Tix tx) {
    const int lane = tx.tid & 63, wid = tx.tid >> 6, nw = tx.gd * 8;
    bf16_t* hdst = (bf16_t*)(p->ws + OFF_A);
    for (int m = tx.bid * 8 + wid; m < MT; m += nw) {
        f32x4 x[4]; row_update(p, c, m, lane, x);
        if (c.write_x) {
#pragma unroll
            for (int q = 0; q < 4; ++q) *(f32x4*)(p->out + (size_t)m * D + 4 * lane + 256 * q) = x[q]; }
        if (c.has_next) { f32x4 h[4]; row_premod(p, c, m, lane, x, h); store_bf16_row(hdst + (size_t)m * D, lane, h); }
    }
}
__device__ void rowpass_shift(CP p, const RowCfg c, LAS float* lf, const Tix tx) {
    const int lane = tx.tid & 63, wid = tx.tid >> 6;
    bf16_t* adst = (bf16_t*)(p->ws + OFF_A);
    for (int blk = tx.bid; blk < MT / 6; blk += tx.gd) {
        const int m = blk * 6 - 1 + wid;
        f32x4 x[4], h[4];
#pragma unroll
        for (int q = 0; q < 4; ++q) { x[q] = (f32x4){0.f, 0.f, 0.f, 0.f}; h[q] = x[q]; }
        if (m >= 0 && m < MT) {
            row_update(p, c, m, lane, x); row_premod(p, c, m, lane, x, h);
#pragma unroll
            for (int q = 0; q < 4; ++q) *(LAS f32x4*)(lf + wid * 1024 + 4 * lane + 256 * q) = h[q];
        }
        __syncthreads();
        if (wid >= 1 && wid <= 6) {
            const int T = m < MP ? 256 : 2048, t = m < MP ? (m & 255) : ((m - MP) & 2047);
#pragma unroll
            for (int q = 0; q < 4; ++q) *(f32x4*)(p->out + (size_t)m * D + 4 * lane + 256 * q) = x[q];
            f32x4 hs[4];
#pragma unroll
            for (int q = 0; q < 4; ++q) { hs[q] = (f32x4){0.f, 0.f, 0.f, 0.f};
                if (t > 0) hs[q] += *(const LAS f32x4*)(lf + (wid - 1) * 1024 + 4 * lane + 256 * q);
                if (t < T - 1) hs[q] += *(const LAS f32x4*)(lf + (wid + 1) * 1024 + 4 * lane + 256 * q);
                hs[q] = 0.5f * hs[q] - h[q]; }
            store_bf16_row(adst + (size_t)m * 2048, lane, h);
            store_bf16_row(adst + (size_t)m * 2048 + 1024, lane, hs);
        }
        __syncthreads();
    }
}
__device__ void rowpass_gn(CP p, const Tix tx) {
    const int lane = tx.tid & 63, wid = tx.tid >> 6, nw = tx.gd * 8;
    const bf16_t* yf = (const bf16_t*)(p->ws + OFF_A); const bf16_t* yb = (const bf16_t*)(p->ws + OFF_B);
    const bf16_t* gb = (const bf16_t*)(p->ws + OFF_C); const bf16_t* vb = (const bf16_t*)(p->ws + OFF_E);
    bf16_t* ob = (bf16_t*)(p->ws + OFF_D); const float* cbp = (const float*)(p->ws + OFF_CBP);
    const float* gnw = p->in[26]; const float* gnb = p->in[27];
    for (int m = tx.bid * 8 + wid; m < MT; m += nw) {
        f32x4 o[4];
#pragma unroll
        for (int q = 0; q < 4; ++q) {
            const int col = 4 * lane + 256 * q, hd = 4 * q + (lane >> 4);
            const u32x2 a = *(const u32x2*)(yf + (size_t)m * D + col), b = *(const u32x2*)(yb + (size_t)m * D + col);
            f32x4 y = (f32x4){bflo(a.x) + bflo(b.x), bfhi(a.x) + bfhi(b.x), bflo(a.y) + bflo(b.y), bfhi(a.y) + bfhi(b.y)};
            float s = y[0] + y[1] + y[2] + y[3];
            s = row16_sum(s);
            const float mean = s * (1.0f / 64.0f); const f32x4 dv = y - mean;
            float vs = dv[0] * dv[0] + dv[1] * dv[1] + dv[2] * dv[2] + dv[3] * dv[3];
            vs = row16_sum(vs);
            const float rstd = rsqrtf(vs * (1.0f / 64.0f) + GN_EPS);
            const f32x4 c0 = *(const f32x4*)(cbp + ((size_t)m * 16 + hd) * 4), c1 = *(const f32x4*)(cbp + ((size_t)(MT + m) * 16 + hd) * 4);
            const float cb = (c0[0] + c0[1] + c0[2] + c0[3]) + (c1[0] + c1[1] + c1[2] + c1[3]);
            const u32x2 vw = *(const u32x2*)(vb + (size_t)m * D + col), gw = *(const u32x2*)(gb + (size_t)m * D + col);
            const f32x4 v = (f32x4){bflo(vw.x), bfhi(vw.x), bflo(vw.y), bfhi(vw.y)}, g = (f32x4){bflo(gw.x), bfhi(gw.x), bflo(gw.y), bfhi(gw.y)};
            const f32x4 w = *(const f32x4*)(gnw + col), bb = *(const f32x4*)(gnb + col);
            o[q] = (dv * rstd * w + bb + cb * v) * g;
        }
        store_bf16_row(ob + (size_t)m * D, lane, o);
    }
}

__device__ __forceinline__ void pool_acc(float (&acc)[8], const u32x4 w, const float wt) {
    acc[0] += wt * bflo(w.x); acc[1] += wt * bfhi(w.x); acc[2] += wt * bflo(w.y); acc[3] += wt * bfhi(w.y); acc[4] += wt * bflo(w.z); acc[5] += wt * bfhi(w.z); acc[6] += wt * bflo(w.w); acc[7] += wt * bfhi(w.w);
}
template <int WIN> __device__ __forceinline__ void pool_unit(CP p, const int pass, const int pair, const int gi, const int lane) {
    constexpr int HW = WIN / 2;
    const bf16_t* h = (const bf16_t*)(p->ws + OFF_A); bf16_t* t1 = (bf16_t*)(p->ws + OFF_B); bf16_t* dl = (bf16_t*)(p->ws + OFF_D);
    const int m = 2 * pair + (lane >> 5), ch = gi * 256 + 8 * (lane & 31);
    float acc[8];
#pragma unroll
    for (int i = 0; i < 8; ++i) acc[i] = 0.f;
    if (m < MP) {
        if (pass != 0) return;
        const int t = m & 255, mb = m - t;
        u32x4 w[WIN];
#pragma unroll
        for (int k = 0; k < WIN; ++k) { const int tt = t - HW + k; const int tc = min(max(tt, 0), 255); w[k] = *(const u32x4*)(h + (size_t)(mb + tc) * D + ch); }
#pragma unroll
        for (int k = 0; k < WIN; ++k) { const int tt = t - HW + k; pool_acc(acc, w[k], (tt >= 0 && tt < 256) ? 1.0f : 0.0f); }
        const float inv = 1.0f / (float)(min(t + HW, 256) - max(t - HW, 0)); const u32x4 c = w[HW];
        u32x4 o; o.x = cvt_pk_bf16(acc[0] * inv - bflo(c.x), acc[1] * inv - bfhi(c.x)); o.y = cvt_pk_bf16(acc[2] * inv - bflo(c.y), acc[3] * inv - bfhi(c.y));
        o.z = cvt_pk_bf16(acc[4] * inv - bflo(c.z), acc[5] * inv - bfhi(c.z)); o.w = cvt_pk_bf16(acc[6] * inv - bflo(c.w), acc[7] * inv - bfhi(c.w));
        *(u32x4*)(dl + (size_t)m * D + ch) = o;
    } else {
        const int ms = m - MP, pos = ms & 2047, r = pos >> 6, cc = pos & 63, sb = ms - pos;
        if (pass == 0) {
            u32x4 w[WIN];
#pragma unroll
            for (int k = 0; k < WIN; ++k) { const int rr = r - HW + k; const int rc = min(max(rr, 0), 31); w[k] = *(const u32x4*)(h + (size_t)(MP + sb + rc * 64 + cc) * D + ch); }
#pragma unroll
            for (int k = 0; k < WIN; ++k) { const int rr = r - HW + k; pool_acc(acc, w[k], (rr >= 0 && rr < 32) ? 1.0f : 0.0f); }
            const float inv = 1.0f / (float)(min(r + HW, 32) - max(r - HW, 0));
            u32x4 o; o.x = cvt_pk_bf16(acc[0] * inv, acc[1] * inv); o.y = cvt_pk_bf16(acc[2] * inv, acc[3] * inv); o.z = cvt_pk_bf16(acc[4] * inv, acc[5] * inv); o.w = cvt_pk_bf16(acc[6] * inv, acc[7] * inv);
            *(u32x4*)(t1 + (size_t)ms * D + ch) = o;
        } else {
            u32x4 w[WIN];
#pragma unroll
            for (int k = 0; k < WIN; ++k) { const int c2 = cc - HW + k; const int c3 = min(max(c2, 0), 63); w[k] = *(const u32x4*)(t1 + (size_t)(sb + r * 64 + c3) * D + ch); }
#pragma unroll
            for (int k = 0; k < WIN; ++k) { const int c2 = cc - HW + k; pool_acc(acc, w[k], (c2 >= 0 && c2 < 64) ? 1.0f : 0.0f); }
            const float inv = 1.0f / (float)(min(cc + HW, 64) - max(cc - HW, 0)); const u32x4 c = *(const u32x4*)(h + (size_t)m * D + ch);
            u32x4 o; o.x = cvt_pk_bf16(acc[0] * inv - bflo(c.x), acc[1] * inv - bfhi(c.x)); o.y = cvt_pk_bf16(acc[2] * inv - bflo(c.y), acc[3] * inv - bfhi(c.y));
            o.z = cvt_pk_bf16(acc[4] * inv - bflo(c.z), acc[5] * inv - bfhi(c.z)); o.w = cvt_pk_bf16(acc[6] * inv - bflo(c.w), acc[7] * inv - bfhi(c.w));
            *(u32x4*)(dl + (size_t)m * D + ch) = o;
        }
    }
}
__device__ void pool_pass(CP p, int pass, const Tix tx) {
    const int lane = tx.tid & 63, wid = tx.tid >> 6;
    const int first = pass == 0 ? 0 : (MP / 2) * 4, total = (MT / 2) * 4;
    for (int u = first + tx.bid * 8 + wid; u < total; u += tx.gd * 8) {
        const int gi = u & 3, pair = u >> 2;
        if (gi == 0) pool_unit<2>(p, pass, pair, 0, lane); else if (gi == 1) pool_unit<4>(p, pass, pair, 1, lane);
        else if (gi == 2) pool_unit<8>(p, pass, pair, 2, lane); else pool_unit<16>(p, pass, pair, 3, lane);
    }
}

constexpr int SST = 324;
constexpr int SBUF = 16 * SST + 64;
template <int VAR> __device__ void scan_phase(CP p, const bf16_t* W, LAS float* lf, const Tix tx, const int skipmask) {
    const int tid = tx.tid, lane = tid & 63, wid = tid >> 6, grp = wid >> 2, q = wid & 3;
    const int l15 = lane & 15, quad = lane >> 4, rl = lane >> 3, cg8 = lane & 7, i0 = 16 * q + 2 * rl;
    const bf16_t* rb = (const bf16_t*)(p->ws + OFF_C); const bf16_t* kb = (const bf16_t*)(p->ws + OFF_D); const bf16_t* vb = (const bf16_t*)(p->ws + OFF_E);
    const bf16_t* lb = (const bf16_t*)(p->ws + OFF_S);
    bf16_t* yout = (bf16_t*)(p->ws + OFF_A);
    float* cbp = (float*)(p->ws + OFF_CBP);
    const int tch = grp == 0 ? 128 : 16, nsub = grp == 0 ? 1 : ((skipmask & 8) ? 0 : 4);
    for (int it = tx.bid; it < 256; it += tx.gd) {
        f32x2 Sa[4], Sb[4];
        bf16x8 W2f[2], A2f[2];
        LAS float* ystage = lf + 4 * SBUF + 8 * 144 + wid * 1024;
        LAS float* wcst = lf + 4 * SBUF + wid * 144;
#pragma unroll
        for (int i = 0; i < 4; ++i) { Sa[i] = (f32x2){0.f, 0.f}; Sb[i] = (f32x2){0.f, 0.f}; }
        W2f[0] = W2f[1] = A2f[0] = A2f[1] = (bf16x8){0, 0, 0, 0, 0, 0, 0, 0};
        for (int c = -1; c < 128; ++c) {
            const int cn = c + 1; const int g1len = ((skipmask & 8) ? 0 : 4) * 16;
            const int lg = (grp == 1 && cn >= g1len) ? 0 : grp;
            const int ltch = lg == 0 ? 128 : 16; const int subn = cn / ltch, ccn = cn % ltch;
            const bool actn = (cn < 128) && (grp == 1 || cn < g1len);
            u32x2 pr = (u32x2){0u, 0u}, pk = pr, pv = pr; u32x4 pkf0 = (u32x4){0u, 0u, 0u, 0u}, pkf1 = pkf0; bf16x8 plw0 = (bf16x8){0, 0, 0, 0, 0, 0, 0, 0}, plw1 = plw0, pla0 = plw0, pla1 = plw0;
            int mn = 0, dn = 0, hhn = 0;
            if (actn && !(skipmask & 4)) {
                const int pid = lg == 0 ? it : 4 * it + subn; dn = pid & 1; hhn = (pid >> 1) & 15; const int b = pid >> 5;
                const int T = lg == 0 ? 2048 : 256, mb = lg == 0 ? MP + b * 2048 : b * 256;
                const int pos = ccn * 16 + l15; mn = mb + (dn == 0 ? pos : T - 1 - pos);
                const int col4 = 64 * hhn + 16 * q + 4 * quad;
                pr = *(const u32x2*)(rb + (size_t)mn * D + col4); pk = *(const u32x2*)(kb + (size_t)mn * D + col4); pv = *(const u32x2*)(vb + (size_t)mn * D + col4);
                pkf0 = *(const u32x4*)(kb + (size_t)mn * D + 64 * hhn + 16 * quad); pkf1 = *(const u32x4*)(kb + (size_t)mn * D + 64 * hhn + 16 * quad + 8);
                plw0 = *(const bf16x8*)(lb + (size_t)mn * 384 + dn * 64 + 8 * quad); plw1 = *(const bf16x8*)(lb + (size_t)mn * 384 + dn * 64 + 32 + 8 * quad);
                pla0 = *(const bf16x8*)(lb + (size_t)mn * 384 + 128 + dn * 64 + 8 * quad); pla1 = *(const bf16x8*)(lb + (size_t)mn * 384 + 128 + dn * 64 + 32 + 8 * quad);
                if (ccn == 0 || (grp == 1 && lg == 0 && cn == g1len)) {
                    const bf16_t* w2r = W + W_W2L + ((size_t)dn * 1024 + 64 * hhn + 16 * q + l15) * 64 + 8 * quad;
                    const bf16_t* a2r = W + W_A2L + ((size_t)dn * 1024 + 64 * hhn + 16 * q + l15) * 64 + 8 * quad;
                    W2f[0] = *(const bf16x8*)w2r; W2f[1] = *(const bf16x8*)(w2r + 32); A2f[0] = *(const bf16x8*)a2r; A2f[1] = *(const bf16x8*)(a2r + 32);
                    const int cw = 64 * hhn + 16 * q + l15;
                    if (lane < 16) { wcst[lane] = p->in[15][dn * D + cw]; wcst[16 + lane] = p->in[18][dn * D + cw]; wcst[32 + lane] = p->in[23][cw]; wcst[48 + lane] = p->in[24][cw]; wcst[64 + lane] = p->in[25][cw]; }
                    wcst[80 + lane] = p->in[23][64 * hhn + lane];
                }
            }
            const int sub = c < 0 ? 0 : c / tch, cc = c < 0 ? 0 : c % tch; const bool act = (c >= 0) && (sub < nsub);
            if (act && !(skipmask & 1)) {
                const int pid = grp == 0 ? it : 4 * it + sub; const int d = pid & 1, hh = (pid >> 1) & 15, b = pid >> 5;
                const int T = grp == 0 ? 2048 : 256, mb = grp == 0 ? MP + b * 2048 : b * 256;
                if (cc == 0) {
                    if (grp == 0) { const float* s0 = (d == 0 ? p->in[3] : p->in[4]) + ((size_t)(b * 16 + hh) * 64 + i0) * 64 + 8 * cg8;
                        const f32x4 a0 = *(const f32x4*)s0, a1 = *(const f32x4*)(s0 + 4), b0 = *(const f32x4*)(s0 + 64), b1 = *(const f32x4*)(s0 + 68);
                        Sa[0] = a0.lo; Sa[1] = a0.hi; Sa[2] = a1.lo; Sa[3] = a1.hi; Sb[0] = b0.lo; Sb[1] = b0.hi; Sb[2] = b1.lo; Sb[3] = b1.hi; }
                    else {
#pragma unroll
                        for (int i = 0; i < 4; ++i) { Sa[i] = (f32x2){0.f, 0.f}; Sb[i] = (f32x2){0.f, 0.f}; } }
                }
                const LAS float* bp0 = lf + (grp * 2 + (c & 1)) * SBUF;
                bf16_t* yo = yout + (size_t)d * MT * D + 64 * hh + i0;
                f32x4 nk0, nk1, nb0, nb1, nd0, nd1; f32x2 nv; f32x2 rp[4];
#define SCAN_LOAD_K(s_) do { const LAS float* bp_ = bp0 + (s_) * SST + 8 * cg8; nk0 = *(const LAS f32x4*)(bp_); nk1 = *(const LAS f32x4*)(bp_ + 4); } while (0)
#define SCAN_LOAD_R(s_) do { const LAS float* bp_ = bp0 + (s_) * SST + 8 * cg8; const f32x4 r0_ = *(const LAS f32x4*)(bp_ + 192), r1_ = *(const LAS f32x4*)(bp_ + 196); rp[0] = r0_.lo; rp[1] = r0_.hi; rp[2] = r1_.lo; rp[3] = r1_.hi; } while (0)
#define SCAN_LOAD_B(s_) do { const LAS float* bp_ = bp0 + (s_) * SST + 8 * cg8; nb0 = *(const LAS f32x4*)(bp_ + 64); nb1 = *(const LAS f32x4*)(bp_ + 68); \
                    nd0 = *(const LAS f32x4*)(bp_ + 128); nd1 = *(const LAS f32x4*)(bp_ + 132); nv = *(const LAS f32x2*)(bp0 + (s_) * SST + 256 + i0); } while (0)
                SCAN_LOAD_K(0); SCAN_LOAD_B(0);
#pragma unroll
                for (int i = 0; i < 4; ++i) rp[i] = (f32x2){0.f, 0.f};
#define SCAN_YFLUSH(b_) do { const LAS float* ys_ = ystage + cg8 * 128 + 16 * rl; const f32x4 q0_ = *(const LAS f32x4*)(ys_), q1_ = *(const LAS f32x4*)(ys_ + 4), q2_ = *(const LAS f32x4*)(ys_ + 8), q3_ = *(const LAS f32x4*)(ys_ + 12); \
                    const float ye_ = ((q0_[0] + q0_[2]) + (q1_[0] + q1_[2])) + ((q2_[0] + q2_[2]) + (q3_[0] + q3_[2])), yo_ = ((q0_[1] + q0_[3]) + (q1_[1] + q1_[3])) + ((q2_[1] + q2_[3]) + (q3_[1] + q3_[3])); \
                    const int pos_ = cc * 16 + 8 * (b_) + cg8; const int m_ = mb + (d == 0 ? pos_ : T - 1 - pos_); *(unsigned*)(yo + (size_t)m_ * D) = cvt_pk_bf16(ye_, yo_); } while (0)
#pragma unroll
                for (int s = 0; s < 16; ++s) {
                    const f32x2 kk[4] = {nk0.lo, nk0.hi, nk1.lo, nk1.hi};
                    f32x2 pa = Sa[0] * kk[0], pb = Sb[0] * kk[0], ya = Sa[0] * rp[0], yb = Sb[0] * rp[0];
#pragma unroll
                    for (int i = 1; i < 4; ++i) { pa = Sa[i] * kk[i] + pa; pb = Sb[i] * kk[i] + pb; ya = Sa[i] * rp[i] + ya; yb = Sb[i] * rp[i] + yb; }
                    if (s < 15 && !(VAR & 2)) SCAN_LOAD_K(s + 1);
                    if (!(VAR & 2)) SCAN_LOAD_R(s);
                    float sa0 = pa.x + pa.y, sa1 = pb.x + pb.y;
                    if (s > 0) *(LAS f32x2*)(ystage + ((s - 1) & 7) * 128 + 2 * lane) = (f32x2){ya.x + ya.y, yb.x + yb.y};
                    sa0 += dpp_f<0xB1>(sa0); sa1 += dpp_f<0xB1>(sa1);
                    sa0 += dpp_f<0x4E>(sa0); sa1 += dpp_f<0x4E>(sa1);
                    sa0 += dpp_f<0x141>(sa0); sa1 += dpp_f<0x141>(sa1);
                    const f32x2 bb[4] = {nb0.lo, nb0.hi, nb1.lo, nb1.hi}, dd[4] = {nd0.lo, nd0.hi, nd1.lo, nd1.hi};
                    const f32x2 n0 = (f32x2){-sa0, -sa0}, n1 = (f32x2){-sa1, -sa1}, v0 = (f32x2){nv.x, nv.x}, v1 = (f32x2){nv.y, nv.y};
#pragma unroll
                    for (int i = 0; i < 4; ++i) { Sa[i] = n0 * bb[i] + Sa[i]; Sb[i] = n1 * bb[i] + Sb[i]; Sa[i] = v0 * dd[i] + Sa[i]; Sb[i] = v1 * dd[i] + Sb[i]; }
                    if (s < 15 && !(VAR & 1)) SCAN_LOAD_B(s + 1);
                    if (s == 8) SCAN_YFLUSH(0);
                }
                {
                    f32x2 ya = Sa[0] * rp[0], yb = Sb[0] * rp[0];
#pragma unroll
                    for (int i = 1; i < 4; ++i) { ya = Sa[i] * rp[i] + ya; yb = Sb[i] * rp[i] + yb; }
                    *(LAS f32x2*)(ystage + 7 * 128 + 2 * lane) = (f32x2){ya.x + ya.y, yb.x + yb.y};
                    const f32x4 c0 = *(const LAS f32x4*)(bp0 + 16 * SST + 8 * cg8), c1 = *(const LAS f32x4*)(bp0 + 16 * SST + 8 * cg8 + 4);
                    Sa[0] *= c0.lo; Sa[1] *= c0.hi; Sa[2] *= c1.lo; Sa[3] *= c1.hi; Sb[0] *= c0.lo; Sb[1] *= c0.hi; Sb[2] *= c1.lo; Sb[3] *= c1.hi;
                    SCAN_YFLUSH(1);
                }
#undef SCAN_YFLUSH
#undef SCAN_LOAD_K
#undef SCAN_LOAD_R
#undef SCAN_LOAD_B
                if (grp == 1 && cc == tch - 1) {
                    float* sf = p->out + (size_t)MT * D + (size_t)d * (32 * 16 * 4096) + ((size_t)(b * 16 + hh) * 64 + i0) * 64 + 8 * cg8;
                    *(f32x4*)sf = (f32x4){Sa[0].x, Sa[0].y, Sa[1].x, Sa[1].y}; *(f32x4*)(sf + 4) = (f32x4){Sa[2].x, Sa[2].y, Sa[3].x, Sa[3].y};
                    *(f32x4*)(sf + 64) = (f32x4){Sb[0].x, Sb[0].y, Sb[1].x, Sb[1].y}; *(f32x4*)(sf + 68) = (f32x4){Sb[2].x, Sb[2].y, Sb[3].x, Sb[3].y};
                }
            }
            if (actn && !(skipmask & 2)) {
                f32x4 aw = (f32x4){0.f, 0.f, 0.f, 0.f}, aa = aw;
                aw = __builtin_amdgcn_mfma_f32_16x16x32_bf16(W2f[0], plw0, aw, 0, 0, 0); aw = __builtin_amdgcn_mfma_f32_16x16x32_bf16(W2f[1], plw1, aw, 0, 0, 0);
                aa = __builtin_amdgcn_mfma_f32_16x16x32_bf16(A2f[0], pla0, aa, 0, 0, 0); aa = __builtin_amdgcn_mfma_f32_16x16x32_bf16(A2f[1], pla1, aa, 0, 0, 0);
                const f32x4 cw0 = *(const LAS f32x4*)(wcst + 4 * quad), ca0 = *(const LAS f32x4*)(wcst + 16 + 4 * quad), ckk = *(const LAS f32x4*)(wcst + 32 + 4 * quad), cka = *(const LAS f32x4*)(wcst + 48 + 4 * quad), crk = *(const LAS f32x4*)(wcst + 64 + 4 * quad);
                f32x4 kn[4];
#pragma unroll
                for (int i = 0; i < 4; ++i) kn[i] = *(const LAS f32x4*)(wcst + 80 + 16 * quad + 4 * i);
                float ssq = 0.f;
                { const unsigned kw[8] = {pkf0.x, pkf0.y, pkf0.z, pkf0.w, pkf1.x, pkf1.y, pkf1.z, pkf1.w};
#pragma unroll
                  for (int i = 0; i < 8; ++i) { const float a = bflo(kw[i]) * kn[i >> 1][(i & 1) * 2], b2 = bfhi(kw[i]) * kn[i >> 1][(i & 1) * 2 + 1]; ssq += a * a + b2 * b2; } }
                { auto s1 = __builtin_amdgcn_permlane16_swap(__float_as_uint(ssq), __float_as_uint(ssq), false, false); ssq = __uint_as_float(s1[0]) + __uint_as_float(s1[1]);
                  auto s2 = __builtin_amdgcn_permlane32_swap(__float_as_uint(ssq), __float_as_uint(ssq), false, false); ssq = __uint_as_float(s2[0]) + __uint_as_float(s2[1]); }
                const float rn = fminf(__builtin_amdgcn_rsqf(ssq), 1e12f);
                const f32x4 r4 = (f32x4){bflo(pr.x), bfhi(pr.x), bflo(pr.y), bfhi(pr.y)}, k4 = (f32x4){bflo(pk.x), bfhi(pk.x), bflo(pk.y), bfhi(pk.y)}, v4 = (f32x4){bflo(pv.x), bfhi(pv.x), bflo(pv.y), bfhi(pv.y)};
                f32x4 e4, E4, kk4, b4, kd4, rh4, cs4; float cbs = 0.f;
#pragma unroll
                for (int j = 0; j < 4; ++j) { e4[j] = 0.60653066f * fast_sigmoid(cw0[j] + aw[j]);
                    float t = e4[j];
                    t += __builtin_bit_cast(float, __builtin_amdgcn_update_dpp(0, __builtin_bit_cast(int, t), 0x111, 0xf, 0xf, true));
                    t += __builtin_bit_cast(float, __builtin_amdgcn_update_dpp(0, __builtin_bit_cast(int, t), 0x112, 0xf, 0xf, true));
                    t += __builtin_bit_cast(float, __builtin_amdgcn_update_dpp(0, __builtin_bit_cast(int, t), 0x114, 0xf, 0xf, true));
                    t += __builtin_bit_cast(float, __builtin_amdgcn_update_dpp(0, __builtin_bit_cast(int, t), 0x118, 0xf, 0xf, true));
                    E4[j] = t; }
#pragma unroll
                for (int j = 0; j < 4; ++j) {
                    const float a = fast_sigmoid(ca0[j] + aa[j]);
                    const float kkn = k4[j] * ckk[j] * rn, bq = kkn * a, kd = k4[j] * (1.0f + (a - 1.0f) * cka[j]);
                    cbs += r4[j] * kd * crk[j];
                    const float cs = __expf(-E4[j]), cinv = __builtin_amdgcn_rcpf(cs);
                    const float cp = __builtin_bit_cast(float, __builtin_amdgcn_update_dpp(0x3f800000, __builtin_bit_cast(int, cs), 0x111, 0xf, 0xf, false));
                    kk4[j] = kkn * cp; b4[j] = bq * cinv; kd4[j] = kd * cinv; rh4[j] = r4[j] * cs; cs4[j] = cs; }
                LAS float* wb = lf + (lg * 2 + (cn & 1)) * SBUF;
                LAS float* wp = wb + l15 * SST + 16 * q + 4 * quad;
                *(LAS f32x4*)(wp) = kk4; *(LAS f32x4*)(wp + 64) = b4; *(LAS f32x4*)(wp + 128) = kd4; *(LAS f32x4*)(wp + 192) = rh4; *(LAS f32x4*)(wp + 256) = v4;
                if (l15 == 15) *(LAS f32x4*)(wb + 16 * SST + 16 * q + 4 * quad) = cs4;
                { auto s1 = __builtin_amdgcn_permlane16_swap(__float_as_uint(cbs), __float_as_uint(cbs), false, false); cbs = __uint_as_float(s1[0]) + __uint_as_float(s1[1]);
                  auto s2 = __builtin_amdgcn_permlane32_swap(__float_as_uint(cbs), __float_as_uint(cbs), false, false); cbs = __uint_as_float(s2[0]) + __uint_as_float(s2[1]); }
                if (quad == 0) cbp[(((size_t)dn * MT + mn) * 16 + hhn) * 4 + q] = cbs;
            }
            asm volatile("s_waitcnt lgkmcnt(0)" ::: "memory"); __builtin_amdgcn_s_barrier(); asm volatile("" ::: "memory");
        }
    }
}

#define XB_TMO      128
#define XB_XCNT(j)  (256  + 64 * (j))
#define XB_XSUB(j)  (1280 + 64 * (j))
#define XB_XGEN(j)  (2304 + 64 * (j))
#define XB_TOP      3328
#define XB_TOPGEN   3392
#define XCD_BAR_WORDS 3456
#define XB_SPIN_CAP (1u << 18)

__device__ __forceinline__ unsigned xb_ld(unsigned* p)              { return __hip_atomic_load(p, __ATOMIC_RELAXED, __HIP_MEMORY_SCOPE_AGENT); }
__device__ __forceinline__ unsigned xb_add(unsigned* p, unsigned v) { return __hip_atomic_fetch_add(p, v, __ATOMIC_RELAXED, __HIP_MEMORY_SCOPE_AGENT); }
__device__ __forceinline__ unsigned xb_xcc_id() { return (unsigned)__builtin_amdgcn_s_getreg((3 << 11) | 20) & 0xFu; }
#define XB_SPIN(cond, bar) do { unsigned _sp = 0; while (cond) { __builtin_amdgcn_s_sleep(1); \
    if ((++_sp & 255u) == 0u) { if (xb_ld(&(bar)[XB_TMO])) break; if (_sp > XB_SPIN_CAP) { atomicAdd(&(bar)[XB_TMO], 1u); break; } } } } while (0)

struct XcdBarrier {
    unsigned* bar; unsigned x;
    volatile LAS unsigned* st;
};

__device__ __forceinline__ XcdBarrier xcd_barrier_post(unsigned* bar, volatile LAS unsigned* st) {
    XcdBarrier b; b.bar = bar; b.x = xb_xcc_id(); b.st = st;
    if (threadIdx.x == 0) (void)xb_add(&bar[XB_XCNT(b.x)], 1u);
    return b;
}
__device__ __forceinline__ void xcd_barrier_complete(unsigned* bar, unsigned x, unsigned& nloc, unsigned& nx) {
    const unsigned G = gridDim.x * gridDim.y * gridDim.z;
    unsigned sum, cnt, mine, sp = 0u;
    for (;;) {
        sum = 0u; cnt = 0u; mine = 0u;
#pragma unroll
        for (unsigned j = 0; j < 16; ++j) { const unsigned c = xb_ld(&bar[XB_XCNT(j)]); sum += c; cnt += (c > 0u) ? 1u : 0u; mine = (j == x) ? c : mine; }
        if (sum == G) break;
        __builtin_amdgcn_s_sleep(1);
        if ((++sp & 255u) == 0u) { if (xb_ld(&bar[XB_TMO])) break; if (sp > XB_SPIN_CAP) { atomicAdd(&bar[XB_TMO], 1u); break; } }
    }
    nloc = mine > 0u ? mine : 1u; nx = cnt > 0u ? cnt : 1u;
}

__device__ __forceinline__ void xcd_barrier(const XcdBarrier& b) {
    asm volatile("s_waitcnt vmcnt(0)" ::: "memory");
    __syncthreads();
    if (threadIdx.x == 0) {
        unsigned* bar = b.bar;
        __builtin_amdgcn_s_waitcnt(0);
        unsigned nloc = b.st[0], nx = b.st[1];
        if (nloc == 0u) { xcd_barrier_complete(bar, b.x, nloc, nx); b.st[0] = nloc; b.st[1] = nx; }
        const unsigned old = xb_add(&bar[XB_XSUB(b.x)], 1u);
        const unsigned gen = old / nloc;
        if (old + 1u == (gen + 1u) * nloc) {
            __builtin_amdgcn_fence(__ATOMIC_RELEASE, "agent");
            asm volatile("s_waitcnt vmcnt(0)" ::: "memory");
            const unsigned og = xb_add(&bar[XB_TOP], 1u);
            const unsigned tg = og / nx;
            if (og + 1u == (tg + 1u) * nx) xb_add(&bar[XB_TOPGEN], 1u);
            else XB_SPIN(xb_ld(&bar[XB_TOPGEN]) == tg, bar);
            __builtin_amdgcn_fence(__ATOMIC_ACQUIRE, "agent");
            xb_add(&bar[XB_XGEN(b.x)], 1u);
            asm volatile("s_waitcnt vmcnt(0)" ::: "memory");
        } else {
            XB_SPIN(xb_ld(&bar[XB_XGEN(b.x)]) == gen, bar);
            __builtin_amdgcn_fence(__ATOMIC_ACQUIRE, "agent");
            asm volatile("s_waitcnt vmcnt(0)" ::: "memory");
        }
    }
    __syncthreads();
}


constexpr int NPHASE = 24;
#ifndef SPLITK
#define SPLITK 1
#endif
#ifndef ONLYMASK
#define ONLYMASK 0x1ff
#endif
#define EN(k) ((ONLYMASK >> (k)) & 1)
constexpr int LDS_BYTES = 131072 + 16;
__global__ void __launch_bounds__(512, 2) mega(Params kp) {
    extern __shared__ __attribute__((aligned(16))) unsigned char shm[];
    PG8_LAS unsigned char* lds = (PG8_LAS unsigned char*)shm;
    LAS float* lf = (LAS float*)shm;
    cg::grid_group grid = cg::this_grid();
    const int pb = kp.pb, pe = kp.pe;
    volatile LAS unsigned* xst = (volatile LAS unsigned*)(lds + 131072);
    if (threadIdx.x < 2) xst[threadIdx.x] = 0u;
    __syncthreads();
    XcdBarrier xb = xcd_barrier_post((unsigned*)(kp.ws + OFF_BAR), xst);
#ifdef PROBE_SYNC
#pragma unroll 1
    for (int i = 0; i < PROBE_SYNC; ++i) grid.sync();
#endif
#pragma unroll 1
    for (int ph = pb; ph < pe; ++ph) {
        CP p = (CP)__builtin_amdgcn_kernarg_segment_ptr();
        asm volatile("" : "+s"(p));
        Tix tx; { int t_ = threadIdx.x, b_ = blockIdx.x, g_ = gridDim.x; asm volatile("" : "+v"(t_)); asm volatile("" : "+s"(b_), "+s"(g_)); tx.tid = t_; tx.bid = b_; tx.gd = g_; }
        bf16_t* rA = (bf16_t*)(p->ws + OFF_A); bf16_t* rB = (bf16_t*)(p->ws + OFF_B); bf16_t* rC = (bf16_t*)(p->ws + OFF_C); bf16_t* rD = (bf16_t*)(p->ws + OFF_D); bf16_t* rE = (bf16_t*)(p->ws + OFF_E);
        bf16_t* rS = (bf16_t*)(p->ws + OFF_S);
        const int wsel = (ph <= 3) ? 0 : (ph <= 9) ? 1 : (ph <= 12) ? 0 : (ph <= 15) ? 1 : (ph <= 19) ? 0 : 1;
        bf16_t* W = (bf16_t*)(p->ws + (wsel ? OFF_W2 : OFF_W)); bf16_t* Wn = (bf16_t*)(p->ws + (wsel ? OFF_W : OFF_W2));
        const float* npre = p->in[8]; const float* npost = p->in[9];
        int kind = 0;
        RowCfg rc{}; int conv = -1;
        const bf16_t* gA = nullptr; const bf16_t* gB = nullptr; bf16_t* gO = nullptr; int gN = 0, gK = 0, pool_pass_id = 0;
        switch (ph) {
            case 0: kind = 0; break;
            case 1: kind = 1; rc = RowCfg{1, 0, 0, 0, 0.f, npost, 1, 0, 0, 1, npre + 0 * D, 0, SPLITK}; break;
            case 2: case 11: case 14: case 21: kind = 2; break;
            case 3: case 12: case 15: case 22: kind = 3; gA = rB; gB = W + W_W2T; gO = rE; gN = 1024; gK = 2816; conv = (ph == 3) ? 4 : (ph == 12) ? 2 : (ph == 15) ? 5 : -1; break;
            case 4: kind = 4; rc = RowCfg{1, 1, 0, 2, 0.5f, npost + 0 * D, 1, 0, 3, 4, npre + 1 * D, 1, SPLITK}; break;
            case 5: kind = 5; break;
            case 6: kind = 6; break;
            case 7: kind = 3; gA = rS; gB = W + W_BTG; gO = rC; gN = 1024; gK = 384; break;
            case 8: kind = 7; break;
            case 9: kind = 3; gA = rD; gB = W + W_WOT; gO = rE; gN = 1024; gK = 1024; conv = 1; break;
            case 10: kind = 1; rc = RowCfg{0, 1, 0, 5, 1.0f, npost + 1 * D, 1, 0, 6, 7, npre + 2 * D, 1, SPLITK}; break;
            case 13: kind = 1; rc = RowCfg{0, 1, 0, 8, 0.5f, npost + 2 * D, 1, 1, 0, 1, npre + 3 * D, 1, SPLITK}; break;
            case 16: kind = 1; rc = RowCfg{0, 1, 1, 2, 0.5f, npost + 3 * D, 1, 1, 3, 4, npre + 4 * D, 1, SPLITK}; break;
            case 17: kind = 8; pool_pass_id = 0; break;
            case 18: kind = 8; pool_pass_id = 1; break;
            case 19: kind = 3; gA = rD; gB = W; gO = rE; gN = 1024; gK = 1024; conv = 3; break;
            case 20: kind = 1; rc = RowCfg{0, 1, 1, 5, 1.0f, npost + 4 * D, 1, 1, 6, 7, npre + 5 * D, 1, SPLITK}; break;
            case 23: kind = 1; rc = RowCfg{0, 1, 1, 8, 0.5f, npost + 5 * D, 0, 0, 0, 0, npre, 1, SPLITK}; break;
            default: break;
        }
        rc.fsplit = (SPLITK && tx.gd == 256) ? 1 : 0;
#ifdef PROBE_PH
        const int reps = (ph == PROBE_PH) ? PROBE_N : 1;
#else
        const int reps = 1;
#endif
#pragma unroll 1
        for (int rep = 0; rep < reps; ++rep) {
        if (rep > 0) xcd_barrier(xb);
        asm volatile("" : "+v"(tx.tid)); asm volatile("" : "+s"(tx.bid), "+s"(tx.gd)); asm volatile("" : "+s"(p));
        if (EN(0) && kind == 0) { mod_phase(p, lf, tx); __syncthreads(); conv_ffn(p, W, 0, lf + 16384, tx); }
        else if (EN(1) && kind == 1) { rowpass_simple(p, rc, tx); }
        else if (EN(4) && kind == 4) { rowpass_shift(p, rc, lf, tx); }
        else if (EN(2) && (kind == 2 || kind == 3 || kind == 5)) {
            if (kind == 2) { gA = rA; gB = W + W_W13; gO = rB; gN = 5632; gK = 1024; } else if (kind == 5) { gA = rA; gB = W + W_BTP; gO = rC; gN = 3584; gK = 2048; }
            const int bal = (SPLITK && kind == 3 && gK >= 1024 && tx.gd == 256) ? 1 : 0;
            pg8::Gemm g{gA, gB, MT, gN, gK}; pg8::FwdOrder S; S.init(MT, gN, gK, tx.gd, tx.bid, bal);
            pg8::EpiAll E{kind == 3 ? 0 : (kind == 2 ? 1 : 2), gO, kind == 2 ? DFF : 1024, rS, (bf16_t*)(p->ws + OFF_FB) - (size_t)16384 * 1024};
#ifdef PROBE_NOEPI
            if (rep + 1 < reps) E.kind = 7;
#endif
            pg8::gemm_phase<pg8::EpiAll, pg8::FwdOrder, false>(lds, g, S, E, nullptr, tx.tid);
            if (conv >= 0) { const int half = bal ? 0 : (tx.gd >> 1); if (tx.bid >= half) { const Tix tv{tx.tid, tx.bid - half, tx.gd - half};
                if (conv < 4) conv_ffn(p, Wn, conv, lf, tv); else if (conv == 4) conv_rwkv(p, Wn, lf, tv); else conv_pool(p, Wn, tv); } } }
        else if (EN(6) && kind == 6) {
#ifdef PROBE_VAR
            if (rep + 1 < reps) scan_phase<PROBE_VAR>(p, W, lf, tx, 0); else scan_phase<0>(p, W, lf, tx, 0);
#elif defined(PROBE_MASK)
            scan_phase<0>(p, W, lf, tx, (rep + 1 < reps) ? PROBE_MASK : 0);
#else
            scan_phase<0>(p, W, lf, tx, 0);
#endif
        }
        else if (EN(7) && kind == 7) rowpass_gn(p, tx);
        else if (EN(8) && kind == 8) pool_pass(p, pool_pass_id, tx);
        }
        if (ph + 1 < pe) { if (pb > pe) grid.sync(); else xcd_barrier(xb); }
    }
}

#include <cstdio>
#ifndef USE_COOP
#define USE_COOP 1
#endif
extern "C" void kernel_launch(void* const* d_in, const int* in_sizes, int n_in, void* d_out, int out_size, void* d_ws, size_t ws_size, hipStream_t stream) {
    static int grid = 0;
    if (grid == 0) {
        if (n_in != NIN || ws_size < WS_NEED) { fprintf(stderr, "kernel_launch: n_in %d ws %zu (need %zu)\n", n_in, ws_size, (size_t)WS_NEED); grid = -1; return; }
        int dev = 0, cus = 0, per_cu = 0;
        hipGetDevice(&dev); hipDeviceGetAttribute(&cus, hipDeviceAttributeMultiprocessorCount, dev);
        if (hipFuncSetAttribute((const void*)mega, hipFuncAttributeMaxDynamicSharedMemorySize, LDS_BYTES) != hipSuccess) { fprintf(stderr, "kernel_launch: hipFuncSetAttribute failed\n"); grid = -1; return; }
        if (hipOccupancyMaxActiveBlocksPerMultiprocessor(&per_cu, (const void*)mega, 512, LDS_BYTES) != hipSuccess || per_cu < 1) { fprintf(stderr, "kernel_launch: occupancy query says %d\n", per_cu); per_cu = 1; }
        (void)hipGetLastError();
        grid = cus * 1;
        if (grid <= 0) grid = 256;
    }
    if (grid < 0) return;
    if (hipMemsetAsync((unsigned char*)d_ws + OFF_BAR, 0, 16384, stream) != hipSuccess) { fprintf(stderr, "kernel_launch: memset of the barrier words failed\n"); return; }
    Params p{};
    for (int i = 0; i < NIN; ++i) p.in[i] = (const float*)d_in[i];
    p.out = (float*)d_out; p.ws = (unsigned char*)d_ws;
#if USE_COOP
    p.pb = 0; p.pe = NPHASE;
    void* args[] = {&p};
    hipError_t e = hipLaunchCooperativeKernel((const void*)mega, dim3(grid), dim3(512), args, LDS_BYTES, stream);
    if (e != hipSuccess) fprintf(stderr, "cooperative launch failed: %s (grid %d)\n", hipGetErrorString(e), grid);
#else
    for (int ph = 0; ph < NPHASE; ++ph) { p.pb = ph; p.pe = ph + 1; hipLaunchKernelGGL(mega, dim3(grid), dim3(512), LDS_BYTES, stream, p); }
#endif
}
```

```cpp
#include <hip/hip_runtime.h>
#include <hip/hip_cooperative_groups.h>
namespace pg8 {
#define PG8_LAS __attribute__((address_space(3)))
typedef unsigned short bf16_t;
typedef short bf16x8 __attribute__((ext_vector_type(8)));
typedef float f32x4 __attribute__((ext_vector_type(4)));
typedef unsigned u32x4 __attribute__((ext_vector_type(4)));
constexpr int BM = 256, BK = 64, HALF = 128, HTB = HALF * BK * 2  , STAGE_BYTES = 8 * HTB, NXCD = 8, WGM = 8;

__host__ __device__ __forceinline__ int lds_byte(int r, int c) { const int st = (r >> 4) * 2 + (c >> 5), rr = r & 15, cc = c & 31, ob = rr * 64 + cc * 2; return st * 1024 + (ob ^ (((ob >> 9) & 1) << 5)); }
__host__ __device__ __forceinline__ void stage_rc(int b, int& R, int& C) { const int st = b / 1024, sb = b % 1024, swz = sb ^ (((sb >> 9) & 1) << 5); R = (st >> 1) * 16 + swz / 64; C = (st & 1) * 32 + (swz % 64) / 2; }
__host__ __device__ __forceinline__ int perm32(int rho) { const int n = rho >> 4, i = rho & 15; return 8 * (i >> 2) + 4 * n + (i & 3); }

struct Unit { int pm, pn, part; };
struct Gemm { const bf16_t* A; const bf16_t* Bt; int M, N, K; };

struct StaticOrder {
    int nM, nN, nwg, G, c;
    __host__ __device__ void init(int M, int N, int G_, int c_) { nM = M / BM; nN = N / BM; nwg = nM * nN; G = G_; c = c_; }
    __host__ __device__ bool next(int i, Unit& u) const {
        const long L = (long)i * G + c; if (L >= nwg) return false;
        int wgid = (int)L; { const int q = nwg / NXCD, r = nwg % NXCD, xcd = wgid % NXCD, off = wgid / NXCD; wgid = (xcd < r ? xcd * (q + 1) : r * (q + 1) + (xcd - r) * q) + off; }
        const int nig = WGM * nN, gid = wgid / nig, fm = gid * WGM, gsz = (nM - fm) < WGM ? (nM - fm) : WGM;
        u.pm = fm + ((wgid % nig) % gsz); u.pn = (wgid % nig) / gsz; u.part = 0; return true;
    }
    __device__ __forceinline__ void a_ready(const Unit&) const {}
    __device__ __forceinline__ void done(const Unit&) const {}
};
struct FwdOrder {
    StaticOrder so; int mode;
    __host__ __device__ void init(int M, int N, int K, int G_, int c_, int mode_) { so.init(M, N, G_, c_); mode = mode_; }
    __host__ __device__ bool next(int i, Unit& u) const {
        if (mode == 0) return so.next(i, u);
        if (i >= 2) return false;
        const int w = (so.c & 7) * 32 + (so.c >> 3);
        if (i == 0) { u.pm = w >> 2; u.pn = w & 3; u.part = 0; }
        else { u.pm = 64 + (w >> 3); u.pn = (w >> 1) & 3; u.part = 1 + (w & 1); }
        return true;
    }
    __device__ __forceinline__ void a_ready(const Unit&) const {}
    __device__ __forceinline__ void done(const Unit&) const {}
};
__device__ __forceinline__ unsigned cvt_pk_bf16(float lo, float hi) { unsigned r; asm volatile("v_cvt_pk_bf16_f32 %0, %1, %2" : "=v"(r) : "v"(lo), "v"(hi)); return r; }
typedef float f32x2 __attribute__((ext_vector_type(2)));
__device__ __forceinline__ float fast_sigmoid(float x) { return __builtin_amdgcn_rcpf(1.0f + __expf(-x)); }
__device__ __forceinline__ float fast_tanh(float x) { return 1.0f - 2.0f * __builtin_amdgcn_rcpf(1.0f + __expf(2.0f * x)); }
struct EpiStore {
    static constexpr bool PERM = true, AFTER_DRAIN = false;
    bf16_t* O; int ldc;
    __device__ __forceinline__ void operator()(const f32x4 (&acc)[2][2][4][2], const Unit& u, int wr, int wc, int fr, int fq) const {
        const int row0 = u.pm * BM + wr * 64 + fr, col0 = u.pn * BM + wc * 32 + 8 * fq;
#pragma unroll
        for (int ai = 0; ai < 2; ++ai)
#pragma unroll
            for (int m = 0; m < 4; ++m) { bf16_t* rowp = O + (size_t)(row0 + ai * HALF + m * 16) * ldc + col0;
#pragma unroll
                for (int bj = 0; bj < 2; ++bj) { const f32x4 v0 = acc[ai][bj][m][0], v1 = acc[ai][bj][m][1];
                    u32x4 w; w.x = cvt_pk_bf16(v0[0], v0[1]); w.y = cvt_pk_bf16(v0[2], v0[3]); w.z = cvt_pk_bf16(v1[0], v1[1]); w.w = cvt_pk_bf16(v1[2], v1[3]);
                    *(u32x4*)(rowp + bj * HALF) = w; } }
    }
};
struct EpiSwiglu {
    static constexpr bool PERM = true, AFTER_DRAIN = false;
    bf16_t* O; int ldc;
    __device__ __forceinline__ void operator()(const f32x4 (&acc)[2][2][4][2], const Unit& u, int wr, int wc, int fr, int fq) const {
        const int row0 = u.pm * BM + wr * 64 + fr, col0 = u.pn * HALF + wc * 32 + 8 * fq;
#pragma unroll
        for (int ai = 0; ai < 2; ++ai)
#pragma unroll
            for (int m = 0; m < 4; ++m) { bf16_t* rowp = O + (size_t)(row0 + ai * HALF + m * 16) * ldc + col0;
                float o[8];
#pragma unroll
                for (int n = 0; n < 2; ++n)
#pragma unroll
                    for (int j = 0; j < 4; ++j) { const float a = acc[ai][0][m][n][j], b = acc[ai][1][m][n][j]; o[n * 4 + j] = a * fast_sigmoid(a) * b; }
                u32x4 w; w.x = cvt_pk_bf16(o[0], o[1]); w.y = cvt_pk_bf16(o[2], o[3]); w.z = cvt_pk_bf16(o[4], o[5]); w.w = cvt_pk_bf16(o[6], o[7]);
                *(u32x4*)rowp = w; }
    }
};
struct EpiRkv {
    static constexpr bool PERM = true, AFTER_DRAIN = false;
    bf16_t* O; size_t tstride; bf16_t* L;
    __device__ __forceinline__ void operator()(const f32x4 (&acc)[2][2][4][2], const Unit& u, int wr, int wc, int fr, int fq) const {
        const int row0 = u.pm * BM + wr * 64 + fr;
        if (u.pn < 12) {
            bf16_t* base = O + (size_t)(u.pn >> 2) * tstride; const int col0 = (u.pn & 3) * BM + wc * 32 + 8 * fq;
#pragma unroll
            for (int ai = 0; ai < 2; ++ai)
#pragma unroll
                for (int m = 0; m < 4; ++m) { bf16_t* rowp = base + (size_t)(row0 + ai * HALF + m * 16) * 1024 + col0;
#pragma unroll
                    for (int bj = 0; bj < 2; ++bj) { const f32x4 v0 = acc[ai][bj][m][0], v1 = acc[ai][bj][m][1];
                        u32x4 w; w.x = cvt_pk_bf16(v0[0], v0[1]); w.y = cvt_pk_bf16(v0[2], v0[3]); w.z = cvt_pk_bf16(v1[0], v1[1]); w.w = cvt_pk_bf16(v1[2], v1[3]);
                        *(u32x4*)(rowp + bj * HALF) = w; } }
        } else {
            const int t13 = (u.pn == 13); const int col0 = (u.pn - 12) * BM + wc * 32 + 8 * fq;
#pragma unroll
            for (int ai = 0; ai < 2; ++ai)
#pragma unroll
                for (int m = 0; m < 4; ++m) { bf16_t* rowp = L + (size_t)(row0 + ai * HALF + m * 16) * 384 + col0;
#pragma unroll
                    for (int bj = 0; bj < 2; ++bj) { if (t13 && bj == 1) continue;
                        float o[8];
#pragma unroll
                        for (int n = 0; n < 2; ++n)
#pragma unroll
                            for (int j = 0; j < 4; ++j) { const float a = acc[ai][bj][m][n][j]; o[n * 4 + j] = t13 ? fast_sigmoid(a) : (bj == 0 ? fast_tanh(a) : a); }
                        u32x4 w; w.x = cvt_pk_bf16(o[0], o[1]); w.y = cvt_pk_bf16(o[2], o[3]); w.z = cvt_pk_bf16(o[4], o[5]); w.w = cvt_pk_bf16(o[6], o[7]);
                        *(u32x4*)(rowp + bj * HALF) = w; } }
        }
    }
};

struct EpiAll {
    static constexpr bool PERM = true, AFTER_DRAIN = false;
    int kind; bf16_t* O; int ldc; bf16_t* L; bf16_t* O2;
    __device__ __forceinline__ void operator()(const f32x4 (&acc)[2][2][4][2], const Unit& u, int wr, int wc, int fr, int fq) const {
        if (kind == 0) { EpiStore e{u.part == 2 ? O2 : O, ldc}; e(acc, u, wr, wc, fr, fq); }
        else if (kind == 1) { EpiSwiglu e{O, ldc}; e(acc, u, wr, wc, fr, fq); }
        else if (kind == 2) { EpiRkv e{O, (size_t)24576 * 1024, L}; e(acc, u, wr, wc, fr, fq); }
    }
};
template <class Epi, class Sched, bool STAMP = false>
__device__ __forceinline__ void gemm_phase(PG8_LAS unsigned char* lds, const Gemm g, const Sched& S, const Epi& E, unsigned long long* stamps, const int tid_in) {
    const int tid = tid_in, wid = __builtin_amdgcn_readfirstlane(tid >> 6), lane = tid & 63, wr = wid >> 2, wc = wid & 3, fr = lane & 15, fq = lane >> 4;
    const int K = g.K; int nt = K / BK;
    int ts_lo = 0, ts_hi = 0, nts = 0; const unsigned long long rt_entry = STAMP ? (unsigned long long)wall_clock64() : 0ull;
#define PG8_STAMP() do { if (STAMP && wid == 0 && nts < 64) { const unsigned long long _c = (unsigned long long)clock64(); \
        ts_lo = (lane == nts) ? (int)(unsigned)_c : ts_lo; ts_hi = (lane == nts) ? (int)(unsigned)(_c >> 32) : ts_hi; ++nts; } } while (0)
    PG8_STAMP();
    unsigned voffA[2], voffB[2];
#pragma unroll
    for (int i = 0; i < 2; ++i) { int R, C; stage_rc(tid * 16 + i * 8192, R, C); const int Rb = Epi::PERM ? ((R & ~31) + perm32(R & 31)) : R;
        voffA[i] = (unsigned)(R * K + C) * 2u; voffB[i] = (unsigned)(Rb * K + C) * 2u; }
    const size_t kstep = (size_t)(BK * 2);
    const size_t hstep = (size_t)HALF * K * 2;
    const size_t tstep = 2 * hstep;
    const unsigned ldsw = (unsigned)wid * 1024u;
    const int aoff = lds_byte(wr * 64 + fr, fq * 8), boff = lds_byte(wc * 32 + fr, fq * 8);
#define PG8_SA(b, h) (((b) * 2 + (h)) * HTB)
#define PG8_SB(b, h) ((4 + (b) * 2 + (h)) * HTB)
#define PG8_STAGE(bufoff, gbase, voff) do { _Pragma("unroll") for (int _i = 0; _i < 2; ++_i) \
        __builtin_amdgcn_global_load_lds((const unsigned*)((const char*)(gbase) + (voff)[_i]), (PG8_LAS unsigned*)(lds + (bufoff) + ldsw + _i * 8192), 16, 0, 0); } while (0)
#define PG8_LDA(dst, b, h) do { _Pragma("unroll") for (int m = 0; m < 4; ++m) _Pragma("unroll") for (int k = 0; k < 2; ++k) dst[m][k] = *(const PG8_LAS bf16x8*)(lds + PG8_SA(b, h) + aoff + m * 2048 + k * 1024); } while (0)
#define PG8_LDB(dst, b, h) do { _Pragma("unroll") for (int n = 0; n < 2; ++n) _Pragma("unroll") for (int k = 0; k < 2; ++k) dst[n][k] = *(const PG8_LAS bf16x8*)(lds + PG8_SB(b, h) + boff + n * 2048 + k * 1024); } while (0)
#define PG8_MMA(ai, bj, At, Bt) do { __builtin_amdgcn_s_setprio(1); _Pragma("unroll") for (int m = 0; m < 4; ++m) _Pragma("unroll") for (int n = 0; n < 2; ++n) _Pragma("unroll") for (int k = 0; k < 2; ++k) \
        acc[ai][bj][m][n] = __builtin_amdgcn_mfma_f32_16x16x32_bf16(Bt[n][k], At[m][k], acc[ai][bj][m][n], 0, 0, 0); __builtin_amdgcn_s_setprio(0); } while (0)
#define PG8_WAIT_V(n) asm volatile("s_waitcnt vmcnt(" #n ")" ::: "memory")
#define PG8_WAIT_L(n) asm volatile("s_waitcnt lgkmcnt(" #n ")" ::: "memory")
#define PG8_BAR __builtin_amdgcn_s_barrier()
#define PG8_SCHED __builtin_amdgcn_sched_barrier(0)
    Unit cur, nxt; int ui = 0;
    if (!S.next(0, cur)) return;
    f32x4 acc[2][2][4][2];
#pragma unroll
    for (int a = 0; a < 2; ++a)
#pragma unroll
        for (int b = 0; b < 2; ++b)
#pragma unroll
            for (int m = 0; m < 4; ++m)
#pragma unroll
                for (int n = 0; n < 2; ++n) acc[a][b][m][n] = (f32x4){0.f, 0.f, 0.f, 0.f};
    bf16x8 At[4][2], B0[2][2], B1[2][2];
    const char* cA = (const char*)g.A + (size_t)cur.pm * tstep + (cur.part == 2 ? (size_t)K : (size_t)0); const char* cB = (const char*)g.Bt + (size_t)cur.pn * tstep + (cur.part == 2 ? (size_t)K : (size_t)0);
    nt = cur.part ? K / (2 * BK) : K / BK;
    S.a_ready(cur);
    PG8_STAGE(PG8_SB(0, 0), cB, voffB); PG8_STAGE(PG8_SA(0, 0), cA, voffA); PG8_STAGE(PG8_SB(0, 1), cB + hstep, voffB); PG8_STAGE(PG8_SA(0, 1), cA + hstep, voffA);
    if (wr == 1) PG8_BAR;
    PG8_WAIT_V(4); PG8_BAR;
    PG8_STAGE(PG8_SB(1, 0), cB + kstep, voffB); PG8_STAGE(PG8_SA(1, 0), cA + kstep, voffA); PG8_STAGE(PG8_SB(1, 1), cB + hstep + kstep, voffB);
    PG8_WAIT_V(6); PG8_BAR;
    PG8_STAMP();
    for (;;) {
        const bool has_next = S.next(ui + 1, nxt);
        const char* nA = has_next ? (const char*)g.A + (size_t)nxt.pm * tstep + (nxt.part == 2 ? (size_t)K : (size_t)0) : cA; const char* nB = has_next ? (const char*)g.Bt + (size_t)nxt.pn * tstep + (nxt.part == 2 ? (size_t)K : (size_t)0) : cB;
        for (int t = 0; t < nt; t += 2) {
            const bool last = (t == nt - 2);
            const char* a1 = cA + (size_t)(t + 1) * kstep;
            const char* a2 = last ? nA : cA + (size_t)(t + 2) * kstep; const char* b2 = last ? nB : cB + (size_t)(t + 2) * kstep;
            const char* a3 = a2 + kstep; const char* b3 = b2 + kstep;
            if (last && has_next) S.a_ready(nxt);
            PG8_LDB(B0, 0, 0); PG8_SCHED; PG8_LDA(At, 0, 0); PG8_STAGE(PG8_SA(1, 1), a1 + hstep, voffA);
            PG8_WAIT_L(8); PG8_BAR; PG8_WAIT_L(0); PG8_MMA(0, 0, At, B0); PG8_BAR; PG8_SCHED;
            PG8_LDB(B1, 0, 1); PG8_STAGE(PG8_SB(0, 0), b2, voffB);
            PG8_BAR; PG8_WAIT_L(0); PG8_MMA(0, 1, At, B1); PG8_BAR;
            PG8_LDA(At, 0, 1); PG8_STAGE(PG8_SA(0, 0), a2, voffA);
            PG8_BAR; PG8_WAIT_L(0); PG8_MMA(1, 0, At, B0); PG8_BAR; PG8_SCHED;
            PG8_STAGE(PG8_SB(0, 1), b2 + hstep, voffB);
            PG8_WAIT_V(6); PG8_BAR; PG8_MMA(1, 1, At, B1); PG8_BAR;
            PG8_LDB(B0, 1, 0); PG8_SCHED; PG8_LDA(At, 1, 0); PG8_STAGE(PG8_SA(0, 1), a2 + hstep, voffA);
            PG8_WAIT_L(8); PG8_BAR; PG8_WAIT_L(0); PG8_MMA(0, 0, At, B0); PG8_BAR; PG8_SCHED;
            PG8_LDB(B1, 1, 1); PG8_STAGE(PG8_SB(1, 0), b3, voffB);
            PG8_BAR; PG8_WAIT_L(0); PG8_MMA(0, 1, At, B1); PG8_BAR;
            PG8_LDA(At, 1, 1); PG8_STAGE(PG8_SA(1, 0), a3, voffA);
            PG8_BAR; PG8_WAIT_L(0); PG8_MMA(1, 0, At, B0); PG8_BAR; PG8_SCHED;
            PG8_STAGE(PG8_SB(1, 1), b3 + hstep, voffB);
            PG8_WAIT_V(6); PG8_BAR; PG8_MMA(1, 1, At, B1); PG8_BAR;
        }
        PG8_STAMP();
        if constexpr (!Epi::AFTER_DRAIN) { E(acc, cur, wr, wc, fr, fq); S.done(cur); }
        PG8_STAMP();
        if (!has_next) break;
#pragma unroll
        for (int a = 0; a < 2; ++a)
#pragma unroll
            for (int b = 0; b < 2; ++b)
#pragma unroll
                for (int m = 0; m < 4; ++m)
#pragma unroll
                    for (int n = 0; n < 2; ++n) acc[a][b][m][n] = (f32x4){0.f, 0.f, 0.f, 0.f};
        cur = nxt; cA = nA; cB = nB; ++ui; nt = cur.part ? K / (2 * BK) : K / BK;
    }
    PG8_WAIT_V(0);
    if (wr == 0) PG8_BAR;
    PG8_BAR;
    if constexpr (Epi::AFTER_DRAIN) { E.fused(acc, cur, wr, wc, fr, fq, lds, wid, lane); S.done(cur); }
    PG8_STAMP();
    if (STAMP && wid == 0) { stamps[lane] = lane < nts ? (((unsigned long long)(unsigned)ts_hi << 32) | (unsigned)ts_lo) : 0ull;
        if (lane == 62) stamps[62] = rt_entry; if (lane == 63) stamps[63] = (unsigned long long)wall_clock64(); }
#undef PG8_STAMP
#undef PG8_SA
#undef PG8_SB
#undef PG8_STAGE
#undef PG8_LDA
#undef PG8_LDB
#undef PG8_MMA
#undef PG8_WAIT_V
#undef PG8_WAIT_L
#undef PG8_BAR
#undef PG8_SCHED
}
}

namespace cg = cooperative_groups;
using pg8::bf16_t; using pg8::bf16x8; using pg8::f32x4; using pg8::u32x4; using pg8::cvt_pk_bf16; using pg8::fast_sigmoid;
#define LAS __attribute__((address_space(3)))
typedef float f32x2 __attribute__((ext_vector_type(2)));
typedef unsigned u32x2 __attribute__((ext_vector_type(2)));

constexpr int D = 1024, DFF = 2816, MP = 8192, MS = 16384, MT = 24576;
constexpr int NIN = 31;
constexpr size_t R48 = (size_t)MT * 1024 * 2;
constexpr size_t OFF_A = 0, OFF_B = R48, OFF_C = 2 * R48, OFF_D = 3 * R48, OFF_E = 4 * R48;
constexpr size_t OFF_S = 5 * R48;
constexpr size_t OFF_W = OFF_S + (size_t)MT * 384 * 2;
constexpr size_t W_ELEMS = 9043968;
constexpr size_t OFF_MOD = OFF_W + W_ELEMS * 2;
constexpr size_t OFF_CBP = OFF_MOD + (size_t)9 * 2 * 9216 * 4;
constexpr size_t OFF_BAR = OFF_CBP + (size_t)2 * MT * 64 * 4;
constexpr size_t OFF_W2 = OFF_BAR + 16384;
constexpr size_t OFF_FB = OFF_W2 + W_ELEMS * 2;
constexpr size_t WS_NEED = OFF_FB + (size_t)8192 * 1024 * 2;
constexpr size_t W_W13 = 0, W_W2T = (size_t)5632 * 1024;
constexpr size_t W_BTP = 0, W_BTG = (size_t)3584 * 2048, W_WOT = W_BTG + (size_t)1024 * 384, W_W2L = W_WOT + (size_t)1024 * 1024, W_A2L = W_W2L + 131072;
constexpr float RMS_EPS = 1e-6f, GN_EPS = 64e-5f;

struct Tix { int tid, bid, gd; };
struct Params { const float* in[NIN]; float* out; unsigned char* ws; int pb, pe; };
typedef const Params __attribute__((address_space(4)))* CP;

__device__ __forceinline__ float bf2f(unsigned short b) { return __uint_as_float(((unsigned)b) << 16); }
__device__ __forceinline__ float bflo(unsigned w) { return __uint_as_float(w << 16); }
__device__ __forceinline__ float bfhi(unsigned w) { return __uint_as_float(w & 0xffff0000u); }
template <int CTRL> __device__ __forceinline__ float dpp_f(float x) { return __builtin_bit_cast(float, __builtin_amdgcn_mov_dpp(__builtin_bit_cast(int, x), CTRL, 0xf, 0xf, true)); }
__device__ __forceinline__ float row16_sum(float v) { v += dpp_f<0xB1>(v); v += dpp_f<0x4E>(v); v += dpp_f<0x141>(v); v += dpp_f<0x128>(v); return v; }
__device__ __forceinline__ float wave_sum(float v) {
    v = row16_sum(v);
    auto s1 = __builtin_amdgcn_permlane16_swap(__float_as_uint(v), __float_as_uint(v), false, false); v = __uint_as_float(s1[0]) + __uint_as_float(s1[1]);
    auto s2 = __builtin_amdgcn_permlane32_swap(__float_as_uint(v), __float_as_uint(v), false, false); v = __uint_as_float(s2[0]) + __uint_as_float(s2[1]);
    return v;
}
__device__ __forceinline__ float reduce8(float x) { x += dpp_f<0xB1>(x); x += dpp_f<0x4E>(x); x += dpp_f<0x141>(x); return x; }

struct ConvJob { const float* src; int K, N; bf16_t* dst; int dld, kofs, blk, blk_stride, row_off; const float* ksc; };
__device__ __forceinline__ void conv_job(const ConvJob j, LAS float* tile, int& rot, const Tix tx) {
    const int tid = tx.tid, G = tx.gd;
    const int tn = j.N >> 6, nt = (j.K >> 6) * tn;
    int t0 = (tx.bid - (rot % G) + G) % G;
    for (int t = t0; t < nt; t += G) {
        const int k0 = (t / tn) << 6, n0 = (t % tn) << 6;
        { const int r = tid >> 4, c4 = tid & 15;
#pragma unroll
          for (int it = 0; it < 2; ++it) { const int k = r + 32 * it; const float4 v = *(const float4*)(j.src + (size_t)(k0 + k) * j.N + n0 + 4 * c4);
              LAS float* tp = tile + k * 65 + 4 * c4; tp[0] = v.x; tp[1] = v.y; tp[2] = v.z; tp[3] = v.w; } }
        __syncthreads();
        { const int n = tid >> 3, kg = tid & 7; float v[8];
#pragma unroll
          for (int i = 0; i < 8; ++i) { v[i] = tile[(8 * kg + i) * 65 + n]; if (j.ksc) v[i] *= j.ksc[k0 + 8 * kg + i]; }
          u32x4 w; w.x = cvt_pk_bf16(v[0], v[1]); w.y = cvt_pk_bf16(v[2], v[3]); w.z = cvt_pk_bf16(v[4], v[5]); w.w = cvt_pk_bf16(v[6], v[7]);
          const int gn = n0 + n; const int drow = (gn / j.blk) * j.blk_stride + (gn % j.blk) + j.row_off;
          *(u32x4*)(j.dst + (size_t)drow * j.dld + j.kofs + k0 + 8 * kg) = w; }
        __syncthreads();
    }
    rot += nt;
}
__device__ void conv_ffn(CP p, bf16_t* W, int fi, LAS float* tile, const Tix tx) {
    int rot = 0;
    conv_job(ConvJob{p->in[10] + (size_t)fi * D * DFF, D, DFF, W + W_W13, 1024, 0, 128, 256, 0, nullptr}, tile, rot, tx);
    conv_job(ConvJob{p->in[11] + (size_t)fi * D * DFF, D, DFF, W + W_W13, 1024, 0, 128, 256, 128, nullptr}, tile, rot, tx);
    conv_job(ConvJob{p->in[12] + (size_t)fi * D * DFF, DFF, D, W + W_W2T, 2816, 0, 1024, 1024, 0, nullptr}, tile, rot, tx);
}
__device__ void conv_rwkv(CP p, bf16_t* W, LAS float* tile, const Tix tx) {
    int rot = 0;
    const float* mu = p->in[13];
    for (int half = 0; half < 2; ++half) {
        const int ko = half * 1024;
        for (int i = 0; i < 3; ++i) { const int mi = (i == 0) ? 0 : (i == 1 ? 2 : 3);
            conv_job(ConvJob{p->in[14] + (size_t)i * D * D, D, D, W + W_BTP, 2048, ko, 1024, 1024, i * 1024, half ? mu + mi * D : nullptr}, tile, rot, tx); }
        for (int d = 0; d < 2; ++d) {
            conv_job(ConvJob{p->in[16] + (size_t)d * D * 64, D, 64, W + W_BTP, 2048, ko, 64, 64, 3072 + 64 * d, half ? mu + 1 * D : nullptr}, tile, rot, tx);
            conv_job(ConvJob{p->in[19] + (size_t)d * D * 64, D, 64, W + W_BTP, 2048, ko, 64, 64, 3200 + 64 * d, half ? mu + 4 * D : nullptr}, tile, rot, tx); }
        conv_job(ConvJob{p->in[21], D, 128, W + W_BTP, 2048, ko, 128, 128, 3328, half ? mu + 5 * D : nullptr}, tile, rot, tx);
    }
    conv_job(ConvJob{p->in[22], 128, D, W + W_BTG, 384, 256, 1024, 1024, 0, nullptr}, tile, rot, tx);
    for (int idx = tx.bid * 512 + tx.tid; idx < 1024 * 32; idx += tx.gd * 512) { const int n = idx >> 5, k8 = idx & 31; *(u32x4*)(W + W_BTG + (size_t)n * 384 + 8 * k8) = (u32x4){0u, 0u, 0u, 0u}; }
    conv_job(ConvJob{p->in[28], D, D, W + W_WOT, 1024, 0, 1024, 1024, 0, nullptr}, tile, rot, tx);
    for (int d = 0; d < 2; ++d) {
        conv_job(ConvJob{p->in[17] + (size_t)d * 64 * D, 64, D, W + W_W2L + (size_t)d * 65536, 64, 0, 1024, 1024, 0, nullptr}, tile, rot, tx);
        conv_job(ConvJob{p->in[20] + (size_t)d * 64 * D, 64, D, W + W_A2L + (size_t)d * 65536, 64, 0, 1024, 1024, 0, nullptr}, tile, rot, tx); }
}
__device__ void conv_pool(CP p, bf16_t* W, const Tix tx) {
    const float* pw = p->in[29]; const float* ps = p->in[30];
    for (int idx = tx.bid * 512 + tx.tid; idx < 1024 * 128; idx += tx.gd * 512) {
        const int k8 = idx >> 10, n = idx & 1023, g = n >> 8; u32x4 w = (u32x4){0u, 0u, 0u, 0u};
        if ((k8 >> 5) == g) { const float s = ps[n]; float v[8];
#pragma unroll
            for (int i = 0; i < 8; ++i) v[i] = pw[((size_t)g * 256 + ((8 * k8 + i) & 255)) * 256 + (n & 255)] * s;
            w.x = cvt_pk_bf16(v[0], v[1]); w.y = cvt_pk_bf16(v[2], v[3]); w.z = cvt_pk_bf16(v[4], v[5]); w.w = cvt_pk_bf16(v[6], v[7]); }
        *(u32x4*)(W + (size_t)n * 1024 + 8 * k8) = w; }
}

__device__ void mod_phase(CP p, LAS float* lf, const Tix tx) {
    LAS float* sc = lf; LAS float* red = lf + 9216;
    const int tid = tx.tid;
    if (tx.bid >= 288) return;
    for (int o = tid; o < 9216; o += 512) { const int c = o >> 10, k = o & 1023; const float v = (c == 0) ? p->in[5][k] : p->in[2][(c - 1) * 1024 + k]; sc[o] = v * fast_sigmoid(v); }
    __syncthreads();
    float* mod = (float*)(p->ws + OFF_MOD);
    for (int item = tx.bid; item < 288; item += tx.gd) {
        const int i = item / 144, n0 = (item % 144) * 64, col = tid & 63, ks = tid >> 6;
        float acc[9];
#pragma unroll
        for (int c = 0; c < 9; ++c) acc[c] = 0.f;
        const float* wp = p->in[6] + ((size_t)i * 1024 + ks * 128) * 9216 + n0 + col;
#pragma unroll 8
        for (int k = 0; k < 128; ++k) { const float w = wp[(size_t)k * 9216];
#pragma unroll
            for (int c = 0; c < 9; ++c) acc[c] += sc[c * 1024 + ks * 128 + k] * w; }
#pragma unroll
        for (int c = 0; c < 9; ++c) red[(ks * 9 + c) * 64 + col] = acc[c];
        __syncthreads();
        for (int o = tid; o < 576; o += 512) { const int c = o >> 6, cl = o & 63; float s = p->in[7][i * 9216 + n0 + cl];
#pragma unroll
            for (int k2 = 0; k2 < 8; ++k2) s += red[(k2 * 9 + c) * 64 + cl];
            mod[((size_t)c * 2 + i) * 9216 + n0 + cl] = s; }
        __syncthreads();
    }
}

struct RowCfg {
    int src_input;
    int pending;
    int lg, gidx; float coef; const float* npost;
    int has_next;
    int lh, shidx, scidx; const float* npre;
    int write_x;
    int fsplit;
};
__device__ __forceinline__ const float* xrow_in(CP p, int m) { return m < MP ? p->in[0] + (size_t)m * D : p->in[1] + (size_t)(m - MP) * D; }
__device__ __forceinline__ int cond_of(int m) { return m < MP ? 0 : 1 + ((m - MP) >> 11); }
__device__ __forceinline__ void row_update(CP p, const RowCfg& c, int m, int lane, f32x4 (&x)[4]) {
    const float* xr = c.src_input ? xrow_in(p, m) : p->out + (size_t)m * D;
    const float* mod = (const float*)(p->ws + OFF_MOD);
    const int cd = cond_of(m);
#pragma unroll
    for (int q = 0; q < 4; ++q) x[q] = *(const f32x4*)(xr + 4 * lane + 256 * q);
    if (c.pending) {
        const bf16_t* fr = (const bf16_t*)(p->ws + OFF_E) + (size_t)m * D; f32x4 f[4]; float ss = 0.f;
#pragma unroll
        for (int q = 0; q < 4; ++q) { const u32x2 w = *(const u32x2*)(fr + 4 * lane + 256 * q); f[q] = (f32x4){bflo(w.x), bfhi(w.x), bflo(w.y), bfhi(w.y)}; }
        if (c.fsplit && m >= 16384) {
            const bf16_t* fr2 = (const bf16_t*)(p->ws + OFF_FB) + (size_t)(m - 16384) * D;
#pragma unroll
            for (int q = 0; q < 4; ++q) { const u32x2 w = *(const u32x2*)(fr2 + 4 * lane + 256 * q); f[q] += (f32x4){bflo(w.x), bfhi(w.x), bflo(w.y), bfhi(w.y)}; } }
#pragma unroll
        for (int q = 0; q < 4; ++q) ss += f[q][0] * f[q][0] + f[q][1] * f[q][1] + f[q][2] * f[q][2] + f[q][3] * f[q][3];
        ss = wave_sum(ss); const float rs = rsqrtf(ss * (1.0f / 1024.0f) + RMS_EPS) * c.coef;
        const float* gate = mod + ((size_t)(cd * 2 + c.lg) * 9 + c.gidx) * D;
#pragma unroll
        for (int q = 0; q < 4; ++q) { const f32x4 g = *(const f32x4*)(gate + 4 * lane + 256 * q), np = *(const f32x4*)(c.npost + 4 * lane + 256 * q); x[q] += g * (f[q] * np) * rs; }
    }
}
__device__ __forceinline__ void row_premod(CP p, const RowCfg& c, int m, int lane, const f32x4 (&x)[4], f32x4 (&h)[4]) {
    const float* mod = (const float*)(p->ws + OFF_MOD);
    const int cd = cond_of(m);
    float ss = 0.f;
#pragma unroll
    for (int q = 0; q < 4; ++q) ss += x[q][0] * x[q][0] + x[q][1] * x[q][1] + x[q][2] * x[q][2] + x[q][3] * x[q][3];
    ss = wave_sum(ss); const float rs = rsqrtf(ss * (1.0f / 1024.0f) + RMS_EPS);
    const float* sh = mod + ((size_t)(cd * 2 + c.lh) * 9 + c.shidx) * D; const float* scl = mod + ((size_t)(cd * 2 + c.lh) * 9 + c.scidx) * D;
#pragma unroll
    for (int q = 0; q < 4; ++q) { const f32x4 g = *(const f32x4*)(c.npre + 4 * lane + 256 * q), s1 = *(const f32x4*)(scl + 4 * lane + 256 * q), s0 = *(const f32x4*)(sh + 4 * lane + 256 * q);
        h[q] = (x[q] * rs * g) * (1.0f + s1) + s0; }
}
__device__ __forceinline__ void store_bf16_row(bf16_t* dst, int lane, const f32x4 (&h)[4]) {
#pragma unroll
    for (int q = 0; q < 4; ++q) { u32x2 w; w.x = cvt_pk_bf16(h[q][0], h[q][1]); w.y = cvt_pk_bf16(h[q][2], h[q][3]); *(u32x2*)(dst + 4 * lane + 256 * q) = w; }
}
__device__ void rowpass_simple(CP p, const RowCfg c, const Tix tx) {
    const int lane = tx.tid & 63, wid = tx.tid >> 6, nw = tx.gd * 8;
    bf16_t* hdst = (bf16_t*)(p->ws + OFF_A);
    for (int m = tx.bid * 8 + wid; m < MT; m += nw) {
        f32x4 x[4]; row_update(p, c, m, lane, x);
        if (c.write_x) {
#pragma unroll
            for (int q = 0; q < 4; ++q) *(f32x4*)(p->out + (size_t)m * D + 4 * lane + 256 * q) = x[q]; }
        if (c.has_next) { f32x4 h[4]; row_premod(p, c, m, lane, x, h); store_bf16_row(hdst + (size_t)m * D, lane, h); }
    }
}
__device__ void rowpass_shift(CP p, const RowCfg c, LAS float* lf, const Tix tx) {
    const int lane = tx.tid & 63, wid = tx.tid >> 6;
    bf16_t* adst = (bf16_t*)(p->ws + OFF_A);
    for (int blk = tx.bid; blk < MT / 6; blk += tx.gd) {
        const int m = blk * 6 - 1 + wid;
        f32x4 x[4], h[4];
#pragma unroll
        for (int q = 0; q < 4; ++q) { x[q] = (f32x4){0.f, 0.f, 0.f, 0.f}; h[q] = x[q]; }
        if (m >= 0 && m < MT) {
            row_update(p, c, m, lane, x); row_premod(p, c, m, lane, x, h);
#pragma unroll
            for (int q = 0; q < 4; ++q) *(LAS f32x4*)(lf + wid * 1024 + 4 * lane + 256 * q) = h[q];
        }
        __syncthreads();
        if (wid >= 1 && wid <= 6) {
            const int T = m < MP ? 256 : 2048, t = m < MP ? (m & 255) : ((m - MP) & 2047);
#pragma unroll
            for (int q = 0; q < 4; ++q) *(f32x4*)(p->out + (size_t)m * D + 4 * lane + 256 * q) = x[q];
            f32x4 hs[4];
#pragma unroll
            for (int q = 0; q < 4; ++q) { hs[q] = (f32x4){0.f, 0.f, 0.f, 0.f};
                if (t > 0) hs[q] += *(const LAS f32x4*)(lf + (wid - 1) * 1024 + 4 * lane + 256 * q);
                if (t < T - 1) hs[q] += *(const LAS f32x4*)(lf + (wid + 1) * 1024 + 4 * lane + 256 * q);
                hs[q] = 0.5f * hs[q] - h[q]; }
            store_bf16_row(adst + (size_t)m * 2048, lane, h);
            store_bf16_row(adst + (size_t)m * 2048 + 1024, lane, hs);
        }
        __syncthreads();
    }
}
__device__ void rowpass_gn(CP p, const Tix tx) {
    const int lane = tx.tid & 63, wid = tx.tid >> 6, nw = tx.gd * 8;
    const bf16_t* yf = (const bf16_t*)(p->ws + OFF_A); const bf16_t* yb = (const bf16_t*)(p->ws + OFF_B);
    const bf16_t* gb = (const bf16_t*)(p->ws + OFF_C); const bf16_t* vb = (const bf16_t*)(p->ws + OFF_E);
    bf16_t* ob = (bf16_t*)(p->ws + OFF_D); const float* cbp = (const float*)(p->ws + OFF_CBP);
    const float* gnw = p->in[26]; const float* gnb = p->in[27];
    for (int m = tx.bid * 8 + wid; m < MT; m += nw) {
        f32x4 o[4];
#pragma unroll
        for (int q = 0; q < 4; ++q) {
            const int col = 4 * lane + 256 * q, hd = 4 * q + (lane >> 4);
            const u32x2 a = *(const u32x2*)(yf + (size_t)m * D + col), b = *(const u32x2*)(yb + (size_t)m * D + col);
            f32x4 y = (f32x4){bflo(a.x) + bflo(b.x), bfhi(a.x) + bfhi(b.x), bflo(a.y) + bflo(b.y), bfhi(a.y) + bfhi(b.y)};
            float s = y[0] + y[1] + y[2] + y[3];
            s = row16_sum(s);
            const float mean = s * (1.0f / 64.0f); const f32x4 dv = y - mean;
            float vs = dv[0] * dv[0] + dv[1] * dv[1] + dv[2] * dv[2] + dv[3] * dv[3];
            vs = row16_sum(vs);
            const float rstd = rsqrtf(vs * (1.0f / 64.0f) + GN_EPS);
            const f32x4 c0 = *(const f32x4*)(cbp + ((size_t)m * 16 + hd) * 4), c1 = *(const f32x4*)(cbp + ((size_t)(MT + m) * 16 + hd) * 4);
            const float cb = (c0[0] + c0[1] + c0[2] + c0[3]) + (c1[0] + c1[1] + c1[2] + c1[3]);
            const u32x2 vw = *(const u32x2*)(vb + (size_t)m * D + col), gw = *(const u32x2*)(gb + (size_t)m * D + col);
            const f32x4 v = (f32x4){bflo(vw.x), bfhi(vw.x), bflo(vw.y), bfhi(vw.y)}, g = (f32x4){bflo(gw.x), bfhi(gw.x), bflo(gw.y), bfhi(gw.y)};
            const f32x4 w = *(const f32x4*)(gnw + col), bb = *(const f32x4*)(gnb + col);
            o[q] = (dv * rstd * w + bb + cb * v) * g;
        }
        store_bf16_row(ob + (size_t)m * D, lane, o);
    }
}

__device__ __forceinline__ void pool_acc(float (&acc)[8], const u32x4 w, const float wt) {
    acc[0] += wt * bflo(w.x); acc[1] += wt * bfhi(w.x); acc[2] += wt * bflo(w.y); acc[3] += wt * bfhi(w.y); acc[4] += wt * bflo(w.z); acc[5] += wt * bfhi(w.z); acc[6] += wt * bflo(w.w); acc[7] += wt * bfhi(w.w);
}
template <int WIN> __device__ __forceinline__ void pool_unit(CP p, const int pass, const int pair, const int gi, const int lane) {
    constexpr int HW = WIN / 2;
    const bf16_t* h = (const bf16_t*)(p->ws + OFF_A); bf16_t* t1 = (bf16_t*)(p->ws + OFF_B); bf16_t* dl = (bf16_t*)(p->ws + OFF_D);
    const int m = 2 * pair + (lane >> 5), ch = gi * 256 + 8 * (lane & 31);
    float acc[8];
#pragma unroll
    for (int i = 0; i < 8; ++i) acc[i] = 0.f;
    if (m < MP) {
        if (pass != 0) return;
        const int t = m & 255, mb = m - t;
        u32x4 w[WIN];
#pragma unroll
        for (int k = 0; k < WIN; ++k) { const int tt = t - HW + k; const int tc = min(max(tt, 0), 255); w[k] = *(const u32x4*)(h + (size_t)(mb + tc) * D + ch); }
#pragma unroll
        for (int k = 0; k < WIN; ++k) { const int tt = t - HW + k; pool_acc(acc, w[k], (tt >= 0 && tt < 256) ? 1.0f : 0.0f); }
        const float inv = 1.0f / (float)(min(t + HW, 256) - max(t - HW, 0)); const u32x4 c = w[HW];
        u32x4 o; o.x = cvt_pk_bf16(acc[0] * inv - bflo(c.x), acc[1] * inv - bfhi(c.x)); o.y = cvt_pk_bf16(acc[2] * inv - bflo(c.y), acc[3] * inv - bfhi(c.y));
        o.z = cvt_pk_bf16(acc[4] * inv - bflo(c.z), acc[5] * inv - bfhi(c.z)); o.w = cvt_pk_bf16(acc[6] * inv - bflo(c.w), acc[7] * inv - bfhi(c.w));
        *(u32x4*)(dl + (size_t)m * D + ch) = o;
    } else {
        const int ms = m - MP, pos = ms & 2047, r = pos >> 6, cc = pos & 63, sb = ms - pos;
        if (pass == 0) {
            u32x4 w[WIN];
#pragma unroll
            for (int k = 0; k < WIN; ++k) { const int rr = r - HW + k; const int rc = min(max(rr, 0), 31); w[k] = *(const u32x4*)(h + (size_t)(MP + sb + rc * 64 + cc) * D + ch); }
#pragma unroll
            for (int k = 0; k < WIN; ++k) { const int rr = r - HW + k; pool_acc(acc, w[k], (rr >= 0 && rr < 32) ? 1.0f : 0.0f); }
            const float inv = 1.0f / (float)(min(r + HW, 32) - max(r - HW, 0));
            u32x4 o; o.x = cvt_pk_bf16(acc[0] * inv, acc[1] * inv); o.y = cvt_pk_bf16(acc[2] * inv, acc[3] * inv); o.z = cvt_pk_bf16(acc[4] * inv, acc[5] * inv); o.w = cvt_pk_bf16(acc[6] * inv, acc[7] * inv);
            *(u32x4*)(t1 + (size_t)ms * D + ch) = o;
        } else {
            u32x4 w[WIN];
#pragma unroll
            for (int k = 0; k < WIN; ++k) { const int c2 = cc - HW + k; const int c3 = min(max(c2, 0), 63); w[k] = *(const u32x4*)(t1 + (size_t)(sb + r * 64 + c3) * D + ch); }
#pragma unroll
            for (int k = 0; k < WIN; ++k) { const int c2 = cc - HW + k; pool_acc(acc, w[k], (c2 >= 0 && c2 < 64) ? 1.0f : 0.0f); }
            const float inv = 1.0f / (float)(min(cc + HW, 64) - max(cc - HW, 0)); const u32x4 c = *(const u32x4*)(h + (size_t)m * D + ch);
            u32x4 o; o.x = cvt_pk_bf16(acc[0] * inv - bflo(c.x), acc[1] * inv - bfhi(c.x)); o.y = cvt_pk_bf16(acc[2] * inv - bflo(c.y), acc[3] * inv - bfhi(c.y));
            o.z = cvt_pk_bf16(acc[4] * inv - bflo(c.z), acc[5] * inv - bfhi(c.z)); o.w = cvt_pk_bf16(acc[6] * inv - bflo(c.w), acc[7] * inv - bfhi(c.w));
            *(u32x4*)(dl + (size_t)m * D + ch) = o;
        }
    }
}
__device__ void pool_pass(CP p, int pass, const Tix tx) {
    const int lane = tx.tid & 63, wid = tx.tid >> 6;
    const int first = pass == 0 ? 0 : (MP / 2) * 4, total = (MT / 2) * 4;
    for (int u = first + tx.bid * 8 + wid; u < total; u += tx.gd * 8) {
        const int gi = u & 3, pair = u >> 2;
        if (gi == 0) pool_unit<2>(p, pass, pair, 0, lane); else if (gi == 1) pool_unit<4>(p, pass, pair, 1, lane);
        else if (gi == 2) pool_unit<8>(p, pass, pair, 2, lane); else pool_unit<16>(p, pass, pair, 3, lane);
    }
}

constexpr int SST = 324;
constexpr int SBUF = 16 * SST + 64;
template <int VAR> __device__ void scan_phase(CP p, const bf16_t* W, LAS float* lf, const Tix tx, const int skipmask) {
    const int tid = tx.tid, lane = tid & 63, wid = tid >> 6, grp = wid >> 2, q = wid & 3;
    const int l15 = lane & 15, quad = lane >> 4, rl = lane >> 3, cg8 = lane & 7, i0 = 16 * q + 2 * rl;
    const bf16_t* rb = (const bf16_t*)(p->ws + OFF_C); const bf16_t* kb = (const bf16_t*)(p->ws + OFF_D); const bf16_t* vb = (const bf16_t*)(p->ws + OFF_E);
    const bf16_t* lb = (const bf16_t*)(p->ws + OFF_S);
    bf16_t* yout = (bf16_t*)(p->ws + OFF_A);
    float* cbp = (float*)(p->ws + OFF_CBP);
    const int tch = grp == 0 ? 128 : 16, nsub = grp == 0 ? 1 : ((skipmask & 8) ? 0 : 4);
    for (int it = tx.bid; it < 256; it += tx.gd) {
        f32x2 Sa[4], Sb[4];
        bf16x8 W2f[2], A2f[2];
        LAS float* ystage = lf + 4 * SBUF + 8 * 144 + wid * 1024;
        LAS float* wcst = lf + 4 * SBUF + wid * 144;
#pragma unroll
        for (int i = 0; i < 4; ++i) { Sa[i] = (f32x2){0.f, 0.f}; Sb[i] = (f32x2){0.f, 0.f}; }
        W2f[0] = W2f[1] = A2f[0] = A2f[1] = (bf16x8){0, 0, 0, 0, 0, 0, 0, 0};
        u32x2 pr = (u32x2){0u, 0u}, pk = pr, pv = pr; u32x4 pkf0 = (u32x4){0u, 0u, 0u, 0u}, pkf1 = pkf0; bf16x8 plw0 = (bf16x8){0, 0, 0, 0, 0, 0, 0, 0}, plw1 = plw0, pla0 = plw0, pla1 = plw0;
        int mn = 0, dn = 0, hhn = 0, scn = 0, slg = 0; bool sact = false;
        for (int c = -2; c < 128; ++c) {
#pragma unroll 1
          for (int slot = 0; slot < 2; ++slot) {
            if ((slot == 0) == (grp == 1)) {
                if (sact && !(skipmask & 2)) {
                    f32x4 aw = (f32x4){0.f, 0.f, 0.f, 0.f}, aa = aw;
                    aw = __builtin_amdgcn_mfma_f32_16x16x32_bf16(W2f[0], plw0, aw, 0, 0, 0); aw = __builtin_amdgcn_mfma_f32_16x16x32_bf16(W2f[1], plw1, aw, 0, 0, 0);
                    aa = __builtin_amdgcn_mfma_f32_16x16x32_bf16(A2f[0], pla0, aa, 0, 0, 0); aa = __builtin_amdgcn_mfma_f32_16x16x32_bf16(A2f[1], pla1, aa, 0, 0, 0);
                    const f32x4 cw0 = *(const LAS f32x4*)(wcst + 4 * quad), ca0 = *(const LAS f32x4*)(wcst + 16 + 4 * quad), ckk = *(const LAS f32x4*)(wcst + 32 + 4 * quad), cka = *(const LAS f32x4*)(wcst + 48 + 4 * quad), crk = *(const LAS f32x4*)(wcst + 64 + 4 * quad);
                    f32x4 kn[4];
    #pragma unroll
                    for (int i = 0; i < 4; ++i) kn[i] = *(const LAS f32x4*)(wcst + 80 + 16 * quad + 4 * i);
                    float ssq = 0.f;
                    { const unsigned kw[8] = {pkf0.x, pkf0.y, pkf0.z, pkf0.w, pkf1.x, pkf1.y, pkf1.z, pkf1.w};
    #pragma unroll
                      for (int i = 0; i < 8; ++i) { const float a = bflo(kw[i]) * kn[i >> 1][(i & 1) * 2], b2 = bfhi(kw[i]) * kn[i >> 1][(i & 1) * 2 + 1]; ssq += a * a + b2 * b2; } }
                    { auto s1 = __builtin_amdgcn_permlane16_swap(__float_as_uint(ssq), __float_as_uint(ssq), false, false); ssq = __uint_as_float(s1[0]) + __uint_as_float(s1[1]);
                      auto s2 = __builtin_amdgcn_permlane32_swap(__float_as_uint(ssq), __float_as_uint(ssq), false, false); ssq = __uint_as_float(s2[0]) + __uint_as_float(s2[1]); }
                    const float rn = fminf(__builtin_amdgcn_rsqf(ssq), 1e12f);
                    const f32x4 r4 = (f32x4){bflo(pr.x), bfhi(pr.x), bflo(pr.y), bfhi(pr.y)}, k4 = (f32x4){bflo(pk.x), bfhi(pk.x), bflo(pk.y), bfhi(pk.y)}, v4 = (f32x4){bflo(pv.x), bfhi(pv.x), bflo(pv.y), bfhi(pv.y)};
                    f32x4 e4, E4, kk4, b4, kd4, rh4, cs4; float cbs = 0.f;
    #pragma unroll
                    for (int j = 0; j < 4; ++j) { e4[j] = 0.60653066f * fast_sigmoid(cw0[j] + aw[j]);
                        float t = e4[j];
                        t += __builtin_bit_cast(float, __builtin_amdgcn_update_dpp(0, __builtin_bit_cast(int, t), 0x111, 0xf, 0xf, true));
                        t += __builtin_bit_cast(float, __builtin_amdgcn_update_dpp(0, __builtin_bit_cast(int, t), 0x112, 0xf, 0xf, true));
                        t += __builtin_bit_cast(float, __builtin_amdgcn_update_dpp(0, __builtin_bit_cast(int, t), 0x114, 0xf, 0xf, true));
                        t += __builtin_bit_cast(float, __builtin_amdgcn_update_dpp(0, __builtin_bit_cast(int, t), 0x118, 0xf, 0xf, true));
                        E4[j] = t; }
    #pragma unroll
                    for (int j = 0; j < 4; ++j) {
                        const float a = fast_sigmoid(ca0[j] + aa[j]);
                        const float kkn = k4[j] * ckk[j] * rn, bq = kkn * a, kd = k4[j] * (1.0f + (a - 1.0f) * cka[j]);
                        cbs += r4[j] * kd * crk[j];
                        const float cs = __expf(-E4[j]), cinv = __builtin_amdgcn_rcpf(cs);
                        const float cp = __builtin_bit_cast(float, __builtin_amdgcn_update_dpp(0x3f800000, __builtin_bit_cast(int, cs), 0x111, 0xf, 0xf, false));
                        kk4[j] = kkn * cp; b4[j] = bq * cinv; kd4[j] = kd * cinv; rh4[j] = r4[j] * cs; cs4[j] = cs; }
                    LAS float* wb = lf + (slg * 2 + (scn & 1)) * SBUF;
                    LAS float* wp = wb + l15 * SST + 16 * q + 4 * quad;
                    *(LAS f32x4*)(wp) = kk4; *(LAS f32x4*)(wp + 64) = b4; *(LAS f32x4*)(wp + 128) = kd4; *(LAS f32x4*)(wp + 192) = rh4; *(LAS f32x4*)(wp + 256) = v4;
                    if (l15 == 15) *(LAS f32x4*)(wb + 16 * SST + 16 * q + 4 * quad) = cs4;
                    { auto s1 = __builtin_amdgcn_permlane16_swap(__float_as_uint(cbs), __float_as_uint(cbs), false, false); cbs = __uint_as_float(s1[0]) + __uint_as_float(s1[1]);
                      auto s2 = __builtin_amdgcn_permlane32_swap(__float_as_uint(cbs), __float_as_uint(cbs), false, false); cbs = __uint_as_float(s2[0]) + __uint_as_float(s2[1]); }
                    if (quad == 0) cbp[(((size_t)dn * MT + mn) * 16 + hhn) * 4 + q] = cbs;
                }
            }
            if (slot == 0) {
                const int cn = c + 1 + grp; const int g1len = ((skipmask & 8) ? 0 : 4) * 16;
                const int lg = (grp == 1 && cn >= g1len) ? 0 : grp;
                const int ltch = lg == 0 ? 128 : 16; const int subn = cn / ltch, ccn = cn % ltch;
                const bool actn = (cn >= 0) && (cn < 128) && (grp == 1 || cn < g1len);
                sact = actn; scn = cn; slg = lg;
                if (actn && !(skipmask & 4)) {
                    const int pid = lg == 0 ? it : 4 * it + subn; dn = pid & 1; hhn = (pid >> 1) & 15; const int b = pid >> 5;
                    const int T = lg == 0 ? 2048 : 256, mb = lg == 0 ? MP + b * 2048 : b * 256;
                    const int pos = ccn * 16 + l15; mn = mb + (dn == 0 ? pos : T - 1 - pos);
                    const int col4 = 64 * hhn + 16 * q + 4 * quad;
                    pr = *(const u32x2*)(rb + (size_t)mn * D + col4); pk = *(const u32x2*)(kb + (size_t)mn * D + col4); pv = *(const u32x2*)(vb + (size_t)mn * D + col4);
                    pkf0 = *(const u32x4*)(kb + (size_t)mn * D + 64 * hhn + 16 * quad); pkf1 = *(const u32x4*)(kb + (size_t)mn * D + 64 * hhn + 16 * quad + 8);
                    plw0 = *(const bf16x8*)(lb + (size_t)mn * 384 + dn * 64 + 8 * quad); plw1 = *(const bf16x8*)(lb + (size_t)mn * 384 + dn * 64 + 32 + 8 * quad);
                    pla0 = *(const bf16x8*)(lb + (size_t)mn * 384 + 128 + dn * 64 + 8 * quad); pla1 = *(const bf16x8*)(lb + (size_t)mn * 384 + 128 + dn * 64 + 32 + 8 * quad);
                    if (ccn == 0 || (grp == 1 && lg == 0 && cn == g1len)) {
                        const bf16_t* w2r = W + W_W2L + ((size_t)dn * 1024 + 64 * hhn + 16 * q + l15) * 64 + 8 * quad;
                        const bf16_t* a2r = W + W_A2L + ((size_t)dn * 1024 + 64 * hhn + 16 * q + l15) * 64 + 8 * quad;
                        W2f[0] = *(const bf16x8*)w2r; W2f[1] = *(const bf16x8*)(w2r + 32); A2f[0] = *(const bf16x8*)a2r; A2f[1] = *(const bf16x8*)(a2r + 32);
                        const int cw = 64 * hhn + 16 * q + l15;
                        if (lane < 16) { wcst[lane] = p->in[15][dn * D + cw]; wcst[16 + lane] = p->in[18][dn * D + cw]; wcst[32 + lane] = p->in[23][cw]; wcst[48 + lane] = p->in[24][cw]; wcst[64 + lane] = p->in[25][cw]; }
                        wcst[80 + lane] = p->in[23][64 * hhn + lane];
                    }
                }
                const int sub = c < 0 ? 0 : c / tch, cc = c < 0 ? 0 : c % tch; const bool act = (c >= 0) && (sub < nsub);
                if (act && !(skipmask & 1)) {
                    const int pid = grp == 0 ? it : 4 * it + sub; const int d = pid & 1, hh = (pid >> 1) & 15, b = pid >> 5;
                    const int T = grp == 0 ? 2048 : 256, mb = grp == 0 ? MP + b * 2048 : b * 256;
                    if (cc == 0) {
                        if (grp == 0) { const float* s0 = (d == 0 ? p->in[3] : p->in[4]) + ((size_t)(b * 16 + hh) * 64 + i0) * 64 + 8 * cg8;
                            const f32x4 a0 = *(const f32x4*)s0, a1 = *(const f32x4*)(s0 + 4), b0 = *(const f32x4*)(s0 + 64), b1 = *(const f32x4*)(s0 + 68);
                            Sa[0] = a0.lo; Sa[1] = a0.hi; Sa[2] = a1.lo; Sa[3] = a1.hi; Sb[0] = b0.lo; Sb[1] = b0.hi; Sb[2] = b1.lo; Sb[3] = b1.hi; }
                        else {
    #pragma unroll
                            for (int i = 0; i < 4; ++i) { Sa[i] = (f32x2){0.f, 0.f}; Sb[i] = (f32x2){0.f, 0.f}; } }
                    }
                    const LAS float* bp0 = lf + (grp * 2 + (c & 1)) * SBUF;
                    bf16_t* yo = yout + (size_t)d * MT * D + 64 * hh + i0;
                    f32x4 nk0, nk1, nb0, nb1, nd0, nd1; f32x2 nv; f32x2 rp[4];
    #define SCAN_LOAD_K(s_) do { const LAS float* bp_ = bp0 + (s_) * SST + 8 * cg8; nk0 = *(const LAS f32x4*)(bp_); nk1 = *(const LAS f32x4*)(bp_ + 4); } while (0)
    #define SCAN_LOAD_R(s_) do { const LAS float* bp_ = bp0 + (s_) * SST + 8 * cg8; const f32x4 r0_ = *(const LAS f32x4*)(bp_ + 192), r1_ = *(const LAS f32x4*)(bp_ + 196); rp[0] = r0_.lo; rp[1] = r0_.hi; rp[2] = r1_.lo; rp[3] = r1_.hi; } while (0)
    #define SCAN_LOAD_B(s_) do { const LAS float* bp_ = bp0 + (s_) * SST + 8 * cg8; nb0 = *(const LAS f32x4*)(bp_ + 64); nb1 = *(const LAS f32x4*)(bp_ + 68); \
                        nd0 = *(const LAS f32x4*)(bp_ + 128); nd1 = *(const LAS f32x4*)(bp_ + 132); nv = *(const LAS f32x2*)(bp0 + (s_) * SST + 256 + i0); } while (0)
                    SCAN_LOAD_K(0); SCAN_LOAD_B(0);
    #pragma unroll
                    for (int i = 0; i < 4; ++i) rp[i] = (f32x2){0.f, 0.f};
    #define SCAN_YFLUSH(b_) do { const LAS float* ys_ = ystage + cg8 * 128 + 16 * rl; const f32x4 q0_ = *(const LAS f32x4*)(ys_), q1_ = *(const LAS f32x4*)(ys_ + 4), q2_ = *(const LAS f32x4*)(ys_ + 8), q3_ = *(const LAS f32x4*)(ys_ + 12); \
                        const float ye_ = ((q0_[0] + q0_[2]) + (q1_[0] + q1_[2])) + ((q2_[0] + q2_[2]) + (q3_[0] + q3_[2])), yo_ = ((q0_[1] + q0_[3]) + (q1_[1] + q1_[3])) + ((q2_[1] + q2_[3]) + (q3_[1] + q3_[3])); \
                        const int pos_ = cc * 16 + 8 * (b_) + cg8; const int m_ = mb + (d == 0 ? pos_ : T - 1 - pos_); *(unsigned*)(yo + (size_t)m_ * D) = cvt_pk_bf16(ye_, yo_); } while (0)
    #pragma unroll
                    for (int s = 0; s < 16; ++s) {
                        const f32x2 kk[4] = {nk0.lo, nk0.hi, nk1.lo, nk1.hi};
                        f32x2 pa = Sa[0] * kk[0], pb = Sb[0] * kk[0], ya = Sa[0] * rp[0], yb = Sb[0] * rp[0];
    #pragma unroll
                        for (int i = 1; i < 4; ++i) { pa = Sa[i] * kk[i] + pa; pb = Sb[i] * kk[i] + pb; ya = Sa[i] * rp[i] + ya; yb = Sb[i] * rp[i] + yb; }
                        if (s < 15 && !(VAR & 2)) SCAN_LOAD_K(s + 1);
                        if (!(VAR & 2)) SCAN_LOAD_R(s);
                        float sa0 = pa.x + pa.y, sa1 = pb.x + pb.y;
                        if (s > 0) *(LAS f32x2*)(ystage + ((s - 1) & 7) * 128 + 2 * lane) = (f32x2){ya.x + ya.y, yb.x + yb.y};
                        sa0 += dpp_f<0xB1>(sa0); sa1 += dpp_f<0xB1>(sa1);
                        sa0 += dpp_f<0x4E>(sa0); sa1 += dpp_f<0x4E>(sa1);
                        sa0 += dpp_f<0x141>(sa0); sa1 += dpp_f<0x141>(sa1);
                        const f32x2 bb[4] = {nb0.lo, nb0.hi, nb1.lo, nb1.hi}, dd[4] = {nd0.lo, nd0.hi, nd1.lo, nd1.hi};
                        const f32x2 n0 = (f32x2){-sa0, -sa0}, n1 = (f32x2){-sa1, -sa1}, v0 = (f32x2){nv.x, nv.x}, v1 = (f32x2){nv.y, nv.y};
    #pragma unroll
                        for (int i = 0; i < 4; ++i) { Sa[i] = n0 * bb[i] + Sa[i]; Sb[i] = n1 * bb[i] + Sb[i]; Sa[i] = v0 * dd[i] + Sa[i]; Sb[i] = v1 * dd[i] + Sb[i]; }
                        if (s < 15 && !(VAR & 1)) SCAN_LOAD_B(s + 1);
                        if (s == 8) SCAN_YFLUSH(0);
                    }
                    {
                        f32x2 ya = Sa[0] * rp[0], yb = Sb[0] * rp[0];
    #pragma unroll
                        for (int i = 1; i < 4; ++i) { ya = Sa[i] * rp[i] + ya; yb = Sb[i] * rp[i] + yb; }
                        *(LAS f32x2*)(ystage + 7 * 128 + 2 * lane) = (f32x2){ya.x + ya.y, yb.x + yb.y};
                        const f32x4 c0 = *(const LAS f32x4*)(bp0 + 16 * SST + 8 * cg8), c1 = *(const LAS f32x4*)(bp0 + 16 * SST + 8 * cg8 + 4);
                        Sa[0] *= c0.lo; Sa[1] *= c0.hi; Sa[2] *= c1.lo; Sa[3] *= c1.hi; Sb[0] *= c0.lo; Sb[1] *= c0.hi; Sb[2] *= c1.lo; Sb[3] *= c1.hi;
                        SCAN_YFLUSH(1);
                    }
    #undef SCAN_YFLUSH
    #undef SCAN_LOAD_K
    #undef SCAN_LOAD_R
    #undef SCAN_LOAD_B
                    if (grp == 1 && cc == tch - 1) {
                        float* sf = p->out + (size_t)MT * D + (size_t)d * (32 * 16 * 4096) + ((size_t)(b * 16 + hh) * 64 + i0) * 64 + 8 * cg8;
                        *(f32x4*)sf = (f32x4){Sa[0].x, Sa[0].y, Sa[1].x, Sa[1].y}; *(f32x4*)(sf + 4) = (f32x4){Sa[2].x, Sa[2].y, Sa[3].x, Sa[3].y};
                        *(f32x4*)(sf + 64) = (f32x4){Sb[0].x, Sb[0].y, Sb[1].x, Sb[1].y}; *(f32x4*)(sf + 68) = (f32x4){Sb[2].x, Sb[2].y, Sb[3].x, Sb[3].y};
                    }
                }
            }
          }
            asm volatile("s_waitcnt lgkmcnt(0)" ::: "memory"); __builtin_amdgcn_s_barrier(); asm volatile("" ::: "memory");
        }
    }
}

#define XB_TMO      128
#define XB_XCNT(j)  (256  + 64 * (j))
#define XB_XSUB(j)  (1280 + 64 * (j))
#define XB_XGEN(j)  (2304 + 64 * (j))
#define XB_TOP      3328
#define XB_TOPGEN   3392
#define XCD_BAR_WORDS 3456
#define XB_SPIN_CAP (1u << 18)

__device__ __forceinline__ unsigned xb_ld(unsigned* p)              { return __hip_atomic_load(p, __ATOMIC_RELAXED, __HIP_MEMORY_SCOPE_AGENT); }
__device__ __forceinline__ unsigned xb_add(unsigned* p, unsigned v) { return __hip_atomic_fetch_add(p, v, __ATOMIC_RELAXED, __HIP_MEMORY_SCOPE_AGENT); }
__device__ __forceinline__ unsigned xb_xcc_id() { return (unsigned)__builtin_amdgcn_s_getreg((3 << 11) | 20) & 0xFu; }
#define XB_SPIN(cond, bar) do { unsigned _sp = 0; while (cond) { __builtin_amdgcn_s_sleep(1); \
    if ((++_sp & 255u) == 0u) { if (xb_ld(&(bar)[XB_TMO])) break; if (_sp > XB_SPIN_CAP) { atomicAdd(&(bar)[XB_TMO], 1u); break; } } } } while (0)

struct XcdBarrier {
    unsigned* bar; unsigned x;
    volatile LAS unsigned* st;
};

__device__ __forceinline__ XcdBarrier xcd_barrier_post(unsigned* bar, volatile LAS unsigned* st) {
    XcdBarrier b; b.bar = bar; b.x = xb_xcc_id(); b.st = st;
    if (threadIdx.x == 0) (void)xb_add(&bar[XB_XCNT(b.x)], 1u);
    return b;
}
__device__ __forceinline__ void xcd_barrier_complete(unsigned* bar, unsigned x, unsigned& nloc, unsigned& nx) {
    const unsigned G = gridDim.x * gridDim.y * gridDim.z;
    unsigned sum, cnt, mine, sp = 0u;
    for (;;) {
        sum = 0u; cnt = 0u; mine = 0u;
#pragma unroll
        for (unsigned j = 0; j < 16; ++j) { const unsigned c = xb_ld(&bar[XB_XCNT(j)]); sum += c; cnt += (c > 0u) ? 1u : 0u; mine = (j == x) ? c : mine; }
        if (sum == G) break;
        __builtin_amdgcn_s_sleep(1);
        if ((++sp & 255u) == 0u) { if (xb_ld(&bar[XB_TMO])) break; if (sp > XB_SPIN_CAP) { atomicAdd(&bar[XB_TMO], 1u); break; } }
    }
    nloc = mine > 0u ? mine : 1u; nx = cnt > 0u ? cnt : 1u;
}

__device__ __forceinline__ void xcd_barrier(const XcdBarrier& b) {
    asm volatile("s_waitcnt vmcnt(0)" ::: "memory");
    __syncthreads();
    if (threadIdx.x == 0) {
        unsigned* bar = b.bar;
        __builtin_amdgcn_s_waitcnt(0);
        unsigned nloc = b.st[0], nx = b.st[1];
        if (nloc == 0u) { xcd_barrier_complete(bar, b.x, nloc, nx); b.st[0] = nloc; b.st[1] = nx; }
        const unsigned old = xb_add(&bar[XB_XSUB(b.x)], 1u);
        const unsigned gen = old / nloc;
        if (old + 1u == (gen + 1u) * nloc) {
            __builtin_amdgcn_fence(__ATOMIC_RELEASE, "agent");
            asm volatile("s_waitcnt vmcnt(0)" ::: "memory");
            const unsigned og = xb_add(&bar[XB_TOP], 1u);
            const unsigned tg = og / nx;
            if (og + 1u == (tg + 1u) * nx) xb_add(&bar[XB_TOPGEN], 1u);
            else XB_SPIN(xb_ld(&bar[XB_TOPGEN]) == tg, bar);
            __builtin_amdgcn_fence(__ATOMIC_ACQUIRE, "agent");
            xb_add(&bar[XB_XGEN(b.x)], 1u);
            asm volatile("s_waitcnt vmcnt(0)" ::: "memory");
        } else {
            XB_SPIN(xb_ld(&bar[XB_XGEN(b.x)]) == gen, bar);
            __builtin_amdgcn_fence(__ATOMIC_ACQUIRE, "agent");
            asm volatile("s_waitcnt vmcnt(0)" ::: "memory");
        }
    }
    __syncthreads();
}


constexpr int NPHASE = 24;
#ifndef SPLITK
#define SPLITK 1
#endif
#ifndef ONLYMASK
#define ONLYMASK 0x1ff
#endif
#define EN(k) ((ONLYMASK >> (k)) & 1)
constexpr int LDS_BYTES = 131072 + 16;
__global__ void __launch_bounds__(512, 2) mega(Params kp) {
    extern __shared__ __attribute__((aligned(16))) unsigned char shm[];
    PG8_LAS unsigned char* lds = (PG8_LAS unsigned char*)shm;
    LAS float* lf = (LAS float*)shm;
    cg::grid_group grid = cg::this_grid();
    const int pb = kp.pb, pe = kp.pe;
    volatile LAS unsigned* xst = (volatile LAS unsigned*)(lds + 131072);
    if (threadIdx.x < 2) xst[threadIdx.x] = 0u;
    __syncthreads();
    XcdBarrier xb = xcd_barrier_post((unsigned*)(kp.ws + OFF_BAR), xst);
#ifdef PROBE_SYNC
#pragma unroll 1
    for (int i = 0; i < PROBE_SYNC; ++i) grid.sync();
#endif
#pragma unroll 1
    for (int ph = pb; ph < pe; ++ph) {
        CP p = (CP)__builtin_amdgcn_kernarg_segment_ptr();
        asm volatile("" : "+s"(p));
        Tix tx; { int t_ = threadIdx.x, b_ = blockIdx.x, g_ = gridDim.x; asm volatile("" : "+v"(t_)); asm volatile("" : "+s"(b_), "+s"(g_)); tx.tid = t_; tx.bid = b_; tx.gd = g_; }
        bf16_t* rA = (bf16_t*)(p->ws + OFF_A); bf16_t* rB = (bf16_t*)(p->ws + OFF_B); bf16_t* rC = (bf16_t*)(p->ws + OFF_C); bf16_t* rD = (bf16_t*)(p->ws + OFF_D); bf16_t* rE = (bf16_t*)(p->ws + OFF_E);
        bf16_t* rS = (bf16_t*)(p->ws + OFF_S);
        const int wsel = (ph <= 3) ? 0 : (ph <= 9) ? 1 : (ph <= 12) ? 0 : (ph <= 15) ? 1 : (ph <= 19) ? 0 : 1;
        bf16_t* W = (bf16_t*)(p->ws + (wsel ? OFF_W2 : OFF_W)); bf16_t* Wn = (bf16_t*)(p->ws + (wsel ? OFF_W : OFF_W2));
        const float* npre = p->in[8]; const float* npost = p->in[9];
        int kind = 0;
        RowCfg rc{}; int conv = -1;
        const bf16_t* gA = nullptr; const bf16_t* gB = nullptr; bf16_t* gO = nullptr; int gN = 0, gK = 0, pool_pass_id = 0;
        switch (ph) {
            case 0: kind = 0; break;
            case 1: kind = 1; rc = RowCfg{1, 0, 0, 0, 0.f, npost, 1, 0, 0, 1, npre + 0 * D, 0, SPLITK}; break;
            case 2: case 11: case 14: case 21: kind = 2; break;
            case 3: case 12: case 15: case 22: kind = 3; gA = rB; gB = W + W_W2T; gO = rE; gN = 1024; gK = 2816; conv = (ph == 3) ? 4 : (ph == 12) ? 2 : (ph == 15) ? 5 : -1; break;
            case 4: kind = 4; rc = RowCfg{1, 1, 0, 2, 0.5f, npost + 0 * D, 1, 0, 3, 4, npre + 1 * D, 1, SPLITK}; break;
            case 5: kind = 5; break;
            case 6: kind = 6; break;
            case 7: kind = 3; gA = rS; gB = W + W_BTG; gO = rC; gN = 1024; gK = 384; break;
            case 8: kind = 7; break;
            case 9: kind = 3; gA = rD; gB = W + W_WOT; gO = rE; gN = 1024; gK = 1024; conv = 1; break;
            case 10: kind = 1; rc = RowCfg{0, 1, 0, 5, 1.0f, npost + 1 * D, 1, 0, 6, 7, npre + 2 * D, 1, SPLITK}; break;
            case 13: kind = 1; rc = RowCfg{0, 1, 0, 8, 0.5f, npost + 2 * D, 1, 1, 0, 1, npre + 3 * D, 1, SPLITK}; break;
            case 16: kind = 1; rc = RowCfg{0, 1, 1, 2, 0.5f, npost + 3 * D, 1, 1, 3, 4, npre + 4 * D, 1, SPLITK}; break;
            case 17: kind = 8; pool_pass_id = 0; break;
            case 18: kind = 8; pool_pass_id = 1; break;
            case 19: kind = 3; gA = rD; gB = W; gO = rE; gN = 1024; gK = 1024; conv = 3; break;
            case 20: kind = 1; rc = RowCfg{0, 1, 1, 5, 1.0f, npost + 4 * D, 1, 1, 6, 7, npre + 5 * D, 1, SPLITK}; break;
            case 23: kind = 1; rc = RowCfg{0, 1, 1, 8, 0.5f, npost + 5 * D, 0, 0, 0, 0, npre, 1, SPLITK}; break;
            default: break;
        }
        rc.fsplit = (SPLITK && tx.gd == 256) ? 1 : 0;
#ifdef PROBE_PH
        const int reps = (ph == PROBE_PH) ? PROBE_N : 1;
#else
        const int reps = 1;
#endif
#pragma unroll 1
        for (int rep = 0; rep < reps; ++rep) {
        if (rep > 0) xcd_barrier(xb);
        asm volatile("" : "+v"(tx.tid)); asm volatile("" : "+s"(tx.bid), "+s"(tx.gd)); asm volatile("" : "+s"(p));
        if (EN(0) && kind == 0) { mod_phase(p, lf, tx); __syncthreads(); conv_ffn(p, W, 0, lf + 16384, tx); }
        else if (EN(1) && kind == 1) { rowpass_simple(p, rc, tx); }
        else if (EN(4) && kind == 4) { rowpass_shift(p, rc, lf, tx); }
        else if (EN(2) && (kind == 2 || kind == 3 || kind == 5)) {
            if (kind == 2) { gA = rA; gB = W + W_W13; gO = rB; gN = 5632; gK = 1024; } else if (kind == 5) { gA = rA; gB = W + W_BTP; gO = rC; gN = 3584; gK = 2048; }
            const int bal = (SPLITK && kind == 3 && gK >= 1024 && tx.gd == 256) ? 1 : 0;
            pg8::Gemm g{gA, gB, MT, gN, gK}; pg8::FwdOrder S; S.init(MT, gN, gK, tx.gd, tx.bid, bal);
            pg8::EpiAll E{kind == 3 ? 0 : (kind == 2 ? 1 : 2), gO, kind == 2 ? DFF : 1024, rS, (bf16_t*)(p->ws + OFF_FB) - (size_t)16384 * 1024};
#ifdef PROBE_NOEPI
            if (rep + 1 < reps) E.kind = 7;
#endif
            pg8::gemm_phase<pg8::EpiAll, pg8::FwdOrder, false>(lds, g, S, E, nullptr, tx.tid);
            if (conv >= 0) { const int half = bal ? 0 : (tx.gd >> 1); if (tx.bid >= half) { const Tix tv{tx.tid, tx.bid - half, tx.gd - half};
                if (conv < 4) conv_ffn(p, Wn, conv, lf, tv); else if (conv == 4) conv_rwkv(p, Wn, lf, tv); else conv_pool(p, Wn, tv); } } }
        else if (EN(6) && kind == 6) {
#ifdef PROBE_VAR
            if (rep + 1 < reps) scan_phase<PROBE_VAR>(p, W, lf, tx, 0); else scan_phase<0>(p, W, lf, tx, 0);
#elif defined(PROBE_MASK)
            scan_phase<0>(p, W, lf, tx, (rep + 1 < reps) ? PROBE_MASK : 0);
#else
            scan_phase<0>(p, W, lf, tx, 0);
#endif
        }
        else if (EN(7) && kind == 7) rowpass_gn(p, tx);
        else if (EN(8) && kind == 8) pool_pass(p, pool_pass_id, tx);
        }
        if (ph + 1 < pe) { if (pb > pe) grid.sync(); else xcd_barrier(xb); }
    }
}

#include <cstdio>
#ifndef USE_COOP
#define USE_COOP 1
#endif
extern "C" void kernel_launch(void* const* d_in, const int* in_sizes, int n_in, void* d_out, int out_size, void* d_ws, size_t ws_size, hipStream_t stream) {
    static int grid = 0;
    if (grid == 0) {
        if (n_in != NIN || ws_size < WS_NEED) { fprintf(stderr, "kernel_launch: n_in %d ws %zu (need %zu)\n", n_in, ws_size, (size_t)WS_NEED); grid = -1; return; }
        int dev = 0, cus = 0, per_cu = 0;
        hipGetDevice(&dev); hipDeviceGetAttribute(&cus, hipDeviceAttributeMultiprocessorCount, dev);
        if (hipFuncSetAttribute((const void*)mega, hipFuncAttributeMaxDynamicSharedMemorySize, LDS_BYTES) != hipSuccess) { fprintf(stderr, "kernel_launch: hipFuncSetAttribute failed\n"); grid = -1; return; }
        if (hipOccupancyMaxActiveBlocksPerMultiprocessor(&per_cu, (const void*)mega, 512, LDS_BYTES) != hipSuccess || per_cu < 1) { fprintf(stderr, "kernel_launch: occupancy query says %d\n", per_cu); per_cu = 1; }
        (void)hipGetLastError();
        grid = cus * 1;
        if (grid <= 0) grid = 256;
    }
    if (grid < 0) return;
    if (hipMemsetAsync((unsigned char*)d_ws + OFF_BAR, 0, 16384, stream) != hipSuccess) { fprintf(stderr, "kernel_launch: memset of the barrier words failed\n"); return; }
    Params p{};
    for (int i = 0; i < NIN; ++i) p.in[i] = (const float*)d_in[i];
    p.out = (float*)d_out; p.ws = (unsigned char*)d_ws;
#if USE_COOP
    p.pb = 0; p.pe = NPHASE;
    void* args[] = {&p};
    hipError_t e = hipLaunchCooperativeKernel((const void*)mega, dim3(grid), dim3(512), args, LDS_BYTES, stream);
    if (e != hipSuccess) fprintf(stderr, "cooperative launch failed: %s (grid %d)\n", hipGetErrorString(e), grid);
#else
    for (int ph = 0; ph < NPHASE; ++ph) { p.pb = ph; p.pe = ph + 1; hipLaunchKernelGGL(mega, dim3(grid), dim3(512), LDS_BYTES, stream, p); }
#endif
}
```

```cpp
#include <hip/hip_runtime.h>
#include <hip/hip_cooperative_groups.h>
namespace pg8 {
#define PG8_LAS __attribute__((address_space(3)))
typedef unsigned short bf16_t;
typedef short bf16x8 __attribute__((ext_vector_type(8)));
typedef float f32x4 __attribute__((ext_vector_type(4)));
typedef unsigned u32x4 __attribute__((ext_vector_type(4)));
constexpr int BM = 256, BK = 64, HALF = 128, HTB = HALF * BK * 2  , STAGE_BYTES = 8 * HTB, NXCD = 8, WGM = 8;

__host__ __device__ __forceinline__ int lds_byte(int r, int c) { const int st = (r >> 4) * 2 + (c >> 5), rr = r & 15, cc = c & 31, ob = rr * 64 + cc * 2; return st * 1024 + (ob ^ (((ob >> 9) & 1) << 5)); }
__host__ __device__ __forceinline__ void stage_rc(int b, int& R, int& C) { const int st = b / 1024, sb = b % 1024, swz = sb ^ (((sb >> 9) & 1) << 5); R = (st >> 1) * 16 + swz / 64; C = (st & 1) * 32 + (swz % 64) / 2; }
__host__ __device__ __forceinline__ int perm32(int rho) { const int n = rho >> 4, i = rho & 15; return 8 * (i >> 2) + 4 * n + (i & 3); }

struct Unit { int pm, pn, part; };
struct Gemm { const bf16_t* A; const bf16_t* Bt; int M, N, K; };

struct StaticOrder {
    int nM, nN, nwg, G, c;
    __host__ __device__ void init(int M, int N, int G_, int c_) { nM = M / BM; nN = N / BM; nwg = nM * nN; G = G_; c = c_; }
    __host__ __device__ bool next(int i, Unit& u) const {
        const long L = (long)i * G + c; if (L >= nwg) return false;
        int wgid = (int)L; { const int q = nwg / NXCD, r = nwg % NXCD, xcd = wgid % NXCD, off = wgid / NXCD; wgid = (xcd < r ? xcd * (q + 1) : r * (q + 1) + (xcd - r) * q) + off; }
        const int nig = WGM * nN, gid = wgid / nig, fm = gid * WGM, gsz = (nM - fm) < WGM ? (nM - fm) : WGM;
        u.pm = fm + ((wgid % nig) % gsz); u.pn = (wgid % nig) / gsz; u.part = 0; return true;
    }
    __device__ __forceinline__ void a_ready(const Unit&) const {}
    __device__ __forceinline__ void done(const Unit&) const {}
};
struct FwdOrder {
    StaticOrder so; int mode;
    __host__ __device__ void init(int M, int N, int K, int G_, int c_, int mode_) { so.init(M, N, G_, c_); mode = mode_; }
    __host__ __device__ bool next(int i, Unit& u) const {
        if (mode == 0) return so.next(i, u);
        if (i >= 2) return false;
        const int w = (so.c & 7) * 32 + (so.c >> 3);
        if (i == 0) { u.pm = w >> 2; u.pn = w & 3; u.part = 0; }
        else { u.pm = 64 + (w >> 3); u.pn = (w >> 1) & 3; u.part = 1 + (w & 1); }
        return true;
    }
    __device__ __forceinline__ void a_ready(const Unit&) const {}
    __device__ __forceinline__ void done(const Unit&) const {}
};
__device__ __forceinline__ unsigned cvt_pk_bf16(float lo, float hi) { unsigned r; asm volatile("v_cvt_pk_bf16_f32 %0, %1, %2" : "=v"(r) : "v"(lo), "v"(hi)); return r; }
typedef float f32x2 __attribute__((ext_vector_type(2)));
__device__ __forceinline__ float fast_sigmoid(float x) { return __builtin_amdgcn_rcpf(1.0f + __expf(-x)); }
__device__ __forceinline__ float fast_tanh(float x) { return 1.0f - 2.0f * __builtin_amdgcn_rcpf(1.0f + __expf(2.0f * x)); }
struct EpiStore {
    static constexpr bool PERM = true, AFTER_DRAIN = false;
    bf16_t* O; int ldc;
    __device__ __forceinline__ void operator()(const f32x4 (&acc)[2][2][4][2], const Unit& u, int wr, int wc, int fr, int fq) const {
        const int row0 = u.pm * BM + wr * 64 + fr, col0 = u.pn * BM + wc * 32 + 8 * fq;
#pragma unroll
        for (int ai = 0; ai < 2; ++ai)
#pragma unroll
            for (int m = 0; m < 4; ++m) { bf16_t* rowp = O + (size_t)(row0 + ai * HALF + m * 16) * ldc + col0;
#pragma unroll
                for (int bj = 0; bj < 2; ++bj) { const f32x4 v0 = acc[ai][bj][m][0], v1 = acc[ai][bj][m][1];
                    u32x4 w; w.x = cvt_pk_bf16(v0[0], v0[1]); w.y = cvt_pk_bf16(v0[2], v0[3]); w.z = cvt_pk_bf16(v1[0], v1[1]); w.w = cvt_pk_bf16(v1[2], v1[3]);
                    *(u32x4*)(rowp + bj * HALF) = w; } }
    }
};
struct EpiSwiglu {
    static constexpr bool PERM = true, AFTER_DRAIN = false;
    bf16_t* O; int ldc;
    __device__ __forceinline__ void operator()(const f32x4 (&acc)[2][2][4][2], const Unit& u, int wr, int wc, int fr, int fq) const {
        const int row0 = u.pm * BM + wr * 64 + fr, col0 = u.pn * HALF + wc * 32 + 8 * fq;
#pragma unroll
        for (int ai = 0; ai < 2; ++ai)
#pragma unroll
            for (int m = 0; m < 4; ++m) { bf16_t* rowp = O + (size_t)(row0 + ai * HALF + m * 16) * ldc + col0;
                float o[8];
#pragma unroll
                for (int n = 0; n < 2; ++n)
#pragma unroll
                    for (int j = 0; j < 4; ++j) { const float a = acc[ai][0][m][n][j], b = acc[ai][1][m][n][j]; o[n * 4 + j] = a * fast_sigmoid(a) * b; }
                u32x4 w; w.x = cvt_pk_bf16(o[0], o[1]); w.y = cvt_pk_bf16(o[2], o[3]); w.z = cvt_pk_bf16(o[4], o[5]); w.w = cvt_pk_bf16(o[6], o[7]);
                *(u32x4*)rowp = w; }
    }
};
struct EpiRkv {
    static constexpr bool PERM = true, AFTER_DRAIN = false;
    bf16_t* O; size_t tstride; bf16_t* L;
    __device__ __forceinline__ void operator()(const f32x4 (&acc)[2][2][4][2], const Unit& u, int wr, int wc, int fr, int fq) const {
        const int row0 = u.pm * BM + wr * 64 + fr;
        if (u.pn < 12) {
            bf16_t* base = O + (size_t)(u.pn >> 2) * tstride; const int col0 = (u.pn & 3) * BM + wc * 32 + 8 * fq;
#pragma unroll
            for (int ai = 0; ai < 2; ++ai)
#pragma unroll
                for (int m = 0; m < 4; ++m) { bf16_t* rowp = base + (size_t)(row0 + ai * HALF + m * 16) * 1024 + col0;
#pragma unroll
                    for (int bj = 0; bj < 2; ++bj) { const f32x4 v0 = acc[ai][bj][m][0], v1 = acc[ai][bj][m][1];
                        u32x4 w; w.x = cvt_pk_bf16(v0[0], v0[1]); w.y = cvt_pk_bf16(v0[2], v0[3]); w.z = cvt_pk_bf16(v1[0], v1[1]); w.w = cvt_pk_bf16(v1[2], v1[3]);
                        *(u32x4*)(rowp + bj * HALF) = w; } }
        } else {
            const int t13 = (u.pn == 13); const int col0 = (u.pn - 12) * BM + wc * 32 + 8 * fq;
#pragma unroll
            for (int ai = 0; ai < 2; ++ai)
#pragma unroll
                for (int m = 0; m < 4; ++m) { bf16_t* rowp = L + (size_t)(row0 + ai * HALF + m * 16) * 384 + col0;
#pragma unroll
                    for (int bj = 0; bj < 2; ++bj) { if (t13 && bj == 1) continue;
                        float o[8];
#pragma unroll
                        for (int n = 0; n < 2; ++n)
#pragma unroll
                            for (int j = 0; j < 4; ++j) { const float a = acc[ai][bj][m][n][j]; o[n * 4 + j] = t13 ? fast_sigmoid(a) : (bj == 0 ? fast_tanh(a) : a); }
                        u32x4 w; w.x = cvt_pk_bf16(o[0], o[1]); w.y = cvt_pk_bf16(o[2], o[3]); w.z = cvt_pk_bf16(o[4], o[5]); w.w = cvt_pk_bf16(o[6], o[7]);
                        *(u32x4*)(rowp + bj * HALF) = w; } }
        }
    }
};

struct EpiAll {
    static constexpr bool PERM = true, AFTER_DRAIN = false;
    int kind; bf16_t* O; int ldc; bf16_t* L; bf16_t* O2;
    __device__ __forceinline__ void operator()(const f32x4 (&acc)[2][2][4][2], const Unit& u, int wr, int wc, int fr, int fq) const {
        if (kind == 0) { EpiStore e{u.part == 2 ? O2 : O, ldc}; e(acc, u, wr, wc, fr, fq); }
        else if (kind == 1) { EpiSwiglu e{O, ldc}; e(acc, u, wr, wc, fr, fq); }
        else if (kind == 2) { EpiRkv e{O, (size_t)24576 * 1024, L}; e(acc, u, wr, wc, fr, fq); }
    }
};
template <class Epi, class Sched, bool STAMP = false>
__device__ __forceinline__ void gemm_phase(PG8_LAS unsigned char* lds, const Gemm g, const Sched& S, const Epi& E, unsigned long long* stamps, const int tid_in) {
    const int tid = tid_in, wid = __builtin_amdgcn_readfirstlane(tid >> 6), lane = tid & 63, wr = wid >> 2, wc = wid & 3, fr = lane & 15, fq = lane >> 4;
    const int K = g.K; int nt = K / BK;
    int ts_lo = 0, ts_hi = 0, nts = 0; const unsigned long long rt_entry = STAMP ? (unsigned long long)wall_clock64() : 0ull;
#define PG8_STAMP() do { if (STAMP && wid == 0 && nts < 64) { const unsigned long long _c = (unsigned long long)clock64(); \
        ts_lo = (lane == nts) ? (int)(unsigned)_c : ts_lo; ts_hi = (lane == nts) ? (int)(unsigned)(_c >> 32) : ts_hi; ++nts; } } while (0)
    PG8_STAMP();
    unsigned voffA[2], voffB[2];
#pragma unroll
    for (int i = 0; i < 2; ++i) { int R, C; stage_rc(tid * 16 + i * 8192, R, C); const int Rb = Epi::PERM ? ((R & ~31) + perm32(R & 31)) : R;
        voffA[i] = (unsigned)(R * K + C) * 2u; voffB[i] = (unsigned)(Rb * K + C) * 2u; }
    const size_t kstep = (size_t)(BK * 2);
    const size_t hstep = (size_t)HALF * K * 2;
    const size_t tstep = 2 * hstep;
    const unsigned ldsw = (unsigned)wid * 1024u;
    const int aoff = lds_byte(wr * 64 + fr, fq * 8), boff = lds_byte(wc * 32 + fr, fq * 8);
#define PG8_SA(b, h) (((b) * 2 + (h)) * HTB)
#define PG8_SB(b, h) ((4 + (b) * 2 + (h)) * HTB)
#define PG8_STAGE(bufoff, gbase, voff) do { _Pragma("unroll") for (int _i = 0; _i < 2; ++_i) \
        __builtin_amdgcn_global_load_lds((const unsigned*)((const char*)(gbase) + (voff)[_i]), (PG8_LAS unsigned*)(lds + (bufoff) + ldsw + _i * 8192), 16, 0, 0); } while (0)
#define PG8_LDA(dst, b, h) do { _Pragma("unroll") for (int m = 0; m < 4; ++m) _Pragma("unroll") for (int k = 0; k < 2; ++k) dst[m][k] = *(const PG8_LAS bf16x8*)(lds + PG8_SA(b, h) + aoff + m * 2048 + k * 1024); } while (0)
#define PG8_LDB(dst, b, h) do { _Pragma("unroll") for (int n = 0; n < 2; ++n) _Pragma("unroll") for (int k = 0; k < 2; ++k) dst[n][k] = *(const PG8_LAS bf16x8*)(lds + PG8_SB(b, h) + boff + n * 2048 + k * 1024); } while (0)
#define PG8_MMA(ai, bj, At, Bt) do { __builtin_amdgcn_s_setprio(1); _Pragma("unroll") for (int m = 0; m < 4; ++m) _Pragma("unroll") for (int n = 0; n < 2; ++n) _Pragma("unroll") for (int k = 0; k < 2; ++k) \
        acc[ai][bj][m][n] = __builtin_amdgcn_mfma_f32_16x16x32_bf16(Bt[n][k], At[m][k], acc[ai][bj][m][n], 0, 0, 0); __builtin_amdgcn_s_setprio(0); } while (0)
#define PG8_WAIT_V(n) asm volatile("s_waitcnt vmcnt(" #n ")" ::: "memory")
#define PG8_WAIT_L(n) asm volatile("s_waitcnt lgkmcnt(" #n ")" ::: "memory")
#define PG8_BAR __builtin_amdgcn_s_barrier()
#define PG8_SCHED __builtin_amdgcn_sched_barrier(0)
    Unit cur, nxt; int ui = 0;
    if (!S.next(0, cur)) return;
    f32x4 acc[2][2][4][2];
#pragma unroll
    for (int a = 0; a < 2; ++a)
#pragma unroll
        for (int b = 0; b < 2; ++b)
#pragma unroll
            for (int m = 0; m < 4; ++m)
#pragma unroll
                for (int n = 0; n < 2; ++n) acc[a][b][m][n] = (f32x4){0.f, 0.f, 0.f, 0.f};
    bf16x8 At[4][2], B0[2][2], B1[2][2];
    const char* cA = (const char*)g.A + (size_t)cur.pm * tstep + (cur.part == 2 ? (size_t)K : (size_t)0); const char* cB = (const char*)g.Bt + (size_t)cur.pn * tstep + (cur.part == 2 ? (size_t)K : (size_t)0);
    nt = cur.part ? K / (2 * BK) : K / BK;
    S.a_ready(cur);
    PG8_STAGE(PG8_SB(0, 0), cB, voffB); PG8_STAGE(PG8_SA(0, 0), cA, voffA); PG8_STAGE(PG8_SB(0, 1), cB + hstep, voffB); PG8_STAGE(PG8_SA(0, 1), cA + hstep, voffA);
    if (wr == 1) PG8_BAR;
    PG8_WAIT_V(4); PG8_BAR;
    PG8_STAGE(PG8_SB(1, 0), cB + kstep, voffB); PG8_STAGE(PG8_SA(1, 0), cA + kstep, voffA); PG8_STAGE(PG8_SB(1, 1), cB + hstep + kstep, voffB);
    PG8_WAIT_V(6); PG8_BAR;
    PG8_STAMP();
    for (;;) {
        const bool has_next = S.next(ui + 1, nxt);
        const char* nA = has_next ? (const char*)g.A + (size_t)nxt.pm * tstep + (nxt.part == 2 ? (size_t)K : (size_t)0) : cA; const char* nB = has_next ? (const char*)g.Bt + (size_t)nxt.pn * tstep + (nxt.part == 2 ? (size_t)K : (size_t)0) : cB;
        for (int t = 0; t < nt; t += 2) {
            const bool last = (t == nt - 2);
            const char* a1 = cA + (size_t)(t + 1) * kstep;
            const char* a2 = last ? nA : cA + (size_t)(t + 2) * kstep; const char* b2 = last ? nB : cB + (size_t)(t + 2) * kstep;
            const char* a3 = a2 + kstep; const char* b3 = b2 + kstep;
            if (last && has_next) S.a_ready(nxt);
            PG8_LDB(B0, 0, 0); PG8_SCHED; PG8_LDA(At, 0, 0); PG8_STAGE(PG8_SA(1, 1), a1 + hstep, voffA);
            PG8_WAIT_L(8); PG8_BAR; PG8_WAIT_L(0); PG8_MMA(0, 0, At, B0); PG8_BAR; PG8_SCHED;
            PG8_LDB(B1, 0, 1); PG8_STAGE(PG8_SB(0, 0), b2, voffB);
            PG8_BAR; PG8_WAIT_L(0); PG8_MMA(0, 1, At, B1); PG8_BAR;
            PG8_LDA(At, 0, 1); PG8_STAGE(PG8_SA(0, 0), a2, voffA);
            PG8_BAR; PG8_WAIT_L(0); PG8_MMA(1, 0, At, B0); PG8_BAR; PG8_SCHED;
            PG8_STAGE(PG8_SB(0, 1), b2 + hstep, voffB);
            PG8_WAIT_V(6); PG8_BAR; PG8_MMA(1, 1, At, B1); PG8_BAR;
            PG8_LDB(B0, 1, 0); PG8_SCHED; PG8_LDA(At, 1, 0); PG8_STAGE(PG8_SA(0, 1), a2 + hstep, voffA);
            PG8_WAIT_L(8); PG8_BAR; PG8_WAIT_L(0); PG8_MMA(0, 0, At, B0); PG8_BAR; PG8_SCHED;
            PG8_LDB(B1, 1, 1); PG8_STAGE(PG8_SB(1, 0), b3, voffB);
            PG8_BAR; PG8_WAIT_L(0); PG8_MMA(0, 1, At, B1); PG8_BAR;
            PG8_LDA(At, 1, 1); PG8_STAGE(PG8_SA(1, 0), a3, voffA);
            PG8_BAR; PG8_WAIT_L(0); PG8_MMA(1, 0, At, B0); PG8_BAR; PG8_SCHED;
            PG8_STAGE(PG8_SB(1, 1), b3 + hstep, voffB);
            PG8_WAIT_V(6); PG8_BAR; PG8_MMA(1, 1, At, B1); PG8_BAR;
        }
        PG8_STAMP();
        if constexpr (!Epi::AFTER_DRAIN) { E(acc, cur, wr, wc, fr, fq); S.done(cur); }
        PG8_STAMP();
        if (!has_next) break;
#pragma unroll
        for (int a = 0; a < 2; ++a)
#pragma unroll
            for (int b = 0; b < 2; ++b)
#pragma unroll
                for (int m = 0; m < 4; ++m)
#pragma unroll
                    for (int n = 0; n < 2; ++n) acc[a][b][m][n] = (f32x4){0.f, 0.f, 0.f, 0.f};
        cur = nxt; cA = nA; cB = nB; ++ui; nt = cur.part ? K / (2 * BK) : K / BK;
    }
    PG8_WAIT_V(0);
    if (wr == 0) PG8_BAR;
    PG8_BAR;
    if constexpr (Epi::AFTER_DRAIN) { E.fused(acc, cur, wr, wc, fr, fq, lds, wid, lane); S.done(cur); }
    PG8_STAMP();
    if (STAMP && wid == 0) { stamps[lane] = lane < nts ? (((unsigned long long)(unsigned)ts_hi << 32) | (unsigned)ts_lo) : 0ull;
        if (lane == 62) stamps[62] = rt_entry; if (lane == 63) stamps[63] = (unsigned long long)wall_clock64(); }
#undef PG8_STAMP
#undef PG8_SA
#undef PG8_SB
#undef PG8_STAGE
#undef PG8_LDA
#undef PG8_LDB
#undef PG8_MMA
#undef PG8_WAIT_V
#undef PG8_WAIT_L
#undef PG8_BAR
#undef PG8_SCHED
}
}

namespace cg = cooperative_groups;
using pg8::bf16_t; using pg8::bf16x8; using pg8::f32x4; using pg8::u32x4; using pg8::cvt_pk_bf16; using pg8::fast_sigmoid;
#define LAS __attribute__((address_space(3)))
typedef float f32x2 __attribute__((ext_vector_type(2)));
typedef unsigned u32x2 __attribute__((ext_vector_type(2)));

constexpr int D = 1024, DFF = 2816, MP = 8192, MS = 16384, MT = 24576;
constexpr int NIN = 31;
constexpr size_t R48 = (size_t)MT * 1024 * 2;
constexpr size_t OFF_A = 0, OFF_B = R48, OFF_C = 2 * R48, OFF_D = 3 * R48, OFF_E = 4 * R48;
constexpr size_t OFF_S = 5 * R48;
constexpr size_t OFF_W = OFF_S + (size_t)MT * 384 * 2;
constexpr size_t W_ELEMS = 9043968;
constexpr size_t OFF_MOD = OFF_W + W_ELEMS * 2;
constexpr size_t OFF_CBP = OFF_MOD + (size_t)9 * 2 * 9216 * 4;
constexpr size_t OFF_BAR = OFF_CBP + (size_t)2 * MT * 64 * 4;
constexpr size_t OFF_W2 = OFF_BAR + 16384;
constexpr size_t OFF_FB = OFF_W2 + W_ELEMS * 2;
constexpr size_t WS_NEED = OFF_FB + (size_t)8192 * 1024 * 2;
constexpr size_t W_W13 = 0, W_W2T = (size_t)5632 * 1024;
constexpr size_t W_BTP = 0, W_BTG = (size_t)3584 * 2048, W_WOT = W_BTG + (size_t)1024 * 384, W_W2L = W_WOT + (size_t)1024 * 1024, W_A2L = W_W2L + 131072;
constexpr float RMS_EPS = 1e-6f, GN_EPS = 64e-5f;

struct Tix { int tid, bid, gd; };
struct Params { const float* in[NIN]; float* out; unsigned char* ws; int pb, pe; };
typedef const Params __attribute__((address_space(4)))* CP;

__device__ __forceinline__ float bf2f(unsigned short b) { return __uint_as_float(((unsigned)b) << 16); }
__device__ __forceinline__ float bflo(unsigned w) { return __uint_as_float(w << 16); }
__device__ __forceinline__ float bfhi(unsigned w) { return __uint_as_float(w & 0xffff0000u); }
template <int CTRL> __device__ __forceinline__ float dpp_f(float x) { return __builtin_bit_cast(float, __builtin_amdgcn_mov_dpp(__builtin_bit_cast(int, x), CTRL, 0xf, 0xf, true)); }
__device__ __forceinline__ float row16_sum(float v) { v += dpp_f<0xB1>(v); v += dpp_f<0x4E>(v); v += dpp_f<0x141>(v); v += dpp_f<0x128>(v); return v; }
__device__ __forceinline__ float wave_sum(float v) {
    v = row16_sum(v);
    auto s1 = __builtin_amdgcn_permlane16_swap(__float_as_uint(v), __float_as_uint(v), false, false); v = __uint_as_float(s1[0]) + __uint_as_float(s1[1]);
    auto s2 = __builtin_amdgcn_permlane32_swap(__float_as_uint(v), __float_as_uint(v), false, false); v = __uint_as_float(s2[0]) + __uint_as_float(s2[1]);
    return v;
}
__device__ __forceinline__ float reduce8(float x) { x += dpp_f<0xB1>(x); x += dpp_f<0x4E>(x); x += dpp_f<0x141>(x); return x; }

struct ConvJob { const float* src; int K, N; bf16_t* dst; int dld, kofs, blk, blk_stride, row_off; const float* ksc; };
__device__ __forceinline__ void conv_job(const ConvJob j, LAS float* tile, int& rot, const Tix tx) {
    const int tid = tx.tid, G = tx.gd;
    const int tn = j.N >> 6, nt = (j.K >> 6) * tn;
    int t0 = (tx.bid - (rot % G) + G) % G;
    for (int t = t0; t < nt; t += G) {
        const int k0 = (t / tn) << 6, n0 = (t % tn) << 6;
        { const int r = tid >> 4, c4 = tid & 15;
#pragma unroll
          for (int it = 0; it < 2; ++it) { const int k = r + 32 * it; const float4 v = *(const float4*)(j.src + (size_t)(k0 + k) * j.N + n0 + 4 * c4);
              LAS float* tp = tile + k * 65 + 4 * c4; tp[0] = v.x; tp[1] = v.y; tp[2] = v.z; tp[3] = v.w; } }
        __syncthreads();
        { const int n = tid >> 3, kg = tid & 7; float v[8];
#pragma unroll
          for (int i = 0; i < 8; ++i) { v[i] = tile[(8 * kg + i) * 65 + n]; if (j.ksc) v[i] *= j.ksc[k0 + 8 * kg + i]; }
          u32x4 w; w.x = cvt_pk_bf16(v[0], v[1]); w.y = cvt_pk_bf16(v[2], v[3]); w.z = cvt_pk_bf16(v[4], v[5]); w.w = cvt_pk_bf16(v[6], v[7]);
          const int gn = n0 + n; const int drow = (gn / j.blk) * j.blk_stride + (gn % j.blk) + j.row_off;
          *(u32x4*)(j.dst + (size_t)drow * j.dld + j.kofs + k0 + 8 * kg) = w; }
        __syncthreads();
    }
    rot += nt;
}
__device__ void conv_ffn(CP p, bf16_t* W, int fi, LAS float* tile, const Tix tx) {
    int rot = 0;
    conv_job(ConvJob{p->in[10] + (size_t)fi * D * DFF, D, DFF, W + W_W13, 1024, 0, 128, 256, 0, nullptr}, tile, rot, tx);
    conv_job(ConvJob{p->in[11] + (size_t)fi * D * DFF, D, DFF, W + W_W13, 1024, 0, 128, 256, 128, nullptr}, tile, rot, tx);
    conv_job(ConvJob{p->in[12] + (size_t)fi * D * DFF, DFF, D, W + W_W2T, 2816, 0, 1024, 1024, 0, nullptr}, tile, rot, tx);
}
__device__ void conv_rwkv(CP p, bf16_t* W, LAS float* tile, const Tix tx) {
    int rot = 0;
    const float* mu = p->in[13];
    for (int half = 0; half < 2; ++half) {
        const int ko = half * 1024;
        for (int i = 0; i < 3; ++i) { const int mi = (i == 0) ? 0 : (i == 1 ? 2 : 3);
            conv_job(ConvJob{p->in[14] + (size_t)i * D * D, D, D, W + W_BTP, 2048, ko, 1024, 1024, i * 1024, half ? mu + mi * D : nullptr}, tile, rot, tx); }
        for (int d = 0; d < 2; ++d) {
            conv_job(ConvJob{p->in[16] + (size_t)d * D * 64, D, 64, W + W_BTP, 2048, ko, 64, 64, 3072 + 64 * d, half ? mu + 1 * D : nullptr}, tile, rot, tx);
            conv_job(ConvJob{p->in[19] + (size_t)d * D * 64, D, 64, W + W_BTP, 2048, ko, 64, 64, 3200 + 64 * d, half ? mu + 4 * D : nullptr}, tile, rot, tx); }
        conv_job(ConvJob{p->in[21], D, 128, W + W_BTP, 2048, ko, 128, 128, 3328, half ? mu + 5 * D : nullptr}, tile, rot, tx);
    }
    conv_job(ConvJob{p->in[22], 128, D, W + W_BTG, 384, 256, 1024, 1024, 0, nullptr}, tile, rot, tx);
    for (int idx = tx.bid * 512 + tx.tid; idx < 1024 * 32; idx += tx.gd * 512) { const int n = idx >> 5, k8 = idx & 31; *(u32x4*)(W + W_BTG + (size_t)n * 384 + 8 * k8) = (u32x4){0u, 0u, 0u, 0u}; }
    conv_job(ConvJob{p->in[28], D, D, W + W_WOT, 1024, 0, 1024, 1024, 0, nullptr}, tile, rot, tx);
    for (int d = 0; d < 2; ++d) {
        conv_job(ConvJob{p->in[17] + (size_t)d * 64 * D, 64, D, W + W_W2L + (size_t)d * 65536, 64, 0, 1024, 1024, 0, nullptr}, tile, rot, tx);
        conv_job(ConvJob{p->in[20] + (size_t)d * 64 * D, 64, D, W + W_A2L + (size_t)d * 65536, 64, 0, 1024, 1024, 0, nullptr}, tile, rot, tx); }
}
__device__ void conv_pool(CP p, bf16_t* W, const Tix tx) {
    const float* pw = p->in[29]; const float* ps = p->in[30];
    for (int idx = tx.bid * 512 + tx.tid; idx < 1024 * 128; idx += tx.gd * 512) {
        const int k8 = idx >> 10, n = idx & 1023, g = n >> 8; u32x4 w = (u32x4){0u, 0u, 0u, 0u};
        if ((k8 >> 5) == g) { const float s = ps[n]; float v[8];
#pragma unroll
            for (int i = 0; i < 8; ++i) v[i] = pw[((size_t)g * 256 + ((8 * k8 + i) & 255)) * 256 + (n & 255)] * s;
            w.x = cvt_pk_bf16(v[0], v[1]); w.y = cvt_pk_bf16(v[2], v[3]); w.z = cvt_pk_bf16(v[4], v[5]); w.w = cvt_pk_bf16(v[6], v[7]); }
        *(u32x4*)(W + (size_t)n * 1024 + 8 * k8) = w; }
}

__device__ void mod_phase(CP p, LAS float* lf, const Tix tx) {
    LAS float* sc = lf; LAS float* red = lf + 9216;
    const int tid = tx.tid;
    if (tx.bid >= 288) return;
    for (int o = tid; o < 9216; o += 512) { const int c = o >> 10, k = o & 1023; const float v = (c == 0) ? p->in[5][k] : p->in[2][(c - 1) * 1024 + k]; sc[o] = v * fast_sigmoid(v); }
    __syncthreads();
    float* mod = (float*)(p->ws + OFF_MOD);
    for (int item = tx.bid; item < 288; item += tx.gd) {
        const int i = item / 144, n0 = (item % 144) * 64, col = tid & 63, ks = tid >> 6;
        float acc[9];
#pragma unroll
        for (int c = 0; c < 9; ++c) acc[c] = 0.f;
        const float* wp = p->in[6] + ((size_t)i * 1024 + ks * 128) * 9216 + n0 + col;
#pragma unroll 8
        for (int k = 0; k < 128; ++k) { const float w = wp[(size_t)k * 9216];
#pragma unroll
            for (int c = 0; c < 9; ++c) acc[c] += sc[c * 1024 + ks * 128 + k] * w; }
#pragma unroll
        for (int c = 0; c < 9; ++c) red[(ks * 9 + c) * 64 + col] = acc[c];
        __syncthreads();
        for (int o = tid; o < 576; o += 512) { const int c = o >> 6, cl = o & 63; float s = p->in[7][i * 9216 + n0 + cl];
#pragma unroll
            for (int k2 = 0; k2 < 8; ++k2) s += red[(k2 * 9 + c) * 64 + cl];
            mod[((size_t)c * 2 + i) * 9216 + n0 + cl] = s; }
        __syncthreads();
    }
}

struct RowCfg {
    int src_input;
    int pending;
    int lg, gidx; float coef; const float* npost;
    int has_next;
    int lh, shidx, scidx; const float* npre;
    int write_x;
    int fsplit;
};
__device__ __forceinline__ const float* xrow_in(CP p, int m) { return m < MP ? p->in[0] + (size_t)m * D : p->in[1] + (size_t)(m - MP) * D; }
__device__ __forceinline__ int cond_of(int m) { return m < MP ? 0 : 1 + ((m - MP) >> 11); }
__device__ __forceinline__ void row_update(CP p, const RowCfg& c, int m, int lane, f32x4 (&x)[4]) {
    const float* xr = c.src_input ? xrow_in(p, m) : p->out + (size_t)m * D;
    const float* mod = (const float*)(p->ws + OFF_MOD);
    const int cd = cond_of(m);
#pragma unroll
    for (int q = 0; q < 4; ++q) x[q] = *(const f32x4*)(xr + 4 * lane + 256 * q);
    if (c.pending) {
        const bf16_t* fr = (const bf16_t*)(p->ws + OFF_E) + (size_t)m * D; f32x4 f[4]; float ss = 0.f;
#pragma unroll
        for (int q = 0; q < 4; ++q) { const u32x2 w = *(const u32x2*)(fr + 4 * lane + 256 * q); f[q] = (f32x4){bflo(w.x), bfhi(w.x), bflo(w.y), bfhi(w.y)}; }
        if (c.fsplit && m >= 16384) {
            const bf16_t* fr2 = (const bf16_t*)(p->ws + OFF_FB) + (size_t)(m - 16384) * D;
#pragma unroll
            for (int q = 0; q < 4; ++q) { const u32x2 w = *(const u32x2*)(fr2 + 4 * lane + 256 * q); f[q] += (f32x4){bflo(w.x), bfhi(w.x), bflo(w.y), bfhi(w.y)}; } }
#pragma unroll
        for (int q = 0; q < 4; ++q) ss += f[q][0] * f[q][0] + f[q][1] * f[q][1] + f[q][2] * f[q][2] + f[q][3] * f[q][3];
        ss = wave_sum(ss); const float rs = rsqrtf(ss * (1.0f / 1024.0f) + RMS_EPS) * c.coef;
        const float* gate = mod + ((size_t)(cd * 2 + c.lg) * 9 + c.gidx) * D;
#pragma unroll
        for (int q = 0; q < 4; ++q) { const f32x4 g = *(const f32x4*)(gate + 4 * lane + 256 * q), np = *(const f32x4*)(c.npost + 4 * lane + 256 * q); x[q] += g * (f[q] * np) * rs; }
    }
}
__device__ __forceinline__ void row_premod(CP p, const RowCfg& c, int m, int lane, const f32x4 (&x)[4], f32x4 (&h)[4]) {
    const float* mod = (const float*)(p->ws + OFF_MOD);
    const int cd = cond_of(m);
    float ss = 0.f;
#pragma unroll
    for (int q = 0; q < 4; ++q) ss += x[q][0] * x[q][0] + x[q][1] * x[q][1] + x[q][2] * x[q][2] + x[q][3] * x[q][3];
    ss = wave_sum(ss); const float rs = rsqrtf(ss * (1.0f / 1024.0f) + RMS_EPS);
    const float* sh = mod + ((size_t)(cd * 2 + c.lh) * 9 + c.shidx) * D; const float* scl = mod + ((size_t)(cd * 2 + c.lh) * 9 + c.scidx) * D;
#pragma unroll
    for (int q = 0; q < 4; ++q) { const f32x4 g = *(const f32x4*)(c.npre + 4 * lane + 256 * q), s1 = *(const f32x4*)(scl + 4 * lane + 256 * q), s0 = *(const f32x4*)(sh + 4 * lane + 256 * q);
        h[q] = (x[q] * rs * g) * (1.0f + s1) + s0; }
}
__device__ __forceinline__ void store_bf16_row(bf16_t* dst, int lane, const f32x4 (&h)[4]) {
#pragma unroll
    for (int q = 0; q < 4; ++q) { u32x2 w; w.x = cvt_pk_bf16(h[q][0], h[q][1]); w.y = cvt_pk_bf16(h[q][2], h[q][3]); *(u32x2*)(dst + 4 * lane + 256 * q) = w; }
}
__device__ void rowpass_simple(CP p, const RowCfg c, const Tix tx) {
    const int lane = tx.tid & 63, wid = tx.tid >> 6, nw = tx.gd * 8;
    bf16_t* hdst = (bf16_t*)(p->ws + OFF_A);
    for (int m = tx.bid * 8 + wid; m < MT; m += nw) {
        f32x4 x[4]; row_update(p, c, m, lane, x);
        if (c.write_x) {
#pragma unroll
            for (int q = 0; q < 4; ++q) *(f32x4*)(p->out + (size_t)m * D + 4 * lane + 256 * q) = x[q]; }
        if (c.has_next) { f32x4 h[4]; row_premod(p, c, m, lane, x, h); store_bf16_row(hdst + (size_t)m * D, lane, h); }
    }
}
__device__ void rowpass_shift(CP p, const RowCfg c, LAS float* lf, const Tix tx) {
    const int lane = tx.tid & 63, wid = tx.tid >> 6;
    bf16_t* adst = (bf16_t*)(p->ws + OFF_A);
    for (int blk = tx.bid; blk < MT / 6; blk += tx.gd) {
        const int m = blk * 6 - 1 + wid;
        f32x4 x[4], h[4];
#pragma unroll
        for (int q = 0; q < 4; ++q) { x[q] = (f32x4){0.f, 0.f, 0.f, 0.f}; h[q] = x[q]; }
        if (m >= 0 && m < MT) {
            row_update(p, c, m, lane, x); row_premod(p, c, m, lane, x, h);
#pragma unroll
            for (int q = 0; q < 4; ++q) *(LAS f32x4*)(lf + wid * 1024 + 4 * lane + 256 * q) = h[q];
        }
        __syncthreads();
        if (wid >= 1 && wid <= 6) {
            const int T = m < MP ? 256 : 2048, t = m < MP ? (m & 255) : ((m - MP) & 2047);
#pragma unroll
            for (int q = 0; q < 4; ++q) *(f32x4*)(p->out + (size_t)m * D + 4 * lane + 256 * q) = x[q];
            f32x4 hs[4];
#pragma unroll
            for (int q = 0; q < 4; ++q) { hs[q] = (f32x4){0.f, 0.f, 0.f, 0.f};
                if (t > 0) hs[q] += *(const LAS f32x4*)(lf + (wid - 1) * 1024 + 4 * lane + 256 * q);
                if (t < T - 1) hs[q] += *(const LAS f32x4*)(lf + (wid + 1) * 1024 + 4 * lane + 256 * q);
                hs[q] = 0.5f * hs[q] - h[q]; }
            store_bf16_row(adst + (size_t)m * 2048, lane, h);
            store_bf16_row(adst + (size_t)m * 2048 + 1024, lane, hs);
        }
        __syncthreads();
    }
}
__device__ void rowpass_gn(CP p, const Tix tx) {
    const int lane = tx.tid & 63, wid = tx.tid >> 6, nw = tx.gd * 8;
    const bf16_t* yf = (const bf16_t*)(p->ws + OFF_A); const bf16_t* yb = (const bf16_t*)(p->ws + OFF_B);
    const bf16_t* gb = (const bf16_t*)(p->ws + OFF_C); const bf16_t* vb = (const bf16_t*)(p->ws + OFF_E);
    bf16_t* ob = (bf16_t*)(p->ws + OFF_D); const float* cbp = (const float*)(p->ws + OFF_CBP);
    const float* gnw = p->in[26]; const float* gnb = p->in[27];
    for (int m = tx.bid * 8 + wid; m < MT; m += nw) {
        f32x4 o[4];
#pragma unroll
        for (int q = 0; q < 4; ++q) {
            const int col = 4 * lane + 256 * q, hd = 4 * q + (lane >> 4);
            const u32x2 a = *(const u32x2*)(yf + (size_t)m * D + col), b = *(const u32x2*)(yb + (size_t)m * D + col);
            f32x4 y = (f32x4){bflo(a.x) + bflo(b.x), bfhi(a.x) + bfhi(b.x), bflo(a.y) + bflo(b.y), bfhi(a.y) + bfhi(b.y)};
            float s = y[0] + y[1] + y[2] + y[3];
            s = row16_sum(s);
            const float mean = s * (1.0f / 64.0f); const f32x4 dv = y - mean;
            float vs = dv[0] * dv[0] + dv[1] * dv[1] + dv[2] * dv[2] + dv[3] * dv[3];
            vs = row16_sum(vs);
            const float rstd = rsqrtf(vs * (1.0f / 64.0f) + GN_EPS);
            const f32x4 c0 = *(const f32x4*)(cbp + ((size_t)m * 16 + hd) * 4), c1 = *(const f32x4*)(cbp + ((size_t)(MT + m) * 16 + hd) * 4);
            const float cb = (c0[0] + c0[1] + c0[2] + c0[3]) + (c1[0] + c1[1] + c1[2] + c1[3]);
            const u32x2 vw = *(const u32x2*)(vb + (size_t)m * D + col), gw = *(const u32x2*)(gb + (size_t)m * D + col);
            const f32x4 v = (f32x4){bflo(vw.x), bfhi(vw.x), bflo(vw.y), bfhi(vw.y)}, g = (f32x4){bflo(gw.x), bfhi(gw.x), bflo(gw.y), bfhi(gw.y)};
            const f32x4 w = *(const f32x4*)(gnw + col), bb = *(const f32x4*)(gnb + col);
            o[q] = (dv * rstd * w + bb + cb * v) * g;
        }
        store_bf16_row(ob + (size_t)m * D, lane, o);
    }
}

__device__ __forceinline__ void pool_acc(float (&acc)[8], const u32x4 w, const float wt) {
    acc[0] += wt * bflo(w.x); acc[1] += wt * bfhi(w.x); acc[2] += wt * bflo(w.y); acc[3] += wt * bfhi(w.y); acc[4] += wt * bflo(w.z); acc[5] += wt * bfhi(w.z); acc[6] += wt * bflo(w.w); acc[7] += wt * bfhi(w.w);
}
template <int WIN> __device__ __forceinline__ void pool_unit(CP p, const int pass, const int pair, const int gi, const int lane) {
    constexpr int HW = WIN / 2;
    const bf16_t* h = (const bf16_t*)(p->ws + OFF_A); bf16_t* t1 = (bf16_t*)(p->ws + OFF_B); bf16_t* dl = (bf16_t*)(p->ws + OFF_D);
    const int m = 2 * pair + (lane >> 5), ch = gi * 256 + 8 * (lane & 31);
    float acc[8];
#pragma unroll
    for (int i = 0; i < 8; ++i) acc[i] = 0.f;
    if (m < MP) {
        if (pass != 0) return;
        const int t = m & 255, mb = m - t;
        u32x4 w[WIN];
#pragma unroll
        for (int k = 0; k < WIN; ++k) { const int tt = t - HW + k; const int tc = min(max(tt, 0), 255); w[k] = *(const u32x4*)(h + (size_t)(mb + tc) * D + ch); }
#pragma unroll
        for (int k = 0; k < WIN; ++k) { const int tt = t - HW + k; pool_acc(acc, w[k], (tt >= 0 && tt < 256) ? 1.0f : 0.0f); }
        const float inv = 1.0f / (float)(min(t + HW, 256) - max(t - HW, 0)); const u32x4 c = w[HW];
        u32x4 o; o.x = cvt_pk_bf16(acc[0] * inv - bflo(c.x), acc[1] * inv - bfhi(c.x)); o.y = cvt_pk_bf16(acc[2] * inv - bflo(c.y), acc[3] * inv - bfhi(c.y));
        o.z = cvt_pk_bf16(acc[4] * inv - bflo(c.z), acc[5] * inv - bfhi(c.z)); o.w = cvt_pk_bf16(acc[6] * inv - bflo(c.w), acc[7] * inv - bfhi(c.w));
        *(u32x4*)(dl + (size_t)m * D + ch) = o;
    } else {
        const int ms = m - MP, pos = ms & 2047, r = pos >> 6, cc = pos & 63, sb = ms - pos;
        if (pass == 0) {
            u32x4 w[WIN];
#pragma unroll
            for (int k = 0; k < WIN; ++k) { const int rr = r - HW + k; const int rc = min(max(rr, 0), 31); w[k] = *(const u32x4*)(h + (size_t)(MP + sb + rc * 64 + cc) * D + ch); }
#pragma unroll
            for (int k = 0; k < WIN; ++k) { const int rr = r - HW + k; pool_acc(acc, w[k], (rr >= 0 && rr < 32) ? 1.0f : 0.0f); }
            const float inv = 1.0f / (float)(min(r + HW, 32) - max(r - HW, 0));
            u32x4 o; o.x = cvt_pk_bf16(acc[0] * inv, acc[1] * inv); o.y = cvt_pk_bf16(acc[2] * inv, acc[3] * inv); o.z = cvt_pk_bf16(acc[4] * inv, acc[5] * inv); o.w = cvt_pk_bf16(acc[6] * inv, acc[7] * inv);
            *(u32x4*)(t1 + (size_t)ms * D + ch) = o;
        } else {
            u32x4 w[WIN];
#pragma unroll
            for (int k = 0; k < WIN; ++k) { const int c2 = cc - HW + k; const int c3 = min(max(c2, 0), 63); w[k] = *(const u32x4*)(t1 + (size_t)(sb + r * 64 + c3) * D + ch); }
#pragma unroll
            for (int k = 0; k < WIN; ++k) { const int c2 = cc - HW + k; pool_acc(acc, w[k], (c2 >= 0 && c2 < 64) ? 1.0f : 0.0f); }
            const float inv = 1.0f / (float)(min(cc + HW, 64) - max(cc - HW, 0)); const u32x4 c = *(const u32x4*)(h + (size_t)m * D + ch);
            u32x4 o; o.x = cvt_pk_bf16(acc[0] * inv - bflo(c.x), acc[1] * inv - bfhi(c.x)); o.y = cvt_pk_bf16(acc[2] * inv - bflo(c.y), acc[3] * inv - bfhi(c.y));
            o.z = cvt_pk_bf16(acc[4] * inv - bflo(c.z), acc[5] * inv - bfhi(c.z)); o.w = cvt_pk_bf16(acc[6] * inv - bflo(c.w), acc[7] * inv - bfhi(c.w));
            *(u32x4*)(dl + (size_t)m * D + ch) = o;
        }
    }
}
__device__ void pool_pass(CP p, int pass, const Tix tx) {
    const int lane = tx.tid & 63, wid = tx.tid >> 6;
    const int first = pass == 0 ? 0 : (MP / 2) * 4, total = (MT / 2) * 4;
    for (int u = first + tx.bid * 8 + wid; u < total; u += tx.gd * 8) {
        const int gi = u & 3, pair = u >> 2;
        if (gi == 0) pool_unit<2>(p, pass, pair, 0, lane); else if (gi == 1) pool_unit<4>(p, pass, pair, 1, lane);
        else if (gi == 2) pool_unit<8>(p, pass, pair, 2, lane); else pool_unit<16>(p, pass, pair, 3, lane);
    }
}

constexpr int SST = 324;
constexpr int SBUF = 16 * SST + 64;
template <int VAR> __device__ void scan_phase(CP p, const bf16_t* W, LAS float* lf, const Tix tx, const int skipmask) {
    const int tid = tx.tid, lane = tid & 63, wid = tid >> 6, grp = wid >> 2, q = wid & 3;
    const int l15 = lane & 15, quad = lane >> 4, rl = lane >> 3, cg8 = lane & 7, i0 = 16 * q + 2 * rl;
    const bf16_t* rb = (const bf16_t*)(p->ws + OFF_C); const bf16_t* kb = (const bf16_t*)(p->ws + OFF_D); const bf16_t* vb = (const bf16_t*)(p->ws + OFF_E);
    const bf16_t* lb = (const bf16_t*)(p->ws + OFF_S);
    bf16_t* yout = (bf16_t*)(p->ws + OFF_A);
    float* cbp = (float*)(p->ws + OFF_CBP);
    const int tch = grp == 0 ? 128 : 16, nsub = grp == 0 ? 1 : ((skipmask & 8) ? 0 : 4);
    for (int it = tx.bid; it < 256; it += tx.gd) {
        f32x2 Sa[4], Sb[4];
        bf16x8 W2f[2], A2f[2];
        LAS float* ystage = lf + 4 * SBUF + 8 * 144 + wid * 1024;
        LAS float* wcst = lf + 4 * SBUF + wid * 144;
#pragma unroll
        for (int i = 0; i < 4; ++i) { Sa[i] = (f32x2){0.f, 0.f}; Sb[i] = (f32x2){0.f, 0.f}; }
        W2f[0] = W2f[1] = A2f[0] = A2f[1] = (bf16x8){0, 0, 0, 0, 0, 0, 0, 0};
        u32x2 pr = (u32x2){0u, 0u}, pk = pr, pv = pr; u32x4 pkf0 = (u32x4){0u, 0u, 0u, 0u}, pkf1 = pkf0; bf16x8 plw0 = (bf16x8){0, 0, 0, 0, 0, 0, 0, 0}, plw1 = plw0, pla0 = plw0, pla1 = plw0;
        int mn = 0, dn = 0, hhn = 0, scn = 0, slg = 0; bool sact = false;
        for (int c = -2; c < 128; ++c) {
#pragma unroll 1
          for (int slot = 0; slot < 2; ++slot) {
            if ((slot == 0) == (grp == 1)) {
                if (sact && !(skipmask & 2)) {
                    f32x4 aw = (f32x4){0.f, 0.f, 0.f, 0.f}, aa = aw;
                    aw = __builtin_amdgcn_mfma_f32_16x16x32_bf16(W2f[0], plw0, aw, 0, 0, 0); aw = __builtin_amdgcn_mfma_f32_16x16x32_bf16(W2f[1], plw1, aw, 0, 0, 0);
                    aa = __builtin_amdgcn_mfma_f32_16x16x32_bf16(A2f[0], pla0, aa, 0, 0, 0); aa = __builtin_amdgcn_mfma_f32_16x16x32_bf16(A2f[1], pla1, aa, 0, 0, 0);
                    const f32x4 cw0 = *(const LAS f32x4*)(wcst + 4 * quad), ca0 = *(const LAS f32x4*)(wcst + 16 + 4 * quad), ckk = *(const LAS f32x4*)(wcst + 32 + 4 * quad), cka = *(const LAS f32x4*)(wcst + 48 + 4 * quad), crk = *(const LAS f32x4*)(wcst + 64 + 4 * quad);
                    f32x4 kn[4];
    #pragma unroll
                    for (int i = 0; i < 4; ++i) kn[i] = *(const LAS f32x4*)(wcst + 80 + 16 * quad + 4 * i);
                    float ssq = 0.f;
                    { const unsigned kw[8] = {pkf0.x, pkf0.y, pkf0.z, pkf0.w, pkf1.x, pkf1.y, pkf1.z, pkf1.w};
    #pragma unroll
                      for (int i = 0; i < 8; ++i) { const float a = bflo(kw[i]) * kn[i >> 1][(i & 1) * 2], b2 = bfhi(kw[i]) * kn[i >> 1][(i & 1) * 2 + 1]; ssq += a * a + b2 * b2; } }
                    { auto s1 = __builtin_amdgcn_permlane16_swap(__float_as_uint(ssq), __float_as_uint(ssq), false, false); ssq = __uint_as_float(s1[0]) + __uint_as_float(s1[1]);
                      auto s2 = __builtin_amdgcn_permlane32_swap(__float_as_uint(ssq), __float_as_uint(ssq), false, false); ssq = __uint_as_float(s2[0]) + __uint_as_float(s2[1]); }
                    const float rn = fminf(__builtin_amdgcn_rsqf(ssq), 1e12f);
                    const f32x4 r4 = (f32x4){bflo(pr.x), bfhi(pr.x), bflo(pr.y), bfhi(pr.y)}, k4 = (f32x4){bflo(pk.x), bfhi(pk.x), bflo(pk.y), bfhi(pk.y)}, v4 = (f32x4){bflo(pv.x), bfhi(pv.x), bflo(pv.y), bfhi(pv.y)};
                    f32x4 e4, E4, kk4, b4, kd4, rh4, cs4; float cbs = 0.f;
    #pragma unroll
                    for (int j = 0; j < 4; ++j) { e4[j] = 0.60653066f * fast_sigmoid(cw0[j] + aw[j]);
                        float t = e4[j];
                        t += __builtin_bit_cast(float, __builtin_amdgcn_update_dpp(0, __builtin_bit_cast(int, t), 0x111, 0xf, 0xf, true));
                        t += __builtin_bit_cast(float, __builtin_amdgcn_update_dpp(0, __builtin_bit_cast(int, t), 0x112, 0xf, 0xf, true));
                        t += __builtin_bit_cast(float, __builtin_amdgcn_update_dpp(0, __builtin_bit_cast(int, t), 0x114, 0xf, 0xf, true));
                        t += __builtin_bit_cast(float, __builtin_amdgcn_update_dpp(0, __builtin_bit_cast(int, t), 0x118, 0xf, 0xf, true));
                        E4[j] = t; }
    #pragma unroll
                    for (int j = 0; j < 4; ++j) {
                        const float a = fast_sigmoid(ca0[j] + aa[j]);
                        const float kkn = k4[j] * ckk[j] * rn, bq = kkn * a, kd = k4[j] * (1.0f + (a - 1.0f) * cka[j]);
                        cbs += r4[j] * kd * crk[j];
                        const float cs = __expf(-E4[j]), cinv = __builtin_amdgcn_rcpf(cs);
                        const float cp = __builtin_bit_cast(float, __builtin_amdgcn_update_dpp(0x3f800000, __builtin_bit_cast(int, cs), 0x111, 0xf, 0xf, false));
                        kk4[j] = kkn * cp; b4[j] = bq * cinv; kd4[j] = kd * cinv; rh4[j] = r4[j] * cs; cs4[j] = cs; }
                    LAS float* wb = lf + (slg * 2 + (scn & 1)) * SBUF;
                    LAS float* wp = wb + l15 * SST + 16 * q + 4 * quad;
                    *(LAS f32x4*)(wp) = kk4; *(LAS f32x4*)(wp + 64) = b4; *(LAS f32x4*)(wp + 128) = kd4; *(LAS f32x4*)(wp + 192) = rh4; *(LAS f32x4*)(wp + 256) = v4;
                    if (l15 == 15) *(LAS f32x4*)(wb + 16 * SST + 16 * q + 4 * quad) = cs4;
                    { auto s1 = __builtin_amdgcn_permlane16_swap(__float_as_uint(cbs), __float_as_uint(cbs), false, false); cbs = __uint_as_float(s1[0]) + __uint_as_float(s1[1]);
                      auto s2 = __builtin_amdgcn_permlane32_swap(__float_as_uint(cbs), __float_as_uint(cbs), false, false); cbs = __uint_as_float(s2[0]) + __uint_as_float(s2[1]); }
                    if (quad == 0) cbp[(((size_t)dn * MT + mn) * 16 + hhn) * 4 + q] = cbs;
                }
            }
            if (slot == 0) {
                const int cn = c + 1 + grp; const int g1len = ((skipmask & 8) ? 0 : 4) * 16;
                const int lg = (grp == 1 && cn >= g1len) ? 0 : grp;
                const int ltch = lg == 0 ? 128 : 16; const int subn = cn / ltch, ccn = cn % ltch;
                const bool actn = (cn >= 0) && (cn < 128) && (grp == 1 || cn < g1len);
                sact = actn; scn = cn; slg = lg;
                if (actn && !(skipmask & 4)) {
                    const int pid = lg == 0 ? it : 4 * it + subn; dn = pid & 1; hhn = (pid >> 1) & 15; const int b = pid >> 5;
                    const int T = lg == 0 ? 2048 : 256, mb = lg == 0 ? MP + b * 2048 : b * 256;
                    const int pos = ccn * 16 + l15; mn = mb + (dn == 0 ? pos : T - 1 - pos);
                    const int col4 = 64 * hhn + 16 * q + 4 * quad;
                    pr = *(const u32x2*)(rb + (size_t)mn * D + col4); pk = *(const u32x2*)(kb + (size_t)mn * D + col4); pv = *(const u32x2*)(vb + (size_t)mn * D + col4);
                    pkf0 = *(const u32x4*)(kb + (size_t)mn * D + 64 * hhn + 16 * quad); pkf1 = *(const u32x4*)(kb + (size_t)mn * D + 64 * hhn + 16 * quad + 8);
                    plw0 = *(const bf16x8*)(lb + (size_t)mn * 384 + dn * 64 + 8 * quad); plw1 = *(const bf16x8*)(lb + (size_t)mn * 384 + dn * 64 + 32 + 8 * quad);
                    pla0 = *(const bf16x8*)(lb + (size_t)mn * 384 + 128 + dn * 64 + 8 * quad); pla1 = *(const bf16x8*)(lb + (size_t)mn * 384 + 128 + dn * 64 + 32 + 8 * quad);
                    if (ccn == 0 || (grp == 1 && lg == 0 && cn == g1len)) {
                        const bf16_t* w2r = W + W_W2L + ((size_t)dn * 1024 + 64 * hhn + 16 * q + l15) * 64 + 8 * quad;
                        const bf16_t* a2r = W + W_A2L + ((size_t)dn * 1024 + 64 * hhn + 16 * q + l15) * 64 + 8 * quad;
                        W2f[0] = *(const bf16x8*)w2r; W2f[1] = *(const bf16x8*)(w2r + 32); A2f[0] = *(const bf16x8*)a2r; A2f[1] = *(const bf16x8*)(a2r + 32);
                        const int cw = 64 * hhn + 16 * q + l15;
                        if (lane < 16) { wcst[lane] = p->in[15][dn * D + cw]; wcst[16 + lane] = p->in[18][dn * D + cw]; wcst[32 + lane] = p->in[23][cw]; wcst[48 + lane] = p->in[24][cw]; wcst[64 + lane] = p->in[25][cw]; }
                        wcst[80 + lane] = p->in[23][64 * hhn + lane];
                    }
                }
                const int sub = c < 0 ? 0 : c / tch, cc = c < 0 ? 0 : c % tch; const bool act = (c >= 0) && (sub < nsub);
                if (act && !(skipmask & 1)) {
                    const int pid = grp == 0 ? it : 4 * it + sub; const int d = pid & 1, hh = (pid >> 1) & 15, b = pid >> 5;
                    const int T = grp == 0 ? 2048 : 256, mb = grp == 0 ? MP + b * 2048 : b * 256;
                    if (cc == 0) {
                        if (grp == 0) { const float* s0 = (d == 0 ? p->in[3] : p->in[4]) + ((size_t)(b * 16 + hh) * 64 + i0) * 64 + 8 * cg8;
                            const f32x4 a0 = *(const f32x4*)s0, a1 = *(const f32x4*)(s0 + 4), b0 = *(const f32x4*)(s0 + 64), b1 = *(const f32x4*)(s0 + 68);
                            Sa[0] = a0.lo; Sa[1] = a0.hi; Sa[2] = a1.lo; Sa[3] = a1.hi; Sb[0] = b0.lo; Sb[1] = b0.hi; Sb[2] = b1.lo; Sb[3] = b1.hi; }
                        else {
    #pragma unroll
                            for (int i = 0; i < 4; ++i) { Sa[i] = (f32x2){0.f, 0.f}; Sb[i] = (f32x2){0.f, 0.f}; } }
                    }
                    const LAS float* bp0 = lf + (grp * 2 + (c & 1)) * SBUF;
                    bf16_t* yo = yout + (size_t)d * MT * D + 64 * hh + i0;
                    f32x4 nk0, nk1, nb0, nb1, nd0, nd1; f32x2 nv; f32x2 rp[4];
    #define SCAN_LOAD_K(s_) do { const LAS float* bp_ = bp0 + (s_) * SST + 8 * cg8; nk0 = *(const LAS f32x4*)(bp_); nk1 = *(const LAS f32x4*)(bp_ + 4); } while (0)
    #define SCAN_LOAD_R(s_) do { const LAS float* bp_ = bp0 + (s_) * SST + 8 * cg8; const f32x4 r0_ = *(const LAS f32x4*)(bp_ + 192), r1_ = *(const LAS f32x4*)(bp_ + 196); rp[0] = r0_.lo; rp[1] = r0_.hi; rp[2] = r1_.lo; rp[3] = r1_.hi; } while (0)
    #define SCAN_LOAD_B(s_) do { const LAS float* bp_ = bp0 + (s_) * SST + 8 * cg8; nb0 = *(const LAS f32x4*)(bp_ + 64); nb1 = *(const LAS f32x4*)(bp_ + 68); \
                        nd0 = *(const LAS f32x4*)(bp_ + 128); nd1 = *(const LAS f32x4*)(bp_ + 132); nv = *(const LAS f32x2*)(bp0 + (s_) * SST + 256 + i0); } while (0)
                    SCAN_LOAD_K(0); SCAN_LOAD_B(0);
    #pragma unroll
                    for (int i = 0; i < 4; ++i) rp[i] = (f32x2){0.f, 0.f};
    #define SCAN_YFLUSH(b_) do { const LAS float* ys_ = ystage + cg8 * 128 + 16 * rl; const f32x4 q0_ = *(const LAS f32x4*)(ys_), q1_ = *(const LAS f32x4*)(ys_ + 4), q2_ = *(const LAS f32x4*)(ys_ + 8), q3_ = *(const LAS f32x4*)(ys_ + 12); \
                        const float ye_ = ((q0_[0] + q0_[2]) + (q1_[0] + q1_[2])) + ((q2_[0] + q2_[2]) + (q3_[0] + q3_[2])), yo_ = ((q0_[1] + q0_[3]) + (q1_[1] + q1_[3])) + ((q2_[1] + q2_[3]) + (q3_[1] + q3_[3])); \
                        const int pos_ = cc * 16 + 8 * (b_) + cg8; const int m_ = mb + (d == 0 ? pos_ : T - 1 - pos_); *(unsigned*)(yo + (size_t)m_ * D) = cvt_pk_bf16(ye_, yo_); } while (0)
    #pragma unroll
                    for (int s = 0; s < 16; ++s) {
                        const f32x2 kk[4] = {nk0.lo, nk0.hi, nk1.lo, nk1.hi};
                        f32x2 pa = Sa[0] * kk[0], pb = Sb[0] * kk[0], ya = Sa[0] * rp[0], yb = Sb[0] * rp[0];
    #pragma unroll
                        for (int i = 1; i < 4; ++i) { pa = Sa[i] * kk[i] + pa; pb = Sb[i] * kk[i] + pb; ya = Sa[i] * rp[i] + ya; yb = Sb[i] * rp[i] + yb; }
                        if (s < 15 && !(VAR & 2)) SCAN_LOAD_K(s + 1);
                        if (!(VAR & 2)) SCAN_LOAD_R(s);
                        float sa0 = pa.x + pa.y, sa1 = pb.x + pb.y;
                        if (s > 0) *(LAS f32x2*)(ystage + ((s - 1) & 7) * 128 + 2 * lane) = (f32x2){ya.x + ya.y, yb.x + yb.y};
                        sa0 += dpp_f<0xB1>(sa0); sa1 += dpp_f<0xB1>(sa1);
                        sa0 += dpp_f<0x4E>(sa0); sa1 += dpp_f<0x4E>(sa1);
                        sa0 += dpp_f<0x141>(sa0); sa1 += dpp_f<0x141>(sa1);
                        const f32x2 bb[4] = {nb0.lo, nb0.hi, nb1.lo, nb1.hi}, dd[4] = {nd0.lo, nd0.hi, nd1.lo, nd1.hi};
                        const f32x2 n0 = (f32x2){-sa0, -sa0}, n1 = (f32x2){-sa1, -sa1}, v0 = (f32x2){nv.x, nv.x}, v1 = (f32x2){nv.y, nv.y};
    #pragma unroll
                        for (int i = 0; i < 4; ++i) { Sa[i] = n0 * bb[i] + Sa[i]; Sb[i] = n1 * bb[i] + Sb[i]; Sa[i] = v0 * dd[i] + Sa[i]; Sb[i] = v1 * dd[i] + Sb[i]; }
                        if (s < 15 && !(VAR & 1)) SCAN_LOAD_B(s + 1);
                        if (s == 8) SCAN_YFLUSH(0);
                    }
                    {
                        f32x2 ya = Sa[0] * rp[0], yb = Sb[0] * rp[0];
    #pragma unroll
                        for (int i = 1; i < 4; ++i) { ya = Sa[i] * rp[i] + ya; yb = Sb[i] * rp[i] + yb; }
                        *(LAS f32x2*)(ystage + 7 * 128 + 2 * lane) = (f32x2){ya.x + ya.y, yb.x + yb.y};
                        const f32x4 c0 = *(const LAS f32x4*)(bp0 + 16 * SST + 8 * cg8), c1 = *(const LAS f32x4*)(bp0 + 16 * SST + 8 * cg8 + 4);
                        Sa[0] *= c0.lo; Sa[1] *= c0.hi; Sa[2] *= c1.lo; Sa[3] *= c1.hi; Sb[0] *= c0.lo; Sb[1] *= c0.hi; Sb[2] *= c1.lo; Sb[3] *= c1.hi;
                        SCAN_YFLUSH(1);
                    }
    #undef SCAN_YFLUSH
    #undef SCAN_LOAD_K
    #undef SCAN_LOAD_R
    #undef SCAN_LOAD_B
                    if (grp == 1 && cc == tch - 1) {
                        float* sf = p->out + (size_t)MT * D + (size_t)d * (32 * 16 * 4096) + ((size_t)(b * 16 + hh) * 64 + i0) * 64 + 8 * cg8;
                        *(f32x4*)sf = (f32x4){Sa[0].x, Sa[0].y, Sa[1].x, Sa[1].y}; *(f32x4*)(sf + 4) = (f32x4){Sa[2].x, Sa[2].y, Sa[3].x, Sa[3].y};
                        *(f32x4*)(sf + 64) = (f32x4){Sb[0].x, Sb[0].y, Sb[1].x, Sb[1].y}; *(f32x4*)(sf + 68) = (f32x4){Sb[2].x, Sb[2].y, Sb[3].x, Sb[3].y};
                    }
                }
            }
          }
            asm volatile("s_waitcnt lgkmcnt(0)" ::: "memory"); __builtin_amdgcn_s_barrier(); asm volatile("" ::: "memory");
        }
    }
}

#define XB_TMO      128
#define XB_XCNT(j)  (256  + 64 * (j))
#define XB_XSUB(j)  (1280 + 64 * (j))
#define XB_XGEN(j)  (2304 + 64 * (j))
#define XB_TOP      3328
#define XB_TOPGEN   3392
#define XCD_BAR_WORDS 3456
#define XB_SPIN_CAP (1u << 18)

__device__ __forceinline__ unsigned xb_ld(unsigned* p)              { return __hip_atomic_load(p, __ATOMIC_RELAXED, __HIP_MEMORY_SCOPE_AGENT); }
__device__ __forceinline__ unsigned xb_add(unsigned* p, unsigned v) { return __hip_atomic_fetch_add(p, v, __ATOMIC_RELAXED, __HIP_MEMORY_SCOPE_AGENT); }
__device__ __forceinline__ unsigned xb_xcc_id() { return (unsigned)__builtin_amdgcn_s_getreg((3 << 11) | 20) & 0xFu; }
#define XB_SPIN(cond, bar) do { unsigned _sp = 0; while (cond) { __builtin_amdgcn_s_sleep(1); \
    if ((++_sp & 255u) == 0u) { if (xb_ld(&(bar)[XB_TMO])) break; if (_sp > XB_SPIN_CAP) { atomicAdd(&(bar)[XB_TMO], 1u); break; } } } } while (0)

struct XcdBarrier {
    unsigned* bar; unsigned x;
    volatile LAS unsigned* st;
};

__device__ __forceinline__ XcdBarrier xcd_barrier_post(unsigned* bar, volatile LAS unsigned* st) {
    XcdBarrier b; b.bar = bar; b.x = xb_xcc_id(); b.st = st;
    if (threadIdx.x == 0) (void)xb_add(&bar[XB_XCNT(b.x)], 1u);
    return b;
}
__device__ __forceinline__ void xcd_barrier_complete(unsigned* bar, unsigned x, unsigned& nloc, unsigned& nx) {
    const unsigned G = gridDim.x * gridDim.y * gridDim.z;
    unsigned sum, cnt, mine, sp = 0u;
    for (;;) {
        sum = 0u; cnt = 0u; mine = 0u;
#pragma unroll
        for (unsigned j = 0; j < 16; ++j) { const unsigned c = xb_ld(&bar[XB_XCNT(j)]); sum += c; cnt += (c > 0u) ? 1u : 0u; mine = (j == x) ? c : mine; }
        if (sum == G) break;
        __builtin_amdgcn_s_sleep(1);
        if ((++sp & 255u) == 0u) { if (xb_ld(&bar[XB_TMO])) break; if (sp > XB_SPIN_CAP) { atomicAdd(&bar[XB_TMO], 1u); break; } }
    }
    nloc = mine > 0u ? mine : 1u; nx = cnt > 0u ? cnt : 1u;
}

__device__ __forceinline__ void xcd_barrier(const XcdBarrier& b) {
    asm volatile("s_waitcnt vmcnt(0)" ::: "memory");
    __syncthreads();
    if (threadIdx.x == 0) {
        unsigned* bar = b.bar;
        __builtin_amdgcn_s_waitcnt(0);
        unsigned nloc = b.st[0], nx = b.st[1];
        if (nloc == 0u) { xcd_barrier_complete(bar, b.x, nloc, nx); b.st[0] = nloc; b.st[1] = nx; }
        const unsigned old = xb_add(&bar[XB_XSUB(b.x)], 1u);
        const unsigned gen = old / nloc;
        if (old + 1u == (gen + 1u) * nloc) {
            __builtin_amdgcn_fence(__ATOMIC_RELEASE, "agent");
            asm volatile("s_waitcnt vmcnt(0)" ::: "memory");
            const unsigned og = xb_add(&bar[XB_TOP], 1u);
            const unsigned tg = og / nx;
            if (og + 1u == (tg + 1u) * nx) xb_add(&bar[XB_TOPGEN], 1u);
            else XB_SPIN(xb_ld(&bar[XB_TOPGEN]) == tg, bar);
            __builtin_amdgcn_fence(__ATOMIC_ACQUIRE, "agent");
            xb_add(&bar[XB_XGEN(b.x)], 1u);
            asm volatile("s_waitcnt vmcnt(0)" ::: "memory");
        } else {
            XB_SPIN(xb_ld(&bar[XB_XGEN(b.x)]) == gen, bar);
            __builtin_amdgcn_fence(__ATOMIC_ACQUIRE, "agent");
            asm volatile("s_waitcnt vmcnt(0)" ::: "memory");
        }
    }
    __syncthreads();
}


constexpr int NPHASE = 24;
#ifndef SPLITK
#define SPLITK 1
#endif
#ifndef ONLYMASK
#define ONLYMASK 0x1ff
#endif
#define EN(k) ((ONLYMASK >> (k)) & 1)
constexpr int LDS_BYTES = 131072 + 16;
__global__ void __launch_bounds__(512, 2) mega(Params kp) {
    extern __shared__ __attribute__((aligned(16))) unsigned char shm[];
    PG8_LAS unsigned char* lds = (PG8_LAS unsigned char*)shm;
    LAS float* lf = (LAS float*)shm;
    cg::grid_group grid = cg::this_grid();
    const int pb = kp.pb, pe = kp.pe;
    volatile LAS unsigned* xst = (volatile LAS unsigned*)(lds + 131072);
    if (threadIdx.x < 2) xst[threadIdx.x] = 0u;
    __syncthreads();
    XcdBarrier xb = xcd_barrier_post((unsigned*)(kp.ws + OFF_BAR), xst);
#ifdef PROBE_SYNC
#pragma unroll 1
    for (int i = 0; i < PROBE_SYNC; ++i) grid.sync();
#endif
#pragma unroll 1
    for (int ph = pb; ph < pe; ++ph) {
        CP p = (CP)__builtin_amdgcn_kernarg_segment_ptr();
        asm volatile("" : "+s"(p));
        Tix tx; { int t_ = threadIdx.x, b_ = blockIdx.x, g_ = gridDim.x; asm volatile("" : "+v"(t_)); asm volatile("" : "+s"(b_), "+s"(g_)); tx.tid = t_; tx.bid = b_; tx.gd = g_; }
        bf16_t* rA = (bf16_t*)(p->ws + OFF_A); bf16_t* rB = (bf16_t*)(p->ws + OFF_B); bf16_t* rC = (bf16_t*)(p->ws + OFF_C); bf16_t* rD = (bf16_t*)(p->ws + OFF_D); bf16_t* rE = (bf16_t*)(p->ws + OFF_E);
        bf16_t* rS = (bf16_t*)(p->ws + OFF_S);
        const int wsel = (ph <= 3) ? 0 : (ph <= 9) ? 1 : (ph <= 12) ? 0 : (ph <= 15) ? 1 : (ph <= 19) ? 0 : 1;
        bf16_t* W = (bf16_t*)(p->ws + (wsel ? OFF_W2 : OFF_W)); bf16_t* Wn = (bf16_t*)(p->ws + (wsel ? OFF_W : OFF_W2));
        const float* npre = p->in[8]; const float* npost = p->in[9];
        int kind = 0;
        RowCfg rc{}; int conv = -1;
        const bf16_t* gA = nullptr; const bf16_t* gB = nullptr; bf16_t* gO = nullptr; int gN = 0, gK = 0, pool_pass_id = 0;
        switch (ph) {
            case 0: kind = 0; break;
            case 1: kind = 1; rc = RowCfg{1, 0, 0, 0, 0.f, npost, 1, 0, 0, 1, npre + 0 * D, 0, SPLITK}; break;
            case 2: case 11: case 14: case 21: kind = 2; break;
            case 3: case 12: case 15: case 22: kind = 3; gA = rB; gB = W + W_W2T; gO = rE; gN = 1024; gK = 2816; conv = (ph == 3) ? 4 : (ph == 12) ? 2 : (ph == 15) ? 5 : -1; break;
            case 4: kind = 4; rc = RowCfg{1, 1, 0, 2, 0.5f, npost + 0 * D, 1, 0, 3, 4, npre + 1 * D, 1, SPLITK}; break;
            case 5: kind = 5; break;
            case 6: kind = 6; break;
            case 7: kind = 3; gA = rS; gB = W + W_BTG; gO = rC; gN = 1024; gK = 384; break;
            case 8: kind = 7; break;
            case 9: kind = 3; gA = rD; gB = W + W_WOT; gO = rE; gN = 1024; gK = 1024; conv = 1; break;
            case 10: kind = 1; rc = RowCfg{0, 1, 0, 5, 1.0f, npost + 1 * D, 1, 0, 6, 7, npre + 2 * D, 1, SPLITK}; break;
            case 13: kind = 1; rc = RowCfg{0, 1, 0, 8, 0.5f, npost + 2 * D, 1, 1, 0, 1, npre + 3 * D, 1, SPLITK}; break;
            case 16: kind = 1; rc = RowCfg{0, 1, 1, 2, 0.5f, npost + 3 * D, 1, 1, 3, 4, npre + 4 * D, 1, SPLITK}; break;
            case 17: kind = 8; pool_pass_id = 0; break;
            case 18: kind = 8; pool_pass_id = 1; break;
            case 19: kind = 3; gA = rD; gB = W; gO = rE; gN = 1024; gK = 1024; conv = 3; break;
            case 20: kind = 1; rc = RowCfg{0, 1, 1, 5, 1.0f, npost + 4 * D, 1, 1, 6, 7, npre + 5 * D, 1, SPLITK}; break;
            case 23: kind = 1; rc = RowCfg{0, 1, 1, 8, 0.5f, npost + 5 * D, 0, 0, 0, 0, npre, 1, SPLITK}; break;
            default: break;
        }
        rc.fsplit = (SPLITK && tx.gd == 256) ? 1 : 0;
#ifdef PROBE_PH
        const int reps = (ph == PROBE_PH) ? PROBE_N : 1;
#else
        const int reps = 1;
#endif
#pragma unroll 1
        for (int rep = 0; rep < reps; ++rep) {
        if (rep > 0) xcd_barrier(xb);
        asm volatile("" : "+v"(tx.tid)); asm volatile("" : "+s"(tx.bid), "+s"(tx.gd)); asm volatile("" : "+s"(p));
        if (EN(0) && kind == 0) { mod_phase(p, lf, tx); __syncthreads();
            if (tx.gd > 64) { if (tx.bid >= 32) { const Tix tv{tx.tid, tx.bid - 32, tx.gd - 32}; conv_ffn(p, W, 0, lf + 16384, tv); } }
            else conv_ffn(p, W, 0, lf + 16384, tx); }
        else if (EN(1) && kind == 1) { rowpass_simple(p, rc, tx); }
        else if (EN(4) && kind == 4) { rowpass_shift(p, rc, lf, tx); }
        else if (EN(2) && (kind == 2 || kind == 3 || kind == 5)) {
            if (kind == 2) { gA = rA; gB = W + W_W13; gO = rB; gN = 5632; gK = 1024; } else if (kind == 5) { gA = rA; gB = W + W_BTP; gO = rC; gN = 3584; gK = 2048; }
            const int bal = (SPLITK && kind == 3 && gK >= 1024 && tx.gd == 256) ? 1 : 0;
            pg8::Gemm g{gA, gB, MT, gN, gK}; pg8::FwdOrder S; S.init(MT, gN, gK, tx.gd, tx.bid, bal);
            pg8::EpiAll E{kind == 3 ? 0 : (kind == 2 ? 1 : 2), gO, kind == 2 ? DFF : 1024, rS, (bf16_t*)(p->ws + OFF_FB) - (size_t)16384 * 1024};
#ifdef PROBE_NOEPI
            if (rep + 1 < reps) E.kind = 7;
#endif
            pg8::gemm_phase<pg8::EpiAll, pg8::FwdOrder, false>(lds, g, S, E, nullptr, tx.tid);
            if (conv >= 0) { const int half = bal ? 0 : (tx.gd >> 1); if (tx.bid >= half) { const Tix tv{tx.tid, tx.bid - half, tx.gd - half};
                if (conv < 4) conv_ffn(p, Wn, conv, lf, tv); else if (conv == 4) conv_rwkv(p, Wn, lf, tv); else conv_pool(p, Wn, tv); } } }
        else if (EN(6) && kind == 6) {
#ifdef PROBE_VAR
            if (rep + 1 < reps) scan_phase<PROBE_VAR>(p, W, lf, tx, 0); else scan_phase<0>(p, W, lf, tx, 0);
#elif defined(PROBE_MASK)
            scan_phase<0>(p, W, lf, tx, (rep + 1 < reps) ? PROBE_MASK : 0);
#else
            scan_phase<0>(p, W, lf, tx, 0);
#endif
        }
        else if (EN(7) && kind == 7) rowpass_gn(p, tx);
        else if (EN(8) && kind == 8) pool_pass(p, pool_pass_id, tx);
        }
        if (ph + 1 < pe) { if (pb > pe) grid.sync(); else xcd_barrier(xb); }
    }
}

#include <cstdio>
#ifndef USE_COOP
#define USE_COOP 1
#endif
extern "C" void kernel_launch(void* const* d_in, const int* in_sizes, int n_in, void* d_out, int out_size, void* d_ws, size_t ws_size, hipStream_t stream) {
    static int grid = 0;
    if (grid == 0) {
        if (n_in != NIN || ws_size < WS_NEED) { fprintf(stderr, "kernel_launch: n_in %d ws %zu (need %zu)\n", n_in, ws_size, (size_t)WS_NEED); grid = -1; return; }
        int dev = 0, cus = 0, per_cu = 0;
        hipGetDevice(&dev); hipDeviceGetAttribute(&cus, hipDeviceAttributeMultiprocessorCount, dev);
        if (hipFuncSetAttribute((const void*)mega, hipFuncAttributeMaxDynamicSharedMemorySize, LDS_BYTES) != hipSuccess) { fprintf(stderr, "kernel_launch: hipFuncSetAttribute failed\n"); grid = -1; return; }
        if (hipOccupancyMaxActiveBlocksPerMultiprocessor(&per_cu, (const void*)mega, 512, LDS_BYTES) != hipSuccess || per_cu < 1) { fprintf(stderr, "kernel_launch: occupancy query says %d\n", per_cu); per_cu = 1; }
        (void)hipGetLastError();
        grid = cus * 1;
        if (grid <= 0) grid = 256;
    }
    if (grid < 0) return;
    if (hipMemsetAsync((unsigned char*)d_ws + OFF_BAR, 0, 16384, stream) != hipSuccess) { fprintf(stderr, "kernel_launch: memset of the barrier words failed\n"); return; }
    Params p{};
    for (int i = 0; i < NIN; ++i) p.in[i] = (const float*)d_in[i];
    p.out = (float*)d_out; p.ws = (unsigned char*)d_ws;
#if USE_COOP
    p.pb = 0; p.pe = NPHASE;
    void* args[] = {&p};
    hipError_t e = hipLaunchCooperativeKernel((const void*)mega, dim3(grid), dim3(512), args, LDS_BYTES, stream);
    if (e != hipSuccess) fprintf(stderr, "cooperative launch failed: %s (grid %d)\n", hipGetErrorString(e), grid);
#else
    for (int ph = 0; ph < NPHASE; ++ph) { p.pb = ph; p.pe = ph + 1; hipLaunchKernelGGL(mega, dim3(grid), dim3(512), LDS_BYTES, stream, p); }
#endif
}
```

```cpp
#include <hip/hip_runtime.h>
#include <hip/hip_cooperative_groups.h>
namespace pg8 {
#define PG8_LAS __attribute__((address_space(3)))
typedef unsigned short bf16_t;
typedef short bf16x8 __attribute__((ext_vector_type(8)));
typedef float f32x4 __attribute__((ext_vector_type(4)));
typedef unsigned u32x4 __attribute__((ext_vector_type(4)));
constexpr int BM = 256, BK = 64, HALF = 128, HTB = HALF * BK * 2  , STAGE_BYTES = 8 * HTB, NXCD = 8, WGM = 8;

__host__ __device__ __forceinline__ int lds_byte(int r, int c) { const int st = (r >> 4) * 2 + (c >> 5), rr = r & 15, cc = c & 31, ob = rr * 64 + cc * 2; return st * 1024 + (ob ^ (((ob >> 9) & 1) << 5)); }
__host__ __device__ __forceinline__ void stage_rc(int b, int& R, int& C) { const int st = b / 1024, sb = b % 1024, swz = sb ^ (((sb >> 9) & 1) << 5); R = (st >> 1) * 16 + swz / 64; C = (st & 1) * 32 + (swz % 64) / 2; }
__host__ __device__ __forceinline__ int perm32(int rho) { const int n = rho >> 4, i = rho & 15; return 8 * (i >> 2) + 4 * n + (i & 3); }

struct Unit { int pm, pn, part; };
struct Gemm { const bf16_t* A; const bf16_t* Bt; int M, N, K; };

struct StaticOrder {
    int nM, nN, nwg, G, c;
    __host__ __device__ void init(int M, int N, int G_, int c_) { nM = M / BM; nN = N / BM; nwg = nM * nN; G = G_; c = c_; }
    __host__ __device__ bool next(int i, Unit& u) const {
        const long L = (long)i * G + c; if (L >= nwg) return false;
        int wgid = (int)L; { const int q = nwg / NXCD, r = nwg % NXCD, xcd = wgid % NXCD, off = wgid / NXCD; wgid = (xcd < r ? xcd * (q + 1) : r * (q + 1) + (xcd - r) * q) + off; }
        const int nig = WGM * nN, gid = wgid / nig, fm = gid * WGM, gsz = (nM - fm) < WGM ? (nM - fm) : WGM;
        u.pm = fm + ((wgid % nig) % gsz); u.pn = (wgid % nig) / gsz; u.part = 0; return true;
    }
    __device__ __forceinline__ void a_ready(const Unit&) const {}
    __device__ __forceinline__ void done(const Unit&) const {}
};
struct FwdOrder {
    StaticOrder so; int mode;
    __host__ __device__ void init(int M, int N, int K, int G_, int c_, int mode_) { so.init(M, N, G_, c_); mode = mode_; }
    __host__ __device__ bool next(int i, Unit& u) const {
        if (mode == 0) return so.next(i, u);
        if (i >= 2) return false;
        const int w = (so.c & 7) * 32 + (so.c >> 3);
        if (i == 0) { u.pm = w >> 2; u.pn = w & 3; u.part = 0; }
        else { u.pm = 64 + (w >> 3); u.pn = (w >> 1) & 3; u.part = 1 + (w & 1); }
        return true;
    }
    __device__ __forceinline__ void a_ready(const Unit&) const {}
    __device__ __forceinline__ void done(const Unit&) const {}
};
__device__ __forceinline__ unsigned cvt_pk_bf16(float lo, float hi) { unsigned r; asm volatile("v_cvt_pk_bf16_f32 %0, %1, %2" : "=v"(r) : "v"(lo), "v"(hi)); return r; }
typedef float f32x2 __attribute__((ext_vector_type(2)));
__device__ __forceinline__ float fast_sigmoid(float x) { return __builtin_amdgcn_rcpf(1.0f + __expf(-x)); }
__device__ __forceinline__ float fast_tanh(float x) { return 1.0f - 2.0f * __builtin_amdgcn_rcpf(1.0f + __expf(2.0f * x)); }
struct EpiStore {
    static constexpr bool PERM = true, AFTER_DRAIN = false;
    bf16_t* O; int ldc;
    __device__ __forceinline__ void operator()(const f32x4 (&acc)[2][2][4][2], const Unit& u, int wr, int wc, int fr, int fq) const {
        const int row0 = u.pm * BM + wr * 64 + fr, col0 = u.pn * BM + wc * 32 + 8 * fq;
#pragma unroll
        for (int ai = 0; ai < 2; ++ai)
#pragma unroll
            for (int m = 0; m < 4; ++m) { bf16_t* rowp = O + (size_t)(row0 + ai * HALF + m * 16) * ldc + col0;
#pragma unroll
                for (int bj = 0; bj < 2; ++bj) { const f32x4 v0 = acc[ai][bj][m][0], v1 = acc[ai][bj][m][1];
                    u32x4 w; w.x = cvt_pk_bf16(v0[0], v0[1]); w.y = cvt_pk_bf16(v0[2], v0[3]); w.z = cvt_pk_bf16(v1[0], v1[1]); w.w = cvt_pk_bf16(v1[2], v1[3]);
                    *(u32x4*)(rowp + bj * HALF) = w; } }
    }
};
struct EpiSwiglu {
    static constexpr bool PERM = true, AFTER_DRAIN = false;
    bf16_t* O; int ldc;
    __device__ __forceinline__ void operator()(const f32x4 (&acc)[2][2][4][2], const Unit& u, int wr, int wc, int fr, int fq) const {
        const int row0 = u.pm * BM + wr * 64 + fr, col0 = u.pn * HALF + wc * 32 + 8 * fq;
#pragma unroll
        for (int ai = 0; ai < 2; ++ai)
#pragma unroll
            for (int m = 0; m < 4; ++m) { bf16_t* rowp = O + (size_t)(row0 + ai * HALF + m * 16) * ldc + col0;
                float o[8];
#pragma unroll
                for (int n = 0; n < 2; ++n)
#pragma unroll
                    for (int j = 0; j < 4; ++j) { const float a = acc[ai][0][m][n][j], b = acc[ai][1][m][n][j]; o[n * 4 + j] = a * fast_sigmoid(a) * b; }
                u32x4 w; w.x = cvt_pk_bf16(o[0], o[1]); w.y = cvt_pk_bf16(o[2], o[3]); w.z = cvt_pk_bf16(o[4], o[5]); w.w = cvt_pk_bf16(o[6], o[7]);
                *(u32x4*)rowp = w; }
    }
};
struct EpiRkv {
    static constexpr bool PERM = true, AFTER_DRAIN = false;
    bf16_t* O; size_t tstride; bf16_t* L;
    __device__ __forceinline__ void operator()(const f32x4 (&acc)[2][2][4][2], const Unit& u, int wr, int wc, int fr, int fq) const {
        const int row0 = u.pm * BM + wr * 64 + fr;
        if (u.pn < 12) {
            bf16_t* base = O + (size_t)(u.pn >> 2) * tstride; const int col0 = (u.pn & 3) * BM + wc * 32 + 8 * fq;
#pragma unroll
            for (int ai = 0; ai < 2; ++ai)
#pragma unroll
                for (int m = 0; m < 4; ++m) { bf16_t* rowp = base + (size_t)(row0 + ai * HALF + m * 16) * 1024 + col0;
#pragma unroll
                    for (int bj = 0; bj < 2; ++bj) { const f32x4 v0 = acc[ai][bj][m][0], v1 = acc[ai][bj][m][1];
                        u32x4 w; w.x = cvt_pk_bf16(v0[0], v0[1]); w.y = cvt_pk_bf16(v0[2], v0[3]); w.z = cvt_pk_bf16(v1[0], v1[1]); w.w = cvt_pk_bf16(v1[2], v1[3]);
                        *(u32x4*)(rowp + bj * HALF) = w; } }
        } else {
            const int t13 = (u.pn == 13); const int col0 = (u.pn - 12) * BM + wc * 32 + 8 * fq;
#pragma unroll
            for (int ai = 0; ai < 2; ++ai)
#pragma unroll
                for (int m = 0; m < 4; ++m) { bf16_t* rowp = L + (size_t)(row0 + ai * HALF + m * 16) * 384 + col0;
#pragma unroll
                    for (int bj = 0; bj < 2; ++bj) { if (t13 && bj == 1) continue;
                        float o[8];
#pragma unroll
                        for (int n = 0; n < 2; ++n)
#pragma unroll
                            for (int j = 0; j < 4; ++j) { const float a = acc[ai][bj][m][n][j]; o[n * 4 + j] = t13 ? fast_sigmoid(a) : (bj == 0 ? fast_tanh(a) : a); }
                        u32x4 w; w.x = cvt_pk_bf16(o[0], o[1]); w.y = cvt_pk_bf16(o[2], o[3]); w.z = cvt_pk_bf16(o[4], o[5]); w.w = cvt_pk_bf16(o[6], o[7]);
                        *(u32x4*)(rowp + bj * HALF) = w; } }
        }
    }
};

struct EpiAll {
    static constexpr bool PERM = true, AFTER_DRAIN = false;
    int kind; bf16_t* O; int ldc; bf16_t* L; bf16_t* O2;
    __device__ __forceinline__ void operator()(const f32x4 (&acc)[2][2][4][2], const Unit& u, int wr, int wc, int fr, int fq) const {
        if (kind == 0) { EpiStore e{u.part == 2 ? O2 : O, ldc}; e(acc, u, wr, wc, fr, fq); }
        else if (kind == 1) { EpiSwiglu e{O, ldc}; e(acc, u, wr, wc, fr, fq); }
        else if (kind == 2) { EpiRkv e{O, (size_t)24576 * 1024, L}; e(acc, u, wr, wc, fr, fq); }
    }
};
template <class Epi, class Sched, bool STAMP = false>
__device__ __forceinline__ void gemm_phase(PG8_LAS unsigned char* lds, const Gemm g, const Sched& S, const Epi& E, unsigned long long* stamps, const int tid_in) {
    const int tid = tid_in, wid = __builtin_amdgcn_readfirstlane(tid >> 6), lane = tid & 63, wr = wid >> 2, wc = wid & 3, fr = lane & 15, fq = lane >> 4;
    const int K = g.K; int nt = K / BK;
    int ts_lo = 0, ts_hi = 0, nts = 0; const unsigned long long rt_entry = STAMP ? (unsigned long long)wall_clock64() : 0ull;
#define PG8_STAMP() do { if (STAMP && wid == 0 && nts < 64) { const unsigned long long _c = (unsigned long long)clock64(); \
        ts_lo = (lane == nts) ? (int)(unsigned)_c : ts_lo; ts_hi = (lane == nts) ? (int)(unsigned)(_c >> 32) : ts_hi; ++nts; } } while (0)
    PG8_STAMP();
    unsigned voffA[2], voffB[2];
#pragma unroll
    for (int i = 0; i < 2; ++i) { int R, C; stage_rc(tid * 16 + i * 8192, R, C); const int Rb = Epi::PERM ? ((R & ~31) + perm32(R & 31)) : R;
        voffA[i] = (unsigned)(R * K + C) * 2u; voffB[i] = (unsigned)(Rb * K + C) * 2u; }
    const size_t kstep = (size_t)(BK * 2);
    const size_t hstep = (size_t)HALF * K * 2;
    const size_t tstep = 2 * hstep;
    const unsigned ldsw = (unsigned)wid * 1024u;
    const int aoff = lds_byte(wr * 64 + fr, fq * 8), boff = lds_byte(wc * 32 + fr, fq * 8);
#define PG8_SA(b, h) (((b) * 2 + (h)) * HTB)
#define PG8_SB(b, h) ((4 + (b) * 2 + (h)) * HTB)
#define PG8_STAGE(bufoff, gbase, voff) do { _Pragma("unroll") for (int _i = 0; _i < 2; ++_i) \
        __builtin_amdgcn_global_load_lds((const unsigned*)((const char*)(gbase) + (voff)[_i]), (PG8_LAS unsigned*)(lds + (bufoff) + ldsw + _i * 8192), 16, 0, 0); } while (0)
#define PG8_LDA(dst, b, h) do { _Pragma("unroll") for (int m = 0; m < 4; ++m) _Pragma("unroll") for (int k = 0; k < 2; ++k) dst[m][k] = *(const PG8_LAS bf16x8*)(lds + PG8_SA(b, h) + aoff + m * 2048 + k * 1024); } while (0)
#define PG8_LDB(dst, b, h) do { _Pragma("unroll") for (int n = 0; n < 2; ++n) _Pragma("unroll") for (int k = 0; k < 2; ++k) dst[n][k] = *(const PG8_LAS bf16x8*)(lds + PG8_SB(b, h) + boff + n * 2048 + k * 1024); } while (0)
#define PG8_MMA(ai, bj, At, Bt) do { __builtin_amdgcn_s_setprio(1); _Pragma("unroll") for (int m = 0; m < 4; ++m) _Pragma("unroll") for (int n = 0; n < 2; ++n) _Pragma("unroll") for (int k = 0; k < 2; ++k) \
        acc[ai][bj][m][n] = __builtin_amdgcn_mfma_f32_16x16x32_bf16(Bt[n][k], At[m][k], acc[ai][bj][m][n], 0, 0, 0); __builtin_amdgcn_s_setprio(0); } while (0)
#define PG8_WAIT_V(n) asm volatile("s_waitcnt vmcnt(" #n ")" ::: "memory")
#define PG8_WAIT_L(n) asm volatile("s_waitcnt lgkmcnt(" #n ")" ::: "memory")
#define PG8_BAR __builtin_amdgcn_s_barrier()
#define PG8_SCHED __builtin_amdgcn_sched_barrier(0)
    Unit cur, nxt; int ui = 0;
    if (!S.next(0, cur)) return;
    f32x4 acc[2][2][4][2];
#pragma unroll
    for (int a = 0; a < 2; ++a)
#pragma unroll
        for (int b = 0; b < 2; ++b)
#pragma unroll
            for (int m = 0; m < 4; ++m)
#pragma unroll
                for (int n = 0; n < 2; ++n) acc[a][b][m][n] = (f32x4){0.f, 0.f, 0.f, 0.f};
    bf16x8 At[4][2], B0[2][2], B1[2][2];
    const char* cA = (const char*)g.A + (size_t)cur.pm * tstep + (cur.part == 2 ? (size_t)K : (size_t)0); const char* cB = (const char*)g.Bt + (size_t)cur.pn * tstep + (cur.part == 2 ? (size_t)K : (size_t)0);
    nt = cur.part ? K / (2 * BK) : K / BK;
    S.a_ready(cur);
    PG8_STAGE(PG8_SB(0, 0), cB, voffB); PG8_STAGE(PG8_SA(0, 0), cA, voffA); PG8_STAGE(PG8_SB(0, 1), cB + hstep, voffB); PG8_STAGE(PG8_SA(0, 1), cA + hstep, voffA);
    if (wr == 1) PG8_BAR;
    PG8_WAIT_V(4); PG8_BAR;
    PG8_STAGE(PG8_SB(1, 0), cB + kstep, voffB); PG8_STAGE(PG8_SA(1, 0), cA + kstep, voffA); PG8_STAGE(PG8_SB(1, 1), cB + hstep + kstep, voffB);
    PG8_WAIT_V(6); PG8_BAR;
    PG8_STAMP();
    for (;;) {
        const bool has_next = S.next(ui + 1, nxt);
        const char* nA = has_next ? (const char*)g.A + (size_t)nxt.pm * tstep + (nxt.part == 2 ? (size_t)K : (size_t)0) : cA; const char* nB = has_next ? (const char*)g.Bt + (size_t)nxt.pn * tstep + (nxt.part == 2 ? (size_t)K : (size_t)0) : cB;
        for (int t = 0; t < nt; t += 2) {
            const bool last = (t == nt - 2);
            const char* a1 = cA + (size_t)(t + 1) * kstep;
            const char* a2 = last ? nA : cA + (size_t)(t + 2) * kstep; const char* b2 = last ? nB : cB + (size_t)(t + 2) * kstep;
            const char* a3 = a2 + kstep; const char* b3 = b2 + kstep;
            if (last && has_next) S.a_ready(nxt);
            PG8_LDB(B0, 0, 0); PG8_SCHED; PG8_LDA(At, 0, 0); PG8_STAGE(PG8_SA(1, 1), a1 + hstep, voffA);
            PG8_WAIT_L(8); PG8_BAR; PG8_WAIT_L(0); PG8_MMA(0, 0, At, B0); PG8_BAR; PG8_SCHED;
            PG8_LDB(B1, 0, 1); PG8_STAGE(PG8_SB(0, 0), b2, voffB);
            PG8_BAR; PG8_WAIT_L(0); PG8_MMA(0, 1, At, B1); PG8_BAR;
            PG8_LDA(At, 0, 1); PG8_STAGE(PG8_SA(0, 0), a2, voffA);
            PG8_BAR; PG8_WAIT_L(0); PG8_MMA(1, 0, At, B0); PG8_BAR; PG8_SCHED;
            PG8_STAGE(PG8_SB(0, 1), b2 + hstep, voffB);
            PG8_WAIT_V(6); PG8_BAR; PG8_MMA(1, 1, At, B1); PG8_BAR;
            PG8_LDB(B0, 1, 0); PG8_SCHED; PG8_LDA(At, 1, 0); PG8_STAGE(PG8_SA(0, 1), a2 + hstep, voffA);
            PG8_WAIT_L(8); PG8_BAR; PG8_WAIT_L(0); PG8_MMA(0, 0, At, B0); PG8_BAR; PG8_SCHED;
            PG8_LDB(B1, 1, 1); PG8_STAGE(PG8_SB(1, 0), b3, voffB);
            PG8_BAR; PG8_WAIT_L(0); PG8_MMA(0, 1, At, B1); PG8_BAR;
            PG8_LDA(At, 1, 1); PG8_STAGE(PG8_SA(1, 0), a3, voffA);
            PG8_BAR; PG8_WAIT_L(0); PG8_MMA(1, 0, At, B0); PG8_BAR; PG8_SCHED;
            PG8_STAGE(PG8_SB(1, 1), b3 + hstep, voffB);
            PG8_WAIT_V(6); PG8_BAR; PG8_MMA(1, 1, At, B1); PG8_BAR;
        }
        PG8_STAMP();
        if constexpr (!Epi::AFTER_DRAIN) { E(acc, cur, wr, wc, fr, fq); S.done(cur); }
        PG8_STAMP();
        if (!has_next) break;
#pragma unroll
        for (int a = 0; a < 2; ++a)
#pragma unroll
            for (int b = 0; b < 2; ++b)
#pragma unroll
                for (int m = 0; m < 4; ++m)
#pragma unroll
                    for (int n = 0; n < 2; ++n) acc[a][b][m][n] = (f32x4){0.f, 0.f, 0.f, 0.f};
        cur = nxt; cA = nA; cB = nB; ++ui; nt = cur.part ? K / (2 * BK) : K / BK;
    }
    PG8_WAIT_V(0);
    if (wr == 0) PG8_BAR;
    PG8_BAR;
    if constexpr (Epi::AFTER_DRAIN) { E.fused(acc, cur, wr, wc, fr, fq, lds, wid, lane); S.done(cur); }
    PG8_STAMP();
    if (STAMP && wid == 0) { stamps[lane] = lane < nts ? (((unsigned long long)(unsigned)ts_hi << 32) | (unsigned)ts_lo) : 0ull;
        if (lane == 62) stamps[62] = rt_entry; if (lane == 63) stamps[63] = (unsigned long long)wall_clock64(); }
#undef PG8_STAMP
#undef PG8_SA
#undef PG8_SB
#undef PG8_STAGE
#undef PG8_LDA
#undef PG8_LDB
#undef PG8_MMA
#undef PG8_WAIT_V
#undef PG8_WAIT_L
#undef PG8_BAR
#undef PG8_SCHED
}
}

namespace cg = cooperative_groups;
using pg8::bf16_t; using pg8::bf16x8; using pg8::f32x4; using pg8::u32x4; using pg8::cvt_pk_bf16; using pg8::fast_sigmoid;
#define LAS __attribute__((address_space(3)))
typedef float f32x2 __attribute__((ext_vector_type(2)));
typedef unsigned u32x2 __attribute__((ext_vector_type(2)));

constexpr int D = 1024, DFF = 2816, MP = 8192, MS = 16384, MT = 24576;
constexpr int NIN = 31;
constexpr size_t R48 = (size_t)MT * 1024 * 2;
constexpr size_t OFF_A = 0, OFF_B = R48, OFF_C = 2 * R48, OFF_D = 3 * R48, OFF_E = 4 * R48;
constexpr size_t OFF_S = 5 * R48;
constexpr size_t OFF_W = OFF_S + (size_t)MT * 384 * 2;
constexpr size_t W_ELEMS = 9043968;
constexpr size_t OFF_MOD = OFF_W + W_ELEMS * 2;
constexpr size_t OFF_CBP = OFF_MOD + (size_t)9 * 2 * 9216 * 4;
constexpr size_t OFF_BAR = OFF_CBP + (size_t)2 * MT * 64 * 4;
constexpr size_t OFF_W2 = OFF_BAR + 16384;
constexpr size_t OFF_FB = OFF_W2 + W_ELEMS * 2;
constexpr size_t WS_NEED = OFF_FB + (size_t)8192 * 1024 * 2;
constexpr size_t W_W13 = 0, W_W2T = (size_t)5632 * 1024;
constexpr size_t W_BTP = 0, W_BTG = (size_t)3584 * 2048, W_WOT = W_BTG + (size_t)1024 * 384, W_W2L = W_WOT + (size_t)1024 * 1024, W_A2L = W_W2L + 131072;
constexpr float RMS_EPS = 1e-6f, GN_EPS = 64e-5f;

struct Tix { int tid, bid, gd; };
struct Params { const float* in[NIN]; float* out; unsigned char* ws; int pb, pe; };
typedef const Params __attribute__((address_space(4)))* CP;

__device__ __forceinline__ float bf2f(unsigned short b) { return __uint_as_float(((unsigned)b) << 16); }
__device__ __forceinline__ float bflo(unsigned w) { return __uint_as_float(w << 16); }
__device__ __forceinline__ float bfhi(unsigned w) { return __uint_as_float(w & 0xffff0000u); }
template <int CTRL> __device__ __forceinline__ float dpp_f(float x) { return __builtin_bit_cast(float, __builtin_amdgcn_mov_dpp(__builtin_bit_cast(int, x), CTRL, 0xf, 0xf, true)); }
__device__ __forceinline__ float row16_sum(float v) { v += dpp_f<0xB1>(v); v += dpp_f<0x4E>(v); v += dpp_f<0x141>(v); v += dpp_f<0x128>(v); return v; }
__device__ __forceinline__ float wave_sum(float v) {
    v = row16_sum(v);
    auto s1 = __builtin_amdgcn_permlane16_swap(__float_as_uint(v), __float_as_uint(v), false, false); v = __uint_as_float(s1[0]) + __uint_as_float(s1[1]);
    auto s2 = __builtin_amdgcn_permlane32_swap(__float_as_uint(v), __float_as_uint(v), false, false); v = __uint_as_float(s2[0]) + __uint_as_float(s2[1]);
    return v;
}
__device__ __forceinline__ float reduce8(float x) { x += dpp_f<0xB1>(x); x += dpp_f<0x4E>(x); x += dpp_f<0x141>(x); return x; }

struct ConvJob { const float* src; int K, N; bf16_t* dst; int dld, kofs, blk, blk_stride, row_off; const float* ksc; };
__device__ __forceinline__ void conv_job(const ConvJob j, LAS float* tile, int& rot, const Tix tx) {
    const int tid = tx.tid, G = tx.gd;
    const int tn = j.N >> 6, nt = (j.K >> 6) * tn;
    int t0 = (tx.bid - (rot % G) + G) % G;
    for (int t = t0; t < nt; t += G) {
        const int k0 = (t / tn) << 6, n0 = (t % tn) << 6;
        { const int r = tid >> 4, c4 = tid & 15;
#pragma unroll
          for (int it = 0; it < 2; ++it) { const int k = r + 32 * it; const float4 v = *(const float4*)(j.src + (size_t)(k0 + k) * j.N + n0 + 4 * c4);
              LAS float* tp = tile + k * 65 + 4 * c4; tp[0] = v.x; tp[1] = v.y; tp[2] = v.z; tp[3] = v.w; } }
        __syncthreads();
        { const int n = tid >> 3, kg = tid & 7; float v[8];
#pragma unroll
          for (int i = 0; i < 8; ++i) { v[i] = tile[(8 * kg + i) * 65 + n]; if (j.ksc) v[i] *= j.ksc[k0 + 8 * kg + i]; }
          u32x4 w; w.x = cvt_pk_bf16(v[0], v[1]); w.y = cvt_pk_bf16(v[2], v[3]); w.z = cvt_pk_bf16(v[4], v[5]); w.w = cvt_pk_bf16(v[6], v[7]);
          const int gn = n0 + n; const int drow = (gn / j.blk) * j.blk_stride + (gn % j.blk) + j.row_off;
          *(u32x4*)(j.dst + (size_t)drow * j.dld + j.kofs + k0 + 8 * kg) = w; }
        __syncthreads();
    }
    rot += nt;
}
__device__ void conv_ffn(CP p, bf16_t* W, int fi, LAS float* tile, const Tix tx) {
    int rot = 0;
    conv_job(ConvJob{p->in[10] + (size_t)fi * D * DFF, D, DFF, W + W_W13, 1024, 0, 128, 256, 0, nullptr}, tile, rot, tx);
    conv_job(ConvJob{p->in[11] + (size_t)fi * D * DFF, D, DFF, W + W_W13, 1024, 0, 128, 256, 128, nullptr}, tile, rot, tx);
    conv_job(ConvJob{p->in[12] + (size_t)fi * D * DFF, DFF, D, W + W_W2T, 2816, 0, 1024, 1024, 0, nullptr}, tile, rot, tx);
}
__device__ void conv_rwkv(CP p, bf16_t* W, LAS float* tile, const Tix tx) {
    int rot = 0;
    const float* mu = p->in[13];
    for (int half = 0; half < 2; ++half) {
        const int ko = half * 1024;
        for (int i = 0; i < 3; ++i) { const int mi = (i == 0) ? 0 : (i == 1 ? 2 : 3);
            conv_job(ConvJob{p->in[14] + (size_t)i * D * D, D, D, W + W_BTP, 2048, ko, 1024, 1024, i * 1024, half ? mu + mi * D : nullptr}, tile, rot, tx); }
        for (int d = 0; d < 2; ++d) {
            conv_job(ConvJob{p->in[16] + (size_t)d * D * 64, D, 64, W + W_BTP, 2048, ko, 64, 64, 3072 + 64 * d, half ? mu + 1 * D : nullptr}, tile, rot, tx);
            conv_job(ConvJob{p->in[19] + (size_t)d * D * 64, D, 64, W + W_BTP, 2048, ko, 64, 64, 3200 + 64 * d, half ? mu + 4 * D : nullptr}, tile, rot, tx); }
        conv_job(ConvJob{p->in[21], D, 128, W + W_BTP, 2048, ko, 128, 128, 3328, half ? mu + 5 * D : nullptr}, tile, rot, tx);
    }
    conv_job(ConvJob{p->in[22], 128, D, W + W_BTG, 384, 256, 1024, 1024, 0, nullptr}, tile, rot, tx);
    for (int idx = tx.bid * 512 + tx.tid; idx < 1024 * 32; idx += tx.gd * 512) { const int n = idx >> 5, k8 = idx & 31; *(u32x4*)(W + W_BTG + (size_t)n * 384 + 8 * k8) = (u32x4){0u, 0u, 0u, 0u}; }
    conv_job(ConvJob{p->in[28], D, D, W + W_WOT, 1024, 0, 1024, 1024, 0, nullptr}, tile, rot, tx);
    for (int d = 0; d < 2; ++d) {
        conv_job(ConvJob{p->in[17] + (size_t)d * 64 * D, 64, D, W + W_W2L + (size_t)d * 65536, 64, 0, 1024, 1024, 0, nullptr}, tile, rot, tx);
        conv_job(ConvJob{p->in[20] + (size_t)d * 64 * D, 64, D, W + W_A2L + (size_t)d * 65536, 64, 0, 1024, 1024, 0, nullptr}, tile, rot, tx); }
}
__device__ void conv_pool(CP p, bf16_t* W, const Tix tx) {
    const float* pw = p->in[29]; const float* ps = p->in[30];
    for (int idx = tx.bid * 512 + tx.tid; idx < 1024 * 128; idx += tx.gd * 512) {
        const int k8 = idx >> 10, n = idx & 1023, g = n >> 8; u32x4 w = (u32x4){0u, 0u, 0u, 0u};
        if ((k8 >> 5) == g) { const float s = ps[n]; float v[8];
#pragma unroll
            for (int i = 0; i < 8; ++i) v[i] = pw[((size_t)g * 256 + ((8 * k8 + i) & 255)) * 256 + (n & 255)] * s;
            w.x = cvt_pk_bf16(v[0], v[1]); w.y = cvt_pk_bf16(v[2], v[3]); w.z = cvt_pk_bf16(v[4], v[5]); w.w = cvt_pk_bf16(v[6], v[7]); }
        *(u32x4*)(W + (size_t)n * 1024 + 8 * k8) = w; }
}

__device__ void mod_phase(CP p, LAS float* lf, const Tix tx) {
    LAS float* sc = lf; LAS float* red = lf + 9216;
    const int tid = tx.tid;
    if (tx.bid >= 288) return;
    for (int o = tid; o < 9216; o += 512) { const int c = o >> 10, k = o & 1023; const float v = (c == 0) ? p->in[5][k] : p->in[2][(c - 1) * 1024 + k]; sc[o] = v * fast_sigmoid(v); }
    __syncthreads();
    float* mod = (float*)(p->ws + OFF_MOD);
    for (int item = tx.bid; item < 288; item += tx.gd) {
        const int i = item / 144, n0 = (item % 144) * 64, col = tid & 63, ks = tid >> 6;
        float acc[9];
#pragma unroll
        for (int c = 0; c < 9; ++c) acc[c] = 0.f;
        const float* wp = p->in[6] + ((size_t)i * 1024 + ks * 128) * 9216 + n0 + col;
#pragma unroll 8
        for (int k = 0; k < 128; ++k) { const float w = wp[(size_t)k * 9216];
#pragma unroll
            for (int c = 0; c < 9; ++c) acc[c] += sc[c * 1024 + ks * 128 + k] * w; }
#pragma unroll
        for (int c = 0; c < 9; ++c) red[(ks * 9 + c) * 64 + col] = acc[c];
        __syncthreads();
        for (int o = tid; o < 576; o += 512) { const int c = o >> 6, cl = o & 63; float s = p->in[7][i * 9216 + n0 + cl];
#pragma unroll
            for (int k2 = 0; k2 < 8; ++k2) s += red[(k2 * 9 + c) * 64 + cl];
            mod[((size_t)c * 2 + i) * 9216 + n0 + cl] = s; }
        __syncthreads();
    }
}

struct RowCfg {
    int src_input;
    int pending;
    int lg, gidx; float coef; const float* npost;
    int has_next;
    int lh, shidx, scidx; const float* npre;
    int write_x;
    int fsplit;
};
__device__ __forceinline__ const float* xrow_in(CP p, int m) { return m < MP ? p->in[0] + (size_t)m * D : p->in[1] + (size_t)(m - MP) * D; }
__device__ __forceinline__ int cond_of(int m) { return m < MP ? 0 : 1 + ((m - MP) >> 11); }
__device__ __forceinline__ void row_update(CP p, const RowCfg& c, int m, int lane, f32x4 (&x)[4]) {
    const float* xr = c.src_input ? xrow_in(p, m) : p->out + (size_t)m * D;
    const float* mod = (const float*)(p->ws + OFF_MOD);
    const int cd = cond_of(m);
#pragma unroll
    for (int q = 0; q < 4; ++q) x[q] = *(const f32x4*)(xr + 4 * lane + 256 * q);
    if (c.pending) {
        const bf16_t* fr = (const bf16_t*)(p->ws + OFF_E) + (size_t)m * D; f32x4 f[4]; float ss = 0.f;
#pragma unroll
        for (int q = 0; q < 4; ++q) { const u32x2 w = *(const u32x2*)(fr + 4 * lane + 256 * q); f[q] = (f32x4){bflo(w.x), bfhi(w.x), bflo(w.y), bfhi(w.y)}; }
        if (c.fsplit && m >= 16384) {
            const bf16_t* fr2 = (const bf16_t*)(p->ws + OFF_FB) + (size_t)(m - 16384) * D;
#pragma unroll
            for (int q = 0; q < 4; ++q) { const u32x2 w = *(const u32x2*)(fr2 + 4 * lane + 256 * q); f[q] += (f32x4){bflo(w.x), bfhi(w.x), bflo(w.y), bfhi(w.y)}; } }
#pragma unroll
        for (int q = 0; q < 4; ++q) ss += f[q][0] * f[q][0] + f[q][1] * f[q][1] + f[q][2] * f[q][2] + f[q][3] * f[q][3];
        ss = wave_sum(ss); const float rs = rsqrtf(ss * (1.0f / 1024.0f) + RMS_EPS) * c.coef;
        const float* gate = mod + ((size_t)(cd * 2 + c.lg) * 9 + c.gidx) * D;
#pragma unroll
        for (int q = 0; q < 4; ++q) { const f32x4 g = *(const f32x4*)(gate + 4 * lane + 256 * q), np = *(const f32x4*)(c.npost + 4 * lane + 256 * q); x[q] += g * (f[q] * np) * rs; }
    }
}
__device__ __forceinline__ void row_premod(CP p, const RowCfg& c, int m, int lane, const f32x4 (&x)[4], f32x4 (&h)[4]) {
    const float* mod = (const float*)(p->ws + OFF_MOD);
    const int cd = cond_of(m);
    float ss = 0.f;
#pragma unroll
    for (int q = 0; q < 4; ++q) ss += x[q][0] * x[q][0] + x[q][1] * x[q][1] + x[q][2] * x[q][2] + x[q][3] * x[q][3];
    ss = wave_sum(ss); const float rs = rsqrtf(ss * (1.0f / 1024.0f) + RMS_EPS);
    const float* sh = mod + ((size_t)(cd * 2 + c.lh) * 9 + c.shidx) * D; const float* scl = mod + ((size_t)(cd * 2 + c.lh) * 9 + c.scidx) * D;
#pragma unroll
    for (int q = 0; q < 4; ++q) { const f32x4 g = *(const f32x4*)(c.npre + 4 * lane + 256 * q), s1 = *(const f32x4*)(scl + 4 * lane + 256 * q), s0 = *(const f32x4*)(sh + 4 * lane + 256 * q);
        h[q] = (x[q] * rs * g) * (1.0f + s1) + s0; }
}
__device__ __forceinline__ void store_bf16_row(bf16_t* dst, int lane, const f32x4 (&h)[4]) {
#pragma unroll
    for (int q = 0; q < 4; ++q) { u32x2 w; w.x = cvt_pk_bf16(h[q][0], h[q][1]); w.y = cvt_pk_bf16(h[q][2], h[q][3]); *(u32x2*)(dst + 4 * lane + 256 * q) = w; }
}
__device__ void rowpass_simple(CP p, const RowCfg c, const Tix tx) {
    const int lane = tx.tid & 63, wid = tx.tid >> 6, nw = tx.gd * 8;
    bf16_t* hdst = (bf16_t*)(p->ws + OFF_A);
    for (int m = tx.bid * 8 + wid; m < MT; m += nw) {
        f32x4 x[4]; row_update(p, c, m, lane, x);
        if (c.write_x) {
#pragma unroll
            for (int q = 0; q < 4; ++q) *(f32x4*)(p->out + (size_t)m * D + 4 * lane + 256 * q) = x[q]; }
        if (c.has_next) { f32x4 h[4]; row_premod(p, c, m, lane, x, h); store_bf16_row(hdst + (size_t)m * D, lane, h); }
    }
}
__device__ void rowpass_shift(CP p, const RowCfg c, LAS float* lf, const Tix tx) {
    const int lane = tx.tid & 63, wid = tx.tid >> 6;
    bf16_t* adst = (bf16_t*)(p->ws + OFF_A);
    for (int blk = tx.bid; blk < MT / 6; blk += tx.gd) {
        const int m = blk * 6 - 1 + wid;
        f32x4 x[4], h[4];
#pragma unroll
        for (int q = 0; q < 4; ++q) { x[q] = (f32x4){0.f, 0.f, 0.f, 0.f}; h[q] = x[q]; }
        if (m >= 0 && m < MT) {
            row_update(p, c, m, lane, x); row_premod(p, c, m, lane, x, h);
#pragma unroll
            for (int q = 0; q < 4; ++q) *(LAS f32x4*)(lf + wid * 1024 + 4 * lane + 256 * q) = h[q];
        }
        __syncthreads();
        if (wid >= 1 && wid <= 6) {
            const int T = m < MP ? 256 : 2048, t = m < MP ? (m & 255) : ((m - MP) & 2047);
#pragma unroll
            for (int q = 0; q < 4; ++q) *(f32x4*)(p->out + (size_t)m * D + 4 * lane + 256 * q) = x[q];
            f32x4 hs[4];
#pragma unroll
            for (int q = 0; q < 4; ++q) { hs[q] = (f32x4){0.f, 0.f, 0.f, 0.f};
                if (t > 0) hs[q] += *(const LAS f32x4*)(lf + (wid - 1) * 1024 + 4 * lane + 256 * q);
                if (t < T - 1) hs[q] += *(const LAS f32x4*)(lf + (wid + 1) * 1024 + 4 * lane + 256 * q);
                hs[q] = 0.5f * hs[q] - h[q]; }
            store_bf16_row(adst + (size_t)m * 2048, lane, h);
            store_bf16_row(adst + (size_t)m * 2048 + 1024, lane, hs);
        }
        __syncthreads();
    }
}
__device__ void rowpass_gn(CP p, const Tix tx) {
    const int lane = tx.tid & 63, wid = tx.tid >> 6, nw = tx.gd * 8;
    const bf16_t* yf = (const bf16_t*)(p->ws + OFF_A); const bf16_t* yb = (const bf16_t*)(p->ws + OFF_B);
    const bf16_t* gb = (const bf16_t*)(p->ws + OFF_C); const bf16_t* vb = (const bf16_t*)(p->ws + OFF_E);
    bf16_t* ob = (bf16_t*)(p->ws + OFF_D); const float* cbp = (const float*)(p->ws + OFF_CBP);
    const float* gnw = p->in[26]; const float* gnb = p->in[27];
    for (int m = tx.bid * 8 + wid; m < MT; m += nw) {
        f32x4 o[4];
#pragma unroll
        for (int q = 0; q < 4; ++q) {
            const int col = 4 * lane + 256 * q, hd = 4 * q + (lane >> 4);
            const u32x2 a = *(const u32x2*)(yf + (size_t)m * D + col), b = *(const u32x2*)(yb + (size_t)m * D + col);
            f32x4 y = (f32x4){bflo(a.x) + bflo(b.x), bfhi(a.x) + bfhi(b.x), bflo(a.y) + bflo(b.y), bfhi(a.y) + bfhi(b.y)};
            float s = y[0] + y[1] + y[2] + y[3];
            s = row16_sum(s);
            const float mean = s * (1.0f / 64.0f); const f32x4 dv = y - mean;
            float vs = dv[0] * dv[0] + dv[1] * dv[1] + dv[2] * dv[2] + dv[3] * dv[3];
            vs = row16_sum(vs);
            const float rstd = rsqrtf(vs * (1.0f / 64.0f) + GN_EPS);
            const f32x4 c0 = *(const f32x4*)(cbp + ((size_t)m * 16 + hd) * 4), c1 = *(const f32x4*)(cbp + ((size_t)(MT + m) * 16 + hd) * 4);
            const float cb = (c0[0] + c0[1] + c0[2] + c0[3]) + (c1[0] + c1[1] + c1[2] + c1[3]);
            const u32x2 vw = *(const u32x2*)(vb + (size_t)m * D + col), gw = *(const u32x2*)(gb + (size_t)m * D + col);
            const f32x4 v = (f32x4){bflo(vw.x), bfhi(vw.x), bflo(vw.y), bfhi(vw.y)}, g = (f32x4){bflo(gw.x), bfhi(gw.x), bflo(gw.y), bfhi(gw.y)};
            const f32x4 w = *(const f32x4*)(gnw + col), bb = *(const f32x4*)(gnb + col);
            o[q] = (dv * rstd * w + bb + cb * v) * g;
        }
        store_bf16_row(ob + (size_t)m * D, lane, o);
    }
}

__device__ __forceinline__ void pool_acc(float (&acc)[8], const u32x4 w, const float wt) {
    acc[0] += wt * bflo(w.x); acc[1] += wt * bfhi(w.x); acc[2] += wt * bflo(w.y); acc[3] += wt * bfhi(w.y); acc[4] += wt * bflo(w.z); acc[5] += wt * bfhi(w.z); acc[6] += wt * bflo(w.w); acc[7] += wt * bfhi(w.w);
}
template <int WIN> __device__ __forceinline__ void pool_unit(CP p, const int pass, const int pair, const int gi, const int lane) {
    constexpr int HW = WIN / 2;
    const bf16_t* h = (const bf16_t*)(p->ws + OFF_A); bf16_t* t1 = (bf16_t*)(p->ws + OFF_B); bf16_t* dl = (bf16_t*)(p->ws + OFF_D);
    const int m = 2 * pair + (lane >> 5), ch = gi * 256 + 8 * (lane & 31);
    float acc[8];
#pragma unroll
    for (int i = 0; i < 8; ++i) acc[i] = 0.f;
    if (m < MP) {
        if (pass != 0) return;
        const int t = m & 255, mb = m - t;
        u32x4 w[WIN];
#pragma unroll
        for (int k = 0; k < WIN; ++k) { const int tt = t - HW + k; const int tc = min(max(tt, 0), 255); w[k] = *(const u32x4*)(h + (size_t)(mb + tc) * D + ch); }
#pragma unroll
        for (int k = 0; k < WIN; ++k) { const int tt = t - HW + k; pool_acc(acc, w[k], (tt >= 0 && tt < 256) ? 1.0f : 0.0f); }
        const float inv = 1.0f / (float)(min(t + HW, 256) - max(t - HW, 0)); const u32x4 c = w[HW];
        u32x4 o; o.x = cvt_pk_bf16(acc[0] * inv - bflo(c.x), acc[1] * inv - bfhi(c.x)); o.y = cvt_pk_bf16(acc[2] * inv - bflo(c.y), acc[3] * inv - bfhi(c.y));
        o.z = cvt_pk_bf16(acc[4] * inv - bflo(c.z), acc[5] * inv - bfhi(c.z)); o.w = cvt_pk_bf16(acc[6] * inv - bflo(c.w), acc[7] * inv - bfhi(c.w));
        *(u32x4*)(dl + (size_t)m * D + ch) = o;
    } else {
        const int ms = m - MP, pos = ms & 2047, r = pos >> 6, cc = pos & 63, sb = ms - pos;
        if (pass == 0) {
            u32x4 w[WIN];
#pragma unroll
            for (int k = 0; k < WIN; ++k) { const int rr = r - HW + k; const int rc = min(max(rr, 0), 31); w[k] = *(const u32x4*)(h + (size_t)(MP + sb + rc * 64 + cc) * D + ch); }
#pragma unroll
            for (int k = 0; k < WIN; ++k) { const int rr = r - HW + k; pool_acc(acc, w[k], (rr >= 0 && rr < 32) ? 1.0f : 0.0f); }
            const float inv = 1.0f / (float)(min(r + HW, 32) - max(r - HW, 0));
            u32x4 o; o.x = cvt_pk_bf16(acc[0] * inv, acc[1] * inv); o.y = cvt_pk_bf16(acc[2] * inv, acc[3] * inv); o.z = cvt_pk_bf16(acc[4] * inv, acc[5] * inv); o.w = cvt_pk_bf16(acc[6] * inv, acc[7] * inv);
            *(u32x4*)(t1 + (size_t)ms * D + ch) = o;
        } else {
            u32x4 w[WIN];
#pragma unroll
            for (int k = 0; k < WIN; ++k) { const int c2 = cc - HW + k; const int c3 = min(max(c2, 0), 63); w[k] = *(const u32x4*)(t1 + (size_t)(sb + r * 64 + c3) * D + ch); }
#pragma unroll
            for (int k = 0; k < WIN; ++k) { const int c2 = cc - HW + k; pool_acc(acc, w[k], (c2 >= 0 && c2 < 64) ? 1.0f : 0.0f); }
            const float inv = 1.0f / (float)(min(cc + HW, 64) - max(cc - HW, 0)); const u32x4 c = *(const u32x4*)(h + (size_t)m * D + ch);
            u32x4 o; o.x = cvt_pk_bf16(acc[0] * inv - bflo(c.x), acc[1] * inv - bfhi(c.x)); o.y = cvt_pk_bf16(acc[2] * inv - bflo(c.y), acc[3] * inv - bfhi(c.y));
            o.z = cvt_pk_bf16(acc[4] * inv - bflo(c.z), acc[5] * inv - bfhi(c.z)); o.w = cvt_pk_bf16(acc[6] * inv - bflo(c.w), acc[7] * inv - bfhi(c.w));
            *(u32x4*)(dl + (size_t)m * D + ch) = o;
        }
    }
}
__device__ void pool_pass(CP p, int pass, const Tix tx) {
    const int lane = tx.tid & 63, wid = tx.tid >> 6;
    const int first = pass == 0 ? 0 : (MP / 2) * 4, total = (MT / 2) * 4;
    for (int u = first + tx.bid * 8 + wid; u < total; u += tx.gd * 8) {
        const int gi = u & 3, pair = u >> 2;
        if (gi == 0) pool_unit<2>(p, pass, pair, 0, lane); else if (gi == 1) pool_unit<4>(p, pass, pair, 1, lane);
        else if (gi == 2) pool_unit<8>(p, pass, pair, 2, lane); else pool_unit<16>(p, pass, pair, 3, lane);
    }
}

constexpr int SST = 324;
constexpr int SBUF = 16 * SST + 64;
template <int VAR> __device__ void scan_phase(CP p, const bf16_t* W, LAS float* lf, const Tix tx, const int skipmask) {
    const int tid = tx.tid, lane = tid & 63, wid = tid >> 6, grp = wid >> 2, q = wid & 3;
    const int l15 = lane & 15, quad = lane >> 4, rl = lane >> 3, cg8 = lane & 7, i0 = 16 * q + 2 * rl;
    const bf16_t* rb = (const bf16_t*)(p->ws + OFF_C); const bf16_t* kb = (const bf16_t*)(p->ws + OFF_D); const bf16_t* vb = (const bf16_t*)(p->ws + OFF_E);
    const bf16_t* lb = (const bf16_t*)(p->ws + OFF_S);
    bf16_t* yout = (bf16_t*)(p->ws + OFF_A);
    float* cbp = (float*)(p->ws + OFF_CBP);
    const int tch = grp == 0 ? 128 : 16, nsub = grp == 0 ? 1 : ((skipmask & 8) ? 0 : 4);
    for (int it = tx.bid; it < 256; it += tx.gd) {
        f32x2 Sa[4], Sb[4];
        bf16x8 W2f[2], A2f[2];
        LAS float* ystage = lf + 4 * SBUF + 8 * 144 + wid * 1024;
        LAS float* wcst = lf + 4 * SBUF + wid * 144;
#pragma unroll
        for (int i = 0; i < 4; ++i) { Sa[i] = (f32x2){0.f, 0.f}; Sb[i] = (f32x2){0.f, 0.f}; }
        W2f[0] = W2f[1] = A2f[0] = A2f[1] = (bf16x8){0, 0, 0, 0, 0, 0, 0, 0};
        u32x2 pr = (u32x2){0u, 0u}, pk = pr, pv = pr; u32x4 pkf0 = (u32x4){0u, 0u, 0u, 0u}, pkf1 = pkf0; bf16x8 plw0 = (bf16x8){0, 0, 0, 0, 0, 0, 0, 0}, plw1 = plw0, pla0 = plw0, pla1 = plw0;
        int mn = 0, dn = 0, hhn = 0, scn = 0, slg = 0; bool sact = false;
        for (int c = -2; c < 128; ++c) {
#pragma unroll 1
          for (int slot = 0; slot < 2; ++slot) {
            if ((slot == 0) == (grp == 1)) {
                if (sact && !(skipmask & 2)) {
                    f32x4 aw = (f32x4){0.f, 0.f, 0.f, 0.f}, aa = aw;
                    aw = __builtin_amdgcn_mfma_f32_16x16x32_bf16(W2f[0], plw0, aw, 0, 0, 0); aw = __builtin_amdgcn_mfma_f32_16x16x32_bf16(W2f[1], plw1, aw, 0, 0, 0);
                    aa = __builtin_amdgcn_mfma_f32_16x16x32_bf16(A2f[0], pla0, aa, 0, 0, 0); aa = __builtin_amdgcn_mfma_f32_16x16x32_bf16(A2f[1], pla1, aa, 0, 0, 0);
                    const f32x4 cw0 = *(const LAS f32x4*)(wcst + 4 * quad), ca0 = *(const LAS f32x4*)(wcst + 16 + 4 * quad), ckk = *(const LAS f32x4*)(wcst + 32 + 4 * quad), cka = *(const LAS f32x4*)(wcst + 48 + 4 * quad), crk = *(const LAS f32x4*)(wcst + 64 + 4 * quad);
                    f32x4 kn[4];
    #pragma unroll
                    for (int i = 0; i < 4; ++i) kn[i] = *(const LAS f32x4*)(wcst + 80 + 16 * quad + 4 * i);
                    float ssq = 0.f;
                    { const unsigned kw[8] = {pkf0.x, pkf0.y, pkf0.z, pkf0.w, pkf1.x, pkf1.y, pkf1.z, pkf1.w};
    #pragma unroll
                      for (int i = 0; i < 8; ++i) { const float a = bflo(kw[i]) * kn[i >> 1][(i & 1) * 2], b2 = bfhi(kw[i]) * kn[i >> 1][(i & 1) * 2 + 1]; ssq += a * a + b2 * b2; } }
                    { auto s1 = __builtin_amdgcn_permlane16_swap(__float_as_uint(ssq), __float_as_uint(ssq), false, false); ssq = __uint_as_float(s1[0]) + __uint_as_float(s1[1]);
                      auto s2 = __builtin_amdgcn_permlane32_swap(__float_as_uint(ssq), __float_as_uint(ssq), false, false); ssq = __uint_as_float(s2[0]) + __uint_as_float(s2[1]); }
                    const float rn = fminf(__builtin_amdgcn_rsqf(ssq), 1e12f);
                    const f32x4 r4 = (f32x4){bflo(pr.x), bfhi(pr.x), bflo(pr.y), bfhi(pr.y)}, k4 = (f32x4){bflo(pk.x), bfhi(pk.x), bflo(pk.y), bfhi(pk.y)}, v4 = (f32x4){bflo(pv.x), bfhi(pv.x), bflo(pv.y), bfhi(pv.y)};
                    f32x4 e4, E4, kk4, b4, kd4, rh4, cs4; float cbs = 0.f;
    #pragma unroll
                    for (int j = 0; j < 4; ++j) { e4[j] = 0.60653066f * fast_sigmoid(cw0[j] + aw[j]);
                        float t = e4[j];
                        t += __builtin_bit_cast(float, __builtin_amdgcn_update_dpp(0, __builtin_bit_cast(int, t), 0x111, 0xf, 0xf, true));
                        t += __builtin_bit_cast(float, __builtin_amdgcn_update_dpp(0, __builtin_bit_cast(int, t), 0x112, 0xf, 0xf, true));
                        t += __builtin_bit_cast(float, __builtin_amdgcn_update_dpp(0, __builtin_bit_cast(int, t), 0x114, 0xf, 0xf, true));
                        t += __builtin_bit_cast(float, __builtin_amdgcn_update_dpp(0, __builtin_bit_cast(int, t), 0x118, 0xf, 0xf, true));
                        E4[j] = t; }
    #pragma unroll
                    for (int j = 0; j < 4; ++j) {
                        const float a = fast_sigmoid(ca0[j] + aa[j]);
                        const float kkn = k4[j] * ckk[j] * rn, bq = kkn * a, kd = k4[j] * (1.0f + (a - 1.0f) * cka[j]);
                        cbs += r4[j] * kd * crk[j];
                        const float cs = __expf(-E4[j]), cinv = __builtin_amdgcn_rcpf(cs);
                        const float cp = __builtin_bit_cast(float, __builtin_amdgcn_update_dpp(0x3f800000, __builtin_bit_cast(int, cs), 0x111, 0xf, 0xf, false));
                        kk4[j] = kkn * cp; b4[j] = bq * cinv; kd4[j] = kd * cinv; rh4[j] = r4[j] * cs; cs4[j] = cs; }
                    LAS float* wb = lf + (slg * 2 + (scn & 1)) * SBUF;
                    LAS float* wp = wb + l15 * SST + 16 * q + 4 * quad;
                    *(LAS f32x4*)(wp) = kk4; *(LAS f32x4*)(wp + 64) = b4; *(LAS f32x4*)(wp + 128) = kd4; *(LAS f32x4*)(wp + 192) = rh4; *(LAS f32x4*)(wp + 256) = v4;
                    if (l15 == 15) *(LAS f32x4*)(wb + 16 * SST + 16 * q + 4 * quad) = cs4;
                    { auto s1 = __builtin_amdgcn_permlane16_swap(__float_as_uint(cbs), __float_as_uint(cbs), false, false); cbs = __uint_as_float(s1[0]) + __uint_as_float(s1[1]);
                      auto s2 = __builtin_amdgcn_permlane32_swap(__float_as_uint(cbs), __float_as_uint(cbs), false, false); cbs = __uint_as_float(s2[0]) + __uint_as_float(s2[1]); }
                    if (quad == 0) cbp[(((size_t)dn * MT + mn) * 16 + hhn) * 4 + q] = cbs;
                }
            }
            if (slot == 0) {
                const int cn = c + 1 + grp; const int g1len = ((skipmask & 8) ? 0 : 4) * 16;
                const int lg = (grp == 1 && cn >= g1len) ? 0 : grp;
                const int ltch = lg == 0 ? 128 : 16; const int subn = cn / ltch, ccn = cn % ltch;
                const bool actn = (cn >= 0) && (cn < 128) && (grp == 1 || cn < g1len);
                sact = actn; scn = cn; slg = lg;
                if (actn && !(skipmask & 4)) {
                    const int pid = lg == 0 ? it : 4 * it + subn; dn = pid & 1; hhn = (pid >> 1) & 15; const int b = pid >> 5;
                    const int T = lg == 0 ? 2048 : 256, mb = lg == 0 ? MP + b * 2048 : b * 256;
                    const int pos = ccn * 16 + l15; mn = mb + (dn == 0 ? pos : T - 1 - pos);
                    const int col4 = 64 * hhn + 16 * q + 4 * quad;
                    pr = *(const u32x2*)(rb + (size_t)mn * D + col4); pk = *(const u32x2*)(kb + (size_t)mn * D + col4); pv = *(const u32x2*)(vb + (size_t)mn * D + col4);
                    pkf0 = *(const u32x4*)(kb + (size_t)mn * D + 64 * hhn + 16 * quad); pkf1 = *(const u32x4*)(kb + (size_t)mn * D + 64 * hhn + 16 * quad + 8);
                    plw0 = *(const bf16x8*)(lb + (size_t)mn * 384 + dn * 64 + 8 * quad); plw1 = *(const bf16x8*)(lb + (size_t)mn * 384 + dn * 64 + 32 + 8 * quad);
                    pla0 = *(const bf16x8*)(lb + (size_t)mn * 384 + 128 + dn * 64 + 8 * quad); pla1 = *(const bf16x8*)(lb + (size_t)mn * 384 + 128 + dn * 64 + 32 + 8 * quad);
                    if (ccn == 0 || (grp == 1 && lg == 0 && cn == g1len)) {
                        const bf16_t* w2r = W + W_W2L + ((size_t)dn * 1024 + 64 * hhn + 16 * q + l15) * 64 + 8 * quad;
                        const bf16_t* a2r = W + W_A2L + ((size_t)dn * 1024 + 64 * hhn + 16 * q + l15) * 64 + 8 * quad;
                        W2f[0] = *(const bf16x8*)w2r; W2f[1] = *(const bf16x8*)(w2r + 32); A2f[0] = *(const bf16x8*)a2r; A2f[1] = *(const bf16x8*)(a2r + 32);
                        const int cw = 64 * hhn + 16 * q + l15;
                        if (lane < 16) { wcst[lane] = p->in[15][dn * D + cw]; wcst[16 + lane] = p->in[18][dn * D + cw]; wcst[32 + lane] = p->in[23][cw]; wcst[48 + lane] = p->in[24][cw]; wcst[64 + lane] = p->in[25][cw]; }
                        wcst[80 + lane] = p->in[23][64 * hhn + lane];
                    }
                }
                const int sub = c < 0 ? 0 : c / tch, cc = c < 0 ? 0 : c % tch; const bool act = (c >= 0) && (sub < nsub);
                if (act && !(skipmask & 1)) {
                    const int pid = grp == 0 ? it : 4 * it + sub; const int d = pid & 1, hh = (pid >> 1) & 15, b = pid >> 5;
                    const int T = grp == 0 ? 2048 : 256, mb = grp == 0 ? MP + b * 2048 : b * 256;
                    if (cc == 0) {
                        if (grp == 0) { const float* s0 = (d == 0 ? p->in[3] : p->in[4]) + ((size_t)(b * 16 + hh) * 64 + i0) * 64 + 8 * cg8;
                            const f32x4 a0 = *(const f32x4*)s0, a1 = *(const f32x4*)(s0 + 4), b0 = *(const f32x4*)(s0 + 64), b1 = *(const f32x4*)(s0 + 68);
                            Sa[0] = a0.lo; Sa[1] = a0.hi; Sa[2] = a1.lo; Sa[3] = a1.hi; Sb[0] = b0.lo; Sb[1] = b0.hi; Sb[2] = b1.lo; Sb[3] = b1.hi; }
                        else {
    #pragma unroll
                            for (int i = 0; i < 4; ++i) { Sa[i] = (f32x2){0.f, 0.f}; Sb[i] = (f32x2){0.f, 0.f}; } }
                    }
                    const LAS float* bp0 = lf + (grp * 2 + (c & 1)) * SBUF;
                    bf16_t* yo = yout + (size_t)d * MT * D + 64 * hh + i0;
                    f32x4 nk0, nk1, nb0, nb1, nd0, nd1; f32x2 nv; f32x2 rp[4];
    #define SCAN_LOAD_K(s_) do { const LAS float* bp_ = bp0 + (s_) * SST + 8 * cg8; nk0 = *(const LAS f32x4*)(bp_); nk1 = *(const LAS f32x4*)(bp_ + 4); } while (0)
    #define SCAN_LOAD_R(s_) do { const LAS float* bp_ = bp0 + (s_) * SST + 8 * cg8; const f32x4 r0_ = *(const LAS f32x4*)(bp_ + 192), r1_ = *(const LAS f32x4*)(bp_ + 196); rp[0] = r0_.lo; rp[1] = r0_.hi; rp[2] = r1_.lo; rp[3] = r1_.hi; } while (0)
    #define SCAN_LOAD_B(s_) do { const LAS float* bp_ = bp0 + (s_) * SST + 8 * cg8; nb0 = *(const LAS f32x4*)(bp_ + 64); nb1 = *(const LAS f32x4*)(bp_ + 68); \
                        nd0 = *(const LAS f32x4*)(bp_ + 128); nd1 = *(const LAS f32x4*)(bp_ + 132); nv = *(const LAS f32x2*)(bp0 + (s_) * SST + 256 + i0); } while (0)
                    SCAN_LOAD_K(0); SCAN_LOAD_B(0);
    #pragma unroll
                    for (int i = 0; i < 4; ++i) rp[i] = (f32x2){0.f, 0.f};
    #define SCAN_YFLUSH(b_) do { const LAS float* ys_ = ystage + cg8 * 128 + 16 * rl; const f32x4 q0_ = *(const LAS f32x4*)(ys_), q1_ = *(const LAS f32x4*)(ys_ + 4), q2_ = *(const LAS f32x4*)(ys_ + 8), q3_ = *(const LAS f32x4*)(ys_ + 12); \
                        const float ye_ = ((q0_[0] + q0_[2]) + (q1_[0] + q1_[2])) + ((q2_[0] + q2_[2]) + (q3_[0] + q3_[2])), yo_ = ((q0_[1] + q0_[3]) + (q1_[1] + q1_[3])) + ((q2_[1] + q2_[3]) + (q3_[1] + q3_[3])); \
                        const int pos_ = cc * 16 + 8 * (b_) + cg8; const int m_ = mb + (d == 0 ? pos_ : T - 1 - pos_); *(unsigned*)(yo + (size_t)m_ * D) = cvt_pk_bf16(ye_, yo_); } while (0)
    #pragma unroll
                    for (int s = 0; s < 16; ++s) {
                        const f32x2 kk[4] = {nk0.lo, nk0.hi, nk1.lo, nk1.hi};
                        f32x2 pa = Sa[0] * kk[0], pb = Sb[0] * kk[0], ya = Sa[0] * rp[0], yb = Sb[0] * rp[0];
    #pragma unroll
                        for (int i = 1; i < 4; ++i) { pa = Sa[i] * kk[i] + pa; pb = Sb[i] * kk[i] + pb; ya = Sa[i] * rp[i] + ya; yb = Sb[i] * rp[i] + yb; }
                        if (s < 15 && !(VAR & 2)) SCAN_LOAD_K(s + 1);
                        if (!(VAR & 2)) SCAN_LOAD_R(s);
                        float sa0 = pa.x + pa.y, sa1 = pb.x + pb.y;
                        if (s > 0) *(LAS f32x2*)(ystage + ((s - 1) & 7) * 128 + 2 * lane) = (f32x2){ya.x + ya.y, yb.x + yb.y};
                        sa0 += dpp_f<0xB1>(sa0); sa1 += dpp_f<0xB1>(sa1);
                        sa0 += dpp_f<0x4E>(sa0); sa1 += dpp_f<0x4E>(sa1);
                        sa0 += dpp_f<0x141>(sa0); sa1 += dpp_f<0x141>(sa1);
                        const f32x2 bb[4] = {nb0.lo, nb0.hi, nb1.lo, nb1.hi}, dd[4] = {nd0.lo, nd0.hi, nd1.lo, nd1.hi};
                        const f32x2 n0 = (f32x2){-sa0, -sa0}, n1 = (f32x2){-sa1, -sa1}, v0 = (f32x2){nv.x, nv.x}, v1 = (f32x2){nv.y, nv.y};
    #pragma unroll
                        for (int i = 0; i < 4; ++i) { Sa[i] = n0 * bb[i] + Sa[i]; Sb[i] = n1 * bb[i] + Sb[i]; Sa[i] = v0 * dd[i] + Sa[i]; Sb[i] = v1 * dd[i] + Sb[i]; }
                        if (s < 15 && !(VAR & 1)) SCAN_LOAD_B(s + 1);
                        if (s == 8) SCAN_YFLUSH(0);
                    }
                    {
                        f32x2 ya = Sa[0] * rp[0], yb = Sb[0] * rp[0];
    #pragma unroll
                        for (int i = 1; i < 4; ++i) { ya = Sa[i] * rp[i] + ya; yb = Sb[i] * rp[i] + yb; }
                        *(LAS f32x2*)(ystage + 7 * 128 + 2 * lane) = (f32x2){ya.x + ya.y, yb.x + yb.y};
                        const f32x4 c0 = *(const LAS f32x4*)(bp0 + 16 * SST + 8 * cg8), c1 = *(const LAS f32x4*)(bp0 + 16 * SST + 8 * cg8 + 4);
                        Sa[0] *= c0.lo; Sa[1] *= c0.hi; Sa[2] *= c1.lo; Sa[3] *= c1.hi; Sb[0] *= c0.lo; Sb[1] *= c0.hi; Sb[2] *= c1.lo; Sb[3] *= c1.hi;
                        SCAN_YFLUSH(1);
                    }
    #undef SCAN_YFLUSH
    #undef SCAN_LOAD_K
    #undef SCAN_LOAD_R
    #undef SCAN_LOAD_B
                    if (grp == 1 && cc == tch - 1) {
                        float* sf = p->out + (size_t)MT * D + (size_t)d * (32 * 16 * 4096) + ((size_t)(b * 16 + hh) * 64 + i0) * 64 + 8 * cg8;
                        *(f32x4*)sf = (f32x4){Sa[0].x, Sa[0].y, Sa[1].x, Sa[1].y}; *(f32x4*)(sf + 4) = (f32x4){Sa[2].x, Sa[2].y, Sa[3].x, Sa[3].y};
                        *(f32x4*)(sf + 64) = (f32x4){Sb[0].x, Sb[0].y, Sb[1].x, Sb[1].y}; *(f32x4*)(sf + 68) = (f32x4){Sb[2].x, Sb[2].y, Sb[3].x, Sb[3].y};
                    }
                }
            }
          }
            asm volatile("s_waitcnt lgkmcnt(0)" ::: "memory"); __builtin_amdgcn_s_barrier(); asm volatile("" ::: "memory");
        }
    }
}

#define XB_TMO      128
#define XB_XCNT(j)  (256  + 64 * (j))
#define XB_XSUB(j)  (1280 + 64 * (j))
#define XB_XGEN(j)  (2304 + 64 * (j))
#define XB_TOP      3328
#define XB_TOPGEN   3392
#define XCD_BAR_WORDS 3456
#define XB_SPIN_CAP (1u << 18)

__device__ __forceinline__ unsigned xb_ld(unsigned* p)              { return __hip_atomic_load(p, __ATOMIC_RELAXED, __HIP_MEMORY_SCOPE_AGENT); }
__device__ __forceinline__ unsigned xb_add(unsigned* p, unsigned v) { return __hip_atomic_fetch_add(p, v, __ATOMIC_RELAXED, __HIP_MEMORY_SCOPE_AGENT); }
__device__ __forceinline__ unsigned xb_xcc_id() { return (unsigned)__builtin_amdgcn_s_getreg((3 << 11) | 20) & 0xFu; }
#define XB_SPIN(cond, bar) do { unsigned _sp = 0; while (cond) { __builtin_amdgcn_s_sleep(1); \
    if ((++_sp & 255u) == 0u) { if (xb_ld(&(bar)[XB_TMO])) break; if (_sp > XB_SPIN_CAP) { atomicAdd(&(bar)[XB_TMO], 1u); break; } } } } while (0)

struct XcdBarrier {
    unsigned* bar; unsigned x;
    volatile LAS unsigned* st;
};

__device__ __forceinline__ XcdBarrier xcd_barrier_post(unsigned* bar, volatile LAS unsigned* st) {
    XcdBarrier b; b.bar = bar; b.x = xb_xcc_id(); b.st = st;
    if (threadIdx.x == 0) (void)xb_add(&bar[XB_XCNT(b.x)], 1u);
    return b;
}
__device__ __forceinline__ void xcd_barrier_complete(unsigned* bar, unsigned x, unsigned& nloc, unsigned& nx) {
    const unsigned G = gridDim.x * gridDim.y * gridDim.z;
    unsigned sum, cnt, mine, sp = 0u;
    for (;;) {
        sum = 0u; cnt = 0u; mine = 0u;
#pragma unroll
        for (unsigned j = 0; j < 16; ++j) { const unsigned c = xb_ld(&bar[XB_XCNT(j)]); sum += c; cnt += (c > 0u) ? 1u : 0u; mine = (j == x) ? c : mine; }
        if (sum == G) break;
        __builtin_amdgcn_s_sleep(1);
        if ((++sp & 255u) == 0u) { if (xb_ld(&bar[XB_TMO])) break; if (sp > XB_SPIN_CAP) { atomicAdd(&bar[XB_TMO], 1u); break; } }
    }
    nloc = mine > 0u ? mine : 1u; nx = cnt > 0u ? cnt : 1u;
}

__device__ __forceinline__ void xcd_barrier(const XcdBarrier& b) {
    asm volatile("s_waitcnt vmcnt(0)" ::: "memory");
    __syncthreads();
    if (threadIdx.x == 0) {
        unsigned* bar = b.bar;
        __builtin_amdgcn_s_waitcnt(0);
        unsigned nloc = b.st[0], nx = b.st[1];
        if (nloc == 0u) { xcd_barrier_complete(bar, b.x, nloc, nx); b.st[0] = nloc; b.st[1] = nx; }
        const unsigned old = xb_add(&bar[XB_XSUB(b.x)], 1u);
        const unsigned gen = old / nloc;
        if (old + 1u == (gen + 1u) * nloc) {
            __builtin_amdgcn_fence(__ATOMIC_RELEASE, "agent");
            asm volatile("s_waitcnt vmcnt(0)" ::: "memory");
            const unsigned og = xb_add(&bar[XB_TOP], 1u);
            const unsigned tg = og / nx;
            if (og + 1u == (tg + 1u) * nx) xb_add(&bar[XB_TOPGEN], 1u);
            else XB_SPIN(xb_ld(&bar[XB_TOPGEN]) == tg, bar);
            __builtin_amdgcn_fence(__ATOMIC_ACQUIRE, "agent");
            xb_add(&bar[XB_XGEN(b.x)], 1u);
            asm volatile("s_waitcnt vmcnt(0)" ::: "memory");
        } else {
            XB_SPIN(xb_ld(&bar[XB_XGEN(b.x)]) == gen, bar);
            __builtin_amdgcn_fence(__ATOMIC_ACQUIRE, "agent");
            asm volatile("s_waitcnt vmcnt(0)" ::: "memory");
        }
    }
    __syncthreads();
}


constexpr int NPHASE = 24;
#ifndef SPLITK
#define SPLITK 1
#endif
#ifndef ONLYMASK
#define ONLYMASK 0x1ff
#endif
#define EN(k) ((ONLYMASK >> (k)) & 1)
constexpr int LDS_BYTES = 131072 + 16;
__global__ void __launch_bounds__(512, 2) mega(Params kp) {
    extern __shared__ __attribute__((aligned(16))) unsigned char shm[];
    PG8_LAS unsigned char* lds = (PG8_LAS unsigned char*)shm;
    LAS float* lf = (LAS float*)shm;
    cg::grid_group grid = cg::this_grid();
    const int pb = kp.pb, pe = kp.pe;
    volatile LAS unsigned* xst = (volatile LAS unsigned*)(lds + 131072);
    if (threadIdx.x < 2) xst[threadIdx.x] = 0u;
    __syncthreads();
    XcdBarrier xb = xcd_barrier_post((unsigned*)(kp.ws + OFF_BAR), xst);
#ifdef PROBE_SYNC
#pragma unroll 1
    for (int i = 0; i < PROBE_SYNC; ++i) grid.sync();
#endif
#pragma unroll 1
    for (int ph = pb; ph < pe; ++ph) {
        CP p = (CP)__builtin_amdgcn_kernarg_segment_ptr();
        asm volatile("" : "+s"(p));
        Tix tx; { int t_ = threadIdx.x, b_ = blockIdx.x, g_ = gridDim.x; asm volatile("" : "+v"(t_)); asm volatile("" : "+s"(b_), "+s"(g_)); tx.tid = t_; tx.bid = b_; tx.gd = g_; }
        bf16_t* rA = (bf16_t*)(p->ws + OFF_A); bf16_t* rB = (bf16_t*)(p->ws + OFF_B); bf16_t* rC = (bf16_t*)(p->ws + OFF_C); bf16_t* rD = (bf16_t*)(p->ws + OFF_D); bf16_t* rE = (bf16_t*)(p->ws + OFF_E);
        bf16_t* rS = (bf16_t*)(p->ws + OFF_S);
        const int wsel = (ph <= 3) ? 0 : (ph <= 9) ? 1 : (ph <= 12) ? 0 : (ph <= 15) ? 1 : (ph <= 19) ? 0 : 1;
        bf16_t* W = (bf16_t*)(p->ws + (wsel ? OFF_W2 : OFF_W)); bf16_t* Wn = (bf16_t*)(p->ws + (wsel ? OFF_W : OFF_W2));
        const float* npre = p->in[8]; const float* npost = p->in[9];
        int kind = 0;
        RowCfg rc{}; int conv = -1;
        const bf16_t* gA = nullptr; const bf16_t* gB = nullptr; bf16_t* gO = nullptr; int gN = 0, gK = 0, pool_pass_id = 0;
        switch (ph) {
            case 0: kind = 0; break;
            case 1: kind = 1; rc = RowCfg{1, 0, 0, 0, 0.f, npost, 1, 0, 0, 1, npre + 0 * D, 0, SPLITK}; break;
            case 2: case 11: case 14: case 21: kind = 2; conv = (ph == 2) ? 4 : (ph == 11) ? 2 : (ph == 14) ? 5 : -1; break;
            case 3: case 12: case 15: case 22: kind = 3; gA = rB; gB = W + W_W2T; gO = rE; gN = 1024; gK = 2816; break;
            case 4: kind = 4; rc = RowCfg{1, 1, 0, 2, 0.5f, npost + 0 * D, 1, 0, 3, 4, npre + 1 * D, 1, SPLITK}; break;
            case 5: kind = 5; conv = 1; break;
            case 6: kind = 6; break;
            case 7: kind = 3; gA = rS; gB = W + W_BTG; gO = rC; gN = 1024; gK = 384; break;
            case 8: kind = 7; break;
            case 9: kind = 3; gA = rD; gB = W + W_WOT; gO = rE; gN = 1024; gK = 1024; break;
            case 10: kind = 1; rc = RowCfg{0, 1, 0, 5, 1.0f, npost + 1 * D, 1, 0, 6, 7, npre + 2 * D, 1, SPLITK}; break;
            case 13: kind = 1; rc = RowCfg{0, 1, 0, 8, 0.5f, npost + 2 * D, 1, 1, 0, 1, npre + 3 * D, 1, SPLITK}; break;
            case 16: kind = 1; rc = RowCfg{0, 1, 1, 2, 0.5f, npost + 3 * D, 1, 1, 3, 4, npre + 4 * D, 1, SPLITK}; break;
            case 17: kind = 8; pool_pass_id = 0; break;
            case 18: kind = 8; pool_pass_id = 1; break;
            case 19: kind = 3; gA = rD; gB = W; gO = rE; gN = 1024; gK = 1024; conv = 3; break;
            case 20: kind = 1; rc = RowCfg{0, 1, 1, 5, 1.0f, npost + 4 * D, 1, 1, 6, 7, npre + 5 * D, 1, SPLITK}; break;
            case 23: kind = 1; rc = RowCfg{0, 1, 1, 8, 0.5f, npost + 5 * D, 0, 0, 0, 0, npre, 1, SPLITK}; break;
            default: break;
        }
        rc.fsplit = (SPLITK && tx.gd == 256) ? 1 : 0;
#ifdef PROBE_PH
        const int reps = (ph == PROBE_PH) ? PROBE_N : 1;
#else
        const int reps = 1;
#endif
#pragma unroll 1
        for (int rep = 0; rep < reps; ++rep) {
        if (rep > 0) xcd_barrier(xb);
        asm volatile("" : "+v"(tx.tid)); asm volatile("" : "+s"(tx.bid), "+s"(tx.gd)); asm volatile("" : "+s"(p));
        if (EN(0) && kind == 0) { mod_phase(p, lf, tx); __syncthreads();
            if (tx.gd > 64) { if (tx.bid >= 32) { const Tix tv{tx.tid, tx.bid - 32, tx.gd - 32}; conv_ffn(p, W, 0, lf + 16384, tv); } }
            else conv_ffn(p, W, 0, lf + 16384, tx); }
        else if (EN(1) && kind == 1) { rowpass_simple(p, rc, tx); }
        else if (EN(4) && kind == 4) { rowpass_shift(p, rc, lf, tx); }
        else if (EN(2) && (kind == 2 || kind == 3 || kind == 5)) {
            if (kind == 2) { gA = rA; gB = W + W_W13; gO = rB; gN = 5632; gK = 1024; } else if (kind == 5) { gA = rA; gB = W + W_BTP; gO = rC; gN = 3584; gK = 2048; }
            const int bal = (SPLITK && kind == 3 && gK >= 1024 && tx.gd == 256) ? 1 : 0;
            pg8::Gemm g{gA, gB, MT, gN, gK}; pg8::FwdOrder S; S.init(MT, gN, gK, tx.gd, tx.bid, bal);
            pg8::EpiAll E{kind == 3 ? 0 : (kind == 2 ? 1 : 2), gO, kind == 2 ? DFF : 1024, rS, (bf16_t*)(p->ws + OFF_FB) - (size_t)16384 * 1024};
#ifdef PROBE_NOEPI
            if (rep + 1 < reps) E.kind = 7;
#endif
            pg8::gemm_phase<pg8::EpiAll, pg8::FwdOrder, false>(lds, g, S, E, nullptr, tx.tid);
            if (conv >= 0) { const int nunit = (MT / 256) * (gN / 256), extra = nunit % tx.gd;
                const int half = (bal || extra == 0 || extra > tx.gd / 2) ? 0 : extra; if (tx.bid >= half) { const Tix tv{tx.tid, tx.bid - half, tx.gd - half};
                if (conv < 4) conv_ffn(p, Wn, conv, lf, tv); else if (conv == 4) conv_rwkv(p, Wn, lf, tv); else conv_pool(p, Wn, tv); } } }
        else if (EN(6) && kind == 6) {
#ifdef PROBE_VAR
            if (rep + 1 < reps) scan_phase<PROBE_VAR>(p, W, lf, tx, 0); else scan_phase<0>(p, W, lf, tx, 0);
#elif defined(PROBE_MASK)
            scan_phase<0>(p, W, lf, tx, (rep + 1 < reps) ? PROBE_MASK : 0);
#else
            scan_phase<0>(p, W, lf, tx, 0);
#endif
        }
        else if (EN(7) && kind == 7) rowpass_gn(p, tx);
        else if (EN(8) && kind == 8) pool_pass(p, pool_pass_id, tx);
        }
        if (ph + 1 < pe) { if (pb > pe) grid.sync(); else xcd_barrier(xb); }
    }
}

#include <cstdio>
#ifndef USE_COOP
#define USE_COOP 1
#endif
extern "C" void kernel_launch(void* const* d_in, const int* in_sizes, int n_in, void* d_out, int out_size, void* d_ws, size_t ws_size, hipStream_t stream) {
    static int grid = 0;
    if (grid == 0) {
        if (n_in != NIN || ws_size < WS_NEED) { fprintf(stderr, "kernel_launch: n_in %d ws %zu (need %zu)\n", n_in, ws_size, (size_t)WS_NEED); grid = -1; return; }
        int dev = 0, cus = 0, per_cu = 0;
        hipGetDevice(&dev); hipDeviceGetAttribute(&cus, hipDeviceAttributeMultiprocessorCount, dev);
        if (hipFuncSetAttribute((const void*)mega, hipFuncAttributeMaxDynamicSharedMemorySize, LDS_BYTES) != hipSuccess) { fprintf(stderr, "kernel_launch: hipFuncSetAttribute failed\n"); grid = -1; return; }
        if (hipOccupancyMaxActiveBlocksPerMultiprocessor(&per_cu, (const void*)mega, 512, LDS_BYTES) != hipSuccess || per_cu < 1) { fprintf(stderr, "kernel_launch: occupancy query says %d\n", per_cu); per_cu = 1; }
        (void)hipGetLastError();
        grid = cus * 1;
        if (grid <= 0) grid = 256;
    }
    if (grid < 0) return;
    if (hipMemsetAsync((unsigned char*)d_ws + OFF_BAR, 0, 16384, stream) != hipSuccess) { fprintf(stderr, "kernel_launch: memset of the barrier words failed\n"); return; }
    Params p{};
    for (int i = 0; i < NIN; ++i) p.in[i] = (const float*)d_in[i];
    p.out = (float*)d_out; p.ws = (unsigned char*)d_ws;
#if USE_COOP
    p.pb = 0; p.pe = NPHASE;
    void* args[] = {&p};
    hipError_t e = hipLaunchCooperativeKernel((const void*)mega, dim3(grid), dim3(512), args, LDS_BYTES, stream);
    if (e != hipSuccess) fprintf(stderr, "cooperative launch failed: %s (grid %d)\n", hipGetErrorString(e), grid);
#else
    for (int ph = 0; ph < NPHASE; ++ph) { p.pb = ph; p.pe = ph + 1; hipLaunchKernelGGL(mega, dim3(grid), dim3(512), LDS_BYTES, stream, p); }
#endif
}
```

```cpp
#include <hip/hip_runtime.h>
#include <hip/hip_cooperative_groups.h>
namespace pg8 {
#define PG8_LAS __attribute__((address_space(3)))
typedef unsigned short bf16_t;
typedef short bf16x8 __attribute__((ext_vector_type(8)));
typedef float f32x4 __attribute__((ext_vector_type(4)));
typedef unsigned u32x4 __attribute__((ext_vector_type(4)));
constexpr int BM = 256, BK = 64, HALF = 128, HTB = HALF * BK * 2  , STAGE_BYTES = 8 * HTB, NXCD = 8, WGM = 8;

__host__ __device__ __forceinline__ int lds_byte(int r, int c) { const int st = (r >> 4) * 2 + (c >> 5), rr = r & 15, cc = c & 31, ob = rr * 64 + cc * 2; return st * 1024 + (ob ^ (((ob >> 9) & 1) << 5)); }
__host__ __device__ __forceinline__ void stage_rc(int b, int& R, int& C) { const int st = b / 1024, sb = b % 1024, swz = sb ^ (((sb >> 9) & 1) << 5); R = (st >> 1) * 16 + swz / 64; C = (st & 1) * 32 + (swz % 64) / 2; }
__host__ __device__ __forceinline__ int perm32(int rho) { const int n = rho >> 4, i = rho & 15; return 8 * (i >> 2) + 4 * n + (i & 3); }

struct Unit { int pm, pn, part; };
struct Gemm { const bf16_t* A; const bf16_t* Bt; int M, N, K; };

struct StaticOrder {
    int nM, nN, nwg, G, c;
    __host__ __device__ void init(int M, int N, int G_, int c_) { nM = M / BM; nN = N / BM; nwg = nM * nN; G = G_; c = c_; }
    __host__ __device__ bool next(int i, Unit& u) const {
        const long L = (long)i * G + c; if (L >= nwg) return false;
        int wgid = (int)L; { const int q = nwg / NXCD, r = nwg % NXCD, xcd = wgid % NXCD, off = wgid / NXCD; wgid = (xcd < r ? xcd * (q + 1) : r * (q + 1) + (xcd - r) * q) + off; }
        const int nig = WGM * nN, gid = wgid / nig, fm = gid * WGM, gsz = (nM - fm) < WGM ? (nM - fm) : WGM;
        u.pm = fm + ((wgid % nig) % gsz); u.pn = (wgid % nig) / gsz; u.part = 0; return true;
    }
    __device__ __forceinline__ void a_ready(const Unit&) const {}
    __device__ __forceinline__ void done(const Unit&) const {}
};
struct FwdOrder {
    StaticOrder so; int mode;
    __host__ __device__ void init(int M, int N, int K, int G_, int c_, int mode_) { so.init(M, N, G_, c_); mode = mode_; }
    __host__ __device__ bool next(int i, Unit& u) const {
        if (mode == 0) return so.next(i, u);
        if (i >= 2) return false;
        const int w = (so.c & 7) * 32 + (so.c >> 3);
        if (i == 0) { u.pm = w >> 2; u.pn = w & 3; u.part = 0; }
        else { u.pm = 64 + (w >> 3); u.pn = (w >> 1) & 3; u.part = 1 + (w & 1); }
        return true;
    }
    __device__ __forceinline__ void a_ready(const Unit&) const {}
    __device__ __forceinline__ void done(const Unit&) const {}
};
__device__ __forceinline__ unsigned cvt_pk_bf16(float lo, float hi) { unsigned r; asm volatile("v_cvt_pk_bf16_f32 %0, %1, %2" : "=v"(r) : "v"(lo), "v"(hi)); return r; }
typedef float f32x2 __attribute__((ext_vector_type(2)));
__device__ __forceinline__ float fast_sigmoid(float x) { return __builtin_amdgcn_rcpf(1.0f + __expf(-x)); }
__device__ __forceinline__ float fast_tanh(float x) { return 1.0f - 2.0f * __builtin_amdgcn_rcpf(1.0f + __expf(2.0f * x)); }
struct EpiStore {
    static constexpr bool PERM = true, AFTER_DRAIN = false;
    bf16_t* O; int ldc;
    __device__ __forceinline__ void operator()(const f32x4 (&acc)[2][2][4][2], const Unit& u, int wr, int wc, int fr, int fq) const {
        const int row0 = u.pm * BM + wr * 64 + fr, col0 = u.pn * BM + wc * 32 + 8 * fq;
#pragma unroll
        for (int ai = 0; ai < 2; ++ai)
#pragma unroll
            for (int m = 0; m < 4; ++m) { bf16_t* rowp = O + (size_t)(row0 + ai * HALF + m * 16) * ldc + col0;
#pragma unroll
                for (int bj = 0; bj < 2; ++bj) { const f32x4 v0 = acc[ai][bj][m][0], v1 = acc[ai][bj][m][1];
                    u32x4 w; w.x = cvt_pk_bf16(v0[0], v0[1]); w.y = cvt_pk_bf16(v0[2], v0[3]); w.z = cvt_pk_bf16(v1[0], v1[1]); w.w = cvt_pk_bf16(v1[2], v1[3]);
                    *(u32x4*)(rowp + bj * HALF) = w; } }
    }
};
struct EpiSwiglu {
    static constexpr bool PERM = true, AFTER_DRAIN = false;
    bf16_t* O; int ldc;
    __device__ __forceinline__ void operator()(const f32x4 (&acc)[2][2][4][2], const Unit& u, int wr, int wc, int fr, int fq) const {
        const int row0 = u.pm * BM + wr * 64 + fr, col0 = u.pn * HALF + wc * 32 + 8 * fq;
#pragma unroll
        for (int ai = 0; ai < 2; ++ai)
#pragma unroll
            for (int m = 0; m < 4; ++m) { bf16_t* rowp = O + (size_t)(row0 + ai * HALF + m * 16) * ldc + col0;
                float o[8];
#pragma unroll
                for (int n = 0; n < 2; ++n)
#pragma unroll
                    for (int j = 0; j < 4; ++j) { const float a = acc[ai][0][m][n][j], b = acc[ai][1][m][n][j]; o[n * 4 + j] = a * fast_sigmoid(a) * b; }
                u32x4 w; w.x = cvt_pk_bf16(o[0], o[1]); w.y = cvt_pk_bf16(o[2], o[3]); w.z = cvt_pk_bf16(o[4], o[5]); w.w = cvt_pk_bf16(o[6], o[7]);
                *(u32x4*)rowp = w; }
    }
};
struct EpiRkv {
    static constexpr bool PERM = true, AFTER_DRAIN = false;
    bf16_t* O; size_t tstride; bf16_t* L;
    __device__ __forceinline__ void operator()(const f32x4 (&acc)[2][2][4][2], const Unit& u, int wr, int wc, int fr, int fq) const {
        const int row0 = u.pm * BM + wr * 64 + fr;
        if (u.pn < 12) {
            bf16_t* base = O + (size_t)(u.pn >> 2) * tstride; const int col0 = (u.pn & 3) * BM + wc * 32 + 8 * fq;
#pragma unroll
            for (int ai = 0; ai < 2; ++ai)
#pragma unroll
                for (int m = 0; m < 4; ++m) { bf16_t* rowp = base + (size_t)(row0 + ai * HALF + m * 16) * 1024 + col0;
#pragma unroll
                    for (int bj = 0; bj < 2; ++bj) { const f32x4 v0 = acc[ai][bj][m][0], v1 = acc[ai][bj][m][1];
                        u32x4 w; w.x = cvt_pk_bf16(v0[0], v0[1]); w.y = cvt_pk_bf16(v0[2], v0[3]); w.z = cvt_pk_bf16(v1[0], v1[1]); w.w = cvt_pk_bf16(v1[2], v1[3]);
                        *(u32x4*)(rowp + bj * HALF) = w; } }
        } else {
            const int t13 = (u.pn == 13); const int col0 = (u.pn - 12) * BM + wc * 32 + 8 * fq;
#pragma unroll
            for (int ai = 0; ai < 2; ++ai)
#pragma unroll
                for (int m = 0; m < 4; ++m) { bf16_t* rowp = L + (size_t)(row0 + ai * HALF + m * 16) * 384 + col0;
#pragma unroll
                    for (int bj = 0; bj < 2; ++bj) { if (t13 && bj == 1) continue;
                        float o[8];
#pragma unroll
                        for (int n = 0; n < 2; ++n)
#pragma unroll
                            for (int j = 0; j < 4; ++j) { const float a = acc[ai][bj][m][n][j]; o[n * 4 + j] = t13 ? fast_sigmoid(a) : (bj == 0 ? fast_tanh(a) : a); }
                        u32x4 w; w.x = cvt_pk_bf16(o[0], o[1]); w.y = cvt_pk_bf16(o[2], o[3]); w.z = cvt_pk_bf16(o[4], o[5]); w.w = cvt_pk_bf16(o[6], o[7]);
                        *(u32x4*)(rowp + bj * HALF) = w; } }
        }
    }
};

struct EpiAll {
    static constexpr bool PERM = true, AFTER_DRAIN = false;
    int kind; bf16_t* O; int ldc; bf16_t* L; bf16_t* O2;
    __device__ __forceinline__ void operator()(const f32x4 (&acc)[2][2][4][2], const Unit& u, int wr, int wc, int fr, int fq) const {
        if (kind == 0) { EpiStore e{u.part == 2 ? O2 : O, ldc}; e(acc, u, wr, wc, fr, fq); }
        else if (kind == 1) { EpiSwiglu e{O, ldc}; e(acc, u, wr, wc, fr, fq); }
        else if (kind == 2) { EpiRkv e{O, (size_t)24576 * 1024, L}; e(acc, u, wr, wc, fr, fq); }
    }
};
template <class Epi, class Sched, bool STAMP = false>
__device__ __forceinline__ void gemm_phase(PG8_LAS unsigned char* lds, const Gemm g, const Sched& S, const Epi& E, unsigned long long* stamps, const int tid_in) {
    const int tid = tid_in, wid = __builtin_amdgcn_readfirstlane(tid >> 6), lane = tid & 63, wr = wid >> 2, wc = wid & 3, fr = lane & 15, fq = lane >> 4;
    const int K = g.K; int nt = K / BK;
    int ts_lo = 0, ts_hi = 0, nts = 0; const unsigned long long rt_entry = STAMP ? (unsigned long long)wall_clock64() : 0ull;
#define PG8_STAMP() do { if (STAMP && wid == 0 && nts < 64) { const unsigned long long _c = (unsigned long long)clock64(); \
        ts_lo = (lane == nts) ? (int)(unsigned)_c : ts_lo; ts_hi = (lane == nts) ? (int)(unsigned)(_c >> 32) : ts_hi; ++nts; } } while (0)
    PG8_STAMP();
    unsigned voffA[2], voffB[2];
#pragma unroll
    for (int i = 0; i < 2; ++i) { int R, C; stage_rc(tid * 16 + i * 8192, R, C); const int Rb = Epi::PERM ? ((R & ~31) + perm32(R & 31)) : R;
        voffA[i] = (unsigned)(R * K + C) * 2u; voffB[i] = (unsigned)(Rb * K + C) * 2u; }
    const size_t kstep = (size_t)(BK * 2);
    const size_t hstep = (size_t)HALF * K * 2;
    const size_t tstep = 2 * hstep;
    const unsigned ldsw = (unsigned)wid * 1024u;
    const int aoff = lds_byte(wr * 64 + fr, fq * 8), boff = lds_byte(wc * 32 + fr, fq * 8);
#define PG8_SA(b, h) (((b) * 2 + (h)) * HTB)
#define PG8_SB(b, h) ((4 + (b) * 2 + (h)) * HTB)
#define PG8_STAGE(bufoff, gbase, voff) do { _Pragma("unroll") for (int _i = 0; _i < 2; ++_i) \
        __builtin_amdgcn_global_load_lds((const unsigned*)((const char*)(gbase) + (voff)[_i]), (PG8_LAS unsigned*)(lds + (bufoff) + ldsw + _i * 8192), 16, 0, 0); } while (0)
#define PG8_LDA(dst, b, h) do { _Pragma("unroll") for (int m = 0; m < 4; ++m) _Pragma("unroll") for (int k = 0; k < 2; ++k) dst[m][k] = *(const PG8_LAS bf16x8*)(lds + PG8_SA(b, h) + aoff + m * 2048 + k * 1024); } while (0)
#define PG8_LDB(dst, b, h) do { _Pragma("unroll") for (int n = 0; n < 2; ++n) _Pragma("unroll") for (int k = 0; k < 2; ++k) dst[n][k] = *(const PG8_LAS bf16x8*)(lds + PG8_SB(b, h) + boff + n * 2048 + k * 1024); } while (0)
#define PG8_MMA(ai, bj, At, Bt) do { __builtin_amdgcn_s_setprio(1); _Pragma("unroll") for (int m = 0; m < 4; ++m) _Pragma("unroll") for (int n = 0; n < 2; ++n) _Pragma("unroll") for (int k = 0; k < 2; ++k) \
        acc[ai][bj][m][n] = __builtin_amdgcn_mfma_f32_16x16x32_bf16(Bt[n][k], At[m][k], acc[ai][bj][m][n], 0, 0, 0); __builtin_amdgcn_s_setprio(0); } while (0)
#define PG8_WAIT_V(n) asm volatile("s_waitcnt vmcnt(" #n ")" ::: "memory")
#define PG8_WAIT_L(n) asm volatile("s_waitcnt lgkmcnt(" #n ")" ::: "memory")
#define PG8_BAR __builtin_amdgcn_s_barrier()
#define PG8_SCHED __builtin_amdgcn_sched_barrier(0)
    Unit cur, nxt; int ui = 0;
    if (!S.next(0, cur)) return;
    f32x4 acc[2][2][4][2];
#pragma unroll
    for (int a = 0; a < 2; ++a)
#pragma unroll
        for (int b = 0; b < 2; ++b)
#pragma unroll
            for (int m = 0; m < 4; ++m)
#pragma unroll
                for (int n = 0; n < 2; ++n) acc[a][b][m][n] = (f32x4){0.f, 0.f, 0.f, 0.f};
    bf16x8 At[4][2], B0[2][2], B1[2][2];
    const char* cA = (const char*)g.A + (size_t)cur.pm * tstep + (cur.part == 2 ? (size_t)K : (size_t)0); const char* cB = (const char*)g.Bt + (size_t)cur.pn * tstep + (cur.part == 2 ? (size_t)K : (size_t)0);
    nt = cur.part ? K / (2 * BK) : K / BK;
    S.a_ready(cur);
    PG8_STAGE(PG8_SB(0, 0), cB, voffB); PG8_STAGE(PG8_SA(0, 0), cA, voffA); PG8_STAGE(PG8_SB(0, 1), cB + hstep, voffB); PG8_STAGE(PG8_SA(0, 1), cA + hstep, voffA);
    if (wr == 1) PG8_BAR;
    PG8_WAIT_V(4); PG8_BAR;
    PG8_STAGE(PG8_SB(1, 0), cB + kstep, voffB); PG8_STAGE(PG8_SA(1, 0), cA + kstep, voffA); PG8_STAGE(PG8_SB(1, 1), cB + hstep + kstep, voffB);
    PG8_WAIT_V(6); PG8_BAR;
    PG8_STAMP();
    for (;;) {
        const bool has_next = S.next(ui + 1, nxt);
        const char* nA = has_next ? (const char*)g.A + (size_t)nxt.pm * tstep + (nxt.part == 2 ? (size_t)K : (size_t)0) : cA; const char* nB = has_next ? (const char*)g.Bt + (size_t)nxt.pn * tstep + (nxt.part == 2 ? (size_t)K : (size_t)0) : cB;
        for (int t = 0; t < nt; t += 2) {
            const bool last = (t == nt - 2);
            const char* a1 = cA + (size_t)(t + 1) * kstep;
            const char* a2 = last ? nA : cA + (size_t)(t + 2) * kstep; const char* b2 = last ? nB : cB + (size_t)(t + 2) * kstep;
            const char* a3 = a2 + kstep; const char* b3 = b2 + kstep;
            if (last && has_next) S.a_ready(nxt);
            PG8_LDB(B0, 0, 0); PG8_SCHED; PG8_LDA(At, 0, 0); PG8_STAGE(PG8_SA(1, 1), a1 + hstep, voffA);
            PG8_WAIT_L(8); PG8_BAR; PG8_WAIT_L(0); PG8_MMA(0, 0, At, B0); PG8_BAR; PG8_SCHED;
            PG8_LDB(B1, 0, 1); PG8_STAGE(PG8_SB(0, 0), b2, voffB);
            PG8_BAR; PG8_WAIT_L(0); PG8_MMA(0, 1, At, B1); PG8_BAR;
            PG8_LDA(At, 0, 1); PG8_STAGE(PG8_SA(0, 0), a2, voffA);
            PG8_BAR; PG8_WAIT_L(0); PG8_MMA(1, 0, At, B0); PG8_BAR; PG8_SCHED;
            PG8_STAGE(PG8_SB(0, 1), b2 + hstep, voffB);
            PG8_WAIT_V(6); PG8_BAR; PG8_MMA(1, 1, At, B1); PG8_BAR;
            PG8_LDB(B0, 1, 0); PG8_SCHED; PG8_LDA(At, 1, 0); PG8_STAGE(PG8_SA(0, 1), a2 + hstep, voffA);
            PG8_WAIT_L(8); PG8_BAR; PG8_WAIT_L(0); PG8_MMA(0, 0, At, B0); PG8_BAR; PG8_SCHED;
            PG8_LDB(B1, 1, 1); PG8_STAGE(PG8_SB(1, 0), b3, voffB);
            PG8_BAR; PG8_WAIT_L(0); PG8_MMA(0, 1, At, B1); PG8_BAR;
            PG8_LDA(At, 1, 1); PG8_STAGE(PG8_SA(1, 0), a3, voffA);
            PG8_BAR; PG8_WAIT_L(0); PG8_MMA(1, 0, At, B0); PG8_BAR; PG8_SCHED;
            PG8_STAGE(PG8_SB(1, 1), b3 + hstep, voffB);
            PG8_WAIT_V(6); PG8_BAR; PG8_MMA(1, 1, At, B1); PG8_BAR;
        }
        PG8_STAMP();
        if constexpr (!Epi::AFTER_DRAIN) { E(acc, cur, wr, wc, fr, fq); S.done(cur); }
        PG8_STAMP();
        if (!has_next) break;
#pragma unroll
        for (int a = 0; a < 2; ++a)
#pragma unroll
            for (int b = 0; b < 2; ++b)
#pragma unroll
                for (int m = 0; m < 4; ++m)
#pragma unroll
                    for (int n = 0; n < 2; ++n) acc[a][b][m][n] = (f32x4){0.f, 0.f, 0.f, 0.f};
        cur = nxt; cA = nA; cB = nB; ++ui; nt = cur.part ? K / (2 * BK) : K / BK;
    }
    PG8_WAIT_V(0);
    if (wr == 0) PG8_BAR;
    PG8_BAR;
    if constexpr (Epi::AFTER_DRAIN) { E.fused(acc, cur, wr, wc, fr, fq, lds, wid, lane); S.done(cur); }
    PG8_STAMP();
    if (STAMP && wid == 0) { stamps[lane] = lane < nts ? (((unsigned long long)(unsigned)ts_hi << 32) | (unsigned)ts_lo) : 0ull;
        if (lane == 62) stamps[62] = rt_entry; if (lane == 63) stamps[63] = (unsigned long long)wall_clock64(); }
#undef PG8_STAMP
#undef PG8_SA
#undef PG8_SB
#undef PG8_STAGE
#undef PG8_LDA
#undef PG8_LDB
#undef PG8_MMA
#undef PG8_WAIT_V
#undef PG8_WAIT_L
#undef PG8_BAR
#undef PG8_SCHED
}
}

namespace cg = cooperative_groups;
using pg8::bf16_t; using pg8::bf16x8; using pg8::f32x4; using pg8::u32x4; using pg8::cvt_pk_bf16; using pg8::fast_sigmoid;
#define LAS __attribute__((address_space(3)))
typedef float f32x2 __attribute__((ext_vector_type(2)));
typedef unsigned u32x2 __attribute__((ext_vector_type(2)));

constexpr int D = 1024, DFF = 2816, MP = 8192, MS = 16384, MT = 24576;
constexpr int NIN = 31;
constexpr size_t R48 = (size_t)MT * 1024 * 2;
constexpr size_t OFF_A = 0, OFF_B = R48, OFF_C = 2 * R48, OFF_D = 3 * R48, OFF_E = 4 * R48;
constexpr size_t OFF_S = 5 * R48;
constexpr size_t OFF_W = OFF_S + (size_t)MT * 384 * 2;
constexpr size_t W_ELEMS = 9043968;
constexpr size_t OFF_MOD = OFF_W + W_ELEMS * 2;
constexpr size_t OFF_CBP = OFF_MOD + (size_t)9 * 2 * 9216 * 4;
constexpr size_t OFF_BAR = OFF_CBP + (size_t)2 * MT * 64 * 4;
constexpr size_t OFF_W2 = OFF_BAR + 16384;
constexpr size_t OFF_FB = OFF_W2 + W_ELEMS * 2;
constexpr size_t WS_NEED = OFF_FB + (size_t)8192 * 1024 * 2;
constexpr size_t W_W13 = 0, W_W2T = (size_t)5632 * 1024;
constexpr size_t W_BTP = 0, W_BTG = (size_t)3584 * 2048, W_WOT = W_BTG + (size_t)1024 * 384, W_W2L = W_WOT + (size_t)1024 * 1024, W_A2L = W_W2L + 131072;
constexpr float RMS_EPS = 1e-6f, GN_EPS = 64e-5f;

struct Tix { int tid, bid, gd; };
struct Params { const float* in[NIN]; float* out; unsigned char* ws; int pb, pe; };
typedef const Params __attribute__((address_space(4)))* CP;

__device__ __forceinline__ float bf2f(unsigned short b) { return __uint_as_float(((unsigned)b) << 16); }
__device__ __forceinline__ float bflo(unsigned w) { return __uint_as_float(w << 16); }
__device__ __forceinline__ float bfhi(unsigned w) { return __uint_as_float(w & 0xffff0000u); }
template <int CTRL> __device__ __forceinline__ float dpp_f(float x) { return __builtin_bit_cast(float, __builtin_amdgcn_mov_dpp(__builtin_bit_cast(int, x), CTRL, 0xf, 0xf, true)); }
__device__ __forceinline__ float row16_sum(float v) { v += dpp_f<0xB1>(v); v += dpp_f<0x4E>(v); v += dpp_f<0x141>(v); v += dpp_f<0x128>(v); return v; }
__device__ __forceinline__ float wave_sum(float v) {
    v = row16_sum(v);
    auto s1 = __builtin_amdgcn_permlane16_swap(__float_as_uint(v), __float_as_uint(v), false, false); v = __uint_as_float(s1[0]) + __uint_as_float(s1[1]);
    auto s2 = __builtin_amdgcn_permlane32_swap(__float_as_uint(v), __float_as_uint(v), false, false); v = __uint_as_float(s2[0]) + __uint_as_float(s2[1]);
    return v;
}
__device__ __forceinline__ float reduce8(float x) { x += dpp_f<0xB1>(x); x += dpp_f<0x4E>(x); x += dpp_f<0x141>(x); return x; }

struct ConvJob { const float* src; int K, N; bf16_t* dst; int dld, kofs, blk, blk_stride, row_off; const float* ksc; };
__device__ __forceinline__ void conv_job(const ConvJob j, LAS float* tile, int& rot, const Tix tx) {
    const int tid = tx.tid, G = tx.gd;
    const int tn = j.N >> 6, nt = (j.K >> 6) * tn;
    int t0 = (tx.bid - (rot % G) + G) % G;
    for (int t = t0; t < nt; t += G) {
        const int k0 = (t / tn) << 6, n0 = (t % tn) << 6;
        { const int r = tid >> 4, c4 = tid & 15;
#pragma unroll
          for (int it = 0; it < 2; ++it) { const int k = r + 32 * it; const float4 v = *(const float4*)(j.src + (size_t)(k0 + k) * j.N + n0 + 4 * c4);
              LAS float* tp = tile + k * 65 + 4 * c4; tp[0] = v.x; tp[1] = v.y; tp[2] = v.z; tp[3] = v.w; } }
        __syncthreads();
        { const int n = tid >> 3, kg = tid & 7; float v[8];
#pragma unroll
          for (int i = 0; i < 8; ++i) { v[i] = tile[(8 * kg + i) * 65 + n]; if (j.ksc) v[i] *= j.ksc[k0 + 8 * kg + i]; }
          u32x4 w; w.x = cvt_pk_bf16(v[0], v[1]); w.y = cvt_pk_bf16(v[2], v[3]); w.z = cvt_pk_bf16(v[4], v[5]); w.w = cvt_pk_bf16(v[6], v[7]);
          const int gn = n0 + n; const int drow = (gn / j.blk) * j.blk_stride + (gn % j.blk) + j.row_off;
          *(u32x4*)(j.dst + (size_t)drow * j.dld + j.kofs + k0 + 8 * kg) = w; }
        __syncthreads();
    }
    rot += nt;
}
__device__ void conv_ffn(CP p, bf16_t* W, int fi, LAS float* tile, const Tix tx) {
    int rot = 0;
    conv_job(ConvJob{p->in[10] + (size_t)fi * D * DFF, D, DFF, W + W_W13, 1024, 0, 128, 256, 0, nullptr}, tile, rot, tx);
    conv_job(ConvJob{p->in[11] + (size_t)fi * D * DFF, D, DFF, W + W_W13, 1024, 0, 128, 256, 128, nullptr}, tile, rot, tx);
    conv_job(ConvJob{p->in[12] + (size_t)fi * D * DFF, DFF, D, W + W_W2T, 2816, 0, 1024, 1024, 0, nullptr}, tile, rot, tx);
}
__device__ void conv_rwkv(CP p, bf16_t* W, LAS float* tile, const Tix tx) {
    int rot = 0;
    const float* mu = p->in[13];
    for (int half = 0; half < 2; ++half) {
        const int ko = half * 1024;
        for (int i = 0; i < 3; ++i) { const int mi = (i == 0) ? 0 : (i == 1 ? 2 : 3);
            conv_job(ConvJob{p->in[14] + (size_t)i * D * D, D, D, W + W_BTP, 2048, ko, 1024, 1024, i * 1024, half ? mu + mi * D : nullptr}, tile, rot, tx); }
        for (int d = 0; d < 2; ++d) {
            conv_job(ConvJob{p->in[16] + (size_t)d * D * 64, D, 64, W + W_BTP, 2048, ko, 64, 64, 3072 + 64 * d, half ? mu + 1 * D : nullptr}, tile, rot, tx);
            conv_job(ConvJob{p->in[19] + (size_t)d * D * 64, D, 64, W + W_BTP, 2048, ko, 64, 64, 3200 + 64 * d, half ? mu + 4 * D : nullptr}, tile, rot, tx); }
        conv_job(ConvJob{p->in[21], D, 128, W + W_BTP, 2048, ko, 128, 128, 3328, half ? mu + 5 * D : nullptr}, tile, rot, tx);
    }
    conv_job(ConvJob{p->in[22], 128, D, W + W_BTG, 384, 256, 1024, 1024, 0, nullptr}, tile, rot, tx);
    for (int idx = tx.bid * 512 + tx.tid; idx < 1024 * 32; idx += tx.gd * 512) { const int n = idx >> 5, k8 = idx & 31; *(u32x4*)(W + W_BTG + (size_t)n * 384 + 8 * k8) = (u32x4){0u, 0u, 0u, 0u}; }
    conv_job(ConvJob{p->in[28], D, D, W + W_WOT, 1024, 0, 1024, 1024, 0, nullptr}, tile, rot, tx);
    for (int d = 0; d < 2; ++d) {
        conv_job(ConvJob{p->in[17] + (size_t)d * 64 * D, 64, D, W + W_W2L + (size_t)d * 65536, 64, 0, 1024, 1024, 0, nullptr}, tile, rot, tx);
        conv_job(ConvJob{p->in[20] + (size_t)d * 64 * D, 64, D, W + W_A2L + (size_t)d * 65536, 64, 0, 1024, 1024, 0, nullptr}, tile, rot, tx); }
}
__device__ void conv_pool(CP p, bf16_t* W, const Tix tx) {
    const float* pw = p->in[29]; const float* ps = p->in[30];
    for (int idx = tx.bid * 512 + tx.tid; idx < 1024 * 128; idx += tx.gd * 512) {
        const int k8 = idx >> 10, n = idx & 1023, g = n >> 8; u32x4 w = (u32x4){0u, 0u, 0u, 0u};
        if ((k8 >> 5) == g) { const float s = ps[n]; float v[8];
#pragma unroll
            for (int i = 0; i < 8; ++i) v[i] = pw[((size_t)g * 256 + ((8 * k8 + i) & 255)) * 256 + (n & 255)] * s;
            w.x = cvt_pk_bf16(v[0], v[1]); w.y = cvt_pk_bf16(v[2], v[3]); w.z = cvt_pk_bf16(v[4], v[5]); w.w = cvt_pk_bf16(v[6], v[7]); }
        *(u32x4*)(W + (size_t)n * 1024 + 8 * k8) = w; }
}

__device__ void mod_phase(CP p, LAS float* lf, const Tix tx) {
    LAS float* sc = lf; LAS float* red = lf + 9216;
    const int tid = tx.tid;
    if (tx.bid >= 288) return;
    for (int o = tid; o < 9216; o += 512) { const int c = o >> 10, k = o & 1023; const float v = (c == 0) ? p->in[5][k] : p->in[2][(c - 1) * 1024 + k]; sc[o] = v * fast_sigmoid(v); }
    __syncthreads();
    float* mod = (float*)(p->ws + OFF_MOD);
    for (int item = tx.bid; item < 288; item += tx.gd) {
        const int i = item / 144, n0 = (item % 144) * 64, col = tid & 63, ks = tid >> 6;
        float acc[9];
#pragma unroll
        for (int c = 0; c < 9; ++c) acc[c] = 0.f;
        const float* wp = p->in[6] + ((size_t)i * 1024 + ks * 128) * 9216 + n0 + col;
#pragma unroll 8
        for (int k = 0; k < 128; ++k) { const float w = wp[(size_t)k * 9216];
#pragma unroll
            for (int c = 0; c < 9; ++c) acc[c] += sc[c * 1024 + ks * 128 + k] * w; }
#pragma unroll
        for (int c = 0; c < 9; ++c) red[(ks * 9 + c) * 64 + col] = acc[c];
        __syncthreads();
        for (int o = tid; o < 576; o += 512) { const int c = o >> 6, cl = o & 63; float s = p->in[7][i * 9216 + n0 + cl];
#pragma unroll
            for (int k2 = 0; k2 < 8; ++k2) s += red[(k2 * 9 + c) * 64 + cl];
            mod[((size_t)c * 2 + i) * 9216 + n0 + cl] = s; }
        __syncthreads();
    }
}

struct RowCfg {
    int src_input;
    int pending;
    int lg, gidx; float coef; const float* npost;
    int has_next;
    int lh, shidx, scidx; const float* npre;
    int write_x;
    int fsplit;
};
__device__ __forceinline__ const float* xrow_in(CP p, int m) { return m < MP ? p->in[0] + (size_t)m * D : p->in[1] + (size_t)(m - MP) * D; }
__device__ __forceinline__ int cond_of(int m) { return m < MP ? 0 : 1 + ((m - MP) >> 11); }
__device__ __forceinline__ void row_update(CP p, const RowCfg& c, int m, int lane, f32x4 (&x)[4]) {
    const float* xr = c.src_input ? xrow_in(p, m) : p->out + (size_t)m * D;
    const float* mod = (const float*)(p->ws + OFF_MOD);
    const int cd = cond_of(m);
#pragma unroll
    for (int q = 0; q < 4; ++q) x[q] = *(const f32x4*)(xr + 4 * lane + 256 * q);
    if (c.pending) {
        const bf16_t* fr = (const bf16_t*)(p->ws + OFF_E) + (size_t)m * D; f32x4 f[4]; float ss = 0.f;
#pragma unroll
        for (int q = 0; q < 4; ++q) { const u32x2 w = *(const u32x2*)(fr + 4 * lane + 256 * q); f[q] = (f32x4){bflo(w.x), bfhi(w.x), bflo(w.y), bfhi(w.y)}; }
        if (c.fsplit && m >= 16384) {
            const bf16_t* fr2 = (const bf16_t*)(p->ws + OFF_FB) + (size_t)(m - 16384) * D;
#pragma unroll
            for (int q = 0; q < 4; ++q) { const u32x2 w = *(const u32x2*)(fr2 + 4 * lane + 256 * q); f[q] += (f32x4){bflo(w.x), bfhi(w.x), bflo(w.y), bfhi(w.y)}; } }
#pragma unroll
        for (int q = 0; q < 4; ++q) ss += f[q][0] * f[q][0] + f[q][1] * f[q][1] + f[q][2] * f[q][2] + f[q][3] * f[q][3];
        ss = wave_sum(ss); const float rs = rsqrtf(ss * (1.0f / 1024.0f) + RMS_EPS) * c.coef;
        const float* gate = mod + ((size_t)(cd * 2 + c.lg) * 9 + c.gidx) * D;
#pragma unroll
        for (int q = 0; q < 4; ++q) { const f32x4 g = *(const f32x4*)(gate + 4 * lane + 256 * q), np = *(const f32x4*)(c.npost + 4 * lane + 256 * q); x[q] += g * (f[q] * np) * rs; }
    }
}
__device__ __forceinline__ void row_premod(CP p, const RowCfg& c, int m, int lane, const f32x4 (&x)[4], f32x4 (&h)[4]) {
    const float* mod = (const float*)(p->ws + OFF_MOD);
    const int cd = cond_of(m);
    float ss = 0.f;
#pragma unroll
    for (int q = 0; q < 4; ++q) ss += x[q][0] * x[q][0] + x[q][1] * x[q][1] + x[q][2] * x[q][2] + x[q][3] * x[q][3];
    ss = wave_sum(ss); const float rs = rsqrtf(ss * (1.0f / 1024.0f) + RMS_EPS);
    const float* sh = mod + ((size_t)(cd * 2 + c.lh) * 9 + c.shidx) * D; const float* scl = mod + ((size_t)(cd * 2 + c.lh) * 9 + c.scidx) * D;
#pragma unroll
    for (int q = 0; q < 4; ++q) { const f32x4 g = *(const f32x4*)(c.npre + 4 * lane + 256 * q), s1 = *(const f32x4*)(scl + 4 * lane + 256 * q), s0 = *(const f32x4*)(sh + 4 * lane + 256 * q);
        h[q] = (x[q] * rs * g) * (1.0f + s1) + s0; }
}
__device__ __forceinline__ void store_bf16_row(bf16_t* dst, int lane, const f32x4 (&h)[4]) {
#pragma unroll
    for (int q = 0; q < 4; ++q) { u32x2 w; w.x = cvt_pk_bf16(h[q][0], h[q][1]); w.y = cvt_pk_bf16(h[q][2], h[q][3]); *(u32x2*)(dst + 4 * lane + 256 * q) = w; }
}
__device__ void rowpass_simple(CP p, const RowCfg c, const Tix tx) {
    const int lane = tx.tid & 63, wid = tx.tid >> 6, nw = tx.gd * 8;
    bf16_t* hdst = (bf16_t*)(p->ws + OFF_A);
    for (int m = tx.bid * 8 + wid; m < MT; m += nw) {
        f32x4 x[4]; row_update(p, c, m, lane, x);
        if (c.write_x) {
#pragma unroll
            for (int q = 0; q < 4; ++q) *(f32x4*)(p->out + (size_t)m * D + 4 * lane + 256 * q) = x[q]; }
        if (c.has_next) { f32x4 h[4]; row_premod(p, c, m, lane, x, h); store_bf16_row(hdst + (size_t)m * D, lane, h); }
    }
}
__device__ void rowpass_shift(CP p, const RowCfg c, LAS float* lf, const Tix tx) {
    const int lane = tx.tid & 63, wid = tx.tid >> 6;
    bf16_t* adst = (bf16_t*)(p->ws + OFF_A);
    for (int blk = tx.bid; blk < MT / 6; blk += tx.gd) {
        const int m = blk * 6 - 1 + wid;
        f32x4 x[4], h[4];
#pragma unroll
        for (int q = 0; q < 4; ++q) { x[q] = (f32x4){0.f, 0.f, 0.f, 0.f}; h[q] = x[q]; }
        if (m >= 0 && m < MT) {
            row_update(p, c, m, lane, x); row_premod(p, c, m, lane, x, h);
#pragma unroll
            for (int q = 0; q < 4; ++q) *(LAS f32x4*)(lf + wid * 1024 + 4 * lane + 256 * q) = h[q];
        }
        __syncthreads();
        if (wid >= 1 && wid <= 6) {
            const int T = m < MP ? 256 : 2048, t = m < MP ? (m & 255) : ((m - MP) & 2047);
#pragma unroll
            for (int q = 0; q < 4; ++q) *(f32x4*)(p->out + (size_t)m * D + 4 * lane + 256 * q) = x[q];
            f32x4 hs[4];
#pragma unroll
            for (int q = 0; q < 4; ++q) { hs[q] = (f32x4){0.f, 0.f, 0.f, 0.f};
                if (t > 0) hs[q] += *(const LAS f32x4*)(lf + (wid - 1) * 1024 + 4 * lane + 256 * q);
                if (t < T - 1) hs[q] += *(const LAS f32x4*)(lf + (wid + 1) * 1024 + 4 * lane + 256 * q);
                hs[q] = 0.5f * hs[q] - h[q]; }
            store_bf16_row(adst + (size_t)m * 2048, lane, h);
            store_bf16_row(adst + (size_t)m * 2048 + 1024, lane, hs);
        }
        __syncthreads();
    }
}
__device__ void rowpass_gn(CP p, const Tix tx) {
    const int lane = tx.tid & 63, wid = tx.tid >> 6, nw = tx.gd * 8;
    const bf16_t* yf = (const bf16_t*)(p->ws + OFF_A); const bf16_t* yb = (const bf16_t*)(p->ws + OFF_B);
    const bf16_t* gb = (const bf16_t*)(p->ws + OFF_C); const bf16_t* vb = (const bf16_t*)(p->ws + OFF_E);
    bf16_t* ob = (bf16_t*)(p->ws + OFF_D); const float* cbp = (const float*)(p->ws + OFF_CBP);
    const float* gnw = p->in[26]; const float* gnb = p->in[27];
    for (int m = tx.bid * 8 + wid; m < MT; m += nw) {
        f32x4 o[4];
#pragma unroll
        for (int q = 0; q < 4; ++q) {
            const int col = 4 * lane + 256 * q, hd = 4 * q + (lane >> 4);
            const u32x2 a = *(const u32x2*)(yf + (size_t)m * D + col), b = *(const u32x2*)(yb + (size_t)m * D + col);
            f32x4 y = (f32x4){bflo(a.x) + bflo(b.x), bfhi(a.x) + bfhi(b.x), bflo(a.y) + bflo(b.y), bfhi(a.y) + bfhi(b.y)};
            float s = y[0] + y[1] + y[2] + y[3];
            s = row16_sum(s);
            const float mean = s * (1.0f / 64.0f); const f32x4 dv = y - mean;
            float vs = dv[0] * dv[0] + dv[1] * dv[1] + dv[2] * dv[2] + dv[3] * dv[3];
            vs = row16_sum(vs);
            const float rstd = rsqrtf(vs * (1.0f / 64.0f) + GN_EPS);
            const f32x4 c0 = *(const f32x4*)(cbp + ((size_t)m * 16 + hd) * 4), c1 = *(const f32x4*)(cbp + ((size_t)(MT + m) * 16 + hd) * 4);
            const float cb = (c0[0] + c0[1] + c0[2] + c0[3]) + (c1[0] + c1[1] + c1[2] + c1[3]);
            const u32x2 vw = *(const u32x2*)(vb + (size_t)m * D + col), gw = *(const u32x2*)(gb + (size_t)m * D + col);
            const f32x4 v = (f32x4){bflo(vw.x), bfhi(vw.x), bflo(vw.y), bfhi(vw.y)}, g = (f32x4){bflo(gw.x), bfhi(gw.x), bflo(gw.y), bfhi(gw.y)};
            const f32x4 w = *(const f32x4*)(gnw + col), bb = *(const f32x4*)(gnb + col);
            o[q] = (dv * rstd * w + bb + cb * v) * g;
        }
        store_bf16_row(ob + (size_t)m * D, lane, o);
    }
}

__device__ __forceinline__ void pool_add(float (&s)[8], const u32x4 w, const float sg) {
    s[0] += sg * bflo(w.x); s[1] += sg * bfhi(w.x); s[2] += sg * bflo(w.y); s[3] += sg * bfhi(w.y); s[4] += sg * bflo(w.z); s[5] += sg * bfhi(w.z); s[6] += sg * bflo(w.w); s[7] += sg * bfhi(w.w);
}
template <int WIN> __device__ __forceinline__ void pool_blk(const bf16_t* src, const int sb, const int stride, const int L, const int a0, const int ch, const int mode,
                                                            bf16_t* dst, const int db, const bf16_t* hsrc, const int hb) {
    constexpr int HW = WIN / 2, NT = WIN + 7;
    u32x4 tap[NT];
#pragma unroll
    for (int j = 0; j < NT; ++j) { const int pp = a0 - HW + j; const int pc = min(max(pp, 0), L - 1);
        const u32x4 w = *(const u32x4*)(src + (size_t)(sb + pc * stride) * D + ch);
        tap[j] = (pp >= 0 && pp < L) ? w : (u32x4){0u, 0u, 0u, 0u}; }
    float s[8];
#pragma unroll
    for (int i = 0; i < 8; ++i) s[i] = 0.f;
#pragma unroll
    for (int j = 0; j < WIN; ++j) pool_add(s, tap[j], 1.0f);
#pragma unroll
    for (int i = 0; i < 8; ++i) {
        const int a = a0 + i;
        const float inv = __builtin_amdgcn_rcpf((float)(min(a + HW, L) - max(a - HW, 0)));
        float c8[8];
        if (mode == 1) {
#pragma unroll
            for (int k = 0; k < 8; ++k) c8[k] = 0.f; }
        else { const u32x4 cw = (mode == 0) ? tap[i + HW] : *(const u32x4*)(hsrc + (size_t)(hb + a * stride) * D + ch);
            c8[0] = bflo(cw.x); c8[1] = bfhi(cw.x); c8[2] = bflo(cw.y); c8[3] = bfhi(cw.y); c8[4] = bflo(cw.z); c8[5] = bfhi(cw.z); c8[6] = bflo(cw.w); c8[7] = bfhi(cw.w); }
        u32x4 o; o.x = cvt_pk_bf16(s[0] * inv - c8[0], s[1] * inv - c8[1]); o.y = cvt_pk_bf16(s[2] * inv - c8[2], s[3] * inv - c8[3]);
        o.z = cvt_pk_bf16(s[4] * inv - c8[4], s[5] * inv - c8[5]); o.w = cvt_pk_bf16(s[6] * inv - c8[6], s[7] * inv - c8[7]);
        *(u32x4*)(dst + (size_t)(db + a * stride) * D + ch) = o;
        if (i < 7) { pool_add(s, tap[i + WIN], 1.0f); pool_add(s, tap[i], -1.0f); }
    }
}
template <int WIN> __device__ __forceinline__ void pool_unit(CP p, const int pass, const int v, const int gi, const int lane) {
    const bf16_t* h = (const bf16_t*)(p->ws + OFF_A); bf16_t* t1 = (bf16_t*)(p->ws + OFF_B); bf16_t* dl = (bf16_t*)(p->ws + OFF_D);
    const int ch = gi * 256 + 8 * (lane & 31), sub = (lane >> 5) * 8;
    if (pass == 0) {
        if (v < 512) { const int seq = v >> 4, k = v & 15; pool_blk<WIN>(h, seq * 256, 1, 256, 16 * k + sub, ch, 0, dl, seq * 256, h, 0); }
        else { const int w = v - 512, b = w >> 7, cc = (w >> 1) & 63, k = w & 1;
            pool_blk<WIN>(h, MP + b * 2048 + cc, 64, 32, 16 * k + sub, ch, 1, t1, b * 2048 + cc, h, 0); }
    } else { const int b = v >> 7, r = (v >> 2) & 31, k = v & 3;
        pool_blk<WIN>(t1, b * 2048 + r * 64, 1, 64, 16 * k + sub, ch, 2, dl, MP + b * 2048 + r * 64, h, MP + b * 2048 + r * 64); }
}
__device__ void pool_pass(CP p, int pass, const Tix tx) {
    const int lane = tx.tid & 63, wid = tx.tid >> 6;
    const int total = (pass == 0 ? 1536 : 1024) * 4;
    for (int u = tx.bid * 8 + wid; u < total; u += tx.gd * 8) {
        const int gi = u & 3, v = u >> 2;
        if (gi == 0) pool_unit<2>(p, pass, v, 0, lane); else if (gi == 1) pool_unit<4>(p, pass, v, 1, lane);
        else if (gi == 2) pool_unit<8>(p, pass, v, 2, lane); else pool_unit<16>(p, pass, v, 3, lane);
    }
}

constexpr int SST = 324;
constexpr int SBUF = 16 * SST + 64;
template <int VAR> __device__ void scan_phase(CP p, const bf16_t* W, LAS float* lf, const Tix tx, const int skipmask) {
    const int tid = tx.tid, lane = tid & 63, wid = tid >> 6, grp = wid >> 2, q = wid & 3;
    const int l15 = lane & 15, quad = lane >> 4, rl = lane >> 3, cg8 = lane & 7, i0 = 16 * q + 2 * rl;
    const bf16_t* rb = (const bf16_t*)(p->ws + OFF_C); const bf16_t* kb = (const bf16_t*)(p->ws + OFF_D); const bf16_t* vb = (const bf16_t*)(p->ws + OFF_E);
    const bf16_t* lb = (const bf16_t*)(p->ws + OFF_S);
    bf16_t* yout = (bf16_t*)(p->ws + OFF_A);
    float* cbp = (float*)(p->ws + OFF_CBP);
    const int tch = grp == 0 ? 128 : 16, nsub = grp == 0 ? 1 : ((skipmask & 8) ? 0 : 4);
    for (int it = tx.bid; it < 256; it += tx.gd) {
        f32x2 Sa[4], Sb[4];
        bf16x8 W2f[2], A2f[2];
        LAS float* ystage = lf + 4 * SBUF + 8 * 144 + wid * 1024;
        LAS float* wcst = lf + 4 * SBUF + wid * 144;
#pragma unroll
        for (int i = 0; i < 4; ++i) { Sa[i] = (f32x2){0.f, 0.f}; Sb[i] = (f32x2){0.f, 0.f}; }
        W2f[0] = W2f[1] = A2f[0] = A2f[1] = (bf16x8){0, 0, 0, 0, 0, 0, 0, 0};
        u32x2 pr = (u32x2){0u, 0u}, pk = pr, pv = pr; u32x4 pkf0 = (u32x4){0u, 0u, 0u, 0u}, pkf1 = pkf0; bf16x8 plw0 = (bf16x8){0, 0, 0, 0, 0, 0, 0, 0}, plw1 = plw0, pla0 = plw0, pla1 = plw0;
        int mn = 0, dn = 0, hhn = 0, scn = 0, slg = 0; bool sact = false;
        for (int c = -2; c < 128; ++c) {
#pragma unroll 1
          for (int slot = 0; slot < 2; ++slot) {
            if ((slot == 0) == (grp == 1)) {
                if (sact && !(skipmask & 2)) {
                    f32x4 aw = (f32x4){0.f, 0.f, 0.f, 0.f}, aa = aw;
                    aw = __builtin_amdgcn_mfma_f32_16x16x32_bf16(W2f[0], plw0, aw, 0, 0, 0); aw = __builtin_amdgcn_mfma_f32_16x16x32_bf16(W2f[1], plw1, aw, 0, 0, 0);
                    aa = __builtin_amdgcn_mfma_f32_16x16x32_bf16(A2f[0], pla0, aa, 0, 0, 0); aa = __builtin_amdgcn_mfma_f32_16x16x32_bf16(A2f[1], pla1, aa, 0, 0, 0);
                    const f32x4 cw0 = *(const LAS f32x4*)(wcst + 4 * quad), ca0 = *(const LAS f32x4*)(wcst + 16 + 4 * quad), ckk = *(const LAS f32x4*)(wcst + 32 + 4 * quad), cka = *(const LAS f32x4*)(wcst + 48 + 4 * quad), crk = *(const LAS f32x4*)(wcst + 64 + 4 * quad);
                    f32x4 kn[4];
    #pragma unroll
                    for (int i = 0; i < 4; ++i) kn[i] = *(const LAS f32x4*)(wcst + 80 + 16 * quad + 4 * i);
                    float ssq = 0.f;
                    { const unsigned kw[8] = {pkf0.x, pkf0.y, pkf0.z, pkf0.w, pkf1.x, pkf1.y, pkf1.z, pkf1.w};
    #pragma unroll
                      for (int i = 0; i < 8; ++i) { const float a = bflo(kw[i]) * kn[i >> 1][(i & 1) * 2], b2 = bfhi(kw[i]) * kn[i >> 1][(i & 1) * 2 + 1]; ssq += a * a + b2 * b2; } }
                    { auto s1 = __builtin_amdgcn_permlane16_swap(__float_as_uint(ssq), __float_as_uint(ssq), false, false); ssq = __uint_as_float(s1[0]) + __uint_as_float(s1[1]);
                      auto s2 = __builtin_amdgcn_permlane32_swap(__float_as_uint(ssq), __float_as_uint(ssq), false, false); ssq = __uint_as_float(s2[0]) + __uint_as_float(s2[1]); }
                    const float rn = fminf(__builtin_amdgcn_rsqf(ssq), 1e12f);
                    const f32x4 r4 = (f32x4){bflo(pr.x), bfhi(pr.x), bflo(pr.y), bfhi(pr.y)}, k4 = (f32x4){bflo(pk.x), bfhi(pk.x), bflo(pk.y), bfhi(pk.y)}, v4 = (f32x4){bflo(pv.x), bfhi(pv.x), bflo(pv.y), bfhi(pv.y)};
                    f32x4 e4, E4, kk4, b4, kd4, rh4, cs4; float cbs = 0.f;
    #pragma unroll
                    for (int j = 0; j < 4; ++j) { e4[j] = 0.60653066f * fast_sigmoid(cw0[j] + aw[j]);
                        float t = e4[j];
                        t += __builtin_bit_cast(float, __builtin_amdgcn_update_dpp(0, __builtin_bit_cast(int, t), 0x111, 0xf, 0xf, true));
                        t += __builtin_bit_cast(float, __builtin_amdgcn_update_dpp(0, __builtin_bit_cast(int, t), 0x112, 0xf, 0xf, true));
                        t += __builtin_bit_cast(float, __builtin_amdgcn_update_dpp(0, __builtin_bit_cast(int, t), 0x114, 0xf, 0xf, true));
                        t += __builtin_bit_cast(float, __builtin_amdgcn_update_dpp(0, __builtin_bit_cast(int, t), 0x118, 0xf, 0xf, true));
                        E4[j] = t; }
    #pragma unroll
                    for (int j = 0; j < 4; ++j) {
                        const float a = fast_sigmoid(ca0[j] + aa[j]);
                        const float kkn = k4[j] * ckk[j] * rn, bq = kkn * a, kd = k4[j] * (1.0f + (a - 1.0f) * cka[j]);
                        cbs += r4[j] * kd * crk[j];
                        const float cs = __expf(-E4[j]), cinv = __builtin_amdgcn_rcpf(cs);
                        const float cp = __builtin_bit_cast(float, __builtin_amdgcn_update_dpp(0x3f800000, __builtin_bit_cast(int, cs), 0x111, 0xf, 0xf, false));
                        kk4[j] = kkn * cp; b4[j] = bq * cinv; kd4[j] = kd * cinv; rh4[j] = r4[j] * cs; cs4[j] = cs; }
                    LAS float* wb = lf + (slg * 2 + (scn & 1)) * SBUF;
                    LAS float* wp = wb + l15 * SST + 16 * q + 4 * quad;
                    *(LAS f32x4*)(wp) = kk4; *(LAS f32x4*)(wp + 64) = b4; *(LAS f32x4*)(wp + 128) = kd4; *(LAS f32x4*)(wp + 192) = rh4; *(LAS f32x4*)(wp + 256) = v4;
                    if (l15 == 15) *(LAS f32x4*)(wb + 16 * SST + 16 * q + 4 * quad) = cs4;
                    { auto s1 = __builtin_amdgcn_permlane16_swap(__float_as_uint(cbs), __float_as_uint(cbs), false, false); cbs = __uint_as_float(s1[0]) + __uint_as_float(s1[1]);
                      auto s2 = __builtin_amdgcn_permlane32_swap(__float_as_uint(cbs), __float_as_uint(cbs), false, false); cbs = __uint_as_float(s2[0]) + __uint_as_float(s2[1]); }
                    if (quad == 0) cbp[(((size_t)dn * MT + mn) * 16 + hhn) * 4 + q] = cbs;
                }
            }
            if (slot == 0) {
                const int cn = c + 1 + grp; const int g1len = ((skipmask & 8) ? 0 : 4) * 16;
                const int lg = (grp == 1 && cn >= g1len) ? 0 : grp;
                const int ltch = lg == 0 ? 128 : 16; const int subn = cn / ltch, ccn = cn % ltch;
                const bool actn = (cn >= 0) && (cn < 128) && (grp == 1 || cn < g1len);
                sact = actn; scn = cn; slg = lg;
                if (actn && !(skipmask & 4)) {
                    const int pid = lg == 0 ? it : 4 * it + subn; dn = pid & 1; hhn = (pid >> 1) & 15; const int b = pid >> 5;
                    const int T = lg == 0 ? 2048 : 256, mb = lg == 0 ? MP + b * 2048 : b * 256;
                    const int pos = ccn * 16 + l15; mn = mb + (dn == 0 ? pos : T - 1 - pos);
                    const int col4 = 64 * hhn + 16 * q + 4 * quad;
                    pr = *(const u32x2*)(rb + (size_t)mn * D + col4); pk = *(const u32x2*)(kb + (size_t)mn * D + col4); pv = *(const u32x2*)(vb + (size_t)mn * D + col4);
                    pkf0 = *(const u32x4*)(kb + (size_t)mn * D + 64 * hhn + 16 * quad); pkf1 = *(const u32x4*)(kb + (size_t)mn * D + 64 * hhn + 16 * quad + 8);
                    plw0 = *(const bf16x8*)(lb + (size_t)mn * 384 + dn * 64 + 8 * quad); plw1 = *(const bf16x8*)(lb + (size_t)mn * 384 + dn * 64 + 32 + 8 * quad);
                    pla0 = *(const bf16x8*)(lb + (size_t)mn * 384 + 128 + dn * 64 + 8 * quad); pla1 = *(const bf16x8*)(lb + (size_t)mn * 384 + 128 + dn * 64 + 32 + 8 * quad);
                    if (ccn == 0 || (grp == 1 && lg == 0 && cn == g1len)) {
                        const bf16_t* w2r = W + W_W2L + ((size_t)dn * 1024 + 64 * hhn + 16 * q + l15) * 64 + 8 * quad;
                        const bf16_t* a2r = W + W_A2L + ((size_t)dn * 1024 + 64 * hhn + 16 * q + l15) * 64 + 8 * quad;
                        W2f[0] = *(const bf16x8*)w2r; W2f[1] = *(const bf16x8*)(w2r + 32); A2f[0] = *(const bf16x8*)a2r; A2f[1] = *(const bf16x8*)(a2r + 32);
                        const int cw = 64 * hhn + 16 * q + l15;
                        if (lane < 16) { wcst[lane] = p->in[15][dn * D + cw]; wcst[16 + lane] = p->in[18][dn * D + cw]; wcst[32 + lane] = p->in[23][cw]; wcst[48 + lane] = p->in[24][cw]; wcst[64 + lane] = p->in[25][cw]; }
                        wcst[80 + lane] = p->in[23][64 * hhn + lane];
                    }
                }
                const int sub = c < 0 ? 0 : c / tch, cc = c < 0 ? 0 : c % tch; const bool act = (c >= 0) && (sub < nsub);
                if (act && !(skipmask & 1)) {
                    const int pid = grp == 0 ? it : 4 * it + sub; const int d = pid & 1, hh = (pid >> 1) & 15, b = pid >> 5;
                    const int T = grp == 0 ? 2048 : 256, mb = grp == 0 ? MP + b * 2048 : b * 256;
                    if (cc == 0) {
                        if (grp == 0) { const float* s0 = (d == 0 ? p->in[3] : p->in[4]) + ((size_t)(b * 16 + hh) * 64 + i0) * 64 + 8 * cg8;
                            const f32x4 a0 = *(const f32x4*)s0, a1 = *(const f32x4*)(s0 + 4), b0 = *(const f32x4*)(s0 + 64), b1 = *(const f32x4*)(s0 + 68);
                            Sa[0] = a0.lo; Sa[1] = a0.hi; Sa[2] = a1.lo; Sa[3] = a1.hi; Sb[0] = b0.lo; Sb[1] = b0.hi; Sb[2] = b1.lo; Sb[3] = b1.hi; }
                        else {
    #pragma unroll
                            for (int i = 0; i < 4; ++i) { Sa[i] = (f32x2){0.f, 0.f}; Sb[i] = (f32x2){0.f, 0.f}; } }
                    }
                    const LAS float* bp0 = lf + (grp * 2 + (c & 1)) * SBUF;
                    bf16_t* yo = yout + (size_t)d * MT * D + 64 * hh + i0;
                    f32x4 nk0, nk1, nb0, nb1, nd0, nd1; f32x2 nv; f32x2 rp[4];
    #define SCAN_LOAD_K(s_) do { const LAS float* bp_ = bp0 + (s_) * SST + 8 * cg8; nk0 = *(const LAS f32x4*)(bp_); nk1 = *(const LAS f32x4*)(bp_ + 4); } while (0)
    #define SCAN_LOAD_R(s_) do { const LAS float* bp_ = bp0 + (s_) * SST + 8 * cg8; const f32x4 r0_ = *(const LAS f32x4*)(bp_ + 192), r1_ = *(const LAS f32x4*)(bp_ + 196); rp[0] = r0_.lo; rp[1] = r0_.hi; rp[2] = r1_.lo; rp[3] = r1_.hi; } while (0)
    #define SCAN_LOAD_B(s_) do { const LAS float* bp_ = bp0 + (s_) * SST + 8 * cg8; nb0 = *(const LAS f32x4*)(bp_ + 64); nb1 = *(const LAS f32x4*)(bp_ + 68); \
                        nd0 = *(const LAS f32x4*)(bp_ + 128); nd1 = *(const LAS f32x4*)(bp_ + 132); nv = *(const LAS f32x2*)(bp0 + (s_) * SST + 256 + i0); } while (0)
                    SCAN_LOAD_K(0); SCAN_LOAD_B(0);
    #pragma unroll
                    for (int i = 0; i < 4; ++i) rp[i] = (f32x2){0.f, 0.f};
    #define SCAN_YFLUSH(b_) do { const LAS float* ys_ = ystage + cg8 * 128 + 16 * rl; const f32x4 q0_ = *(const LAS f32x4*)(ys_), q1_ = *(const LAS f32x4*)(ys_ + 4), q2_ = *(const LAS f32x4*)(ys_ + 8), q3_ = *(const LAS f32x4*)(ys_ + 12); \
                        const float ye_ = ((q0_[0] + q0_[2]) + (q1_[0] + q1_[2])) + ((q2_[0] + q2_[2]) + (q3_[0] + q3_[2])), yo_ = ((q0_[1] + q0_[3]) + (q1_[1] + q1_[3])) + ((q2_[1] + q2_[3]) + (q3_[1] + q3_[3])); \
                        const int pos_ = cc * 16 + 8 * (b_) + cg8; const int m_ = mb + (d == 0 ? pos_ : T - 1 - pos_); *(unsigned*)(yo + (size_t)m_ * D) = cvt_pk_bf16(ye_, yo_); } while (0)
    #pragma unroll
                    for (int s = 0; s < 16; ++s) {
                        const f32x2 kk[4] = {nk0.lo, nk0.hi, nk1.lo, nk1.hi};
                        f32x2 pa = Sa[0] * kk[0], pb = Sb[0] * kk[0], ya = Sa[0] * rp[0], yb = Sb[0] * rp[0];
    #pragma unroll
                        for (int i = 1; i < 4; ++i) { pa = Sa[i] * kk[i] + pa; pb = Sb[i] * kk[i] + pb; ya = Sa[i] * rp[i] + ya; yb = Sb[i] * rp[i] + yb; }
                        if (s < 15 && !(VAR & 2)) SCAN_LOAD_K(s + 1);
                        if (!(VAR & 2)) SCAN_LOAD_R(s);
                        float sa0 = pa.x + pa.y, sa1 = pb.x + pb.y;
                        if (s > 0) *(LAS f32x2*)(ystage + ((s - 1) & 7) * 128 + 2 * lane) = (f32x2){ya.x + ya.y, yb.x + yb.y};
                        sa0 += dpp_f<0xB1>(sa0); sa1 += dpp_f<0xB1>(sa1);
                        sa0 += dpp_f<0x4E>(sa0); sa1 += dpp_f<0x4E>(sa1);
                        sa0 += dpp_f<0x141>(sa0); sa1 += dpp_f<0x141>(sa1);
                        const f32x2 bb[4] = {nb0.lo, nb0.hi, nb1.lo, nb1.hi}, dd[4] = {nd0.lo, nd0.hi, nd1.lo, nd1.hi};
                        const f32x2 n0 = (f32x2){-sa0, -sa0}, n1 = (f32x2){-sa1, -sa1}, v0 = (f32x2){nv.x, nv.x}, v1 = (f32x2){nv.y, nv.y};
    #pragma unroll
                        for (int i = 0; i < 4; ++i) { Sa[i] = n0 * bb[i] + Sa[i]; Sb[i] = n1 * bb[i] + Sb[i]; Sa[i] = v0 * dd[i] + Sa[i]; Sb[i] = v1 * dd[i] + Sb[i]; }
                        if (s < 15 && !(VAR & 1)) SCAN_LOAD_B(s + 1);
                        if (s == 8) SCAN_YFLUSH(0);
                    }
                    {
                        f32x2 ya = Sa[0] * rp[0], yb = Sb[0] * rp[0];
    #pragma unroll
                        for (int i = 1; i < 4; ++i) { ya = Sa[i] * rp[i] + ya; yb = Sb[i] * rp[i] + yb; }
                        *(LAS f32x2*)(ystage + 7 * 128 + 2 * lane) = (f32x2){ya.x + ya.y, yb.x + yb.y};
                        const f32x4 c0 = *(const LAS f32x4*)(bp0 + 16 * SST + 8 * cg8), c1 = *(const LAS f32x4*)(bp0 + 16 * SST + 8 * cg8 + 4);
                        Sa[0] *= c0.lo; Sa[1] *= c0.hi; Sa[2] *= c1.lo; Sa[3] *= c1.hi; Sb[0] *= c0.lo; Sb[1] *= c0.hi; Sb[2] *= c1.lo; Sb[3] *= c1.hi;
                        SCAN_YFLUSH(1);
                    }
    #undef SCAN_YFLUSH
    #undef SCAN_LOAD_K
    #undef SCAN_LOAD_R
    #undef SCAN_LOAD_B
                    if (grp == 1 && cc == tch - 1) {
                        float* sf = p->out + (size_t)MT * D + (size_t)d * (32 * 16 * 4096) + ((size_t)(b * 16 + hh) * 64 + i0) * 64 + 8 * cg8;
                        *(f32x4*)sf = (f32x4){Sa[0].x, Sa[0].y, Sa[1].x, Sa[1].y}; *(f32x4*)(sf + 4) = (f32x4){Sa[2].x, Sa[2].y, Sa[3].x, Sa[3].y};
                        *(f32x4*)(sf + 64) = (f32x4){Sb[0].x, Sb[0].y, Sb[1].x, Sb[1].y}; *(f32x4*)(sf + 68) = (f32x4){Sb[2].x, Sb[2].y, Sb[3].x, Sb[3].y};
                    }
                }
            }
          }
            asm volatile("s_waitcnt lgkmcnt(0)" ::: "memory"); __builtin_amdgcn_s_barrier(); asm volatile("" ::: "memory");
        }
    }
}

#define XB_TMO      128
#define XB_XCNT(j)  (256  + 64 * (j))
#define XB_XSUB(j)  (1280 + 64 * (j))
#define XB_XGEN(j)  (2304 + 64 * (j))
#define XB_TOP      3328
#define XB_TOPGEN   3392
#define XCD_BAR_WORDS 3456
#define XB_SPIN_CAP (1u << 18)

__device__ __forceinline__ unsigned xb_ld(unsigned* p)              { return __hip_atomic_load(p, __ATOMIC_RELAXED, __HIP_MEMORY_SCOPE_AGENT); }
__device__ __forceinline__ unsigned xb_add(unsigned* p, unsigned v) { return __hip_atomic_fetch_add(p, v, __ATOMIC_RELAXED, __HIP_MEMORY_SCOPE_AGENT); }
__device__ __forceinline__ unsigned xb_xcc_id() { return (unsigned)__builtin_amdgcn_s_getreg((3 << 11) | 20) & 0xFu; }
#define XB_SPIN(cond, bar) do { unsigned _sp = 0; while (cond) { __builtin_amdgcn_s_sleep(1); \
    if ((++_sp & 255u) == 0u) { if (xb_ld(&(bar)[XB_TMO])) break; if (_sp > XB_SPIN_CAP) { atomicAdd(&(bar)[XB_TMO], 1u); break; } } } } while (0)

struct XcdBarrier {
    unsigned* bar; unsigned x;
    volatile LAS unsigned* st;
};

__device__ __forceinline__ XcdBarrier xcd_barrier_post(unsigned* bar, volatile LAS unsigned* st) {
    XcdBarrier b; b.bar = bar; b.x = xb_xcc_id(); b.st = st;
    if (threadIdx.x == 0) (void)xb_add(&bar[XB_XCNT(b.x)], 1u);
    return b;
}
__device__ __forceinline__ void xcd_barrier_complete(unsigned* bar, unsigned x, unsigned& nloc, unsigned& nx) {
    const unsigned G = gridDim.x * gridDim.y * gridDim.z;
    unsigned sum, cnt, mine, sp = 0u;
    for (;;) {
        sum = 0u; cnt = 0u; mine = 0u;
#pragma unroll
        for (unsigned j = 0; j < 16; ++j) { const unsigned c = xb_ld(&bar[XB_XCNT(j)]); sum += c; cnt += (c > 0u) ? 1u : 0u; mine = (j == x) ? c : mine; }
        if (sum == G) break;
        __builtin_amdgcn_s_sleep(1);
        if ((++sp & 255u) == 0u) { if (xb_ld(&bar[XB_TMO])) break; if (sp > XB_SPIN_CAP) { atomicAdd(&bar[XB_TMO], 1u); break; } }
    }
    nloc = mine > 0u ? mine : 1u; nx = cnt > 0u ? cnt : 1u;
}

__device__ __forceinline__ void xcd_barrier(const XcdBarrier& b) {
    asm volatile("s_waitcnt vmcnt(0)" ::: "memory");
    __syncthreads();
    if (threadIdx.x == 0) {
        unsigned* bar = b.bar;
        __builtin_amdgcn_s_waitcnt(0);
        unsigned nloc = b.st[0], nx = b.st[1];
        if (nloc == 0u) { xcd_barrier_complete(bar, b.x, nloc, nx); b.st[0] = nloc; b.st[1] = nx; }
        const unsigned old = xb_add(&bar[XB_XSUB(b.x)], 1u);
        const unsigned gen = old / nloc;
        if (old + 1u == (gen + 1u) * nloc) {
            __builtin_amdgcn_fence(__ATOMIC_RELEASE, "agent");
            asm volatile("s_waitcnt vmcnt(0)" ::: "memory");
            const unsigned og = xb_add(&bar[XB_TOP], 1u);
            const unsigned tg = og / nx;
            if (og + 1u == (tg + 1u) * nx) xb_add(&bar[XB_TOPGEN], 1u);
            else XB_SPIN(xb_ld(&bar[XB_TOPGEN]) == tg, bar);
            __builtin_amdgcn_fence(__ATOMIC_ACQUIRE, "agent");
            xb_add(&bar[XB_XGEN(b.x)], 1u);
            asm volatile("s_waitcnt vmcnt(0)" ::: "memory");
        } else {
            XB_SPIN(xb_ld(&bar[XB_XGEN(b.x)]) == gen, bar);
            __builtin_amdgcn_fence(__ATOMIC_ACQUIRE, "agent");
            asm volatile("s_waitcnt vmcnt(0)" ::: "memory");
        }
    }
    __syncthreads();
}


constexpr int NPHASE = 24;
#ifndef SPLITK
#define SPLITK 1
#endif
#ifndef ONLYMASK
#define ONLYMASK 0x1ff
#endif
#define EN(k) ((ONLYMASK >> (k)) & 1)
constexpr int LDS_BYTES = 131072 + 16;
__global__ void __launch_bounds__(512, 2) mega(Params kp) {
    extern __shared__ __attribute__((aligned(16))) unsigned char shm[];
    PG8_LAS unsigned char* lds = (PG8_LAS unsigned char*)shm;
    LAS float* lf = (LAS float*)shm;
    cg::grid_group grid = cg::this_grid();
    const int pb = kp.pb, pe = kp.pe;
    volatile LAS unsigned* xst = (volatile LAS unsigned*)(lds + 131072);
    if (threadIdx.x < 2) xst[threadIdx.x] = 0u;
    __syncthreads();
    XcdBarrier xb = xcd_barrier_post((unsigned*)(kp.ws + OFF_BAR), xst);
#ifdef PROBE_SYNC
#pragma unroll 1
    for (int i = 0; i < PROBE_SYNC; ++i) grid.sync();
#endif
#pragma unroll 1
    for (int ph = pb; ph < pe; ++ph) {
        CP p = (CP)__builtin_amdgcn_kernarg_segment_ptr();
        asm volatile("" : "+s"(p));
        Tix tx; { int t_ = threadIdx.x, b_ = blockIdx.x, g_ = gridDim.x; asm volatile("" : "+v"(t_)); asm volatile("" : "+s"(b_), "+s"(g_)); tx.tid = t_; tx.bid = b_; tx.gd = g_; }
        bf16_t* rA = (bf16_t*)(p->ws + OFF_A); bf16_t* rB = (bf16_t*)(p->ws + OFF_B); bf16_t* rC = (bf16_t*)(p->ws + OFF_C); bf16_t* rD = (bf16_t*)(p->ws + OFF_D); bf16_t* rE = (bf16_t*)(p->ws + OFF_E);
        bf16_t* rS = (bf16_t*)(p->ws + OFF_S);
        const int wsel = (ph <= 3) ? 0 : (ph <= 9) ? 1 : (ph <= 12) ? 0 : (ph <= 15) ? 1 : (ph <= 19) ? 0 : 1;
        bf16_t* W = (bf16_t*)(p->ws + (wsel ? OFF_W2 : OFF_W)); bf16_t* Wn = (bf16_t*)(p->ws + (wsel ? OFF_W : OFF_W2));
        const float* npre = p->in[8]; const float* npost = p->in[9];
        int kind = 0;
        RowCfg rc{}; int conv = -1;
        const bf16_t* gA = nullptr; const bf16_t* gB = nullptr; bf16_t* gO = nullptr; int gN = 0, gK = 0, pool_pass_id = 0;
        switch (ph) {
            case 0: kind = 0; break;
            case 1: kind = 1; rc = RowCfg{1, 0, 0, 0, 0.f, npost, 1, 0, 0, 1, npre + 0 * D, 0, SPLITK}; break;
            case 2: case 11: case 14: case 21: kind = 2; conv = (ph == 2) ? 4 : (ph == 11) ? 2 : (ph == 14) ? 5 : -1; break;
            case 3: case 12: case 15: case 22: kind = 3; gA = rB; gB = W + W_W2T; gO = rE; gN = 1024; gK = 2816; break;
            case 4: kind = 4; rc = RowCfg{1, 1, 0, 2, 0.5f, npost + 0 * D, 1, 0, 3, 4, npre + 1 * D, 1, SPLITK}; break;
            case 5: kind = 5; conv = 1; break;
            case 6: kind = 6; break;
            case 7: kind = 3; gA = rS; gB = W + W_BTG; gO = rC; gN = 1024; gK = 384; break;
            case 8: kind = 7; break;
            case 9: kind = 3; gA = rD; gB = W + W_WOT; gO = rE; gN = 1024; gK = 1024; break;
            case 10: kind = 1; rc = RowCfg{0, 1, 0, 5, 1.0f, npost + 1 * D, 1, 0, 6, 7, npre + 2 * D, 1, SPLITK}; break;
            case 13: kind = 1; rc = RowCfg{0, 1, 0, 8, 0.5f, npost + 2 * D, 1, 1, 0, 1, npre + 3 * D, 1, SPLITK}; break;
            case 16: kind = 1; rc = RowCfg{0, 1, 1, 2, 0.5f, npost + 3 * D, 1, 1, 3, 4, npre + 4 * D, 1, SPLITK}; break;
            case 17: kind = 8; pool_pass_id = 0; break;
            case 18: kind = 8; pool_pass_id = 1; break;
            case 19: kind = 3; gA = rD; gB = W; gO = rE; gN = 1024; gK = 1024; conv = 3; break;
            case 20: kind = 1; rc = RowCfg{0, 1, 1, 5, 1.0f, npost + 4 * D, 1, 1, 6, 7, npre + 5 * D, 1, SPLITK}; break;
            case 23: kind = 1; rc = RowCfg{0, 1, 1, 8, 0.5f, npost + 5 * D, 0, 0, 0, 0, npre, 1, SPLITK}; break;
            default: break;
        }
        rc.fsplit = (SPLITK && tx.gd == 256) ? 1 : 0;
#ifdef PROBE_PH
        const int reps = (ph == PROBE_PH) ? PROBE_N : 1;
#else
        const int reps = 1;
#endif
#pragma unroll 1
        for (int rep = 0; rep < reps; ++rep) {
        if (rep > 0) xcd_barrier(xb);
        asm volatile("" : "+v"(tx.tid)); asm volatile("" : "+s"(tx.bid), "+s"(tx.gd)); asm volatile("" : "+s"(p));
        if (EN(0) && kind == 0) { mod_phase(p, lf, tx); __syncthreads();
            if (tx.gd > 64) { if (tx.bid >= 32) { const Tix tv{tx.tid, tx.bid - 32, tx.gd - 32}; conv_ffn(p, W, 0, lf + 16384, tv); } }
            else conv_ffn(p, W, 0, lf + 16384, tx); }
        else if (EN(1) && kind == 1) { rowpass_simple(p, rc, tx); }
        else if (EN(4) && kind == 4) { rowpass_shift(p, rc, lf, tx); }
        else if (EN(2) && (kind == 2 || kind == 3 || kind == 5)) {
            if (kind == 2) { gA = rA; gB = W + W_W13; gO = rB; gN = 5632; gK = 1024; } else if (kind == 5) { gA = rA; gB = W + W_BTP; gO = rC; gN = 3584; gK = 2048; }
            const int bal = (SPLITK && kind == 3 && gK >= 1024 && tx.gd == 256) ? 1 : 0;
            pg8::Gemm g{gA, gB, MT, gN, gK}; pg8::FwdOrder S; S.init(MT, gN, gK, tx.gd, tx.bid, bal);
            pg8::EpiAll E{kind == 3 ? 0 : (kind == 2 ? 1 : 2), gO, kind == 2 ? DFF : 1024, rS, (bf16_t*)(p->ws + OFF_FB) - (size_t)16384 * 1024};
#ifdef PROBE_NOEPI
            if (rep + 1 < reps) E.kind = 7;
#endif
            pg8::gemm_phase<pg8::EpiAll, pg8::FwdOrder, false>(lds, g, S, E, nullptr, tx.tid);
            if (conv >= 0) { const int nunit = (MT / 256) * (gN / 256), extra = nunit % tx.gd;
                const int half = (bal || extra == 0 || extra > tx.gd / 2) ? 0 : extra; if (tx.bid >= half) { const Tix tv{tx.tid, tx.bid - half, tx.gd - half};
                if (conv < 4) conv_ffn(p, Wn, conv, lf, tv); else if (conv == 4) conv_rwkv(p, Wn, lf, tv); else conv_pool(p, Wn, tv); } } }
        else if (EN(6) && kind == 6) {
#ifdef PROBE_VAR
            if (rep + 1 < reps) scan_phase<PROBE_VAR>(p, W, lf, tx, 0); else scan_phase<0>(p, W, lf, tx, 0);
#elif defined(PROBE_MASK)
            scan_phase<0>(p, W, lf, tx, (rep + 1 < reps) ? PROBE_MASK : 0);
#else
            scan_phase<0>(p, W, lf, tx, 0);
#endif
        }
        else if (EN(7) && kind == 7) rowpass_gn(p, tx);
        else if (EN(8) && kind == 8) pool_pass(p, pool_pass_id, tx);
        }
        if (ph + 1 < pe) { if (pb > pe) grid.sync(); else xcd_barrier(xb); }
    }
}

#include <cstdio>
#ifndef USE_COOP
#define USE_COOP 1
#endif
extern "C" void kernel_launch(void* const* d_in, const int* in_sizes, int n_in, void* d_out, int out_size, void* d_ws, size_t ws_size, hipStream_t stream) {
    static int grid = 0;
    if (grid == 0) {
        if (n_in != NIN || ws_size < WS_NEED) { fprintf(stderr, "kernel_launch: n_in %d ws %zu (need %zu)\n", n_in, ws_size, (size_t)WS_NEED); grid = -1; return; }
        int dev = 0, cus = 0, per_cu = 0;
        hipGetDevice(&dev); hipDeviceGetAttribute(&cus, hipDeviceAttributeMultiprocessorCount, dev);
        if (hipFuncSetAttribute((const void*)mega, hipFuncAttributeMaxDynamicSharedMemorySize, LDS_BYTES) != hipSuccess) { fprintf(stderr, "kernel_launch: hipFuncSetAttribute failed\n"); grid = -1; return; }
        if (hipOccupancyMaxActiveBlocksPerMultiprocessor(&per_cu, (const void*)mega, 512, LDS_BYTES) != hipSuccess || per_cu < 1) { fprintf(stderr, "kernel_launch: occupancy query says %d\n", per_cu); per_cu = 1; }
        (void)hipGetLastError();
        grid = cus * 1;
        if (grid <= 0) grid = 256;
    }
    if (grid < 0) return;
    if (hipMemsetAsync((unsigned char*)d_ws + OFF_BAR, 0, 16384, stream) != hipSuccess) { fprintf(stderr, "kernel_launch: memset of the barrier words failed\n"); return; }
    Params p{};
    for (int i = 0; i < NIN; ++i) p.in[i] = (const float*)d_in[i];
    p.out = (float*)d_out; p.ws = (unsigned char*)d_ws;
#if USE_COOP
    p.pb = 0; p.pe = NPHASE;
    void* args[] = {&p};
    hipError_t e = hipLaunchCooperativeKernel((const void*)mega, dim3(grid), dim3(512), args, LDS_BYTES, stream);
    if (e != hipSuccess) fprintf(stderr, "cooperative launch failed: %s (grid %d)\n", hipGetErrorString(e), grid);
#else
    for (int ph = 0; ph < NPHASE; ++ph) { p.pb = ph; p.pe = ph + 1; hipLaunchKernelGGL(mega, dim3(grid), dim3(512), LDS_BYTES, stream, p); }
#endif
}
```

```cpp
#include <hip/hip_runtime.h>
#include <hip/hip_cooperative_groups.h>
namespace pg8 {
#define PG8_LAS __attribute__((address_space(3)))
typedef unsigned short bf16_t;
typedef short bf16x8 __attribute__((ext_vector_type(8)));
typedef float f32x4 __attribute__((ext_vector_type(4)));
typedef unsigned u32x4 __attribute__((ext_vector_type(4)));
constexpr int BM = 256, BK = 64, HALF = 128, HTB = HALF * BK * 2  , STAGE_BYTES = 8 * HTB, NXCD = 8, WGM = 8;

__host__ __device__ __forceinline__ int lds_byte(int r, int c) { const int st = (r >> 4) * 2 + (c >> 5), rr = r & 15, cc = c & 31, ob = rr * 64 + cc * 2; return st * 1024 + (ob ^ (((ob >> 9) & 1) << 5)); }
__host__ __device__ __forceinline__ void stage_rc(int b, int& R, int& C) { const int st = b / 1024, sb = b % 1024, swz = sb ^ (((sb >> 9) & 1) << 5); R = (st >> 1) * 16 + swz / 64; C = (st & 1) * 32 + (swz % 64) / 2; }
__host__ __device__ __forceinline__ int perm32(int rho) { const int n = rho >> 4, i = rho & 15; return 8 * (i >> 2) + 4 * n + (i & 3); }

struct Unit { int pm, pn, part; };
struct Gemm { const bf16_t* A; const bf16_t* Bt; int M, N, K; };

struct StaticOrder {
    int nM, nN, nwg, G, c;
    __host__ __device__ void init(int M, int N, int G_, int c_) { nM = M / BM; nN = N / BM; nwg = nM * nN; G = G_; c = c_; }
    __host__ __device__ bool next(int i, Unit& u) const {
        const long L = (long)i * G + c; if (L >= nwg) return false;
        int wgid = (int)L; { const int q = nwg / NXCD, r = nwg % NXCD, xcd = wgid % NXCD, off = wgid / NXCD; wgid = (xcd < r ? xcd * (q + 1) : r * (q + 1) + (xcd - r) * q) + off; }
        const int nig = WGM * nN, gid = wgid / nig, fm = gid * WGM, gsz = (nM - fm) < WGM ? (nM - fm) : WGM;
        u.pm = fm + ((wgid % nig) % gsz); u.pn = (wgid % nig) / gsz; u.part = 0; return true;
    }
    __device__ __forceinline__ void a_ready(const Unit&) const {}
    __device__ __forceinline__ void done(const Unit&) const {}
};
struct FwdOrder {
    StaticOrder so; int mode;
    __host__ __device__ void init(int M, int N, int K, int G_, int c_, int mode_) { so.init(M, N, G_, c_); mode = mode_; }
    __host__ __device__ bool next(int i, Unit& u) const {
        if (mode == 0) return so.next(i, u);
        if (i >= 2) return false;
        const int w = (so.c & 7) * 32 + (so.c >> 3);
        if (i == 0) { u.pm = w >> 2; u.pn = w & 3; u.part = 0; }
        else { u.pm = 64 + (w >> 3); u.pn = (w >> 1) & 3; u.part = 1 + (w & 1); }
        return true;
    }
    __device__ __forceinline__ void a_ready(const Unit&) const {}
    __device__ __forceinline__ void done(const Unit&) const {}
};
__device__ __forceinline__ unsigned cvt_pk_bf16(float lo, float hi) { unsigned r; asm volatile("v_cvt_pk_bf16_f32 %0, %1, %2" : "=v"(r) : "v"(lo), "v"(hi)); return r; }
typedef float f32x2 __attribute__((ext_vector_type(2)));
__device__ __forceinline__ float fast_sigmoid(float x) { return __builtin_amdgcn_rcpf(1.0f + __expf(-x)); }
__device__ __forceinline__ float fast_tanh(float x) { return 1.0f - 2.0f * __builtin_amdgcn_rcpf(1.0f + __expf(2.0f * x)); }
struct EpiStore {
    static constexpr bool PERM = true, AFTER_DRAIN = false;
    bf16_t* O; int ldc;
    __device__ __forceinline__ void operator()(const f32x4 (&acc)[2][2][4][2], const Unit& u, int wr, int wc, int fr, int fq) const {
        const int row0 = u.pm * BM + wr * 64 + fr, col0 = u.pn * BM + wc * 32 + 8 * fq;
#pragma unroll
        for (int ai = 0; ai < 2; ++ai)
#pragma unroll
            for (int m = 0; m < 4; ++m) { bf16_t* rowp = O + (size_t)(row0 + ai * HALF + m * 16) * ldc + col0;
#pragma unroll
                for (int bj = 0; bj < 2; ++bj) { const f32x4 v0 = acc[ai][bj][m][0], v1 = acc[ai][bj][m][1];
                    u32x4 w; w.x = cvt_pk_bf16(v0[0], v0[1]); w.y = cvt_pk_bf16(v0[2], v0[3]); w.z = cvt_pk_bf16(v1[0], v1[1]); w.w = cvt_pk_bf16(v1[2], v1[3]);
                    *(u32x4*)(rowp + bj * HALF) = w; } }
    }
};
struct EpiSwiglu {
    static constexpr bool PERM = true, AFTER_DRAIN = false;
    bf16_t* O; int ldc;
    __device__ __forceinline__ void operator()(const f32x4 (&acc)[2][2][4][2], const Unit& u, int wr, int wc, int fr, int fq) const {
        const int row0 = u.pm * BM + wr * 64 + fr, col0 = u.pn * HALF + wc * 32 + 8 * fq;
#pragma unroll
        for (int ai = 0; ai < 2; ++ai)
#pragma unroll
            for (int m = 0; m < 4; ++m) { bf16_t* rowp = O + (size_t)(row0 + ai * HALF + m * 16) * ldc + col0;
                float o[8];
#pragma unroll
                for (int n = 0; n < 2; ++n)
#pragma unroll
                    for (int j = 0; j < 4; ++j) { const float a = acc[ai][0][m][n][j], b = acc[ai][1][m][n][j]; o[n * 4 + j] = a * fast_sigmoid(a) * b; }
                u32x4 w; w.x = cvt_pk_bf16(o[0], o[1]); w.y = cvt_pk_bf16(o[2], o[3]); w.z = cvt_pk_bf16(o[4], o[5]); w.w = cvt_pk_bf16(o[6], o[7]);
                *(u32x4*)rowp = w; }
    }
};
struct EpiRkv {
    static constexpr bool PERM = true, AFTER_DRAIN = false;
    bf16_t* O; size_t tstride; bf16_t* L;
    __device__ __forceinline__ void operator()(const f32x4 (&acc)[2][2][4][2], const Unit& u, int wr, int wc, int fr, int fq) const {
        const int row0 = u.pm * BM + wr * 64 + fr;
        if (u.pn < 12) {
            bf16_t* base = O + (size_t)(u.pn >> 2) * tstride; const int col0 = (u.pn & 3) * BM + wc * 32 + 8 * fq;
#pragma unroll
            for (int ai = 0; ai < 2; ++ai)
#pragma unroll
                for (int m = 0; m < 4; ++m) { bf16_t* rowp = base + (size_t)(row0 + ai * HALF + m * 16) * 1024 + col0;
#pragma unroll
                    for (int bj = 0; bj < 2; ++bj) { const f32x4 v0 = acc[ai][bj][m][0], v1 = acc[ai][bj][m][1];
                        u32x4 w; w.x = cvt_pk_bf16(v0[0], v0[1]); w.y = cvt_pk_bf16(v0[2], v0[3]); w.z = cvt_pk_bf16(v1[0], v1[1]); w.w = cvt_pk_bf16(v1[2], v1[3]);
                        *(u32x4*)(rowp + bj * HALF) = w; } }
        } else {
            const int t13 = (u.pn == 13); const int col0 = (u.pn - 12) * BM + wc * 32 + 8 * fq;
#pragma unroll
            for (int ai = 0; ai < 2; ++ai)
#pragma unroll
                for (int m = 0; m < 4; ++m) { bf16_t* rowp = L + (size_t)(row0 + ai * HALF + m * 16) * 384 + col0;
#pragma unroll
                    for (int bj = 0; bj < 2; ++bj) { if (t13 && bj == 1) continue;
                        float o[8];
#pragma unroll
                        for (int n = 0; n < 2; ++n)
#pragma unroll
                            for (int j = 0; j < 4; ++j) { const float a = acc[ai][bj][m][n][j]; o[n * 4 + j] = t13 ? fast_sigmoid(a) : (bj == 0 ? fast_tanh(a) : a); }
                        u32x4 w; w.x = cvt_pk_bf16(o[0], o[1]); w.y = cvt_pk_bf16(o[2], o[3]); w.z = cvt_pk_bf16(o[4], o[5]); w.w = cvt_pk_bf16(o[6], o[7]);
                        *(u32x4*)(rowp + bj * HALF) = w; } }
        }
    }
};

struct EpiAll {
    static constexpr bool PERM = true, AFTER_DRAIN = false;
    int kind; bf16_t* O; int ldc; bf16_t* L; bf16_t* O2;
    __device__ __forceinline__ void operator()(const f32x4 (&acc)[2][2][4][2], const Unit& u, int wr, int wc, int fr, int fq) const {
        if (kind == 0) { EpiStore e{u.part == 2 ? O2 : O, ldc}; e(acc, u, wr, wc, fr, fq); }
        else if (kind == 1) { EpiSwiglu e{O, ldc}; e(acc, u, wr, wc, fr, fq); }
        else if (kind == 2) { EpiRkv e{O, (size_t)24576 * 1024, L}; e(acc, u, wr, wc, fr, fq); }
    }
};
template <class Epi, class Sched, bool STAMP = false>
__device__ __forceinline__ void gemm_phase(PG8_LAS unsigned char* lds, const Gemm g, const Sched& S, const Epi& E, unsigned long long* stamps, const int tid_in) {
    const int tid = tid_in, wid = __builtin_amdgcn_readfirstlane(tid >> 6), lane = tid & 63, wr = wid >> 2, wc = wid & 3, fr = lane & 15, fq = lane >> 4;
    const int K = g.K; int nt = K / BK;
    int ts_lo = 0, ts_hi = 0, nts = 0; const unsigned long long rt_entry = STAMP ? (unsigned long long)wall_clock64() : 0ull;
#define PG8_STAMP() do { if (STAMP && wid == 0 && nts < 64) { const unsigned long long _c = (unsigned long long)clock64(); \
        ts_lo = (lane == nts) ? (int)(unsigned)_c : ts_lo; ts_hi = (lane == nts) ? (int)(unsigned)(_c >> 32) : ts_hi; ++nts; } } while (0)
    PG8_STAMP();
    unsigned voffA[2], voffB[2];
#pragma unroll
    for (int i = 0; i < 2; ++i) { int R, C; stage_rc(tid * 16 + i * 8192, R, C); const int Rb = Epi::PERM ? ((R & ~31) + perm32(R & 31)) : R;
        voffA[i] = (unsigned)(R * K + C) * 2u; voffB[i] = (unsigned)(Rb * K + C) * 2u; }
    const size_t kstep = (size_t)(BK * 2);
    const size_t hstep = (size_t)HALF * K * 2;
    const size_t tstep = 2 * hstep;
    const unsigned ldsw = (unsigned)wid * 1024u;
    const int aoff = lds_byte(wr * 64 + fr, fq * 8), boff = lds_byte(wc * 32 + fr, fq * 8);
#define PG8_SA(b, h) (((b) * 2 + (h)) * HTB)
#define PG8_SB(b, h) ((4 + (b) * 2 + (h)) * HTB)
#define PG8_STAGE(bufoff, gbase, voff) do { _Pragma("unroll") for (int _i = 0; _i < 2; ++_i) \
        __builtin_amdgcn_global_load_lds((const unsigned*)((const char*)(gbase) + (voff)[_i]), (PG8_LAS unsigned*)(lds + (bufoff) + ldsw + _i * 8192), 16, 0, 0); } while (0)
#define PG8_LDA(dst, b, h) do { _Pragma("unroll") for (int m = 0; m < 4; ++m) _Pragma("unroll") for (int k = 0; k < 2; ++k) dst[m][k] = *(const PG8_LAS bf16x8*)(lds + PG8_SA(b, h) + aoff + m * 2048 + k * 1024); } while (0)
#define PG8_LDB(dst, b, h) do { _Pragma("unroll") for (int n = 0; n < 2; ++n) _Pragma("unroll") for (int k = 0; k < 2; ++k) dst[n][k] = *(const PG8_LAS bf16x8*)(lds + PG8_SB(b, h) + boff + n * 2048 + k * 1024); } while (0)
#define PG8_MMA(ai, bj, At, Bt) do { __builtin_amdgcn_s_setprio(1); _Pragma("unroll") for (int m = 0; m < 4; ++m) _Pragma("unroll") for (int n = 0; n < 2; ++n) _Pragma("unroll") for (int k = 0; k < 2; ++k) \
        acc[ai][bj][m][n] = __builtin_amdgcn_mfma_f32_16x16x32_bf16(Bt[n][k], At[m][k], acc[ai][bj][m][n], 0, 0, 0); __builtin_amdgcn_s_setprio(0); } while (0)
#define PG8_WAIT_V(n) asm volatile("s_waitcnt vmcnt(" #n ")" ::: "memory")
#define PG8_WAIT_L(n) asm volatile("s_waitcnt lgkmcnt(" #n ")" ::: "memory")
#define PG8_BAR __builtin_amdgcn_s_barrier()
#define PG8_SCHED __builtin_amdgcn_sched_barrier(0)
    Unit cur, nxt; int ui = 0;
    if (!S.next(0, cur)) return;
    f32x4 acc[2][2][4][2];
#pragma unroll
    for (int a = 0; a < 2; ++a)
#pragma unroll
        for (int b = 0; b < 2; ++b)
#pragma unroll
            for (int m = 0; m < 4; ++m)
#pragma unroll
                for (int n = 0; n < 2; ++n) acc[a][b][m][n] = (f32x4){0.f, 0.f, 0.f, 0.f};
    bf16x8 At[4][2], B0[2][2], B1[2][2];
    const char* cA = (const char*)g.A + (size_t)cur.pm * tstep + (cur.part == 2 ? (size_t)K : (size_t)0); const char* cB = (const char*)g.Bt + (size_t)cur.pn * tstep + (cur.part == 2 ? (size_t)K : (size_t)0);
    nt = cur.part ? K / (2 * BK) : K / BK;
    S.a_ready(cur);
    PG8_STAGE(PG8_SB(0, 0), cB, voffB); PG8_STAGE(PG8_SA(0, 0), cA, voffA); PG8_STAGE(PG8_SB(0, 1), cB + hstep, voffB); PG8_STAGE(PG8_SA(0, 1), cA + hstep, voffA);
    if (wr == 1) PG8_BAR;
    PG8_WAIT_V(4); PG8_BAR;
    PG8_STAGE(PG8_SB(1, 0), cB + kstep, voffB); PG8_STAGE(PG8_SA(1, 0), cA + kstep, voffA); PG8_STAGE(PG8_SB(1, 1), cB + hstep + kstep, voffB);
    PG8_WAIT_V(6); PG8_BAR;
    PG8_STAMP();
    for (;;) {
        const bool has_next = S.next(ui + 1, nxt);
        const char* nA = has_next ? (const char*)g.A + (size_t)nxt.pm * tstep + (nxt.part == 2 ? (size_t)K : (size_t)0) : cA; const char* nB = has_next ? (const char*)g.Bt + (size_t)nxt.pn * tstep + (nxt.part == 2 ? (size_t)K : (size_t)0) : cB;
        for (int t = 0; t < nt; t += 2) {
            const bool last = (t == nt - 2);
            const char* a1 = cA + (size_t)(t + 1) * kstep;
            const char* a2 = last ? nA : cA + (size_t)(t + 2) * kstep; const char* b2 = last ? nB : cB + (size_t)(t + 2) * kstep;
            const char* a3 = a2 + kstep; const char* b3 = b2 + kstep;
            if (last && has_next) S.a_ready(nxt);
            PG8_LDB(B0, 0, 0); PG8_SCHED; PG8_LDA(At, 0, 0); PG8_STAGE(PG8_SA(1, 1), a1 + hstep, voffA);
            PG8_WAIT_L(8); PG8_BAR; PG8_WAIT_L(0); PG8_MMA(0, 0, At, B0); PG8_BAR; PG8_SCHED;
            PG8_LDB(B1, 0, 1); PG8_STAGE(PG8_SB(0, 0), b2, voffB);
            PG8_BAR; PG8_WAIT_L(0); PG8_MMA(0, 1, At, B1); PG8_BAR;
            PG8_LDA(At, 0, 1); PG8_STAGE(PG8_SA(0, 0), a2, voffA);
            PG8_BAR; PG8_WAIT_L(0); PG8_MMA(1, 0, At, B0); PG8_BAR; PG8_SCHED;
            PG8_STAGE(PG8_SB(0, 1), b2 + hstep, voffB);
            PG8_WAIT_V(6); PG8_BAR; PG8_MMA(1, 1, At, B1); PG8_BAR;
            PG8_LDB(B0, 1, 0); PG8_SCHED; PG8_LDA(At, 1, 0); PG8_STAGE(PG8_SA(0, 1), a2 + hstep, voffA);
            PG8_WAIT_L(8); PG8_BAR; PG8_WAIT_L(0); PG8_MMA(0, 0, At, B0); PG8_BAR; PG8_SCHED;
            PG8_LDB(B1, 1, 1); PG8_STAGE(PG8_SB(1, 0), b3, voffB);
            PG8_BAR; PG8_WAIT_L(0); PG8_MMA(0, 1, At, B1); PG8_BAR;
            PG8_LDA(At, 1, 1); PG8_STAGE(PG8_SA(1, 0), a3, voffA);
            PG8_BAR; PG8_WAIT_L(0); PG8_MMA(1, 0, At, B0); PG8_BAR; PG8_SCHED;
            PG8_STAGE(PG8_SB(1, 1), b3 + hstep, voffB);
            PG8_WAIT_V(6); PG8_BAR; PG8_MMA(1, 1, At, B1); PG8_BAR;
        }
        PG8_STAMP();
        if constexpr (!Epi::AFTER_DRAIN) { E(acc, cur, wr, wc, fr, fq); S.done(cur); }
        PG8_STAMP();
        if (!has_next) break;
#pragma unroll
        for (int a = 0; a < 2; ++a)
#pragma unroll
            for (int b = 0; b < 2; ++b)
#pragma unroll
                for (int m = 0; m < 4; ++m)
#pragma unroll
                    for (int n = 0; n < 2; ++n) acc[a][b][m][n] = (f32x4){0.f, 0.f, 0.f, 0.f};
        cur = nxt; cA = nA; cB = nB; ++ui; nt = cur.part ? K / (2 * BK) : K / BK;
    }
    PG8_WAIT_V(0);
    if (wr == 0) PG8_BAR;
    PG8_BAR;
    if constexpr (Epi::AFTER_DRAIN) { E.fused(acc, cur, wr, wc, fr, fq, lds, wid, lane); S.done(cur); }
    PG8_STAMP();
    if (STAMP && wid == 0) { stamps[lane] = lane < nts ? (((unsigned long long)(unsigned)ts_hi << 32) | (unsigned)ts_lo) : 0ull;
        if (lane == 62) stamps[62] = rt_entry; if (lane == 63) stamps[63] = (unsigned long long)wall_clock64(); }
#undef PG8_STAMP
#undef PG8_SA
#undef PG8_SB
#undef PG8_STAGE
#undef PG8_LDA
#undef PG8_LDB
#undef PG8_MMA
#undef PG8_WAIT_V
#undef PG8_WAIT_L
#undef PG8_BAR
#undef PG8_SCHED
}
}

namespace cg = cooperative_groups;
using pg8::bf16_t; using pg8::bf16x8; using pg8::f32x4; using pg8::u32x4; using pg8::cvt_pk_bf16; using pg8::fast_sigmoid;
#define LAS __attribute__((address_space(3)))
typedef float f32x2 __attribute__((ext_vector_type(2)));
typedef unsigned u32x2 __attribute__((ext_vector_type(2)));

constexpr int D = 1024, DFF = 2816, MP = 8192, MS = 16384, MT = 24576;
constexpr int NIN = 31;
constexpr size_t R48 = (size_t)MT * 1024 * 2;
constexpr size_t OFF_A = 0, OFF_B = R48, OFF_C = 2 * R48, OFF_D = 3 * R48, OFF_E = 4 * R48;
constexpr size_t OFF_S = 5 * R48;
constexpr size_t OFF_W = OFF_S + (size_t)MT * 384 * 2;
constexpr size_t W_ELEMS = 9043968;
constexpr size_t OFF_MOD = OFF_W + W_ELEMS * 2;
constexpr size_t OFF_CBP = OFF_MOD + (size_t)9 * 2 * 9216 * 4;
constexpr size_t OFF_BAR = OFF_CBP + (size_t)2 * MT * 64 * 4;
constexpr size_t OFF_W2 = OFF_BAR + 16384;
constexpr size_t OFF_FB = OFF_W2 + W_ELEMS * 2;
constexpr size_t WS_NEED = OFF_FB + (size_t)8192 * 1024 * 2;
constexpr size_t W_W13 = 0, W_W2T = (size_t)5632 * 1024;
constexpr size_t W_BTP = 0, W_BTG = (size_t)3584 * 2048, W_WOT = W_BTG + (size_t)1024 * 384, W_W2L = W_WOT + (size_t)1024 * 1024, W_A2L = W_W2L + 131072;
constexpr float RMS_EPS = 1e-6f, GN_EPS = 64e-5f;

struct Tix { int tid, bid, gd; };
struct Params { const float* in[NIN]; float* out; unsigned char* ws; int pb, pe; };
typedef const Params __attribute__((address_space(4)))* CP;

__device__ __forceinline__ float bf2f(unsigned short b) { return __uint_as_float(((unsigned)b) << 16); }
__device__ __forceinline__ float bflo(unsigned w) { return __uint_as_float(w << 16); }
__device__ __forceinline__ float bfhi(unsigned w) { return __uint_as_float(w & 0xffff0000u); }
template <int CTRL> __device__ __forceinline__ float dpp_f(float x) { return __builtin_bit_cast(float, __builtin_amdgcn_mov_dpp(__builtin_bit_cast(int, x), CTRL, 0xf, 0xf, true)); }
__device__ __forceinline__ float row16_sum(float v) { v += dpp_f<0xB1>(v); v += dpp_f<0x4E>(v); v += dpp_f<0x141>(v); v += dpp_f<0x128>(v); return v; }
__device__ __forceinline__ float wave_sum(float v) {
    v = row16_sum(v);
    auto s1 = __builtin_amdgcn_permlane16_swap(__float_as_uint(v), __float_as_uint(v), false, false); v = __uint_as_float(s1[0]) + __uint_as_float(s1[1]);
    auto s2 = __builtin_amdgcn_permlane32_swap(__float_as_uint(v), __float_as_uint(v), false, false); v = __uint_as_float(s2[0]) + __uint_as_float(s2[1]);
    return v;
}
__device__ __forceinline__ float reduce8(float x) { x += dpp_f<0xB1>(x); x += dpp_f<0x4E>(x); x += dpp_f<0x141>(x); return x; }

struct ConvJob { const float* src; int K, N; bf16_t* dst; int dld, kofs, blk, blk_stride, row_off; const float* ksc; };
__device__ __forceinline__ void conv_job(const ConvJob j, LAS float* tile, int& rot, const Tix tx) {
    const int tid = tx.tid, G = tx.gd;
    const int tn = j.N >> 6, nt = (j.K >> 6) * tn;
    int t0 = (tx.bid - (rot % G) + G) % G;
    for (int t = t0; t < nt; t += G) {
        const int k0 = (t / tn) << 6, n0 = (t % tn) << 6;
        { const int r = tid >> 4, c4 = tid & 15;
#pragma unroll
          for (int it = 0; it < 2; ++it) { const int k = r + 32 * it; const float4 v = *(const float4*)(j.src + (size_t)(k0 + k) * j.N + n0 + 4 * c4);
              LAS float* tp = tile + k * 65 + 4 * c4; tp[0] = v.x; tp[1] = v.y; tp[2] = v.z; tp[3] = v.w; } }
        __syncthreads();
        { const int n = tid >> 3, kg = tid & 7; float v[8];
#pragma unroll
          for (int i = 0; i < 8; ++i) { v[i] = tile[(8 * kg + i) * 65 + n]; if (j.ksc) v[i] *= j.ksc[k0 + 8 * kg + i]; }
          u32x4 w; w.x = cvt_pk_bf16(v[0], v[1]); w.y = cvt_pk_bf16(v[2], v[3]); w.z = cvt_pk_bf16(v[4], v[5]); w.w = cvt_pk_bf16(v[6], v[7]);
          const int gn = n0 + n; const int drow = (gn / j.blk) * j.blk_stride + (gn % j.blk) + j.row_off;
          *(u32x4*)(j.dst + (size_t)drow * j.dld + j.kofs + k0 + 8 * kg) = w; }
        __syncthreads();
    }
    rot += nt;
}
__device__ void conv_ffn(CP p, bf16_t* W, int fi, LAS float* tile, const Tix tx) {
    int rot = 0;
    conv_job(ConvJob{p->in[10] + (size_t)fi * D * DFF, D, DFF, W + W_W13, 1024, 0, 128, 256, 0, nullptr}, tile, rot, tx);
    conv_job(ConvJob{p->in[11] + (size_t)fi * D * DFF, D, DFF, W + W_W13, 1024, 0, 128, 256, 128, nullptr}, tile, rot, tx);
    conv_job(ConvJob{p->in[12] + (size_t)fi * D * DFF, DFF, D, W + W_W2T, 2816, 0, 1024, 1024, 0, nullptr}, tile, rot, tx);
}
__device__ void conv_rwkv(CP p, bf16_t* W, LAS float* tile, const Tix tx) {
    int rot = 0;
    const float* mu = p->in[13];
    for (int half = 0; half < 2; ++half) {
        const int ko = half * 1024;
        for (int i = 0; i < 3; ++i) { const int mi = (i == 0) ? 0 : (i == 1 ? 2 : 3);
            conv_job(ConvJob{p->in[14] + (size_t)i * D * D, D, D, W + W_BTP, 2048, ko, 1024, 1024, i * 1024, half ? mu + mi * D : nullptr}, tile, rot, tx); }
        for (int d = 0; d < 2; ++d) {
            conv_job(ConvJob{p->in[16] + (size_t)d * D * 64, D, 64, W + W_BTP, 2048, ko, 64, 64, 3072 + 64 * d, half ? mu + 1 * D : nullptr}, tile, rot, tx);
            conv_job(ConvJob{p->in[19] + (size_t)d * D * 64, D, 64, W + W_BTP, 2048, ko, 64, 64, 3200 + 64 * d, half ? mu + 4 * D : nullptr}, tile, rot, tx); }
        conv_job(ConvJob{p->in[21], D, 128, W + W_BTP, 2048, ko, 128, 128, 3328, half ? mu + 5 * D : nullptr}, tile, rot, tx);
    }
    conv_job(ConvJob{p->in[22], 128, D, W + W_BTG, 384, 256, 1024, 1024, 0, nullptr}, tile, rot, tx);
    for (int idx = tx.bid * 512 + tx.tid; idx < 1024 * 32; idx += tx.gd * 512) { const int n = idx >> 5, k8 = idx & 31; *(u32x4*)(W + W_BTG + (size_t)n * 384 + 8 * k8) = (u32x4){0u, 0u, 0u, 0u}; }
    conv_job(ConvJob{p->in[28], D, D, W + W_WOT, 1024, 0, 1024, 1024, 0, nullptr}, tile, rot, tx);
    for (int d = 0; d < 2; ++d) {
        conv_job(ConvJob{p->in[17] + (size_t)d * 64 * D, 64, D, W + W_W2L + (size_t)d * 65536, 64, 0, 1024, 1024, 0, nullptr}, tile, rot, tx);
        conv_job(ConvJob{p->in[20] + (size_t)d * 64 * D, 64, D, W + W_A2L + (size_t)d * 65536, 64, 0, 1024, 1024, 0, nullptr}, tile, rot, tx); }
}
__device__ void conv_pool(CP p, bf16_t* W, const Tix tx) {
    const float* pw = p->in[29]; const float* ps = p->in[30];
    for (int idx = tx.bid * 512 + tx.tid; idx < 1024 * 128; idx += tx.gd * 512) {
        const int k8 = idx >> 10, n = idx & 1023, g = n >> 8; u32x4 w = (u32x4){0u, 0u, 0u, 0u};
        if ((k8 >> 5) == g) { const float s = ps[n]; float v[8];
#pragma unroll
            for (int i = 0; i < 8; ++i) v[i] = pw[((size_t)g * 256 + ((8 * k8 + i) & 255)) * 256 + (n & 255)] * s;
            w.x = cvt_pk_bf16(v[0], v[1]); w.y = cvt_pk_bf16(v[2], v[3]); w.z = cvt_pk_bf16(v[4], v[5]); w.w = cvt_pk_bf16(v[6], v[7]); }
        *(u32x4*)(W + (size_t)n * 1024 + 8 * k8) = w; }
}

__device__ void mod_phase(CP p, LAS float* lf, const Tix tx) {
    LAS float* sc = lf; LAS float* red = lf + 9216;
    const int tid = tx.tid;
    if (tx.bid >= 288) return;
    for (int o = tid; o < 9216; o += 512) { const int c = o >> 10, k = o & 1023; const float v = (c == 0) ? p->in[5][k] : p->in[2][(c - 1) * 1024 + k]; sc[o] = v * fast_sigmoid(v); }
    __syncthreads();
    float* mod = (float*)(p->ws + OFF_MOD);
    for (int item = tx.bid; item < 288; item += tx.gd) {
        const int i = item / 144, n0 = (item % 144) * 64, col = tid & 63, ks = tid >> 6;
        float acc[9];
#pragma unroll
        for (int c = 0; c < 9; ++c) acc[c] = 0.f;
        const float* wp = p->in[6] + ((size_t)i * 1024 + ks * 128) * 9216 + n0 + col;
#pragma unroll 8
        for (int k = 0; k < 128; ++k) { const float w = wp[(size_t)k * 9216];
#pragma unroll
            for (int c = 0; c < 9; ++c) acc[c] += sc[c * 1024 + ks * 128 + k] * w; }
#pragma unroll
        for (int c = 0; c < 9; ++c) red[(ks * 9 + c) * 64 + col] = acc[c];
        __syncthreads();
        for (int o = tid; o < 576; o += 512) { const int c = o >> 6, cl = o & 63; float s = p->in[7][i * 9216 + n0 + cl];
#pragma unroll
            for (int k2 = 0; k2 < 8; ++k2) s += red[(k2 * 9 + c) * 64 + cl];
            mod[((size_t)c * 2 + i) * 9216 + n0 + cl] = s; }
        __syncthreads();
    }
}

struct RowCfg {
    int src_input;
    int pending;
    int lg, gidx; float coef; const float* npost;
    int has_next;
    int lh, shidx, scidx; const float* npre;
    int write_x;
    int fsplit;
};
__device__ __forceinline__ const float* xrow_in(CP p, int m) { return m < MP ? p->in[0] + (size_t)m * D : p->in[1] + (size_t)(m - MP) * D; }
__device__ __forceinline__ int cond_of(int m) { return m < MP ? 0 : 1 + ((m - MP) >> 11); }
__device__ __forceinline__ void row_update(CP p, const RowCfg& c, int m, int lane, f32x4 (&x)[4]) {
    const float* xr = c.src_input ? xrow_in(p, m) : p->out + (size_t)m * D;
    const float* mod = (const float*)(p->ws + OFF_MOD);
    const int cd = cond_of(m);
#pragma unroll
    for (int q = 0; q < 4; ++q) x[q] = *(const f32x4*)(xr + 4 * lane + 256 * q);
    if (c.pending) {
        const bf16_t* fr = (const bf16_t*)(p->ws + OFF_E) + (size_t)m * D; f32x4 f[4]; float ss = 0.f;
#pragma unroll
        for (int q = 0; q < 4; ++q) { const u32x2 w = *(const u32x2*)(fr + 4 * lane + 256 * q); f[q] = (f32x4){bflo(w.x), bfhi(w.x), bflo(w.y), bfhi(w.y)}; }
        if (c.fsplit && m >= 16384) {
            const bf16_t* fr2 = (const bf16_t*)(p->ws + OFF_FB) + (size_t)(m - 16384) * D;
#pragma unroll
            for (int q = 0; q < 4; ++q) { const u32x2 w = *(const u32x2*)(fr2 + 4 * lane + 256 * q); f[q] += (f32x4){bflo(w.x), bfhi(w.x), bflo(w.y), bfhi(w.y)}; } }
#pragma unroll
        for (int q = 0; q < 4; ++q) ss += f[q][0] * f[q][0] + f[q][1] * f[q][1] + f[q][2] * f[q][2] + f[q][3] * f[q][3];
        ss = wave_sum(ss); const float rs = rsqrtf(ss * (1.0f / 1024.0f) + RMS_EPS) * c.coef;
        const float* gate = mod + ((size_t)(cd * 2 + c.lg) * 9 + c.gidx) * D;
#pragma unroll
        for (int q = 0; q < 4; ++q) { const f32x4 g = *(const f32x4*)(gate + 4 * lane + 256 * q), np = *(const f32x4*)(c.npost + 4 * lane + 256 * q); x[q] += g * (f[q] * np) * rs; }
    }
}
__device__ __forceinline__ void row_premod(CP p, const RowCfg& c, int m, int lane, const f32x4 (&x)[4], f32x4 (&h)[4]) {
    const float* mod = (const float*)(p->ws + OFF_MOD);
    const int cd = cond_of(m);
    float ss = 0.f;
#pragma unroll
    for (int q = 0; q < 4; ++q) ss += x[q][0] * x[q][0] + x[q][1] * x[q][1] + x[q][2] * x[q][2] + x[q][3] * x[q][3];
    ss = wave_sum(ss); const float rs = rsqrtf(ss * (1.0f / 1024.0f) + RMS_EPS);
    const float* sh = mod + ((size_t)(cd * 2 + c.lh) * 9 + c.shidx) * D; const float* scl = mod + ((size_t)(cd * 2 + c.lh) * 9 + c.scidx) * D;
#pragma unroll
    for (int q = 0; q < 4; ++q) { const f32x4 g = *(const f32x4*)(c.npre + 4 * lane + 256 * q), s1 = *(const f32x4*)(scl + 4 * lane + 256 * q), s0 = *(const f32x4*)(sh + 4 * lane + 256 * q);
        h[q] = (x[q] * rs * g) * (1.0f + s1) + s0; }
}
__device__ __forceinline__ void store_bf16_row(bf16_t* dst, int lane, const f32x4 (&h)[4]) {
#pragma unroll
    for (int q = 0; q < 4; ++q) { u32x2 w; w.x = cvt_pk_bf16(h[q][0], h[q][1]); w.y = cvt_pk_bf16(h[q][2], h[q][3]); *(u32x2*)(dst + 4 * lane + 256 * q) = w; }
}
__device__ void rowpass_simple(CP p, const RowCfg c, const Tix tx) {
    const int lane = tx.tid & 63, wid = tx.tid >> 6, nw = tx.gd * 8;
    bf16_t* hdst = (bf16_t*)(p->ws + OFF_A);
    for (int m = tx.bid * 8 + wid; m < MT; m += nw) {
        f32x4 x[4]; row_update(p, c, m, lane, x);
        if (c.write_x) {
#pragma unroll
            for (int q = 0; q < 4; ++q) *(f32x4*)(p->out + (size_t)m * D + 4 * lane + 256 * q) = x[q]; }
        if (c.has_next) { f32x4 h[4]; row_premod(p, c, m, lane, x, h); store_bf16_row(hdst + (size_t)m * D, lane, h); }
    }
}
__device__ void rowpass_shift(CP p, const RowCfg c, LAS float* lf, const Tix tx) {
    const int lane = tx.tid & 63, wid = tx.tid >> 6;
    bf16_t* adst = (bf16_t*)(p->ws + OFF_A);
    constexpr int RUN = 12;
    for (int run = tx.bid * 8 + wid; run < MT / RUN; run += tx.gd * 8) {
        const int m0 = run * RUN;
        f32x4 hA[4], hB[4], xB[4];
#pragma unroll
        for (int q = 0; q < 4; ++q) { hA[q] = (f32x4){0.f, 0.f, 0.f, 0.f}; hB[q] = hA[q]; xB[q] = hA[q]; }
#pragma unroll 1
        for (int j = -1; j <= RUN; ++j) {
            const int m = m0 + j;
            f32x4 xC[4], hC[4];
#pragma unroll
            for (int q = 0; q < 4; ++q) { xC[q] = (f32x4){0.f, 0.f, 0.f, 0.f}; hC[q] = xC[q]; }
            if (m >= 0 && m < MT) { row_update(p, c, m, lane, xC); row_premod(p, c, m, lane, xC, hC); }
            if (j >= 1) {
                const int mo = m - 1; const int T = mo < MP ? 256 : 2048, t = mo < MP ? (mo & 255) : ((mo - MP) & 2047);
                f32x4 hs[4];
#pragma unroll
                for (int q = 0; q < 4; ++q) { *(f32x4*)(p->out + (size_t)mo * D + 4 * lane + 256 * q) = xB[q];
                    hs[q] = (f32x4){0.f, 0.f, 0.f, 0.f};
                    if (t > 0) hs[q] += hA[q];
                    if (t < T - 1) hs[q] += hC[q];
                    hs[q] = 0.5f * hs[q] - hB[q]; }
                store_bf16_row(adst + (size_t)mo * 2048, lane, hB);
                store_bf16_row(adst + (size_t)mo * 2048 + 1024, lane, hs);
            }
#pragma unroll
            for (int q = 0; q < 4; ++q) { hA[q] = hB[q]; hB[q] = hC[q]; xB[q] = xC[q]; }
        }
    }
}
__device__ void rowpass_gn(CP p, const Tix tx) {
    const int lane = tx.tid & 63, wid = tx.tid >> 6, nw = tx.gd * 8;
    const bf16_t* yf = (const bf16_t*)(p->ws + OFF_A); const bf16_t* yb = (const bf16_t*)(p->ws + OFF_B);
    const bf16_t* gb = (const bf16_t*)(p->ws + OFF_C); const bf16_t* vb = (const bf16_t*)(p->ws + OFF_E);
    bf16_t* ob = (bf16_t*)(p->ws + OFF_D); const float* cbp = (const float*)(p->ws + OFF_CBP);
    const float* gnw = p->in[26]; const float* gnb = p->in[27];
    for (int m = tx.bid * 8 + wid; m < MT; m += nw) {
        f32x4 o[4];
#pragma unroll
        for (int q = 0; q < 4; ++q) {
            const int col = 4 * lane + 256 * q, hd = 4 * q + (lane >> 4);
            const u32x2 a = *(const u32x2*)(yf + (size_t)m * D + col), b = *(const u32x2*)(yb + (size_t)m * D + col);
            f32x4 y = (f32x4){bflo(a.x) + bflo(b.x), bfhi(a.x) + bfhi(b.x), bflo(a.y) + bflo(b.y), bfhi(a.y) + bfhi(b.y)};
            float s = y[0] + y[1] + y[2] + y[3];
            s = row16_sum(s);
            const float mean = s * (1.0f / 64.0f); const f32x4 dv = y - mean;
            float vs = dv[0] * dv[0] + dv[1] * dv[1] + dv[2] * dv[2] + dv[3] * dv[3];
            vs = row16_sum(vs);
            const float rstd = rsqrtf(vs * (1.0f / 64.0f) + GN_EPS);
            const f32x4 c0 = *(const f32x4*)(cbp + ((size_t)m * 16 + hd) * 4), c1 = *(const f32x4*)(cbp + ((size_t)(MT + m) * 16 + hd) * 4);
            const float cb = (c0[0] + c0[1] + c0[2] + c0[3]) + (c1[0] + c1[1] + c1[2] + c1[3]);
            const u32x2 vw = *(const u32x2*)(vb + (size_t)m * D + col), gw = *(const u32x2*)(gb + (size_t)m * D + col);
            const f32x4 v = (f32x4){bflo(vw.x), bfhi(vw.x), bflo(vw.y), bfhi(vw.y)}, g = (f32x4){bflo(gw.x), bfhi(gw.x), bflo(gw.y), bfhi(gw.y)};
            const f32x4 w = *(const f32x4*)(gnw + col), bb = *(const f32x4*)(gnb + col);
            o[q] = (dv * rstd * w + bb + cb * v) * g;
        }
        store_bf16_row(ob + (size_t)m * D, lane, o);
    }
}

__device__ __forceinline__ void pool_add(float (&s)[8], const u32x4 w, const float sg) {
    s[0] += sg * bflo(w.x); s[1] += sg * bfhi(w.x); s[2] += sg * bflo(w.y); s[3] += sg * bfhi(w.y); s[4] += sg * bflo(w.z); s[5] += sg * bfhi(w.z); s[6] += sg * bflo(w.w); s[7] += sg * bfhi(w.w);
}
template <int WIN> __device__ __forceinline__ void pool_blk(const bf16_t* src, const int sb, const int stride, const int L, const int a0, const int ch, const int mode,
                                                            bf16_t* dst, const int db, const bf16_t* hsrc, const int hb) {
    constexpr int HW = WIN / 2, NT = WIN + 7;
    u32x4 tap[NT];
#pragma unroll
    for (int j = 0; j < NT; ++j) { const int pp = a0 - HW + j; const int pc = min(max(pp, 0), L - 1);
        const u32x4 w = *(const u32x4*)(src + (size_t)(sb + pc * stride) * D + ch);
        tap[j] = (pp >= 0 && pp < L) ? w : (u32x4){0u, 0u, 0u, 0u}; }
    float s[8];
#pragma unroll
    for (int i = 0; i < 8; ++i) s[i] = 0.f;
#pragma unroll
    for (int j = 0; j < WIN; ++j) pool_add(s, tap[j], 1.0f);
#pragma unroll
    for (int i = 0; i < 8; ++i) {
        const int a = a0 + i;
        const float inv = __builtin_amdgcn_rcpf((float)(min(a + HW, L) - max(a - HW, 0)));
        float c8[8];
        if (mode == 1) {
#pragma unroll
            for (int k = 0; k < 8; ++k) c8[k] = 0.f; }
        else { const u32x4 cw = (mode == 0) ? tap[i + HW] : *(const u32x4*)(hsrc + (size_t)(hb + a * stride) * D + ch);
            c8[0] = bflo(cw.x); c8[1] = bfhi(cw.x); c8[2] = bflo(cw.y); c8[3] = bfhi(cw.y); c8[4] = bflo(cw.z); c8[5] = bfhi(cw.z); c8[6] = bflo(cw.w); c8[7] = bfhi(cw.w); }
        u32x4 o; o.x = cvt_pk_bf16(s[0] * inv - c8[0], s[1] * inv - c8[1]); o.y = cvt_pk_bf16(s[2] * inv - c8[2], s[3] * inv - c8[3]);
        o.z = cvt_pk_bf16(s[4] * inv - c8[4], s[5] * inv - c8[5]); o.w = cvt_pk_bf16(s[6] * inv - c8[6], s[7] * inv - c8[7]);
        *(u32x4*)(dst + (size_t)(db + a * stride) * D + ch) = o;
        if (i < 7) { pool_add(s, tap[i + WIN], 1.0f); pool_add(s, tap[i], -1.0f); }
    }
}
template <int WIN> __device__ __forceinline__ void pool_unit(CP p, const int pass, const int v, const int gi, const int lane) {
    const bf16_t* h = (const bf16_t*)(p->ws + OFF_A); bf16_t* t1 = (bf16_t*)(p->ws + OFF_B); bf16_t* dl = (bf16_t*)(p->ws + OFF_D);
    const int ch = gi * 256 + 8 * (lane & 31), sub = (lane >> 5) * 8;
    if (pass == 0) {
        if (v < 512) { const int seq = v >> 4, k = v & 15; pool_blk<WIN>(h, seq * 256, 1, 256, 16 * k + sub, ch, 0, dl, seq * 256, h, 0); }
        else { const int w = v - 512, b = w >> 7, cc = (w >> 1) & 63, k = w & 1;
            pool_blk<WIN>(h, MP + b * 2048 + cc, 64, 32, 16 * k + sub, ch, 1, t1, b * 2048 + cc, h, 0); }
    } else { const int b = v >> 7, r = (v >> 2) & 31, k = v & 3;
        pool_blk<WIN>(t1, b * 2048 + r * 64, 1, 64, 16 * k + sub, ch, 2, dl, MP + b * 2048 + r * 64, h, MP + b * 2048 + r * 64); }
}
__device__ void pool_pass(CP p, int pass, const Tix tx) {
    const int lane = tx.tid & 63, wid = tx.tid >> 6;
    const int total = (pass == 0 ? 1536 : 1024) * 4;
    for (int u = tx.bid * 8 + wid; u < total; u += tx.gd * 8) {
        const int gi = u & 3, v = u >> 2;
        if (gi == 0) pool_unit<2>(p, pass, v, 0, lane); else if (gi == 1) pool_unit<4>(p, pass, v, 1, lane);
        else if (gi == 2) pool_unit<8>(p, pass, v, 2, lane); else pool_unit<16>(p, pass, v, 3, lane);
    }
}

constexpr int SST = 324;
constexpr int SBUF = 16 * SST + 64;
template <int VAR> __device__ void scan_phase(CP p, const bf16_t* W, LAS float* lf, const Tix tx, const int skipmask) {
    const int tid = tx.tid, lane = tid & 63, wid = tid >> 6, grp = wid >> 2, q = wid & 3;
    const int l15 = lane & 15, quad = lane >> 4, rl = lane >> 3, cg8 = lane & 7, i0 = 16 * q + 2 * rl;
    const bf16_t* rb = (const bf16_t*)(p->ws + OFF_C); const bf16_t* kb = (const bf16_t*)(p->ws + OFF_D); const bf16_t* vb = (const bf16_t*)(p->ws + OFF_E);
    const bf16_t* lb = (const bf16_t*)(p->ws + OFF_S);
    bf16_t* yout = (bf16_t*)(p->ws + OFF_A);
    float* cbp = (float*)(p->ws + OFF_CBP);
    const int tch = grp == 0 ? 128 : 16, nsub = grp == 0 ? 1 : ((skipmask & 8) ? 0 : 4);
    for (int it = tx.bid; it < 256; it += tx.gd) {
        f32x2 Sa[4], Sb[4];
        bf16x8 W2f[2], A2f[2];
        LAS float* ystage = lf + 4 * SBUF + 8 * 144 + wid * 1024;
        LAS float* wcst = lf + 4 * SBUF + wid * 144;
#pragma unroll
        for (int i = 0; i < 4; ++i) { Sa[i] = (f32x2){0.f, 0.f}; Sb[i] = (f32x2){0.f, 0.f}; }
        W2f[0] = W2f[1] = A2f[0] = A2f[1] = (bf16x8){0, 0, 0, 0, 0, 0, 0, 0};
        u32x2 pr = (u32x2){0u, 0u}, pk = pr, pv = pr; u32x4 pkf0 = (u32x4){0u, 0u, 0u, 0u}, pkf1 = pkf0; bf16x8 plw0 = (bf16x8){0, 0, 0, 0, 0, 0, 0, 0}, plw1 = plw0, pla0 = plw0, pla1 = plw0;
        int mn = 0, dn = 0, hhn = 0, scn = 0, slg = 0; bool sact = false;
        for (int c = -2; c < 128; ++c) {
#pragma unroll 1
          for (int slot = 0; slot < 2; ++slot) {
            if ((slot == 0) == (grp == 1)) {
                if (sact && !(skipmask & 2)) {
                    f32x4 aw = (f32x4){0.f, 0.f, 0.f, 0.f}, aa = aw;
                    aw = __builtin_amdgcn_mfma_f32_16x16x32_bf16(W2f[0], plw0, aw, 0, 0, 0); aw = __builtin_amdgcn_mfma_f32_16x16x32_bf16(W2f[1], plw1, aw, 0, 0, 0);
                    aa = __builtin_amdgcn_mfma_f32_16x16x32_bf16(A2f[0], pla0, aa, 0, 0, 0); aa = __builtin_amdgcn_mfma_f32_16x16x32_bf16(A2f[1], pla1, aa, 0, 0, 0);
                    const f32x4 cw0 = *(const LAS f32x4*)(wcst + 4 * quad), ca0 = *(const LAS f32x4*)(wcst + 16 + 4 * quad), ckk = *(const LAS f32x4*)(wcst + 32 + 4 * quad), cka = *(const LAS f32x4*)(wcst + 48 + 4 * quad), crk = *(const LAS f32x4*)(wcst + 64 + 4 * quad);
                    f32x4 kn[4];
    #pragma unroll
                    for (int i = 0; i < 4; ++i) kn[i] = *(const LAS f32x4*)(wcst + 80 + 16 * quad + 4 * i);
                    float ssq = 0.f;
                    { const unsigned kw[8] = {pkf0.x, pkf0.y, pkf0.z, pkf0.w, pkf1.x, pkf1.y, pkf1.z, pkf1.w};
    #pragma unroll
                      for (int i = 0; i < 8; ++i) { const float a = bflo(kw[i]) * kn[i >> 1][(i & 1) * 2], b2 = bfhi(kw[i]) * kn[i >> 1][(i & 1) * 2 + 1]; ssq += a * a + b2 * b2; } }
                    { auto s1 = __builtin_amdgcn_permlane16_swap(__float_as_uint(ssq), __float_as_uint(ssq), false, false); ssq = __uint_as_float(s1[0]) + __uint_as_float(s1[1]);
                      auto s2 = __builtin_amdgcn_permlane32_swap(__float_as_uint(ssq), __float_as_uint(ssq), false, false); ssq = __uint_as_float(s2[0]) + __uint_as_float(s2[1]); }
                    const float rn = fminf(__builtin_amdgcn_rsqf(ssq), 1e12f);
                    const f32x4 r4 = (f32x4){bflo(pr.x), bfhi(pr.x), bflo(pr.y), bfhi(pr.y)}, k4 = (f32x4){bflo(pk.x), bfhi(pk.x), bflo(pk.y), bfhi(pk.y)}, v4 = (f32x4){bflo(pv.x), bfhi(pv.x), bflo(pv.y), bfhi(pv.y)};
                    f32x4 e4, E4, kk4, b4, kd4, rh4, cs4; float cbs = 0.f;
    #pragma unroll
                    for (int j = 0; j < 4; ++j) { e4[j] = 0.60653066f * fast_sigmoid(cw0[j] + aw[j]);
                        float t = e4[j];
                        t += __builtin_bit_cast(float, __builtin_amdgcn_update_dpp(0, __builtin_bit_cast(int, t), 0x111, 0xf, 0xf, true));
                        t += __builtin_bit_cast(float, __builtin_amdgcn_update_dpp(0, __builtin_bit_cast(int, t), 0x112, 0xf, 0xf, true));
                        t += __builtin_bit_cast(float, __builtin_amdgcn_update_dpp(0, __builtin_bit_cast(int, t), 0x114, 0xf, 0xf, true));
                        t += __builtin_bit_cast(float, __builtin_amdgcn_update_dpp(0, __builtin_bit_cast(int, t), 0x118, 0xf, 0xf, true));
                        E4[j] = t; }
    #pragma unroll
                    for (int j = 0; j < 4; ++j) {
                        const float a = fast_sigmoid(ca0[j] + aa[j]);
                        const float kkn = k4[j] * ckk[j] * rn, bq = kkn * a, kd = k4[j] * (1.0f + (a - 1.0f) * cka[j]);
                        cbs += r4[j] * kd * crk[j];
                        const float cs = __expf(-E4[j]), cinv = __builtin_amdgcn_rcpf(cs);
                        const float cp = __builtin_bit_cast(float, __builtin_amdgcn_update_dpp(0x3f800000, __builtin_bit_cast(int, cs), 0x111, 0xf, 0xf, false));
                        kk4[j] = kkn * cp; b4[j] = bq * cinv; kd4[j] = kd * cinv; rh4[j] = r4[j] * cs; cs4[j] = cs; }
                    LAS float* wb = lf + (slg * 2 + (scn & 1)) * SBUF;
                    LAS float* wp = wb + l15 * SST + 16 * q + 4 * quad;
                    *(LAS f32x4*)(wp) = kk4; *(LAS f32x4*)(wp + 64) = b4; *(LAS f32x4*)(wp + 128) = kd4; *(LAS f32x4*)(wp + 192) = rh4; *(LAS f32x4*)(wp + 256) = v4;
                    if (l15 == 15) *(LAS f32x4*)(wb + 16 * SST + 16 * q + 4 * quad) = cs4;
                    { auto s1 = __builtin_amdgcn_permlane16_swap(__float_as_uint(cbs), __float_as_uint(cbs), false, false); cbs = __uint_as_float(s1[0]) + __uint_as_float(s1[1]);
                      auto s2 = __builtin_amdgcn_permlane32_swap(__float_as_uint(cbs), __float_as_uint(cbs), false, false); cbs = __uint_as_float(s2[0]) + __uint_as_float(s2[1]); }
                    if (quad == 0) cbp[(((size_t)dn * MT + mn) * 16 + hhn) * 4 + q] = cbs;
                }
            }
            if (slot == 0) {
                const int cn = c + 1 + grp; const int g1len = ((skipmask & 8) ? 0 : 4) * 16;
                const int lg = (grp == 1 && cn >= g1len) ? 0 : grp;
                const int ltch = lg == 0 ? 128 : 16; const int subn = cn / ltch, ccn = cn % ltch;
                const bool actn = (cn >= 0) && (cn < 128) && (grp == 1 || cn < g1len);
                sact = actn; scn = cn; slg = lg;
                if (actn && !(skipmask & 4)) {
                    const int pid = lg == 0 ? it : 4 * it + subn; dn = pid & 1; hhn = (pid >> 1) & 15; const int b = pid >> 5;
                    const int T = lg == 0 ? 2048 : 256, mb = lg == 0 ? MP + b * 2048 : b * 256;
                    const int pos = ccn * 16 + l15; mn = mb + (dn == 0 ? pos : T - 1 - pos);
                    const int col4 = 64 * hhn + 16 * q + 4 * quad;
                    pr = *(const u32x2*)(rb + (size_t)mn * D + col4); pk = *(const u32x2*)(kb + (size_t)mn * D + col4); pv = *(const u32x2*)(vb + (size_t)mn * D + col4);
                    pkf0 = *(const u32x4*)(kb + (size_t)mn * D + 64 * hhn + 16 * quad); pkf1 = *(const u32x4*)(kb + (size_t)mn * D + 64 * hhn + 16 * quad + 8);
                    plw0 = *(const bf16x8*)(lb + (size_t)mn * 384 + dn * 64 + 8 * quad); plw1 = *(const bf16x8*)(lb + (size_t)mn * 384 + dn * 64 + 32 + 8 * quad);
                    pla0 = *(const bf16x8*)(lb + (size_t)mn * 384 + 128 + dn * 64 + 8 * quad); pla1 = *(const bf16x8*)(lb + (size_t)mn * 384 + 128 + dn * 64 + 32 + 8 * quad);
                    if (ccn == 0 || (grp == 1 && lg == 0 && cn == g1len)) {
                        const bf16_t* w2r = W + W_W2L + ((size_t)dn * 1024 + 64 * hhn + 16 * q + l15) * 64 + 8 * quad;
                        const bf16_t* a2r = W + W_A2L + ((size_t)dn * 1024 + 64 * hhn + 16 * q + l15) * 64 + 8 * quad;
                        W2f[0] = *(const bf16x8*)w2r; W2f[1] = *(const bf16x8*)(w2r + 32); A2f[0] = *(const bf16x8*)a2r; A2f[1] = *(const bf16x8*)(a2r + 32);
                        const int cw = 64 * hhn + 16 * q + l15;
                        if (lane < 16) { wcst[lane] = p->in[15][dn * D + cw]; wcst[16 + lane] = p->in[18][dn * D + cw]; wcst[32 + lane] = p->in[23][cw]; wcst[48 + lane] = p->in[24][cw]; wcst[64 + lane] = p->in[25][cw]; }
                        wcst[80 + lane] = p->in[23][64 * hhn + lane];
                    }
                }
                const int sub = c < 0 ? 0 : c / tch, cc = c < 0 ? 0 : c % tch; const bool act = (c >= 0) && (sub < nsub);
                if (act && !(skipmask & 1)) {
                    const int pid = grp == 0 ? it : 4 * it + sub; const int d = pid & 1, hh = (pid >> 1) & 15, b = pid >> 5;
                    const int T = grp == 0 ? 2048 : 256, mb = grp == 0 ? MP + b * 2048 : b * 256;
                    if (cc == 0) {
                        if (grp == 0) { const float* s0 = (d == 0 ? p->in[3] : p->in[4]) + ((size_t)(b * 16 + hh) * 64 + i0) * 64 + 8 * cg8;
                            const f32x4 a0 = *(const f32x4*)s0, a1 = *(const f32x4*)(s0 + 4), b0 = *(const f32x4*)(s0 + 64), b1 = *(const f32x4*)(s0 + 68);
                            Sa[0] = a0.lo; Sa[1] = a0.hi; Sa[2] = a1.lo; Sa[3] = a1.hi; Sb[0] = b0.lo; Sb[1] = b0.hi; Sb[2] = b1.lo; Sb[3] = b1.hi; }
                        else {
    #pragma unroll
                            for (int i = 0; i < 4; ++i) { Sa[i] = (f32x2){0.f, 0.f}; Sb[i] = (f32x2){0.f, 0.f}; } }
                    }
                    const LAS float* bp0 = lf + (grp * 2 + (c & 1)) * SBUF;
                    bf16_t* yo = yout + (size_t)d * MT * D + 64 * hh + i0;
                    f32x4 nk0, nk1, nb0, nb1, nd0, nd1; f32x2 nv; f32x2 rp[4];
    #define SCAN_LOAD_K(s_) do { const LAS float* bp_ = bp0 + (s_) * SST + 8 * cg8; nk0 = *(const LAS f32x4*)(bp_); nk1 = *(const LAS f32x4*)(bp_ + 4); } while (0)
    #define SCAN_LOAD_R(s_) do { const LAS float* bp_ = bp0 + (s_) * SST + 8 * cg8; const f32x4 r0_ = *(const LAS f32x4*)(bp_ + 192), r1_ = *(const LAS f32x4*)(bp_ + 196); rp[0] = r0_.lo; rp[1] = r0_.hi; rp[2] = r1_.lo; rp[3] = r1_.hi; } while (0)
    #define SCAN_LOAD_B(s_) do { const LAS float* bp_ = bp0 + (s_) * SST + 8 * cg8; nb0 = *(const LAS f32x4*)(bp_ + 64); nb1 = *(const LAS f32x4*)(bp_ + 68); \
                        nd0 = *(const LAS f32x4*)(bp_ + 128); nd1 = *(const LAS f32x4*)(bp_ + 132); nv = *(const LAS f32x2*)(bp0 + (s_) * SST + 256 + i0); } while (0)
                    SCAN_LOAD_K(0); SCAN_LOAD_B(0);
    #pragma unroll
                    for (int i = 0; i < 4; ++i) rp[i] = (f32x2){0.f, 0.f};
    #define SCAN_YFLUSH(b_) do { const LAS float* ys_ = ystage + cg8 * 128 + 16 * rl; const f32x4 q0_ = *(const LAS f32x4*)(ys_), q1_ = *(const LAS f32x4*)(ys_ + 4), q2_ = *(const LAS f32x4*)(ys_ + 8), q3_ = *(const LAS f32x4*)(ys_ + 12); \
                        const float ye_ = ((q0_[0] + q0_[2]) + (q1_[0] + q1_[2])) + ((q2_[0] + q2_[2]) + (q3_[0] + q3_[2])), yo_ = ((q0_[1] + q0_[3]) + (q1_[1] + q1_[3])) + ((q2_[1] + q2_[3]) + (q3_[1] + q3_[3])); \
                        const int pos_ = cc * 16 + 8 * (b_) + cg8; const int m_ = mb + (d == 0 ? pos_ : T - 1 - pos_); *(unsigned*)(yo + (size_t)m_ * D) = cvt_pk_bf16(ye_, yo_); } while (0)
    #pragma unroll
                    for (int s = 0; s < 16; ++s) {
                        const f32x2 kk[4] = {nk0.lo, nk0.hi, nk1.lo, nk1.hi};
                        f32x2 pa = Sa[0] * kk[0], pb = Sb[0] * kk[0], ya = Sa[0] * rp[0], yb = Sb[0] * rp[0];
    #pragma unroll
                        for (int i = 1; i < 4; ++i) { pa = Sa[i] * kk[i] + pa; pb = Sb[i] * kk[i] + pb; ya = Sa[i] * rp[i] + ya; yb = Sb[i] * rp[i] + yb; }
                        if (s < 15 && !(VAR & 2)) SCAN_LOAD_K(s + 1);
                        if (!(VAR & 2)) SCAN_LOAD_R(s);
                        float sa0 = pa.x + pa.y, sa1 = pb.x + pb.y;
                        if (s > 0) *(LAS f32x2*)(ystage + ((s - 1) & 7) * 128 + 2 * lane) = (f32x2){ya.x + ya.y, yb.x + yb.y};
                        sa0 += dpp_f<0xB1>(sa0); sa1 += dpp_f<0xB1>(sa1);
                        sa0 += dpp_f<0x4E>(sa0); sa1 += dpp_f<0x4E>(sa1);
                        sa0 += dpp_f<0x141>(sa0); sa1 += dpp_f<0x141>(sa1);
                        const f32x2 bb[4] = {nb0.lo, nb0.hi, nb1.lo, nb1.hi}, dd[4] = {nd0.lo, nd0.hi, nd1.lo, nd1.hi};
                        const f32x2 n0 = (f32x2){-sa0, -sa0}, n1 = (f32x2){-sa1, -sa1}, v0 = (f32x2){nv.x, nv.x}, v1 = (f32x2){nv.y, nv.y};
    #pragma unroll
                        for (int i = 0; i < 4; ++i) { Sa[i] = n0 * bb[i] + Sa[i]; Sb[i] = n1 * bb[i] + Sb[i]; Sa[i] = v0 * dd[i] + Sa[i]; Sb[i] = v1 * dd[i] + Sb[i]; }
                        if (s < 15 && !(VAR & 1)) SCAN_LOAD_B(s + 1);
                        if (s == 8) SCAN_YFLUSH(0);
                    }
                    {
                        f32x2 ya = Sa[0] * rp[0], yb = Sb[0] * rp[0];
    #pragma unroll
                        for (int i = 1; i < 4; ++i) { ya = Sa[i] * rp[i] + ya; yb = Sb[i] * rp[i] + yb; }
                        *(LAS f32x2*)(ystage + 7 * 128 + 2 * lane) = (f32x2){ya.x + ya.y, yb.x + yb.y};
                        const f32x4 c0 = *(const LAS f32x4*)(bp0 + 16 * SST + 8 * cg8), c1 = *(const LAS f32x4*)(bp0 + 16 * SST + 8 * cg8 + 4);
                        Sa[0] *= c0.lo; Sa[1] *= c0.hi; Sa[2] *= c1.lo; Sa[3] *= c1.hi; Sb[0] *= c0.lo; Sb[1] *= c0.hi; Sb[2] *= c1.lo; Sb[3] *= c1.hi;
                        SCAN_YFLUSH(1);
                    }
    #undef SCAN_YFLUSH
    #undef SCAN_LOAD_K
    #undef SCAN_LOAD_R
    #undef SCAN_LOAD_B
                    if (grp == 1 && cc == tch - 1) {
                        float* sf = p->out + (size_t)MT * D + (size_t)d * (32 * 16 * 4096) + ((size_t)(b * 16 + hh) * 64 + i0) * 64 + 8 * cg8;
                        *(f32x4*)sf = (f32x4){Sa[0].x, Sa[0].y, Sa[1].x, Sa[1].y}; *(f32x4*)(sf + 4) = (f32x4){Sa[2].x, Sa[2].y, Sa[3].x, Sa[3].y};
                        *(f32x4*)(sf + 64) = (f32x4){Sb[0].x, Sb[0].y, Sb[1].x, Sb[1].y}; *(f32x4*)(sf + 68) = (f32x4){Sb[2].x, Sb[2].y, Sb[3].x, Sb[3].y};
                    }
                }
            }
          }
            asm volatile("s_waitcnt lgkmcnt(0)" ::: "memory"); __builtin_amdgcn_s_barrier(); asm volatile("" ::: "memory");
        }
    }
}

#define XB_TMO      128
#define XB_XCNT(j)  (256  + 64 * (j))
#define XB_XSUB(j)  (1280 + 64 * (j))
#define XB_XGEN(j)  (2304 + 64 * (j))
#define XB_TOP      3328
#define XB_TOPGEN   3392
#define XCD_BAR_WORDS 3456
#define XB_SPIN_CAP (1u << 18)

__device__ __forceinline__ unsigned xb_ld(unsigned* p)              { return __hip_atomic_load(p, __ATOMIC_RELAXED, __HIP_MEMORY_SCOPE_AGENT); }
__device__ __forceinline__ unsigned xb_add(unsigned* p, unsigned v) { return __hip_atomic_fetch_add(p, v, __ATOMIC_RELAXED, __HIP_MEMORY_SCOPE_AGENT); }
__device__ __forceinline__ unsigned xb_xcc_id() { return (unsigned)__builtin_amdgcn_s_getreg((3 << 11) | 20) & 0xFu; }
#define XB_SPIN(cond, bar) do { unsigned _sp = 0; while (cond) { __builtin_amdgcn_s_sleep(1); \
    if ((++_sp & 255u) == 0u) { if (xb_ld(&(bar)[XB_TMO])) break; if (_sp > XB_SPIN_CAP) { atomicAdd(&(bar)[XB_TMO], 1u); break; } } } } while (0)

struct XcdBarrier {
    unsigned* bar; unsigned x;
    volatile LAS unsigned* st;
};

__device__ __forceinline__ XcdBarrier xcd_barrier_post(unsigned* bar, volatile LAS unsigned* st) {
    XcdBarrier b; b.bar = bar; b.x = xb_xcc_id(); b.st = st;
    if (threadIdx.x == 0) (void)xb_add(&bar[XB_XCNT(b.x)], 1u);
    return b;
}
__device__ __forceinline__ void xcd_barrier_complete(unsigned* bar, unsigned x, unsigned& nloc, unsigned& nx) {
    const unsigned G = gridDim.x * gridDim.y * gridDim.z;
    unsigned sum, cnt, mine, sp = 0u;
    for (;;) {
        sum = 0u; cnt = 0u; mine = 0u;
#pragma unroll
        for (unsigned j = 0; j < 16; ++j) { const unsigned c = xb_ld(&bar[XB_XCNT(j)]); sum += c; cnt += (c > 0u) ? 1u : 0u; mine = (j == x) ? c : mine; }
        if (sum == G) break;
        __builtin_amdgcn_s_sleep(1);
        if ((++sp & 255u) == 0u) { if (xb_ld(&bar[XB_TMO])) break; if (sp > XB_SPIN_CAP) { atomicAdd(&bar[XB_TMO], 1u); break; } }
    }
    nloc = mine > 0u ? mine : 1u; nx = cnt > 0u ? cnt : 1u;
}

__device__ __forceinline__ void xcd_barrier(const XcdBarrier& b) {
    asm volatile("s_waitcnt vmcnt(0)" ::: "memory");
    __syncthreads();
    if (threadIdx.x == 0) {
        unsigned* bar = b.bar;
        __builtin_amdgcn_s_waitcnt(0);
        unsigned nloc = b.st[0], nx = b.st[1];
        if (nloc == 0u) { xcd_barrier_complete(bar, b.x, nloc, nx); b.st[0] = nloc; b.st[1] = nx; }
        const unsigned old = xb_add(&bar[XB_XSUB(b.x)], 1u);
        const unsigned gen = old / nloc;
        if (old + 1u == (gen + 1u) * nloc) {
            __builtin_amdgcn_fence(__ATOMIC_RELEASE, "agent");
            asm volatile("s_waitcnt vmcnt(0)" ::: "memory");
            const unsigned og = xb_add(&bar[XB_TOP], 1u);
            const unsigned tg = og / nx;
            if (og + 1u == (tg + 1u) * nx) xb_add(&bar[XB_TOPGEN], 1u);
            else XB_SPIN(xb_ld(&bar[XB_TOPGEN]) == tg, bar);
            __builtin_amdgcn_fence(__ATOMIC_ACQUIRE, "agent");
            xb_add(&bar[XB_XGEN(b.x)], 1u);
            asm volatile("s_waitcnt vmcnt(0)" ::: "memory");
        } else {
            XB_SPIN(xb_ld(&bar[XB_XGEN(b.x)]) == gen, bar);
            __builtin_amdgcn_fence(__ATOMIC_ACQUIRE, "agent");
            asm volatile("s_waitcnt vmcnt(0)" ::: "memory");
        }
    }
    __syncthreads();
}


constexpr int NPHASE = 24;
#ifndef SPLITK
#define SPLITK 1
#endif
#ifndef ONLYMASK
#define ONLYMASK 0x1ff
#endif
#define EN(k) ((ONLYMASK >> (k)) & 1)
constexpr int LDS_BYTES = 131072 + 16;
__global__ void __launch_bounds__(512, 2) mega(Params kp) {
    extern __shared__ __attribute__((aligned(16))) unsigned char shm[];
    PG8_LAS unsigned char* lds = (PG8_LAS unsigned char*)shm;
    LAS float* lf = (LAS float*)shm;
    cg::grid_group grid = cg::this_grid();
    const int pb = kp.pb, pe = kp.pe;
    volatile LAS unsigned* xst = (volatile LAS unsigned*)(lds + 131072);
    if (threadIdx.x < 2) xst[threadIdx.x] = 0u;
    __syncthreads();
    XcdBarrier xb = xcd_barrier_post((unsigned*)(kp.ws + OFF_BAR), xst);
#ifdef PROBE_SYNC
#pragma unroll 1
    for (int i = 0; i < PROBE_SYNC; ++i) grid.sync();
#endif
#pragma unroll 1
    for (int ph = pb; ph < pe; ++ph) {
        CP p = (CP)__builtin_amdgcn_kernarg_segment_ptr();
        asm volatile("" : "+s"(p));
        Tix tx; { int t_ = threadIdx.x, b_ = blockIdx.x, g_ = gridDim.x; asm volatile("" : "+v"(t_)); asm volatile("" : "+s"(b_), "+s"(g_)); tx.tid = t_; tx.bid = b_; tx.gd = g_; }
        bf16_t* rA = (bf16_t*)(p->ws + OFF_A); bf16_t* rB = (bf16_t*)(p->ws + OFF_B); bf16_t* rC = (bf16_t*)(p->ws + OFF_C); bf16_t* rD = (bf16_t*)(p->ws + OFF_D); bf16_t* rE = (bf16_t*)(p->ws + OFF_E);
        bf16_t* rS = (bf16_t*)(p->ws + OFF_S);
        const int wsel = (ph <= 3) ? 0 : (ph <= 9) ? 1 : (ph <= 12) ? 0 : (ph <= 15) ? 1 : (ph <= 19) ? 0 : 1;
        bf16_t* W = (bf16_t*)(p->ws + (wsel ? OFF_W2 : OFF_W)); bf16_t* Wn = (bf16_t*)(p->ws + (wsel ? OFF_W : OFF_W2));
        const float* npre = p->in[8]; const float* npost = p->in[9];
        int kind = 0;
        RowCfg rc{}; int conv = -1;
        const bf16_t* gA = nullptr; const bf16_t* gB = nullptr; bf16_t* gO = nullptr; int gN = 0, gK = 0, pool_pass_id = 0;
        switch (ph) {
            case 0: kind = 0; break;
            case 1: kind = 1; rc = RowCfg{1, 0, 0, 0, 0.f, npost, 1, 0, 0, 1, npre + 0 * D, 0, SPLITK}; break;
            case 2: case 11: case 14: case 21: kind = 2; conv = (ph == 2) ? 4 : (ph == 11) ? 2 : (ph == 14) ? 5 : -1; break;
            case 3: case 12: case 15: case 22: kind = 3; gA = rB; gB = W + W_W2T; gO = rE; gN = 1024; gK = 2816; break;
            case 4: kind = 4; rc = RowCfg{1, 1, 0, 2, 0.5f, npost + 0 * D, 1, 0, 3, 4, npre + 1 * D, 1, SPLITK}; break;
            case 5: kind = 5; conv = 1; break;
            case 6: kind = 6; break;
            case 7: kind = 3; gA = rS; gB = W + W_BTG; gO = rC; gN = 1024; gK = 384; break;
            case 8: kind = 7; break;
            case 9: kind = 3; gA = rD; gB = W + W_WOT; gO = rE; gN = 1024; gK = 1024; break;
            case 10: kind = 1; rc = RowCfg{0, 1, 0, 5, 1.0f, npost + 1 * D, 1, 0, 6, 7, npre + 2 * D, 1, SPLITK}; break;
            case 13: kind = 1; rc = RowCfg{0, 1, 0, 8, 0.5f, npost + 2 * D, 1, 1, 0, 1, npre + 3 * D, 1, SPLITK}; break;
            case 16: kind = 1; rc = RowCfg{0, 1, 1, 2, 0.5f, npost + 3 * D, 1, 1, 3, 4, npre + 4 * D, 1, SPLITK}; break;
            case 17: kind = 8; pool_pass_id = 0; break;
            case 18: kind = 8; pool_pass_id = 1; break;
            case 19: kind = 3; gA = rD; gB = W; gO = rE; gN = 1024; gK = 1024; conv = 3; break;
            case 20: kind = 1; rc = RowCfg{0, 1, 1, 5, 1.0f, npost + 4 * D, 1, 1, 6, 7, npre + 5 * D, 1, SPLITK}; break;
            case 23: kind = 1; rc = RowCfg{0, 1, 1, 8, 0.5f, npost + 5 * D, 0, 0, 0, 0, npre, 1, SPLITK}; break;
            default: break;
        }
        rc.fsplit = (SPLITK && tx.gd == 256) ? 1 : 0;
#ifdef PROBE_PH
        const int reps = (ph == PROBE_PH) ? PROBE_N : 1;
#else
        const int reps = 1;
#endif
#pragma unroll 1
        for (int rep = 0; rep < reps; ++rep) {
        if (rep > 0) xcd_barrier(xb);
        asm volatile("" : "+v"(tx.tid)); asm volatile("" : "+s"(tx.bid), "+s"(tx.gd)); asm volatile("" : "+s"(p));
        if (EN(0) && kind == 0) { mod_phase(p, lf, tx); __syncthreads();
            if (tx.gd > 64) { if (tx.bid >= 32) { const Tix tv{tx.tid, tx.bid - 32, tx.gd - 32}; conv_ffn(p, W, 0, lf + 16384, tv); } }
            else conv_ffn(p, W, 0, lf + 16384, tx); }
        else if (EN(1) && kind == 1) { rowpass_simple(p, rc, tx); }
        else if (EN(4) && kind == 4) { rowpass_shift(p, rc, lf, tx); }
        else if (EN(2) && (kind == 2 || kind == 3 || kind == 5)) {
            if (kind == 2) { gA = rA; gB = W + W_W13; gO = rB; gN = 5632; gK = 1024; } else if (kind == 5) { gA = rA; gB = W + W_BTP; gO = rC; gN = 3584; gK = 2048; }
            const int bal = (SPLITK && kind == 3 && gK >= 1024 && tx.gd == 256) ? 1 : 0;
            pg8::Gemm g{gA, gB, MT, gN, gK}; pg8::FwdOrder S; S.init(MT, gN, gK, tx.gd, tx.bid, bal);
            pg8::EpiAll E{kind == 3 ? 0 : (kind == 2 ? 1 : 2), gO, kind == 2 ? DFF : 1024, rS, (bf16_t*)(p->ws + OFF_FB) - (size_t)16384 * 1024};
#ifdef PROBE_NOEPI
            if (rep + 1 < reps) E.kind = 7;
#endif
            pg8::gemm_phase<pg8::EpiAll, pg8::FwdOrder, false>(lds, g, S, E, nullptr, tx.tid);
            if (conv >= 0) { const int nunit = (MT / 256) * (gN / 256), extra = nunit % tx.gd;
                const int half = (bal || extra == 0 || extra > tx.gd / 2) ? 0 : extra; if (tx.bid >= half) { const Tix tv{tx.tid, tx.bid - half, tx.gd - half};
                if (conv < 4) conv_ffn(p, Wn, conv, lf, tv); else if (conv == 4) conv_rwkv(p, Wn, lf, tv); else conv_pool(p, Wn, tv); } } }
        else if (EN(6) && kind == 6) {
#ifdef PROBE_VAR
            if (rep + 1 < reps) scan_phase<PROBE_VAR>(p, W, lf, tx, 0); else scan_phase<0>(p, W, lf, tx, 0);
#elif defined(PROBE_MASK)
            scan_phase<0>(p, W, lf, tx, (rep + 1 < reps) ? PROBE_MASK : 0);
#else
            scan_phase<0>(p, W, lf, tx, 0);
#endif
        }
        else if (EN(7) && kind == 7) rowpass_gn(p, tx);
        else if (EN(8) && kind == 8) pool_pass(p, pool_pass_id, tx);
        }
        if (ph + 1 < pe) { if (pb > pe) grid.sync(); else xcd_barrier(xb); }
    }
}

#include <cstdio>
#ifndef USE_COOP
#define USE_COOP 1
#endif
extern "C" void kernel_launch(void* const* d_in, const int* in_sizes, int n_in, void* d_out, int out_size, void* d_ws, size_t ws_size, hipStream_t stream) {
    static int grid = 0;
    if (grid == 0) {
        if (n_in != NIN || ws_size < WS_NEED) { fprintf(stderr, "kernel_launch: n_in %d ws %zu (need %zu)\n", n_in, ws_size, (size_t)WS_NEED); grid = -1; return; }
        int dev = 0, cus = 0, per_cu = 0;
        hipGetDevice(&dev); hipDeviceGetAttribute(&cus, hipDeviceAttributeMultiprocessorCount, dev);
        if (hipFuncSetAttribute((const void*)mega, hipFuncAttributeMaxDynamicSharedMemorySize, LDS_BYTES) != hipSuccess) { fprintf(stderr, "kernel_launch: hipFuncSetAttribute failed\n"); grid = -1; return; }
        if (hipOccupancyMaxActiveBlocksPerMultiprocessor(&per_cu, (const void*)mega, 512, LDS_BYTES) != hipSuccess || per_cu < 1) { fprintf(stderr, "kernel_launch: occupancy query says %d\n", per_cu); per_cu = 1; }
        (void)hipGetLastError();
        grid = cus * 1;
        if (grid <= 0) grid = 256;
    }
    if (grid < 0) return;
    if (hipMemsetAsync((unsigned char*)d_ws + OFF_BAR, 0, 16384, stream) != hipSuccess) { fprintf(stderr, "kernel_launch: memset of the barrier words failed\n"); return; }
    Params p{};
    for (int i = 0; i < NIN; ++i) p.in[i] = (const float*)d_in[i];
    p.out = (float*)d_out; p.ws = (unsigned char*)d_ws;
#if USE_COOP
    p.pb = 0; p.pe = NPHASE;
    void* args[] = {&p};
    hipError_t e = hipLaunchCooperativeKernel((const void*)mega, dim3(grid), dim3(512), args, LDS_BYTES, stream);
    if (e != hipSuccess) fprintf(stderr, "cooperative launch failed: %s (grid %d)\n", hipGetErrorString(e), grid);
#else
    for (int ph = 0; ph < NPHASE; ++ph) { p.pb = ph; p.pe = ph + 1; hipLaunchKernelGGL(mega, dim3(grid), dim3(512), LDS_BYTES, stream, p); }
#endif
}
```

```cpp
#include <hip/hip_runtime.h>
#include <hip/hip_cooperative_groups.h>
namespace pg8 {
#define PG8_LAS __attribute__((address_space(3)))
typedef unsigned short bf16_t;
typedef short bf16x8 __attribute__((ext_vector_type(8)));
typedef float f32x4 __attribute__((ext_vector_type(4)));
typedef unsigned u32x4 __attribute__((ext_vector_type(4)));
constexpr int BM = 256, BK = 64, HALF = 128, HTB = HALF * BK * 2  , STAGE_BYTES = 8 * HTB, NXCD = 8, WGM = 8;

__host__ __device__ __forceinline__ int lds_byte(int r, int c) { const int st = (r >> 4) * 2 + (c >> 5), rr = r & 15, cc = c & 31, ob = rr * 64 + cc * 2; return st * 1024 + (ob ^ (((ob >> 9) & 1) << 5)); }
__host__ __device__ __forceinline__ void stage_rc(int b, int& R, int& C) { const int st = b / 1024, sb = b % 1024, swz = sb ^ (((sb >> 9) & 1) << 5); R = (st >> 1) * 16 + swz / 64; C = (st & 1) * 32 + (swz % 64) / 2; }
__host__ __device__ __forceinline__ int perm32(int rho) { const int n = rho >> 4, i = rho & 15; return 8 * (i >> 2) + 4 * n + (i & 3); }

struct Unit { int pm, pn, part; };
struct Gemm { const bf16_t* A; const bf16_t* Bt; int M, N, K; };

struct StaticOrder {
    int nM, nN, nwg, G, c;
    __host__ __device__ void init(int M, int N, int G_, int c_) { nM = M / BM; nN = N / BM; nwg = nM * nN; G = G_; c = c_; }
    __host__ __device__ bool next(int i, Unit& u) const {
        const long L = (long)i * G + c; if (L >= nwg) return false;
        int wgid = (int)L; { const int q = nwg / NXCD, r = nwg % NXCD, xcd = wgid % NXCD, off = wgid / NXCD; wgid = (xcd < r ? xcd * (q + 1) : r * (q + 1) + (xcd - r) * q) + off; }
        const int nig = WGM * nN, gid = wgid / nig, fm = gid * WGM, gsz = (nM - fm) < WGM ? (nM - fm) : WGM;
        u.pm = fm + ((wgid % nig) % gsz); u.pn = (wgid % nig) / gsz; u.part = 0; return true;
    }
    __device__ __forceinline__ void a_ready(const Unit&) const {}
    __device__ __forceinline__ void done(const Unit&) const {}
};
struct FwdOrder {
    StaticOrder so; int mode;
    __host__ __device__ void init(int M, int N, int K, int G_, int c_, int mode_) { so.init(M, N, G_, c_); mode = mode_; }
    __host__ __device__ bool next(int i, Unit& u) const {
        if (mode == 0) return so.next(i, u);
        if (mode == 2) { const bool ok = so.next(i, u); u.part = 3; return ok; }
        if (i >= 2) return false;
        const int w = (so.c & 7) * 32 + (so.c >> 3);
        if (i == 0) { u.pm = w >> 2; u.pn = w & 3; u.part = 0; }
        else { u.pm = 64 + (w >> 3); u.pn = (w >> 1) & 3; u.part = 1 + (w & 1); }
        return true;
    }
    __device__ __forceinline__ void a_ready(const Unit&) const {}
    __device__ __forceinline__ void done(const Unit&) const {}
};
__device__ __forceinline__ unsigned cvt_pk_bf16(float lo, float hi) { unsigned r; asm volatile("v_cvt_pk_bf16_f32 %0, %1, %2" : "=v"(r) : "v"(lo), "v"(hi)); return r; }
typedef float f32x2 __attribute__((ext_vector_type(2)));
__device__ __forceinline__ float fast_sigmoid(float x) { return __builtin_amdgcn_rcpf(1.0f + __expf(-x)); }
__device__ __forceinline__ float fast_tanh(float x) { return 1.0f - 2.0f * __builtin_amdgcn_rcpf(1.0f + __expf(2.0f * x)); }
struct EpiStore {
    static constexpr bool PERM = true, AFTER_DRAIN = false;
    bf16_t* O; int ldc;
    __device__ __forceinline__ void operator()(const f32x4 (&acc)[2][2][4][2], const Unit& u, int wr, int wc, int fr, int fq) const {
        const int row0 = u.pm * BM + wr * 64 + fr, col0 = u.pn * BM + wc * 32 + 8 * fq;
#pragma unroll
        for (int ai = 0; ai < 2; ++ai)
#pragma unroll
            for (int m = 0; m < 4; ++m) { bf16_t* rowp = O + (size_t)(row0 + ai * HALF + m * 16) * ldc + col0;
#pragma unroll
                for (int bj = 0; bj < 2; ++bj) { const f32x4 v0 = acc[ai][bj][m][0], v1 = acc[ai][bj][m][1];
                    u32x4 w; w.x = cvt_pk_bf16(v0[0], v0[1]); w.y = cvt_pk_bf16(v0[2], v0[3]); w.z = cvt_pk_bf16(v1[0], v1[1]); w.w = cvt_pk_bf16(v1[2], v1[3]);
                    *(u32x4*)(rowp + bj * HALF) = w; } }
    }
};
struct EpiSwiglu {
    static constexpr bool PERM = true, AFTER_DRAIN = false;
    bf16_t* O; int ldc;
    __device__ __forceinline__ void operator()(const f32x4 (&acc)[2][2][4][2], const Unit& u, int wr, int wc, int fr, int fq) const {
        const int row0 = u.pm * BM + wr * 64 + fr, col0 = u.pn * HALF + wc * 32 + 8 * fq;
#pragma unroll
        for (int ai = 0; ai < 2; ++ai)
#pragma unroll
            for (int m = 0; m < 4; ++m) { bf16_t* rowp = O + (size_t)(row0 + ai * HALF + m * 16) * ldc + col0;
                float o[8];
#pragma unroll
                for (int n = 0; n < 2; ++n)
#pragma unroll
                    for (int j = 0; j < 4; ++j) { const float a = acc[ai][0][m][n][j], b = acc[ai][1][m][n][j]; o[n * 4 + j] = a * fast_sigmoid(a) * b; }
                u32x4 w; w.x = cvt_pk_bf16(o[0], o[1]); w.y = cvt_pk_bf16(o[2], o[3]); w.z = cvt_pk_bf16(o[4], o[5]); w.w = cvt_pk_bf16(o[6], o[7]);
                *(u32x4*)rowp = w; }
    }
};
struct EpiRkv {
    static constexpr bool PERM = true, AFTER_DRAIN = false;
    bf16_t* O; size_t tstride; bf16_t* L;
    __device__ __forceinline__ void operator()(const f32x4 (&acc)[2][2][4][2], const Unit& u, int wr, int wc, int fr, int fq) const {
        const int row0 = u.pm * BM + wr * 64 + fr;
        if (u.pn < 12) {
            bf16_t* base = O + (size_t)(u.pn >> 2) * tstride; const int col0 = (u.pn & 3) * BM + wc * 32 + 8 * fq;
#pragma unroll
            for (int ai = 0; ai < 2; ++ai)
#pragma unroll
                for (int m = 0; m < 4; ++m) { bf16_t* rowp = base + (size_t)(row0 + ai * HALF + m * 16) * 1024 + col0;
#pragma unroll
                    for (int bj = 0; bj < 2; ++bj) { const f32x4 v0 = acc[ai][bj][m][0], v1 = acc[ai][bj][m][1];
                        u32x4 w; w.x = cvt_pk_bf16(v0[0], v0[1]); w.y = cvt_pk_bf16(v0[2], v0[3]); w.z = cvt_pk_bf16(v1[0], v1[1]); w.w = cvt_pk_bf16(v1[2], v1[3]);
                        *(u32x4*)(rowp + bj * HALF) = w; } }
        } else {
            const int t13 = (u.pn == 13); const int col0 = (u.pn - 12) * BM + wc * 32 + 8 * fq;
#pragma unroll
            for (int ai = 0; ai < 2; ++ai)
#pragma unroll
                for (int m = 0; m < 4; ++m) { bf16_t* rowp = L + (size_t)(row0 + ai * HALF + m * 16) * 384 + col0;
#pragma unroll
                    for (int bj = 0; bj < 2; ++bj) { if (t13 && bj == 1) continue;
                        float o[8];
#pragma unroll
                        for (int n = 0; n < 2; ++n)
#pragma unroll
                            for (int j = 0; j < 4; ++j) { const float a = acc[ai][bj][m][n][j]; o[n * 4 + j] = t13 ? fast_sigmoid(a) : (bj == 0 ? fast_tanh(a) : a); }
                        u32x4 w; w.x = cvt_pk_bf16(o[0], o[1]); w.y = cvt_pk_bf16(o[2], o[3]); w.z = cvt_pk_bf16(o[4], o[5]); w.w = cvt_pk_bf16(o[6], o[7]);
                        *(u32x4*)(rowp + bj * HALF) = w; } }
        }
    }
};

struct EpiAll {
    static constexpr bool PERM = true, AFTER_DRAIN = false;
    int kind; bf16_t* O; int ldc; bf16_t* L; bf16_t* O2;
    __device__ __forceinline__ void operator()(const f32x4 (&acc)[2][2][4][2], const Unit& u, int wr, int wc, int fr, int fq) const {
        if (kind == 0) { EpiStore e{u.part == 2 ? O2 : O, ldc}; e(acc, u, wr, wc, fr, fq); }
        else if (kind == 1) { EpiSwiglu e{O, ldc}; e(acc, u, wr, wc, fr, fq); }
        else if (kind == 2) { EpiRkv e{O, (size_t)24576 * 1024, L}; e(acc, u, wr, wc, fr, fq); }
    }
};
template <class Epi, class Sched, bool STAMP = false>
__device__ __forceinline__ void gemm_phase(PG8_LAS unsigned char* lds, const Gemm g, const Sched& S, const Epi& E, unsigned long long* stamps, const int tid_in) {
    const int tid = tid_in, wid = __builtin_amdgcn_readfirstlane(tid >> 6), lane = tid & 63, wr = wid >> 2, wc = wid & 3, fr = lane & 15, fq = lane >> 4;
    const int K = g.K; int nt = K / BK;
    int ts_lo = 0, ts_hi = 0, nts = 0; const unsigned long long rt_entry = STAMP ? (unsigned long long)wall_clock64() : 0ull;
#define PG8_STAMP() do { if (STAMP && wid == 0 && nts < 64) { const unsigned long long _c = (unsigned long long)clock64(); \
        ts_lo = (lane == nts) ? (int)(unsigned)_c : ts_lo; ts_hi = (lane == nts) ? (int)(unsigned)(_c >> 32) : ts_hi; ++nts; } } while (0)
    PG8_STAMP();
    unsigned voffA[2], voffB[2];
#pragma unroll
    for (int i = 0; i < 2; ++i) { int R, C; stage_rc(tid * 16 + i * 8192, R, C); const int Rb = Epi::PERM ? ((R & ~31) + perm32(R & 31)) : R;
        voffA[i] = (unsigned)(R * K + C) * 2u; voffB[i] = (unsigned)(Rb * K + C) * 2u; }
    const size_t kstep = (size_t)(BK * 2);
    const size_t hstep = (size_t)HALF * K * 2;
    const size_t tstep = 2 * hstep;
    const unsigned ldsw = (unsigned)wid * 1024u;
    const int aoff = lds_byte(wr * 64 + fr, fq * 8), boff = lds_byte(wc * 32 + fr, fq * 8);
#define PG8_SA(b, h) (((b) * 2 + (h)) * HTB)
#define PG8_SB(b, h) ((4 + (b) * 2 + (h)) * HTB)
#define PG8_STAGE(bufoff, gbase, voff) do { _Pragma("unroll") for (int _i = 0; _i < 2; ++_i) \
        __builtin_amdgcn_global_load_lds((const unsigned*)((const char*)(gbase) + (voff)[_i]), (PG8_LAS unsigned*)(lds + (bufoff) + ldsw + _i * 8192), 16, 0, 0); } while (0)
#define PG8_LDA(dst, b, h) do { _Pragma("unroll") for (int m = 0; m < 4; ++m) _Pragma("unroll") for (int k = 0; k < 2; ++k) dst[m][k] = *(const PG8_LAS bf16x8*)(lds + PG8_SA(b, h) + aoff + m * 2048 + k * 1024); } while (0)
#define PG8_LDB(dst, b, h) do { _Pragma("unroll") for (int n = 0; n < 2; ++n) _Pragma("unroll") for (int k = 0; k < 2; ++k) dst[n][k] = *(const PG8_LAS bf16x8*)(lds + PG8_SB(b, h) + boff + n * 2048 + k * 1024); } while (0)
#define PG8_MMA(ai, bj, At, Bt) do { __builtin_amdgcn_s_setprio(1); _Pragma("unroll") for (int m = 0; m < 4; ++m) _Pragma("unroll") for (int n = 0; n < 2; ++n) _Pragma("unroll") for (int k = 0; k < 2; ++k) \
        acc[ai][bj][m][n] = __builtin_amdgcn_mfma_f32_16x16x32_bf16(Bt[n][k], At[m][k], acc[ai][bj][m][n], 0, 0, 0); __builtin_amdgcn_s_setprio(0); } while (0)
#define PG8_WAIT_V(n) asm volatile("s_waitcnt vmcnt(" #n ")" ::: "memory")
#define PG8_WAIT_L(n) asm volatile("s_waitcnt lgkmcnt(" #n ")" ::: "memory")
#define PG8_BAR __builtin_amdgcn_s_barrier()
#define PG8_SCHED __builtin_amdgcn_sched_barrier(0)
    Unit cur, nxt; int ui = 0;
    if (!S.next(0, cur)) return;
    f32x4 acc[2][2][4][2];
#pragma unroll
    for (int a = 0; a < 2; ++a)
#pragma unroll
        for (int b = 0; b < 2; ++b)
#pragma unroll
            for (int m = 0; m < 4; ++m)
#pragma unroll
                for (int n = 0; n < 2; ++n) acc[a][b][m][n] = (f32x4){0.f, 0.f, 0.f, 0.f};
    bf16x8 At[4][2], B0[2][2], B1[2][2];
    const char* cA = (const char*)g.A + (size_t)cur.pm * tstep + (cur.part == 2 ? (size_t)K : cur.part == 3 ? (size_t)cur.pn * 512 : (size_t)0); const char* cB = (const char*)g.Bt + (size_t)cur.pn * tstep + (cur.part == 2 ? (size_t)K : cur.part == 3 ? (size_t)cur.pn * 512 : (size_t)0);
    nt = cur.part == 3 ? 4 : cur.part ? K / (2 * BK) : K / BK;
    S.a_ready(cur);
    PG8_STAGE(PG8_SB(0, 0), cB, voffB); PG8_STAGE(PG8_SA(0, 0), cA, voffA); PG8_STAGE(PG8_SB(0, 1), cB + hstep, voffB); PG8_STAGE(PG8_SA(0, 1), cA + hstep, voffA);
    if (wr == 1) PG8_BAR;
    PG8_WAIT_V(4); PG8_BAR;
    PG8_STAGE(PG8_SB(1, 0), cB + kstep, voffB); PG8_STAGE(PG8_SA(1, 0), cA + kstep, voffA); PG8_STAGE(PG8_SB(1, 1), cB + hstep + kstep, voffB);
    PG8_WAIT_V(6); PG8_BAR;
    PG8_STAMP();
    for (;;) {
        const bool has_next = S.next(ui + 1, nxt);
        const char* nA = has_next ? (const char*)g.A + (size_t)nxt.pm * tstep + (nxt.part == 2 ? (size_t)K : nxt.part == 3 ? (size_t)nxt.pn * 512 : (size_t)0) : cA; const char* nB = has_next ? (const char*)g.Bt + (size_t)nxt.pn * tstep + (nxt.part == 2 ? (size_t)K : nxt.part == 3 ? (size_t)nxt.pn * 512 : (size_t)0) : cB;
        for (int t = 0; t < nt; t += 2) {
            const bool last = (t == nt - 2);
            const char* a1 = cA + (size_t)(t + 1) * kstep;
            const char* a2 = last ? nA : cA + (size_t)(t + 2) * kstep; const char* b2 = last ? nB : cB + (size_t)(t + 2) * kstep;
            const char* a3 = a2 + kstep; const char* b3 = b2 + kstep;
            if (last && has_next) S.a_ready(nxt);
            PG8_LDB(B0, 0, 0); PG8_SCHED; PG8_LDA(At, 0, 0); PG8_STAGE(PG8_SA(1, 1), a1 + hstep, voffA);
            PG8_WAIT_L(8); PG8_BAR; PG8_WAIT_L(0); PG8_MMA(0, 0, At, B0); PG8_BAR; PG8_SCHED;
            PG8_LDB(B1, 0, 1); PG8_STAGE(PG8_SB(0, 0), b2, voffB);
            PG8_BAR; PG8_WAIT_L(0); PG8_MMA(0, 1, At, B1); PG8_BAR;
            PG8_LDA(At, 0, 1); PG8_STAGE(PG8_SA(0, 0), a2, voffA);
            PG8_BAR; PG8_WAIT_L(0); PG8_MMA(1, 0, At, B0); PG8_BAR; PG8_SCHED;
            PG8_STAGE(PG8_SB(0, 1), b2 + hstep, voffB);
            PG8_WAIT_V(6); PG8_BAR; PG8_MMA(1, 1, At, B1); PG8_BAR;
            PG8_LDB(B0, 1, 0); PG8_SCHED; PG8_LDA(At, 1, 0); PG8_STAGE(PG8_SA(0, 1), a2 + hstep, voffA);
            PG8_WAIT_L(8); PG8_BAR; PG8_WAIT_L(0); PG8_MMA(0, 0, At, B0); PG8_BAR; PG8_SCHED;
            PG8_LDB(B1, 1, 1); PG8_STAGE(PG8_SB(1, 0), b3, voffB);
            PG8_BAR; PG8_WAIT_L(0); PG8_MMA(0, 1, At, B1); PG8_BAR;
            PG8_LDA(At, 1, 1); PG8_STAGE(PG8_SA(1, 0), a3, voffA);
            PG8_BAR; PG8_WAIT_L(0); PG8_MMA(1, 0, At, B0); PG8_BAR; PG8_SCHED;
            PG8_STAGE(PG8_SB(1, 1), b3 + hstep, voffB);
            PG8_WAIT_V(6); PG8_BAR; PG8_MMA(1, 1, At, B1); PG8_BAR;
        }
        PG8_STAMP();
        if constexpr (!Epi::AFTER_DRAIN) { E(acc, cur, wr, wc, fr, fq); S.done(cur); }
        PG8_STAMP();
        if (!has_next) break;
#pragma unroll
        for (int a = 0; a < 2; ++a)
#pragma unroll
            for (int b = 0; b < 2; ++b)
#pragma unroll
                for (int m = 0; m < 4; ++m)
#pragma unroll
                    for (int n = 0; n < 2; ++n) acc[a][b][m][n] = (f32x4){0.f, 0.f, 0.f, 0.f};
        cur = nxt; cA = nA; cB = nB; ++ui; nt = cur.part == 3 ? 4 : cur.part ? K / (2 * BK) : K / BK;
    }
    PG8_WAIT_V(0);
    if (wr == 0) PG8_BAR;
    PG8_BAR;
    if constexpr (Epi::AFTER_DRAIN) { E.fused(acc, cur, wr, wc, fr, fq, lds, wid, lane); S.done(cur); }
    PG8_STAMP();
    if (STAMP && wid == 0) { stamps[lane] = lane < nts ? (((unsigned long long)(unsigned)ts_hi << 32) | (unsigned)ts_lo) : 0ull;
        if (lane == 62) stamps[62] = rt_entry; if (lane == 63) stamps[63] = (unsigned long long)wall_clock64(); }
#undef PG8_STAMP
#undef PG8_SA
#undef PG8_SB
#undef PG8_STAGE
#undef PG8_LDA
#undef PG8_LDB
#undef PG8_MMA
#undef PG8_WAIT_V
#undef PG8_WAIT_L
#undef PG8_BAR
#undef PG8_SCHED
}
}

namespace cg = cooperative_groups;
using pg8::bf16_t; using pg8::bf16x8; using pg8::f32x4; using pg8::u32x4; using pg8::cvt_pk_bf16; using pg8::fast_sigmoid;
#define LAS __attribute__((address_space(3)))
typedef float f32x2 __attribute__((ext_vector_type(2)));
typedef unsigned u32x2 __attribute__((ext_vector_type(2)));

constexpr int D = 1024, DFF = 2816, MP = 8192, MS = 16384, MT = 24576;
constexpr int NIN = 31;
constexpr size_t R48 = (size_t)MT * 1024 * 2;
constexpr size_t OFF_A = 0, OFF_B = R48, OFF_C = 2 * R48, OFF_D = 3 * R48, OFF_E = 4 * R48;
constexpr size_t OFF_S = 5 * R48;
constexpr size_t OFF_W = OFF_S + (size_t)MT * 384 * 2;
constexpr size_t W_ELEMS = 9043968;
constexpr size_t OFF_MOD = OFF_W + W_ELEMS * 2;
constexpr size_t OFF_CBP = OFF_MOD + (size_t)9 * 2 * 9216 * 4;
constexpr size_t OFF_BAR = OFF_CBP + (size_t)2 * MT * 64 * 4;
constexpr size_t OFF_W2 = OFF_BAR + 16384;
constexpr size_t OFF_FB = OFF_W2 + W_ELEMS * 2;
constexpr size_t WS_NEED = OFF_FB + (size_t)8192 * 1024 * 2;
constexpr size_t W_W13 = 0, W_W2T = (size_t)5632 * 1024;
constexpr size_t W_BTP = 0, W_BTG = (size_t)3584 * 2048, W_WOT = W_BTG + (size_t)1024 * 384, W_W2L = W_WOT + (size_t)1024 * 1024, W_A2L = W_W2L + 131072;
constexpr float RMS_EPS = 1e-6f, GN_EPS = 64e-5f;

struct Tix { int tid, bid, gd; };
struct Params { const float* in[NIN]; float* out; unsigned char* ws; int pb, pe; };
typedef const Params __attribute__((address_space(4)))* CP;

__device__ __forceinline__ float bf2f(unsigned short b) { return __uint_as_float(((unsigned)b) << 16); }
__device__ __forceinline__ float bflo(unsigned w) { return __uint_as_float(w << 16); }
__device__ __forceinline__ float bfhi(unsigned w) { return __uint_as_float(w & 0xffff0000u); }
template <int CTRL> __device__ __forceinline__ float dpp_f(float x) { return __builtin_bit_cast(float, __builtin_amdgcn_mov_dpp(__builtin_bit_cast(int, x), CTRL, 0xf, 0xf, true)); }
__device__ __forceinline__ float row16_sum(float v) { v += dpp_f<0xB1>(v); v += dpp_f<0x4E>(v); v += dpp_f<0x141>(v); v += dpp_f<0x128>(v); return v; }
__device__ __forceinline__ float wave_sum(float v) {
    v = row16_sum(v);
    auto s1 = __builtin_amdgcn_permlane16_swap(__float_as_uint(v), __float_as_uint(v), false, false); v = __uint_as_float(s1[0]) + __uint_as_float(s1[1]);
    auto s2 = __builtin_amdgcn_permlane32_swap(__float_as_uint(v), __float_as_uint(v), false, false); v = __uint_as_float(s2[0]) + __uint_as_float(s2[1]);
    return v;
}
__device__ __forceinline__ float reduce8(float x) { x += dpp_f<0xB1>(x); x += dpp_f<0x4E>(x); x += dpp_f<0x141>(x); return x; }

struct ConvJob { const float* src; int K, N; bf16_t* dst; int dld, kofs, blk, blk_stride, row_off; const float* ksc; };
__device__ __forceinline__ void conv_job(const ConvJob j, LAS float* tile, int& rot, const Tix tx) {
    const int tid = tx.tid, G = tx.gd;
    const int tn = j.N >> 6, nt = (j.K >> 6) * tn;
    int t0 = (tx.bid - (rot % G) + G) % G;
    for (int t = t0; t < nt; t += G) {
        const int k0 = (t / tn) << 6, n0 = (t % tn) << 6;
        { const int r = tid >> 4, c4 = tid & 15;
#pragma unroll
          for (int it = 0; it < 2; ++it) { const int k = r + 32 * it; const float4 v = *(const float4*)(j.src + (size_t)(k0 + k) * j.N + n0 + 4 * c4);
              LAS float* tp = tile + k * 65 + 4 * c4; tp[0] = v.x; tp[1] = v.y; tp[2] = v.z; tp[3] = v.w; } }
        __syncthreads();
        { const int n = tid >> 3, kg = tid & 7; float v[8];
#pragma unroll
          for (int i = 0; i < 8; ++i) { v[i] = tile[(8 * kg + i) * 65 + n]; if (j.ksc) v[i] *= j.ksc[k0 + 8 * kg + i]; }
          u32x4 w; w.x = cvt_pk_bf16(v[0], v[1]); w.y = cvt_pk_bf16(v[2], v[3]); w.z = cvt_pk_bf16(v[4], v[5]); w.w = cvt_pk_bf16(v[6], v[7]);
          const int gn = n0 + n; const int drow = (gn / j.blk) * j.blk_stride + (gn % j.blk) + j.row_off;
          *(u32x4*)(j.dst + (size_t)drow * j.dld + j.kofs + k0 + 8 * kg) = w; }
        __syncthreads();
    }
    rot += nt;
}
__device__ void conv_ffn(CP p, bf16_t* W, int fi, LAS float* tile, const Tix tx) {
    int rot = 0;
    conv_job(ConvJob{p->in[10] + (size_t)fi * D * DFF, D, DFF, W + W_W13, 1024, 0, 128, 256, 0, nullptr}, tile, rot, tx);
    conv_job(ConvJob{p->in[11] + (size_t)fi * D * DFF, D, DFF, W + W_W13, 1024, 0, 128, 256, 128, nullptr}, tile, rot, tx);
    conv_job(ConvJob{p->in[12] + (size_t)fi * D * DFF, DFF, D, W + W_W2T, 2816, 0, 1024, 1024, 0, nullptr}, tile, rot, tx);
}
__device__ void conv_rwkv(CP p, bf16_t* W, LAS float* tile, const Tix tx) {
    int rot = 0;
    const float* mu = p->in[13];
    for (int half = 0; half < 2; ++half) {
        const int ko = half * 1024;
        for (int i = 0; i < 3; ++i) { const int mi = (i == 0) ? 0 : (i == 1 ? 2 : 3);
            conv_job(ConvJob{p->in[14] + (size_t)i * D * D, D, D, W + W_BTP, 2048, ko, 1024, 1024, i * 1024, half ? mu + mi * D : nullptr}, tile, rot, tx); }
        for (int d = 0; d < 2; ++d) {
            conv_job(ConvJob{p->in[16] + (size_t)d * D * 64, D, 64, W + W_BTP, 2048, ko, 64, 64, 3072 + 64 * d, half ? mu + 1 * D : nullptr}, tile, rot, tx);
            conv_job(ConvJob{p->in[19] + (size_t)d * D * 64, D, 64, W + W_BTP, 2048, ko, 64, 64, 3200 + 64 * d, half ? mu + 4 * D : nullptr}, tile, rot, tx); }
        conv_job(ConvJob{p->in[21], D, 128, W + W_BTP, 2048, ko, 128, 128, 3328, half ? mu + 5 * D : nullptr}, tile, rot, tx);
    }
    conv_job(ConvJob{p->in[22], 128, D, W + W_BTG, 384, 256, 1024, 1024, 0, nullptr}, tile, rot, tx);
    for (int idx = tx.bid * 512 + tx.tid; idx < 1024 * 32; idx += tx.gd * 512) { const int n = idx >> 5, k8 = idx & 31; *(u32x4*)(W + W_BTG + (size_t)n * 384 + 8 * k8) = (u32x4){0u, 0u, 0u, 0u}; }
    conv_job(ConvJob{p->in[28], D, D, W + W_WOT, 1024, 0, 1024, 1024, 0, nullptr}, tile, rot, tx);
    for (int d = 0; d < 2; ++d) {
        conv_job(ConvJob{p->in[17] + (size_t)d * 64 * D, 64, D, W + W_W2L + (size_t)d * 65536, 64, 0, 1024, 1024, 0, nullptr}, tile, rot, tx);
        conv_job(ConvJob{p->in[20] + (size_t)d * 64 * D, 64, D, W + W_A2L + (size_t)d * 65536, 64, 0, 1024, 1024, 0, nullptr}, tile, rot, tx); }
}
__device__ void conv_pool(CP p, bf16_t* W, const Tix tx) {
    const float* pw = p->in[29]; const float* ps = p->in[30];
    for (int idx = tx.bid * 512 + tx.tid; idx < 1024 * 128; idx += tx.gd * 512) {
        const int k8 = idx >> 10, n = idx & 1023, g = n >> 8; u32x4 w = (u32x4){0u, 0u, 0u, 0u};
        if ((k8 >> 5) == g) { const float s = ps[n]; float v[8];
#pragma unroll
            for (int i = 0; i < 8; ++i) v[i] = pw[((size_t)g * 256 + ((8 * k8 + i) & 255)) * 256 + (n & 255)] * s;
            w.x = cvt_pk_bf16(v[0], v[1]); w.y = cvt_pk_bf16(v[2], v[3]); w.z = cvt_pk_bf16(v[4], v[5]); w.w = cvt_pk_bf16(v[6], v[7]); }
        *(u32x4*)(W + (size_t)n * 1024 + 8 * k8) = w; }
}

__device__ void mod_phase(CP p, LAS float* lf, const Tix tx) {
    LAS float* sc = lf; LAS float* red = lf + 9216;
    const int tid = tx.tid;
    if (tx.bid >= 288) return;
    for (int o = tid; o < 9216; o += 512) { const int c = o >> 10, k = o & 1023; const float v = (c == 0) ? p->in[5][k] : p->in[2][(c - 1) * 1024 + k]; sc[o] = v * fast_sigmoid(v); }
    __syncthreads();
    float* mod = (float*)(p->ws + OFF_MOD);
    for (int item = tx.bid; item < 288; item += tx.gd) {
        const int i = item / 144, n0 = (item % 144) * 64, col = tid & 63, ks = tid >> 6;
        float acc[9];
#pragma unroll
        for (int c = 0; c < 9; ++c) acc[c] = 0.f;
        const float* wp = p->in[6] + ((size_t)i * 1024 + ks * 128) * 9216 + n0 + col;
#pragma unroll 8
        for (int k = 0; k < 128; ++k) { const float w = wp[(size_t)k * 9216];
#pragma unroll
            for (int c = 0; c < 9; ++c) acc[c] += sc[c * 1024 + ks * 128 + k] * w; }
#pragma unroll
        for (int c = 0; c < 9; ++c) red[(ks * 9 + c) * 64 + col] = acc[c];
        __syncthreads();
        for (int o = tid; o < 576; o += 512) { const int c = o >> 6, cl = o & 63; float s = p->in[7][i * 9216 + n0 + cl];
#pragma unroll
            for (int k2 = 0; k2 < 8; ++k2) s += red[(k2 * 9 + c) * 64 + cl];
            mod[((size_t)c * 2 + i) * 9216 + n0 + cl] = s; }
        __syncthreads();
    }
}

struct RowCfg {
    int src_input;
    int pending;
    int lg, gidx; float coef; const float* npost;
    int has_next;
    int lh, shidx, scidx; const float* npre;
    int write_x;
    int fsplit;
};
__device__ __forceinline__ const float* xrow_in(CP p, int m) { return m < MP ? p->in[0] + (size_t)m * D : p->in[1] + (size_t)(m - MP) * D; }
__device__ __forceinline__ int cond_of(int m) { return m < MP ? 0 : 1 + ((m - MP) >> 11); }
__device__ __forceinline__ void row_update(CP p, const RowCfg& c, int m, int lane, f32x4 (&x)[4]) {
    const float* xr = c.src_input ? xrow_in(p, m) : p->out + (size_t)m * D;
    const float* mod = (const float*)(p->ws + OFF_MOD);
    const int cd = cond_of(m);
#pragma unroll
    for (int q = 0; q < 4; ++q) x[q] = *(const f32x4*)(xr + 4 * lane + 256 * q);
    if (c.pending) {
        const bf16_t* fr = (const bf16_t*)(p->ws + OFF_E) + (size_t)m * D; f32x4 f[4]; float ss = 0.f;
#pragma unroll
        for (int q = 0; q < 4; ++q) { const u32x2 w = *(const u32x2*)(fr + 4 * lane + 256 * q); f[q] = (f32x4){bflo(w.x), bfhi(w.x), bflo(w.y), bfhi(w.y)}; }
        if (c.fsplit && m >= 16384) {
            const bf16_t* fr2 = (const bf16_t*)(p->ws + OFF_FB) + (size_t)(m - 16384) * D;
#pragma unroll
            for (int q = 0; q < 4; ++q) { const u32x2 w = *(const u32x2*)(fr2 + 4 * lane + 256 * q); f[q] += (f32x4){bflo(w.x), bfhi(w.x), bflo(w.y), bfhi(w.y)}; } }
#pragma unroll
        for (int q = 0; q < 4; ++q) ss += f[q][0] * f[q][0] + f[q][1] * f[q][1] + f[q][2] * f[q][2] + f[q][3] * f[q][3];
        ss = wave_sum(ss); const float rs = rsqrtf(ss * (1.0f / 1024.0f) + RMS_EPS) * c.coef;
        const float* gate = mod + ((size_t)(cd * 2 + c.lg) * 9 + c.gidx) * D;
#pragma unroll
        for (int q = 0; q < 4; ++q) { const f32x4 g = *(const f32x4*)(gate + 4 * lane + 256 * q), np = *(const f32x4*)(c.npost + 4 * lane + 256 * q); x[q] += g * (f[q] * np) * rs; }
    }
}
__device__ __forceinline__ void row_premod(CP p, const RowCfg& c, int m, int lane, const f32x4 (&x)[4], f32x4 (&h)[4]) {
    const float* mod = (const float*)(p->ws + OFF_MOD);
    const int cd = cond_of(m);
    float ss = 0.f;
#pragma unroll
    for (int q = 0; q < 4; ++q) ss += x[q][0] * x[q][0] + x[q][1] * x[q][1] + x[q][2] * x[q][2] + x[q][3] * x[q][3];
    ss = wave_sum(ss); const float rs = rsqrtf(ss * (1.0f / 1024.0f) + RMS_EPS);
    const float* sh = mod + ((size_t)(cd * 2 + c.lh) * 9 + c.shidx) * D; const float* scl = mod + ((size_t)(cd * 2 + c.lh) * 9 + c.scidx) * D;
#pragma unroll
    for (int q = 0; q < 4; ++q) { const f32x4 g = *(const f32x4*)(c.npre + 4 * lane + 256 * q), s1 = *(const f32x4*)(scl + 4 * lane + 256 * q), s0 = *(const f32x4*)(sh + 4 * lane + 256 * q);
        h[q] = (x[q] * rs * g) * (1.0f + s1) + s0; }
}
__device__ __forceinline__ void store_bf16_row(bf16_t* dst, int lane, const f32x4 (&h)[4]) {
#pragma unroll
    for (int q = 0; q < 4; ++q) { u32x2 w; w.x = cvt_pk_bf16(h[q][0], h[q][1]); w.y = cvt_pk_bf16(h[q][2], h[q][3]); *(u32x2*)(dst + 4 * lane + 256 * q) = w; }
}
__device__ void rowpass_simple(CP p, const RowCfg c, const Tix tx) {
    const int lane = tx.tid & 63, wid = tx.tid >> 6, nw = tx.gd * 8;
    bf16_t* hdst = (bf16_t*)(p->ws + OFF_A);
    for (int m = tx.bid * 8 + wid; m < MT; m += nw) {
        f32x4 x[4]; row_update(p, c, m, lane, x);
        if (c.write_x) {
#pragma unroll
            for (int q = 0; q < 4; ++q) *(f32x4*)(p->out + (size_t)m * D + 4 * lane + 256 * q) = x[q]; }
        if (c.has_next) { f32x4 h[4]; row_premod(p, c, m, lane, x, h); store_bf16_row(hdst + (size_t)m * D, lane, h); }
    }
}
__device__ void rowpass_shift(CP p, const RowCfg c, LAS float* lf, const Tix tx) {
    const int lane = tx.tid & 63, wid = tx.tid >> 6;
    bf16_t* adst = (bf16_t*)(p->ws + OFF_A);
    constexpr int RUN = 12;
    for (int run = tx.bid * 8 + wid; run < MT / RUN; run += tx.gd * 8) {
        const int m0 = run * RUN;
        f32x4 hA[4], hB[4], xB[4];
#pragma unroll
        for (int q = 0; q < 4; ++q) { hA[q] = (f32x4){0.f, 0.f, 0.f, 0.f}; hB[q] = hA[q]; xB[q] = hA[q]; }
#pragma unroll 1
        for (int j = -1; j <= RUN; ++j) {
            const int m = m0 + j;
            f32x4 xC[4], hC[4];
#pragma unroll
            for (int q = 0; q < 4; ++q) { xC[q] = (f32x4){0.f, 0.f, 0.f, 0.f}; hC[q] = xC[q]; }
            if (m >= 0 && m < MT) { row_update(p, c, m, lane, xC); row_premod(p, c, m, lane, xC, hC); }
            if (j >= 1) {
                const int mo = m - 1; const int T = mo < MP ? 256 : 2048, t = mo < MP ? (mo & 255) : ((mo - MP) & 2047);
                f32x4 hs[4];
#pragma unroll
                for (int q = 0; q < 4; ++q) { *(f32x4*)(p->out + (size_t)mo * D + 4 * lane + 256 * q) = xB[q];
                    hs[q] = (f32x4){0.f, 0.f, 0.f, 0.f};
                    if (t > 0) hs[q] += hA[q];
                    if (t < T - 1) hs[q] += hC[q];
                    hs[q] = 0.5f * hs[q] - hB[q]; }
                store_bf16_row(adst + (size_t)mo * 2048, lane, hB);
                store_bf16_row(adst + (size_t)mo * 2048 + 1024, lane, hs);
            }
#pragma unroll
            for (int q = 0; q < 4; ++q) { hA[q] = hB[q]; hB[q] = hC[q]; xB[q] = xC[q]; }
        }
    }
}
__device__ void rowpass_gn(CP p, const Tix tx) {
    const int lane = tx.tid & 63, wid = tx.tid >> 6, nw = tx.gd * 8;
    const bf16_t* yf = (const bf16_t*)(p->ws + OFF_A); const bf16_t* yb = (const bf16_t*)(p->ws + OFF_B);
    const bf16_t* gb = (const bf16_t*)(p->ws + OFF_C); const bf16_t* vb = (const bf16_t*)(p->ws + OFF_E);
    bf16_t* ob = (bf16_t*)(p->ws + OFF_D); const float* cbp = (const float*)(p->ws + OFF_CBP);
    const float* gnw = p->in[26]; const float* gnb = p->in[27];
    for (int m = tx.bid * 8 + wid; m < MT; m += nw) {
        f32x4 o[4];
#pragma unroll
        for (int q = 0; q < 4; ++q) {
            const int col = 4 * lane + 256 * q, hd = 4 * q + (lane >> 4);
            const u32x2 a = *(const u32x2*)(yf + (size_t)m * D + col), b = *(const u32x2*)(yb + (size_t)m * D + col);
            f32x4 y = (f32x4){bflo(a.x) + bflo(b.x), bfhi(a.x) + bfhi(b.x), bflo(a.y) + bflo(b.y), bfhi(a.y) + bfhi(b.y)};
            float s = y[0] + y[1] + y[2] + y[3];
            s = row16_sum(s);
            const float mean = s * (1.0f / 64.0f); const f32x4 dv = y - mean;
            float vs = dv[0] * dv[0] + dv[1] * dv[1] + dv[2] * dv[2] + dv[3] * dv[3];
            vs = row16_sum(vs);
            const float rstd = rsqrtf(vs * (1.0f / 64.0f) + GN_EPS);
            const f32x4 c0 = *(const f32x4*)(cbp + ((size_t)m * 16 + hd) * 4), c1 = *(const f32x4*)(cbp + ((size_t)(MT + m) * 16 + hd) * 4);
            const float cb = (c0[0] + c0[1] + c0[2] + c0[3]) + (c1[0] + c1[1] + c1[2] + c1[3]);
            const u32x2 vw = *(const u32x2*)(vb + (size_t)m * D + col), gw = *(const u32x2*)(gb + (size_t)m * D + col);
            const f32x4 v = (f32x4){bflo(vw.x), bfhi(vw.x), bflo(vw.y), bfhi(vw.y)}, g = (f32x4){bflo(gw.x), bfhi(gw.x), bflo(gw.y), bfhi(gw.y)};
            const f32x4 w = *(const f32x4*)(gnw + col), bb = *(const f32x4*)(gnb + col);
            o[q] = (dv * rstd * w + bb + cb * v) * g;
        }
        store_bf16_row(ob + (size_t)m * D, lane, o);
    }
}

__device__ __forceinline__ void pool_add(float (&s)[8], const u32x4 w, const float sg) {
    s[0] += sg * bflo(w.x); s[1] += sg * bfhi(w.x); s[2] += sg * bflo(w.y); s[3] += sg * bfhi(w.y); s[4] += sg * bflo(w.z); s[5] += sg * bfhi(w.z); s[6] += sg * bflo(w.w); s[7] += sg * bfhi(w.w);
}
template <int WIN> __device__ __forceinline__ void pool_blk(const bf16_t* src, const int sb, const int stride, const int L, const int a0, const int ch, const int mode,
                                                            bf16_t* dst, const int db, const bf16_t* hsrc, const int hb) {
    constexpr int HW = WIN / 2, NT = WIN + 7;
    u32x4 tap[NT];
#pragma unroll
    for (int j = 0; j < NT; ++j) { const int pp = a0 - HW + j; const int pc = min(max(pp, 0), L - 1);
        const u32x4 w = *(const u32x4*)(src + (size_t)(sb + pc * stride) * D + ch);
        tap[j] = (pp >= 0 && pp < L) ? w : (u32x4){0u, 0u, 0u, 0u}; }
    float s[8];
#pragma unroll
    for (int i = 0; i < 8; ++i) s[i] = 0.f;
#pragma unroll
    for (int j = 0; j < WIN; ++j) pool_add(s, tap[j], 1.0f);
#pragma unroll
    for (int i = 0; i < 8; ++i) {
        const int a = a0 + i;
        const float inv = __builtin_amdgcn_rcpf((float)(min(a + HW, L) - max(a - HW, 0)));
        float c8[8];
        if (mode == 1) {
#pragma unroll
            for (int k = 0; k < 8; ++k) c8[k] = 0.f; }
        else { const u32x4 cw = (mode == 0) ? tap[i + HW] : *(const u32x4*)(hsrc + (size_t)(hb + a * stride) * D + ch);
            c8[0] = bflo(cw.x); c8[1] = bfhi(cw.x); c8[2] = bflo(cw.y); c8[3] = bfhi(cw.y); c8[4] = bflo(cw.z); c8[5] = bfhi(cw.z); c8[6] = bflo(cw.w); c8[7] = bfhi(cw.w); }
        u32x4 o; o.x = cvt_pk_bf16(s[0] * inv - c8[0], s[1] * inv - c8[1]); o.y = cvt_pk_bf16(s[2] * inv - c8[2], s[3] * inv - c8[3]);
        o.z = cvt_pk_bf16(s[4] * inv - c8[4], s[5] * inv - c8[5]); o.w = cvt_pk_bf16(s[6] * inv - c8[6], s[7] * inv - c8[7]);
        *(u32x4*)(dst + (size_t)(db + a * stride) * D + ch) = o;
        if (i < 7) { pool_add(s, tap[i + WIN], 1.0f); pool_add(s, tap[i], -1.0f); }
    }
}
template <int WIN> __device__ __forceinline__ void pool_unit(CP p, const int pass, const int v, const int gi, const int lane) {
    const bf16_t* h = (const bf16_t*)(p->ws + OFF_A); bf16_t* t1 = (bf16_t*)(p->ws + OFF_B); bf16_t* dl = (bf16_t*)(p->ws + OFF_D);
    const int ch = gi * 256 + 8 * (lane & 31), sub = (lane >> 5) * 8;
    if (pass == 0) {
        if (v < 512) { const int seq = v >> 4, k = v & 15; pool_blk<WIN>(h, seq * 256, 1, 256, 16 * k + sub, ch, 0, dl, seq * 256, h, 0); }
        else { const int w = v - 512, b = w >> 7, cc = (w >> 1) & 63, k = w & 1;
            pool_blk<WIN>(h, MP + b * 2048 + cc, 64, 32, 16 * k + sub, ch, 1, t1, b * 2048 + cc, h, 0); }
    } else { const int b = v >> 7, r = (v >> 2) & 31, k = v & 3;
        pool_blk<WIN>(t1, b * 2048 + r * 64, 1, 64, 16 * k + sub, ch, 2, dl, MP + b * 2048 + r * 64, h, MP + b * 2048 + r * 64); }
}
__device__ void pool_pass(CP p, int pass, const Tix tx) {
    const int lane = tx.tid & 63, wid = tx.tid >> 6;
    const int total = (pass == 0 ? 1536 : 1024) * 4;
    for (int u = tx.bid * 8 + wid; u < total; u += tx.gd * 8) {
        const int gi = u & 3, v = u >> 2;
        if (gi == 0) pool_unit<2>(p, pass, v, 0, lane); else if (gi == 1) pool_unit<4>(p, pass, v, 1, lane);
        else if (gi == 2) pool_unit<8>(p, pass, v, 2, lane); else pool_unit<16>(p, pass, v, 3, lane);
    }
}

constexpr int SST = 324;
constexpr int SBUF = 16 * SST + 64;
template <int VAR> __device__ void scan_phase(CP p, const bf16_t* W, LAS float* lf, const Tix tx, const int skipmask) {
    const int tid = tx.tid, lane = tid & 63, wid = tid >> 6, grp = wid >> 2, q = wid & 3;
    const int l15 = lane & 15, quad = lane >> 4, rl = lane >> 3, cg8 = lane & 7, i0 = 16 * q + 2 * rl;
    const bf16_t* rb = (const bf16_t*)(p->ws + OFF_C); const bf16_t* kb = (const bf16_t*)(p->ws + OFF_D); const bf16_t* vb = (const bf16_t*)(p->ws + OFF_E);
    const bf16_t* lb = (const bf16_t*)(p->ws + OFF_S);
    bf16_t* yout = (bf16_t*)(p->ws + OFF_A);
    float* cbp = (float*)(p->ws + OFF_CBP);
    const int tch = grp == 0 ? 128 : 16, nsub = grp == 0 ? 1 : ((skipmask & 8) ? 0 : 4);
    for (int it = tx.bid; it < 256; it += tx.gd) {
        f32x2 Sa[4], Sb[4];
        bf16x8 W2f[2], A2f[2];
        LAS float* ystage = lf + 4 * SBUF + 8 * 144 + wid * 1024;
        LAS float* wcst = lf + 4 * SBUF + wid * 144;
#pragma unroll
        for (int i = 0; i < 4; ++i) { Sa[i] = (f32x2){0.f, 0.f}; Sb[i] = (f32x2){0.f, 0.f}; }
        W2f[0] = W2f[1] = A2f[0] = A2f[1] = (bf16x8){0, 0, 0, 0, 0, 0, 0, 0};
        u32x2 pr = (u32x2){0u, 0u}, pk = pr, pv = pr; u32x4 pkf0 = (u32x4){0u, 0u, 0u, 0u}, pkf1 = pkf0; bf16x8 plw0 = (bf16x8){0, 0, 0, 0, 0, 0, 0, 0}, plw1 = plw0, pla0 = plw0, pla1 = plw0;
        int mn = 0, dn = 0, hhn = 0, scn = 0, slg = 0; bool sact = false;
        for (int c = -2; c < 128; ++c) {
#pragma unroll 1
          for (int slot = 0; slot < 2; ++slot) {
            if ((slot == 0) == (grp == 1)) {
                if (sact && !(skipmask & 2)) {
                    f32x4 aw = (f32x4){0.f, 0.f, 0.f, 0.f}, aa = aw;
                    aw = __builtin_amdgcn_mfma_f32_16x16x32_bf16(W2f[0], plw0, aw, 0, 0, 0); aw = __builtin_amdgcn_mfma_f32_16x16x32_bf16(W2f[1], plw1, aw, 0, 0, 0);
                    aa = __builtin_amdgcn_mfma_f32_16x16x32_bf16(A2f[0], pla0, aa, 0, 0, 0); aa = __builtin_amdgcn_mfma_f32_16x16x32_bf16(A2f[1], pla1, aa, 0, 0, 0);
                    const f32x4 cw0 = *(const LAS f32x4*)(wcst + 4 * quad), ca0 = *(const LAS f32x4*)(wcst + 16 + 4 * quad), ckk = *(const LAS f32x4*)(wcst + 32 + 4 * quad), cka = *(const LAS f32x4*)(wcst + 48 + 4 * quad), crk = *(const LAS f32x4*)(wcst + 64 + 4 * quad);
                    f32x4 kn[4];
    #pragma unroll
                    for (int i = 0; i < 4; ++i) kn[i] = *(const LAS f32x4*)(wcst + 80 + 16 * quad + 4 * i);
                    float ssq = 0.f;
                    { const unsigned kw[8] = {pkf0.x, pkf0.y, pkf0.z, pkf0.w, pkf1.x, pkf1.y, pkf1.z, pkf1.w};
    #pragma unroll
                      for (int i = 0; i < 8; ++i) { const float a = bflo(kw[i]) * kn[i >> 1][(i & 1) * 2], b2 = bfhi(kw[i]) * kn[i >> 1][(i & 1) * 2 + 1]; ssq += a * a + b2 * b2; } }
                    { auto s1 = __builtin_amdgcn_permlane16_swap(__float_as_uint(ssq), __float_as_uint(ssq), false, false); ssq = __uint_as_float(s1[0]) + __uint_as_float(s1[1]);
                      auto s2 = __builtin_amdgcn_permlane32_swap(__float_as_uint(ssq), __float_as_uint(ssq), false, false); ssq = __uint_as_float(s2[0]) + __uint_as_float(s2[1]); }
                    const float rn = fminf(__builtin_amdgcn_rsqf(ssq), 1e12f);
                    const f32x4 r4 = (f32x4){bflo(pr.x), bfhi(pr.x), bflo(pr.y), bfhi(pr.y)}, k4 = (f32x4){bflo(pk.x), bfhi(pk.x), bflo(pk.y), bfhi(pk.y)}, v4 = (f32x4){bflo(pv.x), bfhi(pv.x), bflo(pv.y), bfhi(pv.y)};
                    f32x4 e4, E4, kk4, b4, kd4, rh4, cs4; float cbs = 0.f;
    #pragma unroll
                    for (int j = 0; j < 4; ++j) { e4[j] = 0.60653066f * fast_sigmoid(cw0[j] + aw[j]);
                        float t = e4[j];
                        t += __builtin_bit_cast(float, __builtin_amdgcn_update_dpp(0, __builtin_bit_cast(int, t), 0x111, 0xf, 0xf, true));
                        t += __builtin_bit_cast(float, __builtin_amdgcn_update_dpp(0, __builtin_bit_cast(int, t), 0x112, 0xf, 0xf, true));
                        t += __builtin_bit_cast(float, __builtin_amdgcn_update_dpp(0, __builtin_bit_cast(int, t), 0x114, 0xf, 0xf, true));
                        t += __builtin_bit_cast(float, __builtin_amdgcn_update_dpp(0, __builtin_bit_cast(int, t), 0x118, 0xf, 0xf, true));
                        E4[j] = t; }
    #pragma unroll
                    for (int j = 0; j < 4; ++j) {
                        const float a = fast_sigmoid(ca0[j] + aa[j]);
                        const float kkn = k4[j] * ckk[j] * rn, bq = kkn * a, kd = k4[j] * (1.0f + (a - 1.0f) * cka[j]);
                        cbs += r4[j] * kd * crk[j];
                        const float cs = __expf(-E4[j]), cinv = __builtin_amdgcn_rcpf(cs);
                        const float cp = __builtin_bit_cast(float, __builtin_amdgcn_update_dpp(0x3f800000, __builtin_bit_cast(int, cs), 0x111, 0xf, 0xf, false));
                        kk4[j] = kkn * cp; b4[j] = bq * cinv; kd4[j] = kd * cinv; rh4[j] = r4[j] * cs; cs4[j] = cs; }
                    LAS float* wb = lf + (slg * 2 + (scn & 1)) * SBUF;
                    LAS float* wp = wb + l15 * SST + 16 * q + 4 * quad;
                    *(LAS f32x4*)(wp) = kk4; *(LAS f32x4*)(wp + 64) = b4; *(LAS f32x4*)(wp + 128) = kd4; *(LAS f32x4*)(wp + 192) = rh4; *(LAS f32x4*)(wp + 256) = v4;
                    if (l15 == 15) *(LAS f32x4*)(wb + 16 * SST + 16 * q + 4 * quad) = cs4;
                    { auto s1 = __builtin_amdgcn_permlane16_swap(__float_as_uint(cbs), __float_as_uint(cbs), false, false); cbs = __uint_as_float(s1[0]) + __uint_as_float(s1[1]);
                      auto s2 = __builtin_amdgcn_permlane32_swap(__float_as_uint(cbs), __float_as_uint(cbs), false, false); cbs = __uint_as_float(s2[0]) + __uint_as_float(s2[1]); }
                    if (quad == 0) cbp[(((size_t)dn * MT + mn) * 16 + hhn) * 4 + q] = cbs;
                }
            }
            if (slot == 0) {
                const int cn = c + 1 + grp; const int g1len = ((skipmask & 8) ? 0 : 4) * 16;
                const int lg = (grp == 1 && cn >= g1len) ? 0 : grp;
                const int ltch = lg == 0 ? 128 : 16; const int subn = cn / ltch, ccn = cn % ltch;
                const bool actn = (cn >= 0) && (cn < 128) && (grp == 1 || cn < g1len);
                sact = actn; scn = cn; slg = lg;
                if (actn && !(skipmask & 4)) {
                    const int pid = lg == 0 ? it : 4 * it + subn; dn = pid & 1; hhn = (pid >> 1) & 15; const int b = pid >> 5;
                    const int T = lg == 0 ? 2048 : 256, mb = lg == 0 ? MP + b * 2048 : b * 256;
                    const int pos = ccn * 16 + l15; mn = mb + (dn == 0 ? pos : T - 1 - pos);
                    const int col4 = 64 * hhn + 16 * q + 4 * quad;
                    pr = *(const u32x2*)(rb + (size_t)mn * D + col4); pk = *(const u32x2*)(kb + (size_t)mn * D + col4); pv = *(const u32x2*)(vb + (size_t)mn * D + col4);
                    pkf0 = *(const u32x4*)(kb + (size_t)mn * D + 64 * hhn + 16 * quad); pkf1 = *(const u32x4*)(kb + (size_t)mn * D + 64 * hhn + 16 * quad + 8);
                    plw0 = *(const bf16x8*)(lb + (size_t)mn * 384 + dn * 64 + 8 * quad); plw1 = *(const bf16x8*)(lb + (size_t)mn * 384 + dn * 64 + 32 + 8 * quad);
                    pla0 = *(const bf16x8*)(lb + (size_t)mn * 384 + 128 + dn * 64 + 8 * quad); pla1 = *(const bf16x8*)(lb + (size_t)mn * 384 + 128 + dn * 64 + 32 + 8 * quad);
                    if (ccn == 0 || (grp == 1 && lg == 0 && cn == g1len)) {
                        const bf16_t* w2r = W + W_W2L + ((size_t)dn * 1024 + 64 * hhn + 16 * q + l15) * 64 + 8 * quad;
                        const bf16_t* a2r = W + W_A2L + ((size_t)dn * 1024 + 64 * hhn + 16 * q + l15) * 64 + 8 * quad;
                        W2f[0] = *(const bf16x8*)w2r; W2f[1] = *(const bf16x8*)(w2r + 32); A2f[0] = *(const bf16x8*)a2r; A2f[1] = *(const bf16x8*)(a2r + 32);
                        const int cw = 64 * hhn + 16 * q + l15;
                        if (lane < 16) { wcst[lane] = p->in[15][dn * D + cw]; wcst[16 + lane] = p->in[18][dn * D + cw]; wcst[32 + lane] = p->in[23][cw]; wcst[48 + lane] = p->in[24][cw]; wcst[64 + lane] = p->in[25][cw]; }
                        wcst[80 + lane] = p->in[23][64 * hhn + lane];
                    }
                }
                const int sub = c < 0 ? 0 : c / tch, cc = c < 0 ? 0 : c % tch; const bool act = (c >= 0) && (sub < nsub);
                if (act && !(skipmask & 1)) {
                    const int pid = grp == 0 ? it : 4 * it + sub; const int d = pid & 1, hh = (pid >> 1) & 15, b = pid >> 5;
                    const int T = grp == 0 ? 2048 : 256, mb = grp == 0 ? MP + b * 2048 : b * 256;
                    if (cc == 0) {
                        if (grp == 0) { const float* s0 = (d == 0 ? p->in[3] : p->in[4]) + ((size_t)(b * 16 + hh) * 64 + i0) * 64 + 8 * cg8;
                            const f32x4 a0 = *(const f32x4*)s0, a1 = *(const f32x4*)(s0 + 4), b0 = *(const f32x4*)(s0 + 64), b1 = *(const f32x4*)(s0 + 68);
                            Sa[0] = a0.lo; Sa[1] = a0.hi; Sa[2] = a1.lo; Sa[3] = a1.hi; Sb[0] = b0.lo; Sb[1] = b0.hi; Sb[2] = b1.lo; Sb[3] = b1.hi; }
                        else {
    #pragma unroll
                            for (int i = 0; i < 4; ++i) { Sa[i] = (f32x2){0.f, 0.f}; Sb[i] = (f32x2){0.f, 0.f}; } }
                    }
                    const LAS float* bp0 = lf + (grp * 2 + (c & 1)) * SBUF;
                    bf16_t* yo = yout + (size_t)d * MT * D + 64 * hh + i0;
                    f32x4 nk0, nk1, nb0, nb1, nd0, nd1; f32x2 nv; f32x2 rp[4];
    #define SCAN_LOAD_K(s_) do { const LAS float* bp_ = bp0 + (s_) * SST + 8 * cg8; nk0 = *(const LAS f32x4*)(bp_); nk1 = *(const LAS f32x4*)(bp_ + 4); } while (0)
    #define SCAN_LOAD_R(s_) do { const LAS float* bp_ = bp0 + (s_) * SST + 8 * cg8; const f32x4 r0_ = *(const LAS f32x4*)(bp_ + 192), r1_ = *(const LAS f32x4*)(bp_ + 196); rp[0] = r0_.lo; rp[1] = r0_.hi; rp[2] = r1_.lo; rp[3] = r1_.hi; } while (0)
    #define SCAN_LOAD_B(s_) do { const LAS float* bp_ = bp0 + (s_) * SST + 8 * cg8; nb0 = *(const LAS f32x4*)(bp_ + 64); nb1 = *(const LAS f32x4*)(bp_ + 68); \
                        nd0 = *(const LAS f32x4*)(bp_ + 128); nd1 = *(const LAS f32x4*)(bp_ + 132); nv = *(const LAS f32x2*)(bp0 + (s_) * SST + 256 + i0); } while (0)
                    SCAN_LOAD_K(0); SCAN_LOAD_B(0);
    #pragma unroll
                    for (int i = 0; i < 4; ++i) rp[i] = (f32x2){0.f, 0.f};
    #define SCAN_YFLUSH(b_) do { const LAS float* ys_ = ystage + cg8 * 128 + 16 * rl; const f32x4 q0_ = *(const LAS f32x4*)(ys_), q1_ = *(const LAS f32x4*)(ys_ + 4), q2_ = *(const LAS f32x4*)(ys_ + 8), q3_ = *(const LAS f32x4*)(ys_ + 12); \
                        const float ye_ = ((q0_[0] + q0_[2]) + (q1_[0] + q1_[2])) + ((q2_[0] + q2_[2]) + (q3_[0] + q3_[2])), yo_ = ((q0_[1] + q0_[3]) + (q1_[1] + q1_[3])) + ((q2_[1] + q2_[3]) + (q3_[1] + q3_[3])); \
                        const int pos_ = cc * 16 + 8 * (b_) + cg8; const int m_ = mb + (d == 0 ? pos_ : T - 1 - pos_); *(unsigned*)(yo + (size_t)m_ * D) = cvt_pk_bf16(ye_, yo_); } while (0)
    #pragma unroll
                    for (int s = 0; s < 16; ++s) {
                        const f32x2 kk[4] = {nk0.lo, nk0.hi, nk1.lo, nk1.hi};
                        f32x2 pa = Sa[0] * kk[0], pb = Sb[0] * kk[0], ya = Sa[0] * rp[0], yb = Sb[0] * rp[0];
    #pragma unroll
                        for (int i = 1; i < 4; ++i) { pa = Sa[i] * kk[i] + pa; pb = Sb[i] * kk[i] + pb; ya = Sa[i] * rp[i] + ya; yb = Sb[i] * rp[i] + yb; }
                        if (s < 15 && !(VAR & 2)) SCAN_LOAD_K(s + 1);
                        if (!(VAR & 2)) SCAN_LOAD_R(s);
                        float sa0 = pa.x + pa.y, sa1 = pb.x + pb.y;
                        if (s > 0) *(LAS f32x2*)(ystage + ((s - 1) & 7) * 128 + 2 * lane) = (f32x2){ya.x + ya.y, yb.x + yb.y};
                        sa0 += dpp_f<0xB1>(sa0); sa1 += dpp_f<0xB1>(sa1);
                        sa0 += dpp_f<0x4E>(sa0); sa1 += dpp_f<0x4E>(sa1);
                        sa0 += dpp_f<0x141>(sa0); sa1 += dpp_f<0x141>(sa1);
                        const f32x2 bb[4] = {nb0.lo, nb0.hi, nb1.lo, nb1.hi}, dd[4] = {nd0.lo, nd0.hi, nd1.lo, nd1.hi};
                        const f32x2 n0 = (f32x2){-sa0, -sa0}, n1 = (f32x2){-sa1, -sa1}, v0 = (f32x2){nv.x, nv.x}, v1 = (f32x2){nv.y, nv.y};
    #pragma unroll
                        for (int i = 0; i < 4; ++i) { Sa[i] = n0 * bb[i] + Sa[i]; Sb[i] = n1 * bb[i] + Sb[i]; Sa[i] = v0 * dd[i] + Sa[i]; Sb[i] = v1 * dd[i] + Sb[i]; }
                        if (s < 15 && !(VAR & 1)) SCAN_LOAD_B(s + 1);
                        if (s == 8) SCAN_YFLUSH(0);
                    }
                    {
                        f32x2 ya = Sa[0] * rp[0], yb = Sb[0] * rp[0];
    #pragma unroll
                        for (int i = 1; i < 4; ++i) { ya = Sa[i] * rp[i] + ya; yb = Sb[i] * rp[i] + yb; }
                        *(LAS f32x2*)(ystage + 7 * 128 + 2 * lane) = (f32x2){ya.x + ya.y, yb.x + yb.y};
                        const f32x4 c0 = *(const LAS f32x4*)(bp0 + 16 * SST + 8 * cg8), c1 = *(const LAS f32x4*)(bp0 + 16 * SST + 8 * cg8 + 4);
                        Sa[0] *= c0.lo; Sa[1] *= c0.hi; Sa[2] *= c1.lo; Sa[3] *= c1.hi; Sb[0] *= c0.lo; Sb[1] *= c0.hi; Sb[2] *= c1.lo; Sb[3] *= c1.hi;
                        SCAN_YFLUSH(1);
                    }
    #undef SCAN_YFLUSH
    #undef SCAN_LOAD_K
    #undef SCAN_LOAD_R
    #undef SCAN_LOAD_B
                    if (grp == 1 && cc == tch - 1) {
                        float* sf = p->out + (size_t)MT * D + (size_t)d * (32 * 16 * 4096) + ((size_t)(b * 16 + hh) * 64 + i0) * 64 + 8 * cg8;
                        *(f32x4*)sf = (f32x4){Sa[0].x, Sa[0].y, Sa[1].x, Sa[1].y}; *(f32x4*)(sf + 4) = (f32x4){Sa[2].x, Sa[2].y, Sa[3].x, Sa[3].y};
                        *(f32x4*)(sf + 64) = (f32x4){Sb[0].x, Sb[0].y, Sb[1].x, Sb[1].y}; *(f32x4*)(sf + 68) = (f32x4){Sb[2].x, Sb[2].y, Sb[3].x, Sb[3].y};
                    }
                }
            }
          }
            asm volatile("s_waitcnt lgkmcnt(0)" ::: "memory"); __builtin_amdgcn_s_barrier(); asm volatile("" ::: "memory");
        }
    }
}

#define XB_TMO      128
#define XB_XCNT(j)  (256  + 64 * (j))
#define XB_XSUB(j)  (1280 + 64 * (j))
#define XB_XGEN(j)  (2304 + 64 * (j))
#define XB_TOP      3328
#define XB_TOPGEN   3392
#define XCD_BAR_WORDS 3456
#define XB_SPIN_CAP (1u << 18)

__device__ __forceinline__ unsigned xb_ld(unsigned* p)              { return __hip_atomic_load(p, __ATOMIC_RELAXED, __HIP_MEMORY_SCOPE_AGENT); }
__device__ __forceinline__ unsigned xb_add(unsigned* p, unsigned v) { return __hip_atomic_fetch_add(p, v, __ATOMIC_RELAXED, __HIP_MEMORY_SCOPE_AGENT); }
__device__ __forceinline__ unsigned xb_xcc_id() { return (unsigned)__builtin_amdgcn_s_getreg((3 << 11) | 20) & 0xFu; }
#define XB_SPIN(cond, bar) do { unsigned _sp = 0; while (cond) { __builtin_amdgcn_s_sleep(1); \
    if ((++_sp & 255u) == 0u) { if (xb_ld(&(bar)[XB_TMO])) break; if (_sp > XB_SPIN_CAP) { atomicAdd(&(bar)[XB_TMO], 1u); break; } } } } while (0)

struct XcdBarrier {
    unsigned* bar; unsigned x;
    volatile LAS unsigned* st;
};

__device__ __forceinline__ XcdBarrier xcd_barrier_post(unsigned* bar, volatile LAS unsigned* st) {
    XcdBarrier b; b.bar = bar; b.x = xb_xcc_id(); b.st = st;
    if (threadIdx.x == 0) (void)xb_add(&bar[XB_XCNT(b.x)], 1u);
    return b;
}
__device__ __forceinline__ void xcd_barrier_complete(unsigned* bar, unsigned x, unsigned& nloc, unsigned& nx) {
    const unsigned G = gridDim.x * gridDim.y * gridDim.z;
    unsigned sum, cnt, mine, sp = 0u;
    for (;;) {
        sum = 0u; cnt = 0u; mine = 0u;
#pragma unroll
        for (unsigned j = 0; j < 16; ++j) { const unsigned c = xb_ld(&bar[XB_XCNT(j)]); sum += c; cnt += (c > 0u) ? 1u : 0u; mine = (j == x) ? c : mine; }
        if (sum == G) break;
        __builtin_amdgcn_s_sleep(1);
        if ((++sp & 255u) == 0u) { if (xb_ld(&bar[XB_TMO])) break; if (sp > XB_SPIN_CAP) { atomicAdd(&bar[XB_TMO], 1u); break; } }
    }
    nloc = mine > 0u ? mine : 1u; nx = cnt > 0u ? cnt : 1u;
}

__device__ __forceinline__ void xcd_barrier(const XcdBarrier& b) {
    asm volatile("s_waitcnt vmcnt(0)" ::: "memory");
    __syncthreads();
    if (threadIdx.x == 0) {
        unsigned* bar = b.bar;
        __builtin_amdgcn_s_waitcnt(0);
        unsigned nloc = b.st[0], nx = b.st[1];
        if (nloc == 0u) { xcd_barrier_complete(bar, b.x, nloc, nx); b.st[0] = nloc; b.st[1] = nx; }
        const unsigned old = xb_add(&bar[XB_XSUB(b.x)], 1u);
        const unsigned gen = old / nloc;
        if (old + 1u == (gen + 1u) * nloc) {
            __builtin_amdgcn_fence(__ATOMIC_RELEASE, "agent");
            asm volatile("s_waitcnt vmcnt(0)" ::: "memory");
            const unsigned og = xb_add(&bar[XB_TOP], 1u);
            const unsigned tg = og / nx;
            if (og + 1u == (tg + 1u) * nx) xb_add(&bar[XB_TOPGEN], 1u);
            else XB_SPIN(xb_ld(&bar[XB_TOPGEN]) == tg, bar);
            __builtin_amdgcn_fence(__ATOMIC_ACQUIRE, "agent");
            xb_add(&bar[XB_XGEN(b.x)], 1u);
            asm volatile("s_waitcnt vmcnt(0)" ::: "memory");
        } else {
            XB_SPIN(xb_ld(&bar[XB_XGEN(b.x)]) == gen, bar);
            __builtin_amdgcn_fence(__ATOMIC_ACQUIRE, "agent");
            asm volatile("s_waitcnt vmcnt(0)" ::: "memory");
        }
    }
    __syncthreads();
}


constexpr int NPHASE = 24;
#ifndef SPLITK
#define SPLITK 1
#endif
#ifndef ONLYMASK
#define ONLYMASK 0x1ff
#endif
#define EN(k) ((ONLYMASK >> (k)) & 1)
constexpr int LDS_BYTES = 131072 + 16;
__global__ void __launch_bounds__(512, 2) mega(Params kp) {
    extern __shared__ __attribute__((aligned(16))) unsigned char shm[];
    PG8_LAS unsigned char* lds = (PG8_LAS unsigned char*)shm;
    LAS float* lf = (LAS float*)shm;
    cg::grid_group grid = cg::this_grid();
    const int pb = kp.pb, pe = kp.pe;
    volatile LAS unsigned* xst = (volatile LAS unsigned*)(lds + 131072);
    if (threadIdx.x < 2) xst[threadIdx.x] = 0u;
    __syncthreads();
    XcdBarrier xb = xcd_barrier_post((unsigned*)(kp.ws + OFF_BAR), xst);
#ifdef PROBE_SYNC
#pragma unroll 1
    for (int i = 0; i < PROBE_SYNC; ++i) grid.sync();
#endif
#pragma unroll 1
    for (int ph = pb; ph < pe; ++ph) {
        CP p = (CP)__builtin_amdgcn_kernarg_segment_ptr();
        asm volatile("" : "+s"(p));
        Tix tx; { int t_ = threadIdx.x, b_ = blockIdx.x, g_ = gridDim.x; asm volatile("" : "+v"(t_)); asm volatile("" : "+s"(b_), "+s"(g_)); tx.tid = t_; tx.bid = b_; tx.gd = g_; }
        bf16_t* rA = (bf16_t*)(p->ws + OFF_A); bf16_t* rB = (bf16_t*)(p->ws + OFF_B); bf16_t* rC = (bf16_t*)(p->ws + OFF_C); bf16_t* rD = (bf16_t*)(p->ws + OFF_D); bf16_t* rE = (bf16_t*)(p->ws + OFF_E);
        bf16_t* rS = (bf16_t*)(p->ws + OFF_S);
        const int wsel = (ph <= 3) ? 0 : (ph <= 9) ? 1 : (ph <= 12) ? 0 : (ph <= 15) ? 1 : (ph <= 19) ? 0 : 1;
        bf16_t* W = (bf16_t*)(p->ws + (wsel ? OFF_W2 : OFF_W)); bf16_t* Wn = (bf16_t*)(p->ws + (wsel ? OFF_W : OFF_W2));
        const float* npre = p->in[8]; const float* npost = p->in[9];
        int kind = 0;
        RowCfg rc{}; int conv = -1;
        const bf16_t* gA = nullptr; const bf16_t* gB = nullptr; bf16_t* gO = nullptr; int gN = 0, gK = 0, pool_pass_id = 0;
        switch (ph) {
            case 0: kind = 0; break;
            case 1: kind = 1; rc = RowCfg{1, 0, 0, 0, 0.f, npost, 1, 0, 0, 1, npre + 0 * D, 0, SPLITK}; break;
            case 2: case 11: case 14: case 21: kind = 2; conv = (ph == 2) ? 4 : (ph == 11) ? 2 : (ph == 14) ? 5 : -1; break;
            case 3: case 12: case 15: case 22: kind = 3; gA = rB; gB = W + W_W2T; gO = rE; gN = 1024; gK = 2816; break;
            case 4: kind = 4; rc = RowCfg{1, 1, 0, 2, 0.5f, npost + 0 * D, 1, 0, 3, 4, npre + 1 * D, 1, SPLITK}; break;
            case 5: kind = 5; conv = 1; break;
            case 6: kind = 6; break;
            case 7: kind = 3; gA = rS; gB = W + W_BTG; gO = rC; gN = 1024; gK = 384; break;
            case 8: kind = 7; break;
            case 9: kind = 3; gA = rD; gB = W + W_WOT; gO = rE; gN = 1024; gK = 1024; break;
            case 10: kind = 1; rc = RowCfg{0, 1, 0, 5, 1.0f, npost + 1 * D, 1, 0, 6, 7, npre + 2 * D, 1, SPLITK}; break;
            case 13: kind = 1; rc = RowCfg{0, 1, 0, 8, 0.5f, npost + 2 * D, 1, 1, 0, 1, npre + 3 * D, 1, SPLITK}; break;
            case 16: kind = 1; rc = RowCfg{0, 1, 1, 2, 0.5f, npost + 3 * D, 1, 1, 3, 4, npre + 4 * D, 1, SPLITK}; break;
            case 17: kind = 8; pool_pass_id = 0; break;
            case 18: kind = 8; pool_pass_id = 1; break;
            case 19: kind = 3; gA = rD; gB = W; gO = rE; gN = 1024; gK = 1024; conv = 3; break;
            case 20: kind = 1; rc = RowCfg{0, 1, 1, 5, 1.0f, npost + 4 * D, 1, 1, 6, 7, npre + 5 * D, 1, SPLITK}; break;
            case 23: kind = 1; rc = RowCfg{0, 1, 1, 8, 0.5f, npost + 5 * D, 0, 0, 0, 0, npre, 1, SPLITK}; break;
            default: break;
        }
        rc.fsplit = (SPLITK && tx.gd == 256 && ph != 20) ? 1 : 0;
#ifdef PROBE_PH
        const int reps = (ph == PROBE_PH) ? PROBE_N : 1;
#else
        const int reps = 1;
#endif
#pragma unroll 1
        for (int rep = 0; rep < reps; ++rep) {
        if (rep > 0) xcd_barrier(xb);
        asm volatile("" : "+v"(tx.tid)); asm volatile("" : "+s"(tx.bid), "+s"(tx.gd)); asm volatile("" : "+s"(p));
        if (EN(0) && kind == 0) { mod_phase(p, lf, tx); __syncthreads();
            if (tx.gd > 64) { if (tx.bid >= 32) { const Tix tv{tx.tid, tx.bid - 32, tx.gd - 32}; conv_ffn(p, W, 0, lf + 16384, tv); } }
            else conv_ffn(p, W, 0, lf + 16384, tx); }
        else if (EN(1) && kind == 1) { rowpass_simple(p, rc, tx); }
        else if (EN(4) && kind == 4) { rowpass_shift(p, rc, lf, tx); }
        else if (EN(2) && (kind == 2 || kind == 3 || kind == 5)) {
            if (kind == 2) { gA = rA; gB = W + W_W13; gO = rB; gN = 5632; gK = 1024; } else if (kind == 5) { gA = rA; gB = W + W_BTP; gO = rC; gN = 3584; gK = 2048; }
            const int diag = (ph == 19) ? 1 : 0;
            const int bal = (!diag && SPLITK && kind == 3 && gK >= 1024 && tx.gd == 256) ? 1 : 0;
            pg8::Gemm g{gA, gB, MT, gN, gK}; pg8::FwdOrder S; S.init(MT, gN, gK, tx.gd, tx.bid, diag ? 2 : bal);
            pg8::EpiAll E{kind == 3 ? 0 : (kind == 2 ? 1 : 2), gO, kind == 2 ? DFF : 1024, rS, (bf16_t*)(p->ws + OFF_FB) - (size_t)16384 * 1024};
#ifdef PROBE_NOEPI
            if (rep + 1 < reps) E.kind = 7;
#endif
            pg8::gemm_phase<pg8::EpiAll, pg8::FwdOrder, false>(lds, g, S, E, nullptr, tx.tid);
            if (conv >= 0) { const int nunit = (MT / 256) * (gN / 256), extra = nunit % tx.gd;
                const int half = (bal || extra == 0 || extra > tx.gd / 2) ? 0 : extra; if (tx.bid >= half) { const Tix tv{tx.tid, tx.bid - half, tx.gd - half};
                if (conv < 4) conv_ffn(p, Wn, conv, lf, tv); else if (conv == 4) conv_rwkv(p, Wn, lf, tv); else conv_pool(p, Wn, tv); } } }
        else if (EN(6) && kind == 6) {
#ifdef PROBE_VAR
            if (rep + 1 < reps) scan_phase<PROBE_VAR>(p, W, lf, tx, 0); else scan_phase<0>(p, W, lf, tx, 0);
#elif defined(PROBE_MASK)
            scan_phase<0>(p, W, lf, tx, (rep + 1 < reps) ? PROBE_MASK : 0);
#else
            scan_phase<0>(p, W, lf, tx, 0);
#endif
        }
        else if (EN(7) && kind == 7) rowpass_gn(p, tx);
        else if (EN(8) && kind == 8) pool_pass(p, pool_pass_id, tx);
        }
        if (ph + 1 < pe) { if (pb > pe) grid.sync(); else xcd_barrier(xb); }
    }
}

#include <cstdio>
#ifndef USE_COOP
#define USE_COOP 1
#endif
extern "C" void kernel_launch(void* const* d_in, const int* in_sizes, int n_in, void* d_out, int out_size, void* d_ws, size_t ws_size, hipStream_t stream) {
    static int grid = 0;
    if (grid == 0) {
        if (n_in != NIN || ws_size < WS_NEED) { fprintf(stderr, "kernel_launch: n_in %d ws %zu (need %zu)\n", n_in, ws_size, (size_t)WS_NEED); grid = -1; return; }
        int dev = 0, cus = 0, per_cu = 0;
        hipGetDevice(&dev); hipDeviceGetAttribute(&cus, hipDeviceAttributeMultiprocessorCount, dev);
        if (hipFuncSetAttribute((const void*)mega, hipFuncAttributeMaxDynamicSharedMemorySize, LDS_BYTES) != hipSuccess) { fprintf(stderr, "kernel_launch: hipFuncSetAttribute failed\n"); grid = -1; return; }
        if (hipOccupancyMaxActiveBlocksPerMultiprocessor(&per_cu, (const void*)mega, 512, LDS_BYTES) != hipSuccess || per_cu < 1) { fprintf(stderr, "kernel_launch: occupancy query says %d\n", per_cu); per_cu = 1; }
        (void)hipGetLastError();
        grid = cus * 1;
        if (grid <= 0) grid = 256;
    }
    if (grid < 0) return;
    if (hipMemsetAsync((unsigned char*)d_ws + OFF_BAR, 0, 16384, stream) != hipSuccess) { fprintf(stderr, "kernel_launch: memset of the barrier words failed\n"); return; }
    Params p{};
    for (int i = 0; i < NIN; ++i) p.in[i] = (const float*)d_in[i];
    p.out = (float*)d_out; p.ws = (unsigned char*)d_ws;
#if USE_COOP
    p.pb = 0; p.pe = NPHASE;
    void* args[] = {&p};
    hipError_t e = hipLaunchCooperativeKernel((const void*)mega, dim3(grid), dim3(512), args, LDS_BYTES, stream);
    if (e != hipSuccess) fprintf(stderr, "cooperative launch failed: %s (grid %d)\n", hipGetErrorString(e), grid);
#else
    for (int ph = 0; ph < NPHASE; ++ph) { p.pb = ph; p.pe = ph + 1; hipLaunchKernelGGL(mega, dim3(grid), dim3(512), LDS_BYTES, stream, p); }
#endif
}
```

```cpp
#include <hip/hip_runtime.h>
#include <hip/hip_cooperative_groups.h>
namespace pg8 {
#define PG8_LAS __attribute__((address_space(3)))
typedef unsigned short bf16_t;
typedef short bf16x8 __attribute__((ext_vector_type(8)));
typedef float f32x4 __attribute__((ext_vector_type(4)));
typedef unsigned u32x4 __attribute__((ext_vector_type(4)));
constexpr int BM = 256, BK = 64, HALF = 128, HTB = HALF * BK * 2  , STAGE_BYTES = 8 * HTB, NXCD = 8, WGM = 8;

__host__ __device__ __forceinline__ int lds_byte(int r, int c) { const int st = (r >> 4) * 2 + (c >> 5), rr = r & 15, cc = c & 31, ob = rr * 64 + cc * 2; return st * 1024 + (ob ^ (((ob >> 9) & 1) << 5)); }
__host__ __device__ __forceinline__ void stage_rc(int b, int& R, int& C) { const int st = b / 1024, sb = b % 1024, swz = sb ^ (((sb >> 9) & 1) << 5); R = (st >> 1) * 16 + swz / 64; C = (st & 1) * 32 + (swz % 64) / 2; }
__host__ __device__ __forceinline__ int perm32(int rho) { const int n = rho >> 4, i = rho & 15; return 8 * (i >> 2) + 4 * n + (i & 3); }

struct Unit { int pm, pn, part; };
struct Gemm { const bf16_t* A; const bf16_t* Bt; int M, N, K; };

struct StaticOrder {
    int nM, nN, nwg, G, c;
    __host__ __device__ void init(int M, int N, int G_, int c_) { nM = M / BM; nN = N / BM; nwg = nM * nN; G = G_; c = c_; }
    __host__ __device__ bool next(int i, Unit& u) const {
        const long L = (long)i * G + c; if (L >= nwg) return false;
        int wgid = (int)L; { const int q = nwg / NXCD, r = nwg % NXCD, xcd = wgid % NXCD, off = wgid / NXCD; wgid = (xcd < r ? xcd * (q + 1) : r * (q + 1) + (xcd - r) * q) + off; }
        const int nig = WGM * nN, gid = wgid / nig, fm = gid * WGM, gsz = (nM - fm) < WGM ? (nM - fm) : WGM;
        u.pm = fm + ((wgid % nig) % gsz); u.pn = (wgid % nig) / gsz; u.part = 0; return true;
    }
    __device__ __forceinline__ void a_ready(const Unit&) const {}
    __device__ __forceinline__ void done(const Unit&) const {}
};
struct FwdOrder {
    StaticOrder so; int mode;
    __host__ __device__ void init(int M, int N, int K, int G_, int c_, int mode_) { so.init(M, N, G_, c_); mode = mode_; }
    __host__ __device__ bool next(int i, Unit& u) const {
        if (mode == 0) return so.next(i, u);
        if (mode == 2) { const bool ok = so.next(i, u); u.part = 3; return ok; }
        if (mode == 3) { const bool ok = so.next(i, u); u.part = 4; return ok; }
        if (i >= 2) return false;
        const int w = (so.c & 7) * 32 + (so.c >> 3);
        if (i == 0) { u.pm = w >> 2; u.pn = w & 3; u.part = 0; }
        else { u.pm = 64 + (w >> 3); u.pn = (w >> 1) & 3; u.part = 1 + (w & 1); }
        return true;
    }
    __device__ __forceinline__ void a_ready(const Unit&) const {}
    __device__ __forceinline__ void done(const Unit&) const {}
};
__device__ __forceinline__ unsigned cvt_pk_bf16(float lo, float hi) { unsigned r; asm volatile("v_cvt_pk_bf16_f32 %0, %1, %2" : "=v"(r) : "v"(lo), "v"(hi)); return r; }
typedef float f32x2 __attribute__((ext_vector_type(2)));
__device__ __forceinline__ float fast_sigmoid(float x) { return __builtin_amdgcn_rcpf(1.0f + __expf(-x)); }
__device__ __forceinline__ float fast_tanh(float x) { return 1.0f - 2.0f * __builtin_amdgcn_rcpf(1.0f + __expf(2.0f * x)); }
struct EpiStore {
    static constexpr bool PERM = true, AFTER_DRAIN = false;
    bf16_t* O; int ldc;
    __device__ __forceinline__ void operator()(const f32x4 (&acc)[2][2][4][2], const Unit& u, int wr, int wc, int fr, int fq) const {
        const int row0 = u.pm * BM + wr * 64 + fr, col0 = u.pn * BM + wc * 32 + 8 * fq;
#pragma unroll
        for (int ai = 0; ai < 2; ++ai)
#pragma unroll
            for (int m = 0; m < 4; ++m) { bf16_t* rowp = O + (size_t)(row0 + ai * HALF + m * 16) * ldc + col0;
#pragma unroll
                for (int bj = 0; bj < 2; ++bj) { const f32x4 v0 = acc[ai][bj][m][0], v1 = acc[ai][bj][m][1];
                    u32x4 w; w.x = cvt_pk_bf16(v0[0], v0[1]); w.y = cvt_pk_bf16(v0[2], v0[3]); w.z = cvt_pk_bf16(v1[0], v1[1]); w.w = cvt_pk_bf16(v1[2], v1[3]);
                    *(u32x4*)(rowp + bj * HALF) = w; } }
    }
};
struct EpiSwiglu {
    static constexpr bool PERM = true, AFTER_DRAIN = false;
    bf16_t* O; int ldc;
    __device__ __forceinline__ void operator()(const f32x4 (&acc)[2][2][4][2], const Unit& u, int wr, int wc, int fr, int fq) const {
        const int row0 = u.pm * BM + wr * 64 + fr, col0 = u.pn * HALF + wc * 32 + 8 * fq;
#pragma unroll
        for (int ai = 0; ai < 2; ++ai)
#pragma unroll
            for (int m = 0; m < 4; ++m) { bf16_t* rowp = O + (size_t)(row0 + ai * HALF + m * 16) * ldc + col0;
                float o[8];
#pragma unroll
                for (int n = 0; n < 2; ++n)
#pragma unroll
                    for (int j = 0; j < 4; ++j) { const float a = acc[ai][0][m][n][j], b = acc[ai][1][m][n][j]; o[n * 4 + j] = a * fast_sigmoid(a) * b; }
                u32x4 w; w.x = cvt_pk_bf16(o[0], o[1]); w.y = cvt_pk_bf16(o[2], o[3]); w.z = cvt_pk_bf16(o[4], o[5]); w.w = cvt_pk_bf16(o[6], o[7]);
                *(u32x4*)rowp = w; }
    }
};
struct EpiRkv {
    static constexpr bool PERM = true, AFTER_DRAIN = false;
    bf16_t* O; size_t tstride; bf16_t* L;
    __device__ __forceinline__ void operator()(const f32x4 (&acc)[2][2][4][2], const Unit& u, int wr, int wc, int fr, int fq) const {
        const int row0 = u.pm * BM + wr * 64 + fr;
        if (u.pn < 12) {
            bf16_t* base = O + (size_t)(u.pn >> 2) * tstride; const int col0 = (u.pn & 3) * BM + wc * 32 + 8 * fq;
#pragma unroll
            for (int ai = 0; ai < 2; ++ai)
#pragma unroll
                for (int m = 0; m < 4; ++m) { bf16_t* rowp = base + (size_t)(row0 + ai * HALF + m * 16) * 1024 + col0;
#pragma unroll
                    for (int bj = 0; bj < 2; ++bj) { const f32x4 v0 = acc[ai][bj][m][0], v1 = acc[ai][bj][m][1];
                        u32x4 w; w.x = cvt_pk_bf16(v0[0], v0[1]); w.y = cvt_pk_bf16(v0[2], v0[3]); w.z = cvt_pk_bf16(v1[0], v1[1]); w.w = cvt_pk_bf16(v1[2], v1[3]);
                        *(u32x4*)(rowp + bj * HALF) = w; } }
        } else {
            const int t13 = (u.pn == 13); const int col0 = (u.pn - 12) * BM + wc * 32 + 8 * fq;
#pragma unroll
            for (int ai = 0; ai < 2; ++ai)
#pragma unroll
                for (int m = 0; m < 4; ++m) { bf16_t* rowp = L + (size_t)(row0 + ai * HALF + m * 16) * 384 + col0;
#pragma unroll
                    for (int bj = 0; bj < 2; ++bj) { if (t13 && bj == 1) continue;
                        float o[8];
#pragma unroll
                        for (int n = 0; n < 2; ++n)
#pragma unroll
                            for (int j = 0; j < 4; ++j) { const float a = acc[ai][bj][m][n][j]; o[n * 4 + j] = t13 ? fast_sigmoid(a) : (bj == 0 ? fast_tanh(a) : a); }
                        u32x4 w; w.x = cvt_pk_bf16(o[0], o[1]); w.y = cvt_pk_bf16(o[2], o[3]); w.z = cvt_pk_bf16(o[4], o[5]); w.w = cvt_pk_bf16(o[6], o[7]);
                        *(u32x4*)(rowp + bj * HALF) = w; } }
        }
    }
};

struct EpiAll {
    static constexpr bool PERM = true, AFTER_DRAIN = false;
    int kind; bf16_t* O; int ldc; bf16_t* L; bf16_t* O2;
    __device__ __forceinline__ void operator()(const f32x4 (&acc)[2][2][4][2], const Unit& u, int wr, int wc, int fr, int fq) const {
        if (kind == 0) { EpiStore e{u.part == 2 ? O2 : O, ldc}; e(acc, u, wr, wc, fr, fq); }
        else if (kind == 1) { EpiSwiglu e{O, ldc}; e(acc, u, wr, wc, fr, fq); }
        else if (kind == 2) { EpiRkv e{O, (size_t)24576 * 1024, L}; e(acc, u, wr, wc, fr, fq); }
    }
};
template <class Epi, class Sched, bool STAMP = false>
__device__ __forceinline__ void gemm_phase(PG8_LAS unsigned char* lds, const Gemm g, const Sched& S, const Epi& E, unsigned long long* stamps, const int tid_in) {
    const int tid = tid_in, wid = __builtin_amdgcn_readfirstlane(tid >> 6), lane = tid & 63, wr = wid >> 2, wc = wid & 3, fr = lane & 15, fq = lane >> 4;
    const int K = g.K; int nt = K / BK;
    int ts_lo = 0, ts_hi = 0, nts = 0; const unsigned long long rt_entry = STAMP ? (unsigned long long)wall_clock64() : 0ull;
#define PG8_STAMP() do { if (STAMP && wid == 0 && nts < 64) { const unsigned long long _c = (unsigned long long)clock64(); \
        ts_lo = (lane == nts) ? (int)(unsigned)_c : ts_lo; ts_hi = (lane == nts) ? (int)(unsigned)(_c >> 32) : ts_hi; ++nts; } } while (0)
    PG8_STAMP();
    unsigned voffA[2], voffB[2];
#pragma unroll
    for (int i = 0; i < 2; ++i) { int R, C; stage_rc(tid * 16 + i * 8192, R, C); const int Rb = Epi::PERM ? ((R & ~31) + perm32(R & 31)) : R;
        voffA[i] = (unsigned)(R * K + C) * 2u; voffB[i] = (unsigned)(Rb * K + C) * 2u; }
    const size_t kstep = (size_t)(BK * 2);
    const size_t hstep = (size_t)HALF * K * 2;
    const size_t tstep = 2 * hstep;
    const unsigned ldsw = (unsigned)wid * 1024u;
    const int aoff = lds_byte(wr * 64 + fr, fq * 8), boff = lds_byte(wc * 32 + fr, fq * 8);
#define PG8_SA(b, h) (((b) * 2 + (h)) * HTB)
#define PG8_SB(b, h) ((4 + (b) * 2 + (h)) * HTB)
#define PG8_STAGE(bufoff, gbase, voff) do { _Pragma("unroll") for (int _i = 0; _i < 2; ++_i) \
        __builtin_amdgcn_global_load_lds((const unsigned*)((const char*)(gbase) + (voff)[_i]), (PG8_LAS unsigned*)(lds + (bufoff) + ldsw + _i * 8192), 16, 0, 0); } while (0)
#define PG8_LDA(dst, b, h) do { _Pragma("unroll") for (int m = 0; m < 4; ++m) _Pragma("unroll") for (int k = 0; k < 2; ++k) dst[m][k] = *(const PG8_LAS bf16x8*)(lds + PG8_SA(b, h) + aoff + m * 2048 + k * 1024); } while (0)
#define PG8_LDB(dst, b, h) do { _Pragma("unroll") for (int n = 0; n < 2; ++n) _Pragma("unroll") for (int k = 0; k < 2; ++k) dst[n][k] = *(const PG8_LAS bf16x8*)(lds + PG8_SB(b, h) + boff + n * 2048 + k * 1024); } while (0)
#define PG8_MMA(ai, bj, At, Bt) do { __builtin_amdgcn_s_setprio(1); _Pragma("unroll") for (int m = 0; m < 4; ++m) _Pragma("unroll") for (int n = 0; n < 2; ++n) _Pragma("unroll") for (int k = 0; k < 2; ++k) \
        acc[ai][bj][m][n] = __builtin_amdgcn_mfma_f32_16x16x32_bf16(Bt[n][k], At[m][k], acc[ai][bj][m][n], 0, 0, 0); __builtin_amdgcn_s_setprio(0); } while (0)
#define PG8_WAIT_V(n) asm volatile("s_waitcnt vmcnt(" #n ")" ::: "memory")
#define PG8_WAIT_L(n) asm volatile("s_waitcnt lgkmcnt(" #n ")" ::: "memory")
#define PG8_BAR __builtin_amdgcn_s_barrier()
#define PG8_SCHED __builtin_amdgcn_sched_barrier(0)
    Unit cur, nxt; int ui = 0;
    if (!S.next(0, cur)) return;
    f32x4 acc[2][2][4][2];
#pragma unroll
    for (int a = 0; a < 2; ++a)
#pragma unroll
        for (int b = 0; b < 2; ++b)
#pragma unroll
            for (int m = 0; m < 4; ++m)
#pragma unroll
                for (int n = 0; n < 2; ++n) acc[a][b][m][n] = (f32x4){0.f, 0.f, 0.f, 0.f};
    bf16x8 At[4][2], B0[2][2], B1[2][2];
    const char* cA = (const char*)g.A + (size_t)cur.pm * tstep + (cur.part == 2 ? (size_t)K : cur.part == 3 ? (size_t)cur.pn * 512 : cur.part == 4 ? (size_t)512 : (size_t)0); const char* cB = (const char*)g.Bt + (size_t)cur.pn * tstep + (cur.part == 2 ? (size_t)K : cur.part == 3 ? (size_t)cur.pn * 512 : cur.part == 4 ? (size_t)512 : (size_t)0);
    nt = cur.part == 3 ? 4 : cur.part == 4 ? 2 : cur.part ? K / (2 * BK) : K / BK;
    S.a_ready(cur);
    PG8_STAGE(PG8_SB(0, 0), cB, voffB); PG8_STAGE(PG8_SA(0, 0), cA, voffA); PG8_STAGE(PG8_SB(0, 1), cB + hstep, voffB); PG8_STAGE(PG8_SA(0, 1), cA + hstep, voffA);
    if (wr == 1) PG8_BAR;
    PG8_WAIT_V(4); PG8_BAR;
    PG8_STAGE(PG8_SB(1, 0), cB + kstep, voffB); PG8_STAGE(PG8_SA(1, 0), cA + kstep, voffA); PG8_STAGE(PG8_SB(1, 1), cB + hstep + kstep, voffB);
    PG8_WAIT_V(6); PG8_BAR;
    PG8_STAMP();
    for (;;) {
        const bool has_next = S.next(ui + 1, nxt);
        const char* nA = has_next ? (const char*)g.A + (size_t)nxt.pm * tstep + (nxt.part == 2 ? (size_t)K : nxt.part == 3 ? (size_t)nxt.pn * 512 : nxt.part == 4 ? (size_t)512 : (size_t)0) : cA; const char* nB = has_next ? (const char*)g.Bt + (size_t)nxt.pn * tstep + (nxt.part == 2 ? (size_t)K : nxt.part == 3 ? (size_t)nxt.pn * 512 : nxt.part == 4 ? (size_t)512 : (size_t)0) : cB;
        for (int t = 0; t < nt; t += 2) {
            const bool last = (t == nt - 2);
            const char* a1 = cA + (size_t)(t + 1) * kstep;
            const char* a2 = last ? nA : cA + (size_t)(t + 2) * kstep; const char* b2 = last ? nB : cB + (size_t)(t + 2) * kstep;
            const char* a3 = a2 + kstep; const char* b3 = b2 + kstep;
            if (last && has_next) S.a_ready(nxt);
            PG8_LDB(B0, 0, 0); PG8_SCHED; PG8_LDA(At, 0, 0); PG8_STAGE(PG8_SA(1, 1), a1 + hstep, voffA);
            PG8_WAIT_L(8); PG8_BAR; PG8_WAIT_L(0); PG8_MMA(0, 0, At, B0); PG8_BAR; PG8_SCHED;
            PG8_LDB(B1, 0, 1); PG8_STAGE(PG8_SB(0, 0), b2, voffB);
            PG8_BAR; PG8_WAIT_L(0); PG8_MMA(0, 1, At, B1); PG8_BAR;
            PG8_LDA(At, 0, 1); PG8_STAGE(PG8_SA(0, 0), a2, voffA);
            PG8_BAR; PG8_WAIT_L(0); PG8_MMA(1, 0, At, B0); PG8_BAR; PG8_SCHED;
            PG8_STAGE(PG8_SB(0, 1), b2 + hstep, voffB);
            PG8_WAIT_V(6); PG8_BAR; PG8_MMA(1, 1, At, B1); PG8_BAR;
            PG8_LDB(B0, 1, 0); PG8_SCHED; PG8_LDA(At, 1, 0); PG8_STAGE(PG8_SA(0, 1), a2 + hstep, voffA);
            PG8_WAIT_L(8); PG8_BAR; PG8_WAIT_L(0); PG8_MMA(0, 0, At, B0); PG8_BAR; PG8_SCHED;
            PG8_LDB(B1, 1, 1); PG8_STAGE(PG8_SB(1, 0), b3, voffB);
            PG8_BAR; PG8_WAIT_L(0); PG8_MMA(0, 1, At, B1); PG8_BAR;
            PG8_LDA(At, 1, 1); PG8_STAGE(PG8_SA(1, 0), a3, voffA);
            PG8_BAR; PG8_WAIT_L(0); PG8_MMA(1, 0, At, B0); PG8_BAR; PG8_SCHED;
            PG8_STAGE(PG8_SB(1, 1), b3 + hstep, voffB);
            PG8_WAIT_V(6); PG8_BAR; PG8_MMA(1, 1, At, B1); PG8_BAR;
        }
        PG8_STAMP();
        if constexpr (!Epi::AFTER_DRAIN) { E(acc, cur, wr, wc, fr, fq); S.done(cur); }
        PG8_STAMP();
        if (!has_next) break;
#pragma unroll
        for (int a = 0; a < 2; ++a)
#pragma unroll
            for (int b = 0; b < 2; ++b)
#pragma unroll
                for (int m = 0; m < 4; ++m)
#pragma unroll
                    for (int n = 0; n < 2; ++n) acc[a][b][m][n] = (f32x4){0.f, 0.f, 0.f, 0.f};
        cur = nxt; cA = nA; cB = nB; ++ui; nt = cur.part == 3 ? 4 : cur.part == 4 ? 2 : cur.part ? K / (2 * BK) : K / BK;
    }
    PG8_WAIT_V(0);
    if (wr == 0) PG8_BAR;
    PG8_BAR;
    if constexpr (Epi::AFTER_DRAIN) { E.fused(acc, cur, wr, wc, fr, fq, lds, wid, lane); S.done(cur); }
    PG8_STAMP();
    if (STAMP && wid == 0) { stamps[lane] = lane < nts ? (((unsigned long long)(unsigned)ts_hi << 32) | (unsigned)ts_lo) : 0ull;
        if (lane == 62) stamps[62] = rt_entry; if (lane == 63) stamps[63] = (unsigned long long)wall_clock64(); }
#undef PG8_STAMP
#undef PG8_SA
#undef PG8_SB
#undef PG8_STAGE
#undef PG8_LDA
#undef PG8_LDB
#undef PG8_MMA
#undef PG8_WAIT_V
#undef PG8_WAIT_L
#undef PG8_BAR
#undef PG8_SCHED
}
}

namespace cg = cooperative_groups;
using pg8::bf16_t; using pg8::bf16x8; using pg8::f32x4; using pg8::u32x4; using pg8::cvt_pk_bf16; using pg8::fast_sigmoid;
#define LAS __attribute__((address_space(3)))
typedef float f32x2 __attribute__((ext_vector_type(2)));
typedef unsigned u32x2 __attribute__((ext_vector_type(2)));

constexpr int D = 1024, DFF = 2816, MP = 8192, MS = 16384, MT = 24576;
constexpr int NIN = 31;
constexpr size_t R48 = (size_t)MT * 1024 * 2;
constexpr size_t OFF_A = 0, OFF_B = R48, OFF_C = 2 * R48, OFF_D = 3 * R48, OFF_E = 4 * R48;
constexpr size_t OFF_S = 5 * R48;
constexpr size_t OFF_W = OFF_S + (size_t)MT * 384 * 2;
constexpr size_t W_ELEMS = 9043968;
constexpr size_t OFF_MOD = OFF_W + W_ELEMS * 2;
constexpr size_t OFF_CBP = OFF_MOD + (size_t)9 * 2 * 9216 * 4;
constexpr size_t OFF_BAR = OFF_CBP + (size_t)2 * MT * 64 * 4;
constexpr size_t OFF_W2 = OFF_BAR + 16384;
constexpr size_t OFF_FB = OFF_W2 + W_ELEMS * 2;
constexpr size_t WS_NEED = OFF_FB + (size_t)8192 * 1024 * 2;
constexpr size_t W_W13 = 0, W_W2T = (size_t)5632 * 1024;
constexpr size_t W_BTP = 0, W_BTG = (size_t)3584 * 2048, W_WOT = W_BTG + (size_t)1024 * 384, W_W2L = W_WOT + (size_t)1024 * 1024, W_A2L = W_W2L + 131072;
constexpr float RMS_EPS = 1e-6f, GN_EPS = 64e-5f;

struct Tix { int tid, bid, gd; };
struct Params { const float* in[NIN]; float* out; unsigned char* ws; int pb, pe; };
typedef const Params __attribute__((address_space(4)))* CP;

__device__ __forceinline__ float bf2f(unsigned short b) { return __uint_as_float(((unsigned)b) << 16); }
__device__ __forceinline__ float bflo(unsigned w) { return __uint_as_float(w << 16); }
__device__ __forceinline__ float bfhi(unsigned w) { return __uint_as_float(w & 0xffff0000u); }
template <int CTRL> __device__ __forceinline__ float dpp_f(float x) { return __builtin_bit_cast(float, __builtin_amdgcn_mov_dpp(__builtin_bit_cast(int, x), CTRL, 0xf, 0xf, true)); }
__device__ __forceinline__ float row16_sum(float v) { v += dpp_f<0xB1>(v); v += dpp_f<0x4E>(v); v += dpp_f<0x141>(v); v += dpp_f<0x128>(v); return v; }
__device__ __forceinline__ float wave_sum(float v) {
    v = row16_sum(v);
    auto s1 = __builtin_amdgcn_permlane16_swap(__float_as_uint(v), __float_as_uint(v), false, false); v = __uint_as_float(s1[0]) + __uint_as_float(s1[1]);
    auto s2 = __builtin_amdgcn_permlane32_swap(__float_as_uint(v), __float_as_uint(v), false, false); v = __uint_as_float(s2[0]) + __uint_as_float(s2[1]);
    return v;
}
__device__ __forceinline__ float reduce8(float x) { x += dpp_f<0xB1>(x); x += dpp_f<0x4E>(x); x += dpp_f<0x141>(x); return x; }

struct ConvJob { const float* src; int K, N; bf16_t* dst; int dld, kofs, blk, blk_stride, row_off; const float* ksc; };
__device__ __forceinline__ void conv_job(const ConvJob j, LAS float* tile, int& rot, const Tix tx) {
    const int tid = tx.tid, G = tx.gd;
    const int tn = j.N >> 6, nt = (j.K >> 6) * tn;
    int t0 = (tx.bid - (rot % G) + G) % G;
    for (int t = t0; t < nt; t += G) {
        const int k0 = (t / tn) << 6, n0 = (t % tn) << 6;
        { const int r = tid >> 4, c4 = tid & 15;
#pragma unroll
          for (int it = 0; it < 2; ++it) { const int k = r + 32 * it; const float4 v = *(const float4*)(j.src + (size_t)(k0 + k) * j.N + n0 + 4 * c4);
              LAS float* tp = tile + k * 65 + 4 * c4; tp[0] = v.x; tp[1] = v.y; tp[2] = v.z; tp[3] = v.w; } }
        __syncthreads();
        { const int n = tid >> 3, kg = tid & 7; float v[8];
#pragma unroll
          for (int i = 0; i < 8; ++i) { v[i] = tile[(8 * kg + i) * 65 + n]; if (j.ksc) v[i] *= j.ksc[k0 + 8 * kg + i]; }
          u32x4 w; w.x = cvt_pk_bf16(v[0], v[1]); w.y = cvt_pk_bf16(v[2], v[3]); w.z = cvt_pk_bf16(v[4], v[5]); w.w = cvt_pk_bf16(v[6], v[7]);
          const int gn = n0 + n; const int drow = (gn / j.blk) * j.blk_stride + (gn % j.blk) + j.row_off;
          *(u32x4*)(j.dst + (size_t)drow * j.dld + j.kofs + k0 + 8 * kg) = w; }
        __syncthreads();
    }
    rot += nt;
}
__device__ void conv_ffn(CP p, bf16_t* W, int fi, LAS float* tile, const Tix tx) {
    int rot = 0;
    conv_job(ConvJob{p->in[10] + (size_t)fi * D * DFF, D, DFF, W + W_W13, 1024, 0, 128, 256, 0, nullptr}, tile, rot, tx);
    conv_job(ConvJob{p->in[11] + (size_t)fi * D * DFF, D, DFF, W + W_W13, 1024, 0, 128, 256, 128, nullptr}, tile, rot, tx);
    conv_job(ConvJob{p->in[12] + (size_t)fi * D * DFF, DFF, D, W + W_W2T, 2816, 0, 1024, 1024, 0, nullptr}, tile, rot, tx);
}
__device__ void conv_rwkv(CP p, bf16_t* W, LAS float* tile, const Tix tx) {
    int rot = 0;
    const float* mu = p->in[13];
    for (int half = 0; half < 2; ++half) {
        const int ko = half * 1024;
        for (int i = 0; i < 3; ++i) { const int mi = (i == 0) ? 0 : (i == 1 ? 2 : 3);
            conv_job(ConvJob{p->in[14] + (size_t)i * D * D, D, D, W + W_BTP, 2048, ko, 1024, 1024, i * 1024, half ? mu + mi * D : nullptr}, tile, rot, tx); }
        for (int d = 0; d < 2; ++d) {
            conv_job(ConvJob{p->in[16] + (size_t)d * D * 64, D, 64, W + W_BTP, 2048, ko, 64, 64, 3072 + 64 * d, half ? mu + 1 * D : nullptr}, tile, rot, tx);
            conv_job(ConvJob{p->in[19] + (size_t)d * D * 64, D, 64, W + W_BTP, 2048, ko, 64, 64, 3200 + 64 * d, half ? mu + 4 * D : nullptr}, tile, rot, tx); }
        conv_job(ConvJob{p->in[21], D, 128, W + W_BTP, 2048, ko, 128, 128, 3328, half ? mu + 5 * D : nullptr}, tile, rot, tx);
    }
    conv_job(ConvJob{p->in[22], 128, D, W + W_BTG, 384, 256, 1024, 1024, 0, nullptr}, tile, rot, tx);
    for (int idx = tx.bid * 512 + tx.tid; idx < 1024 * 32; idx += tx.gd * 512) { const int n = idx >> 5, k8 = idx & 31; *(u32x4*)(W + W_BTG + (size_t)n * 384 + 8 * k8) = (u32x4){0u, 0u, 0u, 0u}; }
    conv_job(ConvJob{p->in[28], D, D, W + W_WOT, 1024, 0, 1024, 1024, 0, nullptr}, tile, rot, tx);
    for (int d = 0; d < 2; ++d) {
        conv_job(ConvJob{p->in[17] + (size_t)d * 64 * D, 64, D, W + W_W2L + (size_t)d * 65536, 64, 0, 1024, 1024, 0, nullptr}, tile, rot, tx);
        conv_job(ConvJob{p->in[20] + (size_t)d * 64 * D, 64, D, W + W_A2L + (size_t)d * 65536, 64, 0, 1024, 1024, 0, nullptr}, tile, rot, tx); }
}
__device__ void conv_pool(CP p, bf16_t* W, const Tix tx) {
    const float* pw = p->in[29]; const float* ps = p->in[30];
    for (int idx = tx.bid * 512 + tx.tid; idx < 1024 * 128; idx += tx.gd * 512) {
        const int k8 = idx >> 10, n = idx & 1023, g = n >> 8; u32x4 w = (u32x4){0u, 0u, 0u, 0u};
        if ((k8 >> 5) == g) { const float s = ps[n]; float v[8];
#pragma unroll
            for (int i = 0; i < 8; ++i) v[i] = pw[((size_t)g * 256 + ((8 * k8 + i) & 255)) * 256 + (n & 255)] * s;
            w.x = cvt_pk_bf16(v[0], v[1]); w.y = cvt_pk_bf16(v[2], v[3]); w.z = cvt_pk_bf16(v[4], v[5]); w.w = cvt_pk_bf16(v[6], v[7]); }
        *(u32x4*)(W + (size_t)n * 1024 + 8 * k8) = w; }
}

__device__ void mod_phase(CP p, LAS float* lf, const Tix tx) {
    LAS float* sc = lf; LAS float* red = lf + 9216;
    const int tid = tx.tid;
    if (tx.bid >= 288) return;
    for (int o = tid; o < 9216; o += 512) { const int c = o >> 10, k = o & 1023; const float v = (c == 0) ? p->in[5][k] : p->in[2][(c - 1) * 1024 + k]; sc[o] = v * fast_sigmoid(v); }
    __syncthreads();
    float* mod = (float*)(p->ws + OFF_MOD);
    for (int item = tx.bid; item < 288; item += tx.gd) {
        const int i = item / 144, n0 = (item % 144) * 64, col = tid & 63, ks = tid >> 6;
        float acc[9];
#pragma unroll
        for (int c = 0; c < 9; ++c) acc[c] = 0.f;
        const float* wp = p->in[6] + ((size_t)i * 1024 + ks * 128) * 9216 + n0 + col;
#pragma unroll 8
        for (int k = 0; k < 128; ++k) { const float w = wp[(size_t)k * 9216];
#pragma unroll
            for (int c = 0; c < 9; ++c) acc[c] += sc[c * 1024 + ks * 128 + k] * w; }
#pragma unroll
        for (int c = 0; c < 9; ++c) red[(ks * 9 + c) * 64 + col] = acc[c];
        __syncthreads();
        for (int o = tid; o < 576; o += 512) { const int c = o >> 6, cl = o & 63; float s = p->in[7][i * 9216 + n0 + cl];
#pragma unroll
            for (int k2 = 0; k2 < 8; ++k2) s += red[(k2 * 9 + c) * 64 + cl];
            mod[((size_t)c * 2 + i) * 9216 + n0 + cl] = s; }
        __syncthreads();
    }
}

struct RowCfg {
    int src_input;
    int pending;
    int lg, gidx; float coef; const float* npost;
    int has_next;
    int lh, shidx, scidx; const float* npre;
    int write_x;
    int fsplit;
};
__device__ __forceinline__ const float* xrow_in(CP p, int m) { return m < MP ? p->in[0] + (size_t)m * D : p->in[1] + (size_t)(m - MP) * D; }
__device__ __forceinline__ int cond_of(int m) { return m < MP ? 0 : 1 + ((m - MP) >> 11); }
__device__ __forceinline__ void row_update(CP p, const RowCfg& c, int m, int lane, f32x4 (&x)[4]) {
    const float* xr = c.src_input ? xrow_in(p, m) : p->out + (size_t)m * D;
    const float* mod = (const float*)(p->ws + OFF_MOD);
    const int cd = cond_of(m);
#pragma unroll
    for (int q = 0; q < 4; ++q) x[q] = *(const f32x4*)(xr + 4 * lane + 256 * q);
    if (c.pending) {
        const bf16_t* fr = (const bf16_t*)(p->ws + OFF_E) + (size_t)m * D; f32x4 f[4]; float ss = 0.f;
#pragma unroll
        for (int q = 0; q < 4; ++q) { const u32x2 w = *(const u32x2*)(fr + 4 * lane + 256 * q); f[q] = (f32x4){bflo(w.x), bfhi(w.x), bflo(w.y), bfhi(w.y)}; }
        if (c.fsplit && m >= 16384) {
            const bf16_t* fr2 = (const bf16_t*)(p->ws + OFF_FB) + (size_t)(m - 16384) * D;
#pragma unroll
            for (int q = 0; q < 4; ++q) { const u32x2 w = *(const u32x2*)(fr2 + 4 * lane + 256 * q); f[q] += (f32x4){bflo(w.x), bfhi(w.x), bflo(w.y), bfhi(w.y)}; } }
#pragma unroll
        for (int q = 0; q < 4; ++q) ss += f[q][0] * f[q][0] + f[q][1] * f[q][1] + f[q][2] * f[q][2] + f[q][3] * f[q][3];
        ss = wave_sum(ss); const float rs = rsqrtf(ss * (1.0f / 1024.0f) + RMS_EPS) * c.coef;
        const float* gate = mod + ((size_t)(cd * 2 + c.lg) * 9 + c.gidx) * D;
#pragma unroll
        for (int q = 0; q < 4; ++q) { const f32x4 g = *(const f32x4*)(gate + 4 * lane + 256 * q), np = *(const f32x4*)(c.npost + 4 * lane + 256 * q); x[q] += g * (f[q] * np) * rs; }
    }
}
__device__ __forceinline__ void row_premod(CP p, const RowCfg& c, int m, int lane, const f32x4 (&x)[4], f32x4 (&h)[4]) {
    const float* mod = (const float*)(p->ws + OFF_MOD);
    const int cd = cond_of(m);
    float ss = 0.f;
#pragma unroll
    for (int q = 0; q < 4; ++q) ss += x[q][0] * x[q][0] + x[q][1] * x[q][1] + x[q][2] * x[q][2] + x[q][3] * x[q][3];
    ss = wave_sum(ss); const float rs = rsqrtf(ss * (1.0f / 1024.0f) + RMS_EPS);
    const float* sh = mod + ((size_t)(cd * 2 + c.lh) * 9 + c.shidx) * D; const float* scl = mod + ((size_t)(cd * 2 + c.lh) * 9 + c.scidx) * D;
#pragma unroll
    for (int q = 0; q < 4; ++q) { const f32x4 g = *(const f32x4*)(c.npre + 4 * lane + 256 * q), s1 = *(const f32x4*)(scl + 4 * lane + 256 * q), s0 = *(const f32x4*)(sh + 4 * lane + 256 * q);
        h[q] = (x[q] * rs * g) * (1.0f + s1) + s0; }
}
__device__ __forceinline__ void store_bf16_row(bf16_t* dst, int lane, const f32x4 (&h)[4]) {
#pragma unroll
    for (int q = 0; q < 4; ++q) { u32x2 w; w.x = cvt_pk_bf16(h[q][0], h[q][1]); w.y = cvt_pk_bf16(h[q][2], h[q][3]); *(u32x2*)(dst + 4 * lane + 256 * q) = w; }
}
__device__ void rowpass_simple(CP p, const RowCfg c, const Tix tx) {
    const int lane = tx.tid & 63, wid = tx.tid >> 6, nw = tx.gd * 8;
    bf16_t* hdst = (bf16_t*)(p->ws + OFF_A);
    for (int m = tx.bid * 8 + wid; m < MT; m += nw) {
        f32x4 x[4]; row_update(p, c, m, lane, x);
        if (c.write_x) {
#pragma unroll
            for (int q = 0; q < 4; ++q) *(f32x4*)(p->out + (size_t)m * D + 4 * lane + 256 * q) = x[q]; }
        if (c.has_next) { f32x4 h[4]; row_premod(p, c, m, lane, x, h); store_bf16_row(hdst + (size_t)m * D, lane, h); }
    }
}
__device__ void rowpass_shift(CP p, const RowCfg c, LAS float* lf, const Tix tx) {
    const int lane = tx.tid & 63, wid = tx.tid >> 6;
    bf16_t* adst = (bf16_t*)(p->ws + OFF_A);
    constexpr int RUN = 12;
    for (int run = tx.bid * 8 + wid; run < MT / RUN; run += tx.gd * 8) {
        const int m0 = run * RUN;
        f32x4 hA[4], hB[4], xB[4];
#pragma unroll
        for (int q = 0; q < 4; ++q) { hA[q] = (f32x4){0.f, 0.f, 0.f, 0.f}; hB[q] = hA[q]; xB[q] = hA[q]; }
#pragma unroll 1
        for (int j = -1; j <= RUN; ++j) {
            const int m = m0 + j;
            f32x4 xC[4], hC[4];
#pragma unroll
            for (int q = 0; q < 4; ++q) { xC[q] = (f32x4){0.f, 0.f, 0.f, 0.f}; hC[q] = xC[q]; }
            if (m >= 0 && m < MT) { row_update(p, c, m, lane, xC); row_premod(p, c, m, lane, xC, hC); }
            if (j >= 1) {
                const int mo = m - 1; const int T = mo < MP ? 256 : 2048, t = mo < MP ? (mo & 255) : ((mo - MP) & 2047);
                f32x4 hs[4];
#pragma unroll
                for (int q = 0; q < 4; ++q) { *(f32x4*)(p->out + (size_t)mo * D + 4 * lane + 256 * q) = xB[q];
                    hs[q] = (f32x4){0.f, 0.f, 0.f, 0.f};
                    if (t > 0) hs[q] += hA[q];
                    if (t < T - 1) hs[q] += hC[q];
                    hs[q] = 0.5f * hs[q] - hB[q]; }
                store_bf16_row(adst + (size_t)mo * 2048, lane, hB);
                store_bf16_row(adst + (size_t)mo * 2048 + 1024, lane, hs);
            }
#pragma unroll
            for (int q = 0; q < 4; ++q) { hA[q] = hB[q]; hB[q] = hC[q]; xB[q] = xC[q]; }
        }
    }
}
__device__ void rowpass_gn(CP p, const Tix tx) {
    const int lane = tx.tid & 63, wid = tx.tid >> 6, nw = tx.gd * 8;
    const bf16_t* yf = (const bf16_t*)(p->ws + OFF_A); const bf16_t* yb = (const bf16_t*)(p->ws + OFF_B);
    const bf16_t* gb = (const bf16_t*)(p->ws + OFF_C); const bf16_t* vb = (const bf16_t*)(p->ws + OFF_E);
    bf16_t* ob = (bf16_t*)(p->ws + OFF_D); const float* cbp = (const float*)(p->ws + OFF_CBP);
    const float* gnw = p->in[26]; const float* gnb = p->in[27];
    for (int m = tx.bid * 8 + wid; m < MT; m += nw) {
        f32x4 o[4];
#pragma unroll
        for (int q = 0; q < 4; ++q) {
            const int col = 4 * lane + 256 * q, hd = 4 * q + (lane >> 4);
            const u32x2 a = *(const u32x2*)(yf + (size_t)m * D + col), b = *(const u32x2*)(yb + (size_t)m * D + col);
            f32x4 y = (f32x4){bflo(a.x) + bflo(b.x), bfhi(a.x) + bfhi(b.x), bflo(a.y) + bflo(b.y), bfhi(a.y) + bfhi(b.y)};
            float s = y[0] + y[1] + y[2] + y[3];
            s = row16_sum(s);
            const float mean = s * (1.0f / 64.0f); const f32x4 dv = y - mean;
            float vs = dv[0] * dv[0] + dv[1] * dv[1] + dv[2] * dv[2] + dv[3] * dv[3];
            vs = row16_sum(vs);
            const float rstd = rsqrtf(vs * (1.0f / 64.0f) + GN_EPS);
            const f32x4 c0 = *(const f32x4*)(cbp + ((size_t)m * 16 + hd) * 4), c1 = *(const f32x4*)(cbp + ((size_t)(MT + m) * 16 + hd) * 4);
            const float cb = (c0[0] + c0[1] + c0[2] + c0[3]) + (c1[0] + c1[1] + c1[2] + c1[3]);
            const u32x2 vw = *(const u32x2*)(vb + (size_t)m * D + col), gw = *(const u32x2*)(gb + (size_t)m * D + col);
            const f32x4 v = (f32x4){bflo(vw.x), bfhi(vw.x), bflo(vw.y), bfhi(vw.y)}, g = (f32x4){bflo(gw.x), bfhi(gw.x), bflo(gw.y), bfhi(gw.y)};
            const f32x4 w = *(const f32x4*)(gnw + col), bb = *(const f32x4*)(gnb + col);
            o[q] = (dv * rstd * w + bb + cb * v) * g;
        }
        store_bf16_row(ob + (size_t)m * D, lane, o);
    }
}

__device__ __forceinline__ void pool_add(float (&s)[8], const u32x4 w, const float sg) {
    s[0] += sg * bflo(w.x); s[1] += sg * bfhi(w.x); s[2] += sg * bflo(w.y); s[3] += sg * bfhi(w.y); s[4] += sg * bflo(w.z); s[5] += sg * bfhi(w.z); s[6] += sg * bflo(w.w); s[7] += sg * bfhi(w.w);
}
template <int WIN> __device__ __forceinline__ void pool_blk(const bf16_t* src, const int sb, const int stride, const int L, const int a0, const int ch, const int mode,
                                                            bf16_t* dst, const int db, const bf16_t* hsrc, const int hb) {
    constexpr int HW = WIN / 2, NT = WIN + 7;
    u32x4 tap[NT];
#pragma unroll
    for (int j = 0; j < NT; ++j) { const int pp = a0 - HW + j; const int pc = min(max(pp, 0), L - 1);
        const u32x4 w = *(const u32x4*)(src + (size_t)(sb + pc * stride) * D + ch);
        tap[j] = (pp >= 0 && pp < L) ? w : (u32x4){0u, 0u, 0u, 0u}; }
    float s[8];
#pragma unroll
    for (int i = 0; i < 8; ++i) s[i] = 0.f;
#pragma unroll
    for (int j = 0; j < WIN; ++j) pool_add(s, tap[j], 1.0f);
#pragma unroll
    for (int i = 0; i < 8; ++i) {
        const int a = a0 + i;
        const float inv = __builtin_amdgcn_rcpf((float)(min(a + HW, L) - max(a - HW, 0)));
        float c8[8];
        if (mode == 1) {
#pragma unroll
            for (int k = 0; k < 8; ++k) c8[k] = 0.f; }
        else { const u32x4 cw = (mode == 0) ? tap[i + HW] : *(const u32x4*)(hsrc + (size_t)(hb + a * stride) * D + ch);
            c8[0] = bflo(cw.x); c8[1] = bfhi(cw.x); c8[2] = bflo(cw.y); c8[3] = bfhi(cw.y); c8[4] = bflo(cw.z); c8[5] = bfhi(cw.z); c8[6] = bflo(cw.w); c8[7] = bfhi(cw.w); }
        u32x4 o; o.x = cvt_pk_bf16(s[0] * inv - c8[0], s[1] * inv - c8[1]); o.y = cvt_pk_bf16(s[2] * inv - c8[2], s[3] * inv - c8[3]);
        o.z = cvt_pk_bf16(s[4] * inv - c8[4], s[5] * inv - c8[5]); o.w = cvt_pk_bf16(s[6] * inv - c8[6], s[7] * inv - c8[7]);
        *(u32x4*)(dst + (size_t)(db + a * stride) * D + ch) = o;
        if (i < 7) { pool_add(s, tap[i + WIN], 1.0f); pool_add(s, tap[i], -1.0f); }
    }
}
template <int WIN> __device__ __forceinline__ void pool_unit(CP p, const int pass, const int v, const int gi, const int lane) {
    const bf16_t* h = (const bf16_t*)(p->ws + OFF_A); bf16_t* t1 = (bf16_t*)(p->ws + OFF_B); bf16_t* dl = (bf16_t*)(p->ws + OFF_D);
    const int ch = gi * 256 + 8 * (lane & 31), sub = (lane >> 5) * 8;
    if (pass == 0) {
        if (v < 512) { const int seq = v >> 4, k = v & 15; pool_blk<WIN>(h, seq * 256, 1, 256, 16 * k + sub, ch, 0, dl, seq * 256, h, 0); }
        else { const int w = v - 512, b = w >> 7, cc = (w >> 1) & 63, k = w & 1;
            pool_blk<WIN>(h, MP + b * 2048 + cc, 64, 32, 16 * k + sub, ch, 1, t1, b * 2048 + cc, h, 0); }
    } else { const int b = v >> 7, r = (v >> 2) & 31, k = v & 3;
        pool_blk<WIN>(t1, b * 2048 + r * 64, 1, 64, 16 * k + sub, ch, 2, dl, MP + b * 2048 + r * 64, h, MP + b * 2048 + r * 64); }
}
__device__ void pool_pass(CP p, int pass, const Tix tx) {
    const int lane = tx.tid & 63, wid = tx.tid >> 6;
    const int total = (pass == 0 ? 1536 : 1024) * 4;
    for (int u = tx.bid * 8 + wid; u < total; u += tx.gd * 8) {
        const int gi = u & 3, v = u >> 2;
        if (gi == 0) pool_unit<2>(p, pass, v, 0, lane); else if (gi == 1) pool_unit<4>(p, pass, v, 1, lane);
        else if (gi == 2) pool_unit<8>(p, pass, v, 2, lane); else pool_unit<16>(p, pass, v, 3, lane);
    }
}

constexpr int SST = 324;
constexpr int SBUF = 16 * SST + 64;
template <int VAR> __device__ void scan_phase(CP p, const bf16_t* W, LAS float* lf, const Tix tx, const int skipmask) {
    const int tid = tx.tid, lane = tid & 63, wid = tid >> 6, grp = wid >> 2, q = wid & 3;
    const int l15 = lane & 15, quad = lane >> 4, rl = lane >> 3, cg8 = lane & 7, i0 = 16 * q + 2 * rl;
    const bf16_t* rb = (const bf16_t*)(p->ws + OFF_C); const bf16_t* kb = (const bf16_t*)(p->ws + OFF_D); const bf16_t* vb = (const bf16_t*)(p->ws + OFF_E);
    const bf16_t* lb = (const bf16_t*)(p->ws + OFF_S);
    bf16_t* yout = (bf16_t*)(p->ws + OFF_A);
    float* cbp = (float*)(p->ws + OFF_CBP);
    const int tch = grp == 0 ? 128 : 16, nsub = grp == 0 ? 1 : ((skipmask & 8) ? 0 : 4);
    for (int it = tx.bid; it < 256; it += tx.gd) {
        f32x2 Sa[4], Sb[4];
        bf16x8 W2f[2], A2f[2];
        LAS float* ystage = lf + 4 * SBUF + 8 * 144 + wid * 1024;
        LAS float* wcst = lf + 4 * SBUF + wid * 144;
#pragma unroll
        for (int i = 0; i < 4; ++i) { Sa[i] = (f32x2){0.f, 0.f}; Sb[i] = (f32x2){0.f, 0.f}; }
        W2f[0] = W2f[1] = A2f[0] = A2f[1] = (bf16x8){0, 0, 0, 0, 0, 0, 0, 0};
        u32x2 pr = (u32x2){0u, 0u}, pk = pr, pv = pr; u32x4 pkf0 = (u32x4){0u, 0u, 0u, 0u}, pkf1 = pkf0; bf16x8 plw0 = (bf16x8){0, 0, 0, 0, 0, 0, 0, 0}, plw1 = plw0, pla0 = plw0, pla1 = plw0;
        int mn = 0, dn = 0, hhn = 0, scn = 0, slg = 0; bool sact = false;
        for (int c = -2; c < 128; ++c) {
#pragma unroll 1
          for (int slot = 0; slot < 2; ++slot) {
            if ((slot == 0) == (grp == 1)) {
                if (sact && !(skipmask & 2)) {
                    f32x4 aw = (f32x4){0.f, 0.f, 0.f, 0.f}, aa = aw;
                    aw = __builtin_amdgcn_mfma_f32_16x16x32_bf16(W2f[0], plw0, aw, 0, 0, 0); aw = __builtin_amdgcn_mfma_f32_16x16x32_bf16(W2f[1], plw1, aw, 0, 0, 0);
                    aa = __builtin_amdgcn_mfma_f32_16x16x32_bf16(A2f[0], pla0, aa, 0, 0, 0); aa = __builtin_amdgcn_mfma_f32_16x16x32_bf16(A2f[1], pla1, aa, 0, 0, 0);
                    const f32x4 cw0 = *(const LAS f32x4*)(wcst + 4 * quad), ca0 = *(const LAS f32x4*)(wcst + 16 + 4 * quad), ckk = *(const LAS f32x4*)(wcst + 32 + 4 * quad), cka = *(const LAS f32x4*)(wcst + 48 + 4 * quad), crk = *(const LAS f32x4*)(wcst + 64 + 4 * quad);
                    f32x4 kn[4];
    #pragma unroll
                    for (int i = 0; i < 4; ++i) kn[i] = *(const LAS f32x4*)(wcst + 80 + 16 * quad + 4 * i);
                    float ssq = 0.f;
                    { const unsigned kw[8] = {pkf0.x, pkf0.y, pkf0.z, pkf0.w, pkf1.x, pkf1.y, pkf1.z, pkf1.w};
    #pragma unroll
                      for (int i = 0; i < 8; ++i) { const float a = bflo(kw[i]) * kn[i >> 1][(i & 1) * 2], b2 = bfhi(kw[i]) * kn[i >> 1][(i & 1) * 2 + 1]; ssq += a * a + b2 * b2; } }
                    { auto s1 = __builtin_amdgcn_permlane16_swap(__float_as_uint(ssq), __float_as_uint(ssq), false, false); ssq = __uint_as_float(s1[0]) + __uint_as_float(s1[1]);
                      auto s2 = __builtin_amdgcn_permlane32_swap(__float_as_uint(ssq), __float_as_uint(ssq), false, false); ssq = __uint_as_float(s2[0]) + __uint_as_float(s2[1]); }
                    const float rn = fminf(__builtin_amdgcn_rsqf(ssq), 1e12f);
                    const f32x4 r4 = (f32x4){bflo(pr.x), bfhi(pr.x), bflo(pr.y), bfhi(pr.y)}, k4 = (f32x4){bflo(pk.x), bfhi(pk.x), bflo(pk.y), bfhi(pk.y)}, v4 = (f32x4){bflo(pv.x), bfhi(pv.x), bflo(pv.y), bfhi(pv.y)};
                    f32x4 e4, E4, kk4, b4, kd4, rh4, cs4; float cbs = 0.f;
    #pragma unroll
                    for (int j = 0; j < 4; ++j) { e4[j] = 0.60653066f * fast_sigmoid(cw0[j] + aw[j]);
                        float t = e4[j];
                        t += __builtin_bit_cast(float, __builtin_amdgcn_update_dpp(0, __builtin_bit_cast(int, t), 0x111, 0xf, 0xf, true));
                        t += __builtin_bit_cast(float, __builtin_amdgcn_update_dpp(0, __builtin_bit_cast(int, t), 0x112, 0xf, 0xf, true));
                        t += __builtin_bit_cast(float, __builtin_amdgcn_update_dpp(0, __builtin_bit_cast(int, t), 0x114, 0xf, 0xf, true));
                        t += __builtin_bit_cast(float, __builtin_amdgcn_update_dpp(0, __builtin_bit_cast(int, t), 0x118, 0xf, 0xf, true));
                        E4[j] = t; }
    #pragma unroll
                    for (int j = 0; j < 4; ++j) {
                        const float a = fast_sigmoid(ca0[j] + aa[j]);
                        const float kkn = k4[j] * ckk[j] * rn, bq = kkn * a, kd = k4[j] * (1.0f + (a - 1.0f) * cka[j]);
                        cbs += r4[j] * kd * crk[j];
                        const float cs = __expf(-E4[j]), cinv = __builtin_amdgcn_rcpf(cs);
                        const float cp = __builtin_bit_cast(float, __builtin_amdgcn_update_dpp(0x3f800000, __builtin_bit_cast(int, cs), 0x111, 0xf, 0xf, false));
                        kk4[j] = kkn * cp; b4[j] = bq * cinv; kd4[j] = kd * cinv; rh4[j] = r4[j] * cs; cs4[j] = cs; }
                    LAS float* wb = lf + (slg * 2 + (scn & 1)) * SBUF;
                    LAS float* wp = wb + l15 * SST + 16 * q + 4 * quad;
                    *(LAS f32x4*)(wp) = kk4; *(LAS f32x4*)(wp + 64) = b4; *(LAS f32x4*)(wp + 128) = kd4; *(LAS f32x4*)(wp + 192) = rh4; *(LAS f32x4*)(wp + 256) = v4;
                    if (l15 == 15) *(LAS f32x4*)(wb + 16 * SST + 16 * q + 4 * quad) = cs4;
                    { auto s1 = __builtin_amdgcn_permlane16_swap(__float_as_uint(cbs), __float_as_uint(cbs), false, false); cbs = __uint_as_float(s1[0]) + __uint_as_float(s1[1]);
                      auto s2 = __builtin_amdgcn_permlane32_swap(__float_as_uint(cbs), __float_as_uint(cbs), false, false); cbs = __uint_as_float(s2[0]) + __uint_as_float(s2[1]); }
                    if (quad == 0) cbp[(((size_t)dn * MT + mn) * 16 + hhn) * 4 + q] = cbs;
                }
            }
            if (slot == 0) {
                const int cn = c + 1 + grp; const int g1len = ((skipmask & 8) ? 0 : 4) * 16;
                const int lg = (grp == 1 && cn >= g1len) ? 0 : grp;
                const int ltch = lg == 0 ? 128 : 16; const int subn = cn / ltch, ccn = cn % ltch;
                const bool actn = (cn >= 0) && (cn < 128) && (grp == 1 || cn < g1len);
                sact = actn; scn = cn; slg = lg;
                if (actn && !(skipmask & 4)) {
                    const int pid = lg == 0 ? it : 4 * it + subn; dn = pid & 1; hhn = (pid >> 1) & 15; const int b = pid >> 5;
                    const int T = lg == 0 ? 2048 : 256, mb = lg == 0 ? MP + b * 2048 : b * 256;
                    const int pos = ccn * 16 + l15; mn = mb + (dn == 0 ? pos : T - 1 - pos);
                    const int col4 = 64 * hhn + 16 * q + 4 * quad;
                    pr = *(const u32x2*)(rb + (size_t)mn * D + col4); pk = *(const u32x2*)(kb + (size_t)mn * D + col4); pv = *(const u32x2*)(vb + (size_t)mn * D + col4);
                    pkf0 = *(const u32x4*)(kb + (size_t)mn * D + 64 * hhn + 16 * quad); pkf1 = *(const u32x4*)(kb + (size_t)mn * D + 64 * hhn + 16 * quad + 8);
                    plw0 = *(const bf16x8*)(lb + (size_t)mn * 384 + dn * 64 + 8 * quad); plw1 = *(const bf16x8*)(lb + (size_t)mn * 384 + dn * 64 + 32 + 8 * quad);
                    pla0 = *(const bf16x8*)(lb + (size_t)mn * 384 + 128 + dn * 64 + 8 * quad); pla1 = *(const bf16x8*)(lb + (size_t)mn * 384 + 128 + dn * 64 + 32 + 8 * quad);
                    if (ccn == 0 || (grp == 1 && lg == 0 && cn == g1len)) {
                        const bf16_t* w2r = W + W_W2L + ((size_t)dn * 1024 + 64 * hhn + 16 * q + l15) * 64 + 8 * quad;
                        const bf16_t* a2r = W + W_A2L + ((size_t)dn * 1024 + 64 * hhn + 16 * q + l15) * 64 + 8 * quad;
                        W2f[0] = *(const bf16x8*)w2r; W2f[1] = *(const bf16x8*)(w2r + 32); A2f[0] = *(const bf16x8*)a2r; A2f[1] = *(const bf16x8*)(a2r + 32);
                        const int cw = 64 * hhn + 16 * q + l15;
                        if (lane < 16) { wcst[lane] = p->in[15][dn * D + cw]; wcst[16 + lane] = p->in[18][dn * D + cw]; wcst[32 + lane] = p->in[23][cw]; wcst[48 + lane] = p->in[24][cw]; wcst[64 + lane] = p->in[25][cw]; }
                        wcst[80 + lane] = p->in[23][64 * hhn + lane];
                    }
                }
                const int sub = c < 0 ? 0 : c / tch, cc = c < 0 ? 0 : c % tch; const bool act = (c >= 0) && (sub < nsub);
                if (act && !(skipmask & 1)) {
                    const int pid = grp == 0 ? it : 4 * it + sub; const int d = pid & 1, hh = (pid >> 1) & 15, b = pid >> 5;
                    const int T = grp == 0 ? 2048 : 256, mb = grp == 0 ? MP + b * 2048 : b * 256;
                    if (cc == 0) {
                        if (grp == 0) { const float* s0 = (d == 0 ? p->in[3] : p->in[4]) + ((size_t)(b * 16 + hh) * 64 + i0) * 64 + 8 * cg8;
                            const f32x4 a0 = *(const f32x4*)s0, a1 = *(const f32x4*)(s0 + 4), b0 = *(const f32x4*)(s0 + 64), b1 = *(const f32x4*)(s0 + 68);
                            Sa[0] = a0.lo; Sa[1] = a0.hi; Sa[2] = a1.lo; Sa[3] = a1.hi; Sb[0] = b0.lo; Sb[1] = b0.hi; Sb[2] = b1.lo; Sb[3] = b1.hi; }
                        else {
    #pragma unroll
                            for (int i = 0; i < 4; ++i) { Sa[i] = (f32x2){0.f, 0.f}; Sb[i] = (f32x2){0.f, 0.f}; } }
                    }
                    const LAS float* bp0 = lf + (grp * 2 + (c & 1)) * SBUF;
                    bf16_t* yo = yout + (size_t)d * MT * D + 64 * hh + i0;
                    f32x4 nk0, nk1, nb0, nb1, nd0, nd1; f32x2 nv; f32x2 rp[4];
    #define SCAN_LOAD_K(s_) do { const LAS float* bp_ = bp0 + (s_) * SST + 8 * cg8; nk0 = *(const LAS f32x4*)(bp_); nk1 = *(const LAS f32x4*)(bp_ + 4); } while (0)
    #define SCAN_LOAD_R(s_) do { const LAS float* bp_ = bp0 + (s_) * SST + 8 * cg8; const f32x4 r0_ = *(const LAS f32x4*)(bp_ + 192), r1_ = *(const LAS f32x4*)(bp_ + 196); rp[0] = r0_.lo; rp[1] = r0_.hi; rp[2] = r1_.lo; rp[3] = r1_.hi; } while (0)
    #define SCAN_LOAD_B(s_) do { const LAS float* bp_ = bp0 + (s_) * SST + 8 * cg8; nb0 = *(const LAS f32x4*)(bp_ + 64); nb1 = *(const LAS f32x4*)(bp_ + 68); \
                        nd0 = *(const LAS f32x4*)(bp_ + 128); nd1 = *(const LAS f32x4*)(bp_ + 132); nv = *(const LAS f32x2*)(bp0 + (s_) * SST + 256 + i0); } while (0)
                    SCAN_LOAD_K(0); SCAN_LOAD_B(0);
    #pragma unroll
                    for (int i = 0; i < 4; ++i) rp[i] = (f32x2){0.f, 0.f};
    #define SCAN_YFLUSH(b_) do { const LAS float* ys_ = ystage + cg8 * 128 + 16 * rl; const f32x4 q0_ = *(const LAS f32x4*)(ys_), q1_ = *(const LAS f32x4*)(ys_ + 4), q2_ = *(const LAS f32x4*)(ys_ + 8), q3_ = *(const LAS f32x4*)(ys_ + 12); \
                        const float ye_ = ((q0_[0] + q0_[2]) + (q1_[0] + q1_[2])) + ((q2_[0] + q2_[2]) + (q3_[0] + q3_[2])), yo_ = ((q0_[1] + q0_[3]) + (q1_[1] + q1_[3])) + ((q2_[1] + q2_[3]) + (q3_[1] + q3_[3])); \
                        const int pos_ = cc * 16 + 8 * (b_) + cg8; const int m_ = mb + (d == 0 ? pos_ : T - 1 - pos_); *(unsigned*)(yo + (size_t)m_ * D) = cvt_pk_bf16(ye_, yo_); } while (0)
    #pragma unroll
                    for (int s = 0; s < 16; ++s) {
                        const f32x2 kk[4] = {nk0.lo, nk0.hi, nk1.lo, nk1.hi};
                        f32x2 pa = Sa[0] * kk[0], pb = Sb[0] * kk[0], ya = Sa[0] * rp[0], yb = Sb[0] * rp[0];
    #pragma unroll
                        for (int i = 1; i < 4; ++i) { pa = Sa[i] * kk[i] + pa; pb = Sb[i] * kk[i] + pb; ya = Sa[i] * rp[i] + ya; yb = Sb[i] * rp[i] + yb; }
                        if (s < 15 && !(VAR & 2)) SCAN_LOAD_K(s + 1);
                        if (!(VAR & 2)) SCAN_LOAD_R(s);
                        float sa0 = pa.x + pa.y, sa1 = pb.x + pb.y;
                        if (s > 0) *(LAS f32x2*)(ystage + ((s - 1) & 7) * 128 + 2 * lane) = (f32x2){ya.x + ya.y, yb.x + yb.y};
                        sa0 += dpp_f<0xB1>(sa0); sa1 += dpp_f<0xB1>(sa1);
                        sa0 += dpp_f<0x4E>(sa0); sa1 += dpp_f<0x4E>(sa1);
                        sa0 += dpp_f<0x141>(sa0); sa1 += dpp_f<0x141>(sa1);
                        const f32x2 bb[4] = {nb0.lo, nb0.hi, nb1.lo, nb1.hi}, dd[4] = {nd0.lo, nd0.hi, nd1.lo, nd1.hi};
                        const f32x2 n0 = (f32x2){-sa0, -sa0}, n1 = (f32x2){-sa1, -sa1}, v0 = (f32x2){nv.x, nv.x}, v1 = (f32x2){nv.y, nv.y};
    #pragma unroll
                        for (int i = 0; i < 4; ++i) { Sa[i] = n0 * bb[i] + Sa[i]; Sb[i] = n1 * bb[i] + Sb[i]; Sa[i] = v0 * dd[i] + Sa[i]; Sb[i] = v1 * dd[i] + Sb[i]; }
                        if (s < 15 && !(VAR & 1)) SCAN_LOAD_B(s + 1);
                        if (s == 8) SCAN_YFLUSH(0);
                    }
                    {
                        f32x2 ya = Sa[0] * rp[0], yb = Sb[0] * rp[0];
    #pragma unroll
                        for (int i = 1; i < 4; ++i) { ya = Sa[i] * rp[i] + ya; yb = Sb[i] * rp[i] + yb; }
                        *(LAS f32x2*)(ystage + 7 * 128 + 2 * lane) = (f32x2){ya.x + ya.y, yb.x + yb.y};
                        const f32x4 c0 = *(const LAS f32x4*)(bp0 + 16 * SST + 8 * cg8), c1 = *(const LAS f32x4*)(bp0 + 16 * SST + 8 * cg8 + 4);
                        Sa[0] *= c0.lo; Sa[1] *= c0.hi; Sa[2] *= c1.lo; Sa[3] *= c1.hi; Sb[0] *= c0.lo; Sb[1] *= c0.hi; Sb[2] *= c1.lo; Sb[3] *= c1.hi;
                        SCAN_YFLUSH(1);
                    }
    #undef SCAN_YFLUSH
    #undef SCAN_LOAD_K
    #undef SCAN_LOAD_R
    #undef SCAN_LOAD_B
                    if (grp == 1 && cc == tch - 1) {
                        float* sf = p->out + (size_t)MT * D + (size_t)d * (32 * 16 * 4096) + ((size_t)(b * 16 + hh) * 64 + i0) * 64 + 8 * cg8;
                        *(f32x4*)sf = (f32x4){Sa[0].x, Sa[0].y, Sa[1].x, Sa[1].y}; *(f32x4*)(sf + 4) = (f32x4){Sa[2].x, Sa[2].y, Sa[3].x, Sa[3].y};
                        *(f32x4*)(sf + 64) = (f32x4){Sb[0].x, Sb[0].y, Sb[1].x, Sb[1].y}; *(f32x4*)(sf + 68) = (f32x4){Sb[2].x, Sb[2].y, Sb[3].x, Sb[3].y};
                    }
                }
            }
          }
            asm volatile("s_waitcnt lgkmcnt(0)" ::: "memory"); __builtin_amdgcn_s_barrier(); asm volatile("" ::: "memory");
        }
    }
}

#define XB_TMO      128
#define XB_XCNT(j)  (256  + 64 * (j))
#define XB_XSUB(j)  (1280 + 64 * (j))
#define XB_XGEN(j)  (2304 + 64 * (j))
#define XB_TOP      3328
#define XB_TOPGEN   3392
#define XCD_BAR_WORDS 3456
#define XB_SPIN_CAP (1u << 18)

__device__ __forceinline__ unsigned xb_ld(unsigned* p)              { return __hip_atomic_load(p, __ATOMIC_RELAXED, __HIP_MEMORY_SCOPE_AGENT); }
__device__ __forceinline__ unsigned xb_add(unsigned* p, unsigned v) { return __hip_atomic_fetch_add(p, v, __ATOMIC_RELAXED, __HIP_MEMORY_SCOPE_AGENT); }
__device__ __forceinline__ unsigned xb_xcc_id() { return (unsigned)__builtin_amdgcn_s_getreg((3 << 11) | 20) & 0xFu; }
#define XB_SPIN(cond, bar) do { unsigned _sp = 0; while (cond) { __builtin_amdgcn_s_sleep(1); \
    if ((++_sp & 255u) == 0u) { if (xb_ld(&(bar)[XB_TMO])) break; if (_sp > XB_SPIN_CAP) { atomicAdd(&(bar)[XB_TMO], 1u); break; } } } } while (0)

struct XcdBarrier {
    unsigned* bar; unsigned x;
    volatile LAS unsigned* st;
};

__device__ __forceinline__ XcdBarrier xcd_barrier_post(unsigned* bar, volatile LAS unsigned* st) {
    XcdBarrier b; b.bar = bar; b.x = xb_xcc_id(); b.st = st;
    if (threadIdx.x == 0) (void)xb_add(&bar[XB_XCNT(b.x)], 1u);
    return b;
}
__device__ __forceinline__ void xcd_barrier_complete(unsigned* bar, unsigned x, unsigned& nloc, unsigned& nx) {
    const unsigned G = gridDim.x * gridDim.y * gridDim.z;
    unsigned sum, cnt, mine, sp = 0u;
    for (;;) {
        sum = 0u; cnt = 0u; mine = 0u;
#pragma unroll
        for (unsigned j = 0; j < 16; ++j) { const unsigned c = xb_ld(&bar[XB_XCNT(j)]); sum += c; cnt += (c > 0u) ? 1u : 0u; mine = (j == x) ? c : mine; }
        if (sum == G) break;
        __builtin_amdgcn_s_sleep(1);
        if ((++sp & 255u) == 0u) { if (xb_ld(&bar[XB_TMO])) break; if (sp > XB_SPIN_CAP) { atomicAdd(&bar[XB_TMO], 1u); break; } }
    }
    nloc = mine > 0u ? mine : 1u; nx = cnt > 0u ? cnt : 1u;
}

__device__ __forceinline__ void xcd_barrier(const XcdBarrier& b) {
    asm volatile("s_waitcnt vmcnt(0)" ::: "memory");
    __syncthreads();
    if (threadIdx.x == 0) {
        unsigned* bar = b.bar;
        __builtin_amdgcn_s_waitcnt(0);
        unsigned nloc = b.st[0], nx = b.st[1];
        if (nloc == 0u) { xcd_barrier_complete(bar, b.x, nloc, nx); b.st[0] = nloc; b.st[1] = nx; }
        const unsigned old = xb_add(&bar[XB_XSUB(b.x)], 1u);
        const unsigned gen = old / nloc;
        if (old + 1u == (gen + 1u) * nloc) {
            __builtin_amdgcn_fence(__ATOMIC_RELEASE, "agent");
            asm volatile("s_waitcnt vmcnt(0)" ::: "memory");
            const unsigned og = xb_add(&bar[XB_TOP], 1u);
            const unsigned tg = og / nx;
            if (og + 1u == (tg + 1u) * nx) xb_add(&bar[XB_TOPGEN], 1u);
            else XB_SPIN(xb_ld(&bar[XB_TOPGEN]) == tg, bar);
            __builtin_amdgcn_fence(__ATOMIC_ACQUIRE, "agent");
            xb_add(&bar[XB_XGEN(b.x)], 1u);
            asm volatile("s_waitcnt vmcnt(0)" ::: "memory");
        } else {
            XB_SPIN(xb_ld(&bar[XB_XGEN(b.x)]) == gen, bar);
            __builtin_amdgcn_fence(__ATOMIC_ACQUIRE, "agent");
            asm volatile("s_waitcnt vmcnt(0)" ::: "memory");
        }
    }
    __syncthreads();
}


constexpr int NPHASE = 24;
#ifndef SPLITK
#define SPLITK 1
#endif
#ifndef ONLYMASK
#define ONLYMASK 0x1ff
#endif
#define EN(k) ((ONLYMASK >> (k)) & 1)
constexpr int LDS_BYTES = 131072 + 16;
__global__ void __launch_bounds__(512, 2) mega(Params kp) {
    extern __shared__ __attribute__((aligned(16))) unsigned char shm[];
    PG8_LAS unsigned char* lds = (PG8_LAS unsigned char*)shm;
    LAS float* lf = (LAS float*)shm;
    cg::grid_group grid = cg::this_grid();
    const int pb = kp.pb, pe = kp.pe;
    volatile LAS unsigned* xst = (volatile LAS unsigned*)(lds + 131072);
    if (threadIdx.x < 2) xst[threadIdx.x] = 0u;
    __syncthreads();
    XcdBarrier xb = xcd_barrier_post((unsigned*)(kp.ws + OFF_BAR), xst);
#ifdef PROBE_SYNC
#pragma unroll 1
    for (int i = 0; i < PROBE_SYNC; ++i) grid.sync();
#endif
#pragma unroll 1
    for (int ph = pb; ph < pe; ++ph) {
        CP p = (CP)__builtin_amdgcn_kernarg_segment_ptr();
        asm volatile("" : "+s"(p));
        Tix tx; { int t_ = threadIdx.x, b_ = blockIdx.x, g_ = gridDim.x; asm volatile("" : "+v"(t_)); asm volatile("" : "+s"(b_), "+s"(g_)); tx.tid = t_; tx.bid = b_; tx.gd = g_; }
        bf16_t* rA = (bf16_t*)(p->ws + OFF_A); bf16_t* rB = (bf16_t*)(p->ws + OFF_B); bf16_t* rC = (bf16_t*)(p->ws + OFF_C); bf16_t* rD = (bf16_t*)(p->ws + OFF_D); bf16_t* rE = (bf16_t*)(p->ws + OFF_E);
        bf16_t* rS = (bf16_t*)(p->ws + OFF_S);
        const int wsel = (ph <= 3) ? 0 : (ph <= 9) ? 1 : (ph <= 12) ? 0 : (ph <= 15) ? 1 : (ph <= 19) ? 0 : 1;
        bf16_t* W = (bf16_t*)(p->ws + (wsel ? OFF_W2 : OFF_W)); bf16_t* Wn = (bf16_t*)(p->ws + (wsel ? OFF_W : OFF_W2));
        const float* npre = p->in[8]; const float* npost = p->in[9];
        int kind = 0;
        RowCfg rc{}; int conv = -1;
        const bf16_t* gA = nullptr; const bf16_t* gB = nullptr; bf16_t* gO = nullptr; int gN = 0, gK = 0, pool_pass_id = 0;
        switch (ph) {
            case 0: kind = 0; break;
            case 1: kind = 1; rc = RowCfg{1, 0, 0, 0, 0.f, npost, 1, 0, 0, 1, npre + 0 * D, 0, SPLITK}; break;
            case 2: case 11: case 14: case 21: kind = 2; conv = (ph == 2) ? 4 : (ph == 11) ? 2 : (ph == 14) ? 5 : -1; break;
            case 3: case 12: case 15: case 22: kind = 3; gA = rB; gB = W + W_W2T; gO = rE; gN = 1024; gK = 2816; break;
            case 4: kind = 4; rc = RowCfg{1, 1, 0, 2, 0.5f, npost + 0 * D, 1, 0, 3, 4, npre + 1 * D, 1, SPLITK}; break;
            case 5: kind = 5; conv = 1; break;
            case 6: kind = 6; break;
            case 7: kind = 3; gA = rS; gB = W + W_BTG; gO = rC; gN = 1024; gK = 384; break;
            case 8: kind = 7; break;
            case 9: kind = 3; gA = rD; gB = W + W_WOT; gO = rE; gN = 1024; gK = 1024; break;
            case 10: kind = 1; rc = RowCfg{0, 1, 0, 5, 1.0f, npost + 1 * D, 1, 0, 6, 7, npre + 2 * D, 1, SPLITK}; break;
            case 13: kind = 1; rc = RowCfg{0, 1, 0, 8, 0.5f, npost + 2 * D, 1, 1, 0, 1, npre + 3 * D, 1, SPLITK}; break;
            case 16: kind = 1; rc = RowCfg{0, 1, 1, 2, 0.5f, npost + 3 * D, 1, 1, 3, 4, npre + 4 * D, 1, SPLITK}; break;
            case 17: kind = 8; pool_pass_id = 0; break;
            case 18: kind = 8; pool_pass_id = 1; break;
            case 19: kind = 3; gA = rD; gB = W; gO = rE; gN = 1024; gK = 1024; conv = 3; break;
            case 20: kind = 1; rc = RowCfg{0, 1, 1, 5, 1.0f, npost + 4 * D, 1, 1, 6, 7, npre + 5 * D, 1, SPLITK}; break;
            case 23: kind = 1; rc = RowCfg{0, 1, 1, 8, 0.5f, npost + 5 * D, 0, 0, 0, 0, npre, 1, SPLITK}; break;
            default: break;
        }
        rc.fsplit = (SPLITK && tx.gd == 256 && ph != 20) ? 1 : 0;
#ifdef PROBE_PH
        const int reps = (ph == PROBE_PH) ? PROBE_N : 1;
#else
        const int reps = 1;
#endif
#pragma unroll 1
        for (int rep = 0; rep < reps; ++rep) {
        if (rep > 0) xcd_barrier(xb);
        asm volatile("" : "+v"(tx.tid)); asm volatile("" : "+s"(tx.bid), "+s"(tx.gd)); asm volatile("" : "+s"(p));
        if (EN(0) && kind == 0) { mod_phase(p, lf, tx); __syncthreads();
            if (tx.gd > 64) { if (tx.bid >= 32) { const Tix tv{tx.tid, tx.bid - 32, tx.gd - 32}; conv_ffn(p, W, 0, lf + 16384, tv); } }
            else conv_ffn(p, W, 0, lf + 16384, tx); }
        else if (EN(1) && kind == 1) { rowpass_simple(p, rc, tx); }
        else if (EN(4) && kind == 4) { rowpass_shift(p, rc, lf, tx); }
        else if (EN(2) && (kind == 2 || kind == 3 || kind == 5)) {
            if (kind == 2) { gA = rA; gB = W + W_W13; gO = rB; gN = 5632; gK = 1024; } else if (kind == 5) { gA = rA; gB = W + W_BTP; gO = rC; gN = 3584; gK = 2048; }
            const int diag = (ph == 19) ? 1 : 0;
            const int bal = (!diag && SPLITK && kind == 3 && gK >= 1024 && tx.gd == 256) ? 1 : 0;
            pg8::Gemm g{gA, gB, MT, gN, gK}; pg8::FwdOrder S; S.init(MT, gN, gK, tx.gd, tx.bid, diag ? 2 : (ph == 7 ? 3 : bal));
            pg8::EpiAll E{kind == 3 ? 0 : (kind == 2 ? 1 : 2), gO, kind == 2 ? DFF : 1024, rS, (bf16_t*)(p->ws + OFF_FB) - (size_t)16384 * 1024};
#ifdef PROBE_NOEPI
            if (rep + 1 < reps) E.kind = 7;
#endif
            pg8::gemm_phase<pg8::EpiAll, pg8::FwdOrder, false>(lds, g, S, E, nullptr, tx.tid);
            if (conv >= 0) { const int nunit = (MT / 256) * (gN / 256), extra = nunit % tx.gd;
                const int half = (bal || extra == 0 || extra > tx.gd / 2) ? 0 : extra; if (tx.bid >= half) { const Tix tv{tx.tid, tx.bid - half, tx.gd - half};
                if (conv < 4) conv_ffn(p, Wn, conv, lf, tv); else if (conv == 4) conv_rwkv(p, Wn, lf, tv); else conv_pool(p, Wn, tv); } } }
        else if (EN(6) && kind == 6) {
#ifdef PROBE_VAR
            if (rep + 1 < reps) scan_phase<PROBE_VAR>(p, W, lf, tx, 0); else scan_phase<0>(p, W, lf, tx, 0);
#elif defined(PROBE_MASK)
            scan_phase<0>(p, W, lf, tx, (rep + 1 < reps) ? PROBE_MASK : 0);
#else
            scan_phase<0>(p, W, lf, tx, 0);
#endif
        }
        else if (EN(7) && kind == 7) rowpass_gn(p, tx);
        else if (EN(8) && kind == 8) pool_pass(p, pool_pass_id, tx);
        }
        if (ph + 1 < pe) { if (pb > pe) grid.sync(); else xcd_barrier(xb); }
    }
}

#include <cstdio>
#ifndef USE_COOP
#define USE_COOP 1
#endif
extern "C" void kernel_launch(void* const* d_in, const int* in_sizes, int n_in, void* d_out, int out_size, void* d_ws, size_t ws_size, hipStream_t stream) {
    static int grid = 0;
    if (grid == 0) {
        if (n_in != NIN || ws_size < WS_NEED) { fprintf(stderr, "kernel_launch: n_in %d ws %zu (need %zu)\n", n_in, ws_size, (size_t)WS_NEED); grid = -1; return; }
        int dev = 0, cus = 0, per_cu = 0;
        hipGetDevice(&dev); hipDeviceGetAttribute(&cus, hipDeviceAttributeMultiprocessorCount, dev);
        if (hipFuncSetAttribute((const void*)mega, hipFuncAttributeMaxDynamicSharedMemorySize, LDS_BYTES) != hipSuccess) { fprintf(stderr, "kernel_launch: hipFuncSetAttribute failed\n"); grid = -1; return; }
        if (hipOccupancyMaxActiveBlocksPerMultiprocessor(&per_cu, (const void*)mega, 512, LDS_BYTES) != hipSuccess || per_cu < 1) { fprintf(stderr, "kernel_launch: occupancy query says %d\n", per_cu); per_cu = 1; }
        (void)hipGetLastError();
        grid = cus * 1;
        if (grid <= 0) grid = 256;
    }
    if (grid < 0) return;
    if (hipMemsetAsync((unsigned char*)d_ws + OFF_BAR, 0, 16384, stream) != hipSuccess) { fprintf(stderr, "kernel_launch: memset of the barrier words failed\n"); return; }
    Params p{};
    for (int i = 0; i < NIN; ++i) p.in[i] = (const float*)d_in[i];
    p.out = (float*)d_out; p.ws = (unsigned char*)d_ws;
#if USE_COOP
    p.pb = 0; p.pe = NPHASE;
    void* args[] = {&p};
    hipError_t e = hipLaunchCooperativeKernel((const void*)mega, dim3(grid), dim3(512), args, LDS_BYTES, stream);
    if (e != hipSuccess) fprintf(stderr, "cooperative launch failed: %s (grid %d)\n", hipGetErrorString(e), grid);
#else
    for (int ph = 0; ph < NPHASE; ++ph) { p.pb = ph; p.pe = ph + 1; hipLaunchKernelGGL(mega, dim3(grid), dim3(512), LDS_BYTES, stream, p); }
#endif
}
```

```cpp
#include <hip/hip_runtime.h>
#include <hip/hip_cooperative_groups.h>
namespace pg8 {
#define PG8_LAS __attribute__((address_space(3)))
typedef unsigned short bf16_t;
typedef short bf16x8 __attribute__((ext_vector_type(8)));
typedef float f32x4 __attribute__((ext_vector_type(4)));
typedef unsigned u32x4 __attribute__((ext_vector_type(4)));
constexpr int BM = 256, BK = 64, HALF = 128, HTB = HALF * BK * 2  , STAGE_BYTES = 8 * HTB, NXCD = 8, WGM = 8;

__host__ __device__ __forceinline__ int lds_byte(int r, int c) { const int st = (r >> 4) * 2 + (c >> 5), rr = r & 15, cc = c & 31, ob = rr * 64 + cc * 2; return st * 1024 + (ob ^ (((ob >> 9) & 1) << 5)); }
__host__ __device__ __forceinline__ void stage_rc(int b, int& R, int& C) { const int st = b / 1024, sb = b % 1024, swz = sb ^ (((sb >> 9) & 1) << 5); R = (st >> 1) * 16 + swz / 64; C = (st & 1) * 32 + (swz % 64) / 2; }
__host__ __device__ __forceinline__ int perm32(int rho) { const int n = rho >> 4, i = rho & 15; return 8 * (i >> 2) + 4 * n + (i & 3); }

struct Unit { int pm, pn, part; };
struct Gemm { const bf16_t* A; const bf16_t* Bt; int M, N, K; };

struct StaticOrder {
    int nM, nN, nwg, G, c;
    __host__ __device__ void init(int M, int N, int G_, int c_) { nM = M / BM; nN = N / BM; nwg = nM * nN; G = G_; c = c_; }
    __host__ __device__ bool next(int i, Unit& u) const {
        const long L = (long)i * G + c; if (L >= nwg) return false;
        int wgid = (int)L; { const int q = nwg / NXCD, r = nwg % NXCD, xcd = wgid % NXCD, off = wgid / NXCD; wgid = (xcd < r ? xcd * (q + 1) : r * (q + 1) + (xcd - r) * q) + off; }
        const int nig = WGM * nN, gid = wgid / nig, fm = gid * WGM, gsz = (nM - fm) < WGM ? (nM - fm) : WGM;
        u.pm = fm + ((wgid % nig) % gsz); u.pn = (wgid % nig) / gsz; u.part = 0; return true;
    }
    __device__ __forceinline__ void a_ready(const Unit&) const {}
    __device__ __forceinline__ void done(const Unit&) const {}
};
struct FwdOrder {
    StaticOrder so; int mode;
    __host__ __device__ void init(int M, int N, int K, int G_, int c_, int mode_) { so.init(M, N, G_, c_); mode = mode_; }
    __host__ __device__ bool next(int i, Unit& u) const {
        if (mode == 0) return so.next(i, u);
        if (mode == 2) { const bool ok = so.next(i, u); u.part = 3; return ok; }
        if (mode == 3) { const bool ok = so.next(i, u); u.part = 4; return ok; }
        if (i >= 2) return false;
        const int w = (so.c & 7) * 32 + (so.c >> 3);
        if (i == 0) { u.pm = w >> 2; u.pn = w & 3; u.part = 0; }
        else { u.pm = 64 + (w >> 3); u.pn = (w >> 1) & 3; u.part = 1 + (w & 1); }
        return true;
    }
    __device__ __forceinline__ void a_ready(const Unit&) const {}
    __device__ __forceinline__ void done(const Unit&) const {}
};
__device__ __forceinline__ unsigned cvt_pk_bf16(float lo, float hi) { unsigned r; asm volatile("v_cvt_pk_bf16_f32 %0, %1, %2" : "=v"(r) : "v"(lo), "v"(hi)); return r; }
typedef float f32x2 __attribute__((ext_vector_type(2)));
__device__ __forceinline__ float fast_sigmoid(float x) { return __builtin_amdgcn_rcpf(1.0f + __expf(-x)); }
__device__ __forceinline__ float fast_tanh(float x) { return 1.0f - 2.0f * __builtin_amdgcn_rcpf(1.0f + __expf(2.0f * x)); }
struct EpiStore {
    static constexpr bool PERM = true, AFTER_DRAIN = false;
    bf16_t* O; int ldc;
    __device__ __forceinline__ void operator()(const f32x4 (&acc)[2][2][4][2], const Unit& u, int wr, int wc, int fr, int fq) const {
        const int row0 = u.pm * BM + wr * 64 + fr, col0 = u.pn * BM + wc * 32 + 8 * fq;
#pragma unroll
        for (int ai = 0; ai < 2; ++ai)
#pragma unroll
            for (int m = 0; m < 4; ++m) { bf16_t* rowp = O + (size_t)(row0 + ai * HALF + m * 16) * ldc + col0;
#pragma unroll
                for (int bj = 0; bj < 2; ++bj) { const f32x4 v0 = acc[ai][bj][m][0], v1 = acc[ai][bj][m][1];
                    u32x4 w; w.x = cvt_pk_bf16(v0[0], v0[1]); w.y = cvt_pk_bf16(v0[2], v0[3]); w.z = cvt_pk_bf16(v1[0], v1[1]); w.w = cvt_pk_bf16(v1[2], v1[3]);
                    *(u32x4*)(rowp + bj * HALF) = w; } }
    }
};
struct EpiSwiglu {
    static constexpr bool PERM = true, AFTER_DRAIN = false;
    bf16_t* O; int ldc;
    __device__ __forceinline__ void operator()(const f32x4 (&acc)[2][2][4][2], const Unit& u, int wr, int wc, int fr, int fq) const {
        const int row0 = u.pm * BM + wr * 64 + fr, col0 = u.pn * HALF + wc * 32 + 8 * fq;
#pragma unroll
        for (int ai = 0; ai < 2; ++ai)
#pragma unroll
            for (int m = 0; m < 4; ++m) { bf16_t* rowp = O + (size_t)(row0 + ai * HALF + m * 16) * ldc + col0;
                float o[8];
#pragma unroll
                for (int n = 0; n < 2; ++n)
#pragma unroll
                    for (int j = 0; j < 4; ++j) { const float a = acc[ai][0][m][n][j], b = acc[ai][1][m][n][j]; o[n * 4 + j] = a * fast_sigmoid(a) * b; }
                u32x4 w; w.x = cvt_pk_bf16(o[0], o[1]); w.y = cvt_pk_bf16(o[2], o[3]); w.z = cvt_pk_bf16(o[4], o[5]); w.w = cvt_pk_bf16(o[6], o[7]);
                *(u32x4*)rowp = w; }
    }
};
struct EpiRkv {
    static constexpr bool PERM = true, AFTER_DRAIN = false;
    bf16_t* O; size_t tstride; bf16_t* L;
    __device__ __forceinline__ void operator()(const f32x4 (&acc)[2][2][4][2], const Unit& u, int wr, int wc, int fr, int fq) const {
        const int row0 = u.pm * BM + wr * 64 + fr;
        if (u.pn < 12) {
            bf16_t* base = O + (size_t)(u.pn >> 2) * tstride; const int col0 = (u.pn & 3) * BM + wc * 32 + 8 * fq;
#pragma unroll
            for (int ai = 0; ai < 2; ++ai)
#pragma unroll
                for (int m = 0; m < 4; ++m) { bf16_t* rowp = base + (size_t)(row0 + ai * HALF + m * 16) * 1024 + col0;
#pragma unroll
                    for (int bj = 0; bj < 2; ++bj) { const f32x4 v0 = acc[ai][bj][m][0], v1 = acc[ai][bj][m][1];
                        u32x4 w; w.x = cvt_pk_bf16(v0[0], v0[1]); w.y = cvt_pk_bf16(v0[2], v0[3]); w.z = cvt_pk_bf16(v1[0], v1[1]); w.w = cvt_pk_bf16(v1[2], v1[3]);
                        *(u32x4*)(rowp + bj * HALF) = w; } }
        } else {
            const int t13 = (u.pn == 13); const int col0 = (u.pn - 12) * BM + wc * 32 + 8 * fq;
#pragma unroll
            for (int ai = 0; ai < 2; ++ai)
#pragma unroll
                for (int m = 0; m < 4; ++m) { bf16_t* rowp = L + (size_t)(row0 + ai * HALF + m * 16) * 384 + col0;
#pragma unroll
                    for (int bj = 0; bj < 2; ++bj) { if (t13 && bj == 1) continue;
                        float o[8];
#pragma unroll
                        for (int n = 0; n < 2; ++n)
#pragma unroll
                            for (int j = 0; j < 4; ++j) { const float a = acc[ai][bj][m][n][j]; o[n * 4 + j] = t13 ? fast_sigmoid(a) : (bj == 0 ? fast_tanh(a) : a); }
                        u32x4 w; w.x = cvt_pk_bf16(o[0], o[1]); w.y = cvt_pk_bf16(o[2], o[3]); w.z = cvt_pk_bf16(o[4], o[5]); w.w = cvt_pk_bf16(o[6], o[7]);
                        *(u32x4*)(rowp + bj * HALF) = w; } }
        }
    }
};

struct EpiAll {
    static constexpr bool PERM = true, AFTER_DRAIN = false;
    int kind; bf16_t* O; int ldc; bf16_t* L; bf16_t* O2;
    __device__ __forceinline__ void operator()(const f32x4 (&acc)[2][2][4][2], const Unit& u, int wr, int wc, int fr, int fq) const {
        if (kind == 0) { EpiStore e{u.part == 2 ? O2 : O, ldc}; e(acc, u, wr, wc, fr, fq); }
        else if (kind == 1) { EpiSwiglu e{O, ldc}; e(acc, u, wr, wc, fr, fq); }
        else if (kind == 2) { EpiRkv e{O, (size_t)24576 * 1024, L}; e(acc, u, wr, wc, fr, fq); }
    }
};
template <class Epi, class Sched, bool STAMP = false>
__device__ __forceinline__ void gemm_phase(PG8_LAS unsigned char* lds, const Gemm g, const Sched& S, const Epi& E, unsigned long long* stamps, const int tid_in) {
    const int tid = tid_in, wid = __builtin_amdgcn_readfirstlane(tid >> 6), lane = tid & 63, wr = wid >> 2, wc = wid & 3, fr = lane & 15, fq = lane >> 4;
    const int K = g.K; int nt = K / BK;
    int ts_lo = 0, ts_hi = 0, nts = 0; const unsigned long long rt_entry = STAMP ? (unsigned long long)wall_clock64() : 0ull;
#define PG8_STAMP() do { if (STAMP && wid == 0 && nts < 64) { const unsigned long long _c = (unsigned long long)clock64(); \
        ts_lo = (lane == nts) ? (int)(unsigned)_c : ts_lo; ts_hi = (lane == nts) ? (int)(unsigned)(_c >> 32) : ts_hi; ++nts; } } while (0)
    PG8_STAMP();
    unsigned voffA[2], voffB[2];
#pragma unroll
    for (int i = 0; i < 2; ++i) { int R, C; stage_rc(tid * 16 + i * 8192, R, C); const int Rb = Epi::PERM ? ((R & ~31) + perm32(R & 31)) : R;
        voffA[i] = (unsigned)(R * K + C) * 2u; voffB[i] = (unsigned)(Rb * K + C) * 2u; }
    const size_t kstep = (size_t)(BK * 2);
    const size_t hstep = (size_t)HALF * K * 2;
    const size_t tstep = 2 * hstep;
    const unsigned ldsw = (unsigned)wid * 1024u;
    const int aoff = lds_byte(wr * 64 + fr, fq * 8), boff = lds_byte(wc * 32 + fr, fq * 8);
#define PG8_SA(b, h) (((b) * 2 + (h)) * HTB)
#define PG8_SB(b, h) ((4 + (b) * 2 + (h)) * HTB)
#define PG8_STAGE(bufoff, gbase, voff) do { _Pragma("unroll") for (int _i = 0; _i < 2; ++_i) \
        __builtin_amdgcn_global_load_lds((const unsigned*)((const char*)(gbase) + (voff)[_i]), (PG8_LAS unsigned*)(lds + (bufoff) + ldsw + _i * 8192), 16, 0, 0); } while (0)
#define PG8_LDA(dst, b, h) do { _Pragma("unroll") for (int m = 0; m < 4; ++m) _Pragma("unroll") for (int k = 0; k < 2; ++k) dst[m][k] = *(const PG8_LAS bf16x8*)(lds + PG8_SA(b, h) + aoff + m * 2048 + k * 1024); } while (0)
#define PG8_LDB(dst, b, h) do { _Pragma("unroll") for (int n = 0; n < 2; ++n) _Pragma("unroll") for (int k = 0; k < 2; ++k) dst[n][k] = *(const PG8_LAS bf16x8*)(lds + PG8_SB(b, h) + boff + n * 2048 + k * 1024); } while (0)
#define PG8_MMA(ai, bj, At, Bt) do { __builtin_amdgcn_s_setprio(1); _Pragma("unroll") for (int m = 0; m < 4; ++m) _Pragma("unroll") for (int n = 0; n < 2; ++n) _Pragma("unroll") for (int k = 0; k < 2; ++k) \
        acc[ai][bj][m][n] = __builtin_amdgcn_mfma_f32_16x16x32_bf16(Bt[n][k], At[m][k], acc[ai][bj][m][n], 0, 0, 0); __builtin_amdgcn_s_setprio(0); } while (0)
#define PG8_WAIT_V(n) asm volatile("s_waitcnt vmcnt(" #n ")" ::: "memory")
#define PG8_WAIT_L(n) asm volatile("s_waitcnt lgkmcnt(" #n ")" ::: "memory")
#define PG8_BAR __builtin_amdgcn_s_barrier()
#define PG8_SCHED __builtin_amdgcn_sched_barrier(0)
    Unit cur, nxt; int ui = 0;
    if (!S.next(0, cur)) return;
    f32x4 acc[2][2][4][2];
#pragma unroll
    for (int a = 0; a < 2; ++a)
#pragma unroll
        for (int b = 0; b < 2; ++b)
#pragma unroll
            for (int m = 0; m < 4; ++m)
#pragma unroll
                for (int n = 0; n < 2; ++n) acc[a][b][m][n] = (f32x4){0.f, 0.f, 0.f, 0.f};
    bf16x8 At[4][2], B0[2][2], B1[2][2];
    const char* cA = (const char*)g.A + (size_t)cur.pm * tstep + (cur.part == 2 ? (size_t)K : cur.part == 3 ? (size_t)cur.pn * 512 : cur.part == 4 ? (size_t)512 : (size_t)0); const char* cB = (const char*)g.Bt + (size_t)cur.pn * tstep + (cur.part == 2 ? (size_t)K : cur.part == 3 ? (size_t)cur.pn * 512 : cur.part == 4 ? (size_t)512 : (size_t)0);
    nt = cur.part == 3 ? 4 : cur.part == 4 ? 2 : cur.part ? K / (2 * BK) : K / BK;
    S.a_ready(cur);
    PG8_STAGE(PG8_SB(0, 0), cB, voffB); PG8_STAGE(PG8_SA(0, 0), cA, voffA); PG8_STAGE(PG8_SB(0, 1), cB + hstep, voffB); PG8_STAGE(PG8_SA(0, 1), cA + hstep, voffA);
    if (wr == 1) PG8_BAR;
    PG8_WAIT_V(4); PG8_BAR;
    PG8_STAGE(PG8_SB(1, 0), cB + kstep, voffB); PG8_STAGE(PG8_SA(1, 0), cA + kstep, voffA); PG8_STAGE(PG8_SB(1, 1), cB + hstep + kstep, voffB);
    PG8_WAIT_V(6); PG8_BAR;
    PG8_STAMP();
    for (;;) {
        const bool has_next = S.next(ui + 1, nxt);
        const char* nA = has_next ? (const char*)g.A + (size_t)nxt.pm * tstep + (nxt.part == 2 ? (size_t)K : nxt.part == 3 ? (size_t)nxt.pn * 512 : nxt.part == 4 ? (size_t)512 : (size_t)0) : cA; const char* nB = has_next ? (const char*)g.Bt + (size_t)nxt.pn * tstep + (nxt.part == 2 ? (size_t)K : nxt.part == 3 ? (size_t)nxt.pn * 512 : nxt.part == 4 ? (size_t)512 : (size_t)0) : cB;
        for (int t = 0; t < nt; t += 2) {
            const bool last = (t == nt - 2);
            const char* a1 = cA + (size_t)(t + 1) * kstep;
            const char* a2 = last ? nA : cA + (size_t)(t + 2) * kstep; const char* b2 = last ? nB : cB + (size_t)(t + 2) * kstep;
            const char* a3 = a2 + kstep; const char* b3 = b2 + kstep;
            if (last && has_next) S.a_ready(nxt);
            PG8_LDB(B0, 0, 0); PG8_SCHED; PG8_LDA(At, 0, 0); PG8_STAGE(PG8_SA(1, 1), a1 + hstep, voffA);
            PG8_WAIT_L(8); PG8_BAR; PG8_WAIT_L(0); PG8_MMA(0, 0, At, B0); PG8_BAR; PG8_SCHED;
            PG8_LDB(B1, 0, 1); PG8_STAGE(PG8_SB(0, 0), b2, voffB);
            PG8_BAR; PG8_WAIT_L(0); PG8_MMA(0, 1, At, B1); PG8_BAR;
            PG8_LDA(At, 0, 1); PG8_STAGE(PG8_SA(0, 0), a2, voffA);
            PG8_BAR; PG8_WAIT_L(0); PG8_MMA(1, 0, At, B0); PG8_BAR; PG8_SCHED;
            PG8_STAGE(PG8_SB(0, 1), b2 + hstep, voffB);
            PG8_WAIT_V(6); PG8_BAR; PG8_MMA(1, 1, At, B1); PG8_BAR;
            PG8_LDB(B0, 1, 0); PG8_SCHED; PG8_LDA(At, 1, 0); PG8_STAGE(PG8_SA(0, 1), a2 + hstep, voffA);
            PG8_WAIT_L(8); PG8_BAR; PG8_WAIT_L(0); PG8_MMA(0, 0, At, B0); PG8_BAR; PG8_SCHED;
            PG8_LDB(B1, 1, 1); PG8_STAGE(PG8_SB(1, 0), b3, voffB);
            PG8_BAR; PG8_WAIT_L(0); PG8_MMA(0, 1, At, B1); PG8_BAR;
            PG8_LDA(At, 1, 1); PG8_STAGE(PG8_SA(1, 0), a3, voffA);
            PG8_BAR; PG8_WAIT_L(0); PG8_MMA(1, 0, At, B0); PG8_BAR; PG8_SCHED;
            PG8_STAGE(PG8_SB(1, 1), b3 + hstep, voffB);
            PG8_WAIT_V(6); PG8_BAR; PG8_MMA(1, 1, At, B1); PG8_BAR;
        }
        PG8_STAMP();
        if constexpr (!Epi::AFTER_DRAIN) { E(acc, cur, wr, wc, fr, fq); S.done(cur); }
        PG8_STAMP();
        if (!has_next) break;
#pragma unroll
        for (int a = 0; a < 2; ++a)
#pragma unroll
            for (int b = 0; b < 2; ++b)
#pragma unroll
                for (int m = 0; m < 4; ++m)
#pragma unroll
                    for (int n = 0; n < 2; ++n) acc[a][b][m][n] = (f32x4){0.f, 0.f, 0.f, 0.f};
        cur = nxt; cA = nA; cB = nB; ++ui; nt = cur.part == 3 ? 4 : cur.part == 4 ? 2 : cur.part ? K / (2 * BK) : K / BK;
    }
    PG8_WAIT_V(0);
    if (wr == 0) PG8_BAR;
    PG8_BAR;
    if constexpr (Epi::AFTER_DRAIN) { E.fused(acc, cur, wr, wc, fr, fq, lds, wid, lane); S.done(cur); }
    PG8_STAMP();
    if (STAMP && wid == 0) { stamps[lane] = lane < nts ? (((unsigned long long)(unsigned)ts_hi << 32) | (unsigned)ts_lo) : 0ull;
        if (lane == 62) stamps[62] = rt_entry; if (lane == 63) stamps[63] = (unsigned long long)wall_clock64(); }
#undef PG8_STAMP
#undef PG8_SA
#undef PG8_SB
#undef PG8_STAGE
#undef PG8_LDA
#undef PG8_LDB
#undef PG8_MMA
#undef PG8_WAIT_V
#undef PG8_WAIT_L
#undef PG8_BAR
#undef PG8_SCHED
}
}

namespace cg = cooperative_groups;
using pg8::bf16_t; using pg8::bf16x8; using pg8::f32x4; using pg8::u32x4; using pg8::cvt_pk_bf16; using pg8::fast_sigmoid;
#define LAS __attribute__((address_space(3)))
typedef float f32x2 __attribute__((ext_vector_type(2)));
typedef unsigned u32x2 __attribute__((ext_vector_type(2)));

constexpr int D = 1024, DFF = 2816, MP = 8192, MS = 16384, MT = 24576;
constexpr int NIN = 31;
constexpr size_t R48 = (size_t)MT * 1024 * 2;
constexpr size_t OFF_A = 0, OFF_B = R48, OFF_C = 2 * R48, OFF_D = 3 * R48, OFF_E = 4 * R48;
constexpr size_t OFF_S = 5 * R48;
constexpr size_t OFF_W = OFF_S + (size_t)MT * 384 * 2;
constexpr size_t W_ELEMS = 9043968;
constexpr size_t OFF_MOD = OFF_W + W_ELEMS * 2;
constexpr size_t OFF_CBP = OFF_MOD + (size_t)9 * 2 * 9216 * 4;
constexpr size_t OFF_BAR = OFF_CBP + (size_t)2 * MT * 64 * 4;
constexpr size_t OFF_W2 = OFF_BAR + 16384;
constexpr size_t OFF_FB = OFF_W2 + W_ELEMS * 2;
constexpr size_t WS_NEED = OFF_FB + (size_t)8192 * 1024 * 2;
constexpr size_t W_W13 = 0, W_W2T = (size_t)5632 * 1024;
constexpr size_t W_BTP = 0, W_BTG = (size_t)3584 * 2048, W_WOT = W_BTG + (size_t)1024 * 384, W_W2L = W_WOT + (size_t)1024 * 1024, W_A2L = W_W2L + 131072;
constexpr float RMS_EPS = 1e-6f, GN_EPS = 64e-5f;

struct Tix { int tid, bid, gd; };
struct Params { const float* in[NIN]; float* out; unsigned char* ws; int pb, pe; };
typedef const Params __attribute__((address_space(4)))* CP;

__device__ __forceinline__ float bf2f(unsigned short b) { return __uint_as_float(((unsigned)b) << 16); }
__device__ __forceinline__ float bflo(unsigned w) { return __uint_as_float(w << 16); }
__device__ __forceinline__ float bfhi(unsigned w) { return __uint_as_float(w & 0xffff0000u); }
template <int CTRL> __device__ __forceinline__ float dpp_f(float x) { return __builtin_bit_cast(float, __builtin_amdgcn_mov_dpp(__builtin_bit_cast(int, x), CTRL, 0xf, 0xf, true)); }
__device__ __forceinline__ float row16_sum(float v) { v += dpp_f<0xB1>(v); v += dpp_f<0x4E>(v); v += dpp_f<0x141>(v); v += dpp_f<0x128>(v); return v; }
__device__ __forceinline__ float wave_sum(float v) {
    v = row16_sum(v);
    auto s1 = __builtin_amdgcn_permlane16_swap(__float_as_uint(v), __float_as_uint(v), false, false); v = __uint_as_float(s1[0]) + __uint_as_float(s1[1]);
    auto s2 = __builtin_amdgcn_permlane32_swap(__float_as_uint(v), __float_as_uint(v), false, false); v = __uint_as_float(s2[0]) + __uint_as_float(s2[1]);
    return v;
}
__device__ __forceinline__ float reduce8(float x) { x += dpp_f<0xB1>(x); x += dpp_f<0x4E>(x); x += dpp_f<0x141>(x); return x; }

struct ConvJob { const float* src; int K, N; bf16_t* dst; int dld, kofs, blk, blk_stride, row_off; const float* ksc; };
__device__ __forceinline__ void conv_job(const ConvJob j, LAS float* tile, int& rot, const Tix tx) {
    const int tid = tx.tid, G = tx.gd;
    const int tn = j.N >> 6, nt = (j.K >> 6) * tn;
    int t0 = (tx.bid - (rot % G) + G) % G;
    for (int t = t0; t < nt; t += G) {
        const int k0 = (t / tn) << 6, n0 = (t % tn) << 6;
        { const int r = tid >> 4, c4 = tid & 15;
#pragma unroll
          for (int it = 0; it < 2; ++it) { const int k = r + 32 * it; const float4 v = *(const float4*)(j.src + (size_t)(k0 + k) * j.N + n0 + 4 * c4);
              LAS float* tp = tile + k * 65 + 4 * c4; tp[0] = v.x; tp[1] = v.y; tp[2] = v.z; tp[3] = v.w; } }
        __syncthreads();
        { const int n = tid >> 3, kg = tid & 7; float v[8];
#pragma unroll
          for (int i = 0; i < 8; ++i) { v[i] = tile[(8 * kg + i) * 65 + n]; if (j.ksc) v[i] *= j.ksc[k0 + 8 * kg + i]; }
          u32x4 w; w.x = cvt_pk_bf16(v[0], v[1]); w.y = cvt_pk_bf16(v[2], v[3]); w.z = cvt_pk_bf16(v[4], v[5]); w.w = cvt_pk_bf16(v[6], v[7]);
          const int gn = n0 + n; const int drow = (gn / j.blk) * j.blk_stride + (gn % j.blk) + j.row_off;
          *(u32x4*)(j.dst + (size_t)drow * j.dld + j.kofs + k0 + 8 * kg) = w; }
        __syncthreads();
    }
    rot += nt;
}
__device__ void conv_ffn(CP p, bf16_t* W, int fi, LAS float* tile, const Tix tx) {
    int rot = 0;
    conv_job(ConvJob{p->in[10] + (size_t)fi * D * DFF, D, DFF, W + W_W13, 1024, 0, 128, 256, 0, nullptr}, tile, rot, tx);
    conv_job(ConvJob{p->in[11] + (size_t)fi * D * DFF, D, DFF, W + W_W13, 1024, 0, 128, 256, 128, nullptr}, tile, rot, tx);
    conv_job(ConvJob{p->in[12] + (size_t)fi * D * DFF, DFF, D, W + W_W2T, 2816, 0, 1024, 1024, 0, nullptr}, tile, rot, tx);
}
__device__ void conv_rwkv(CP p, bf16_t* W, LAS float* tile, const Tix tx) {
    int rot = 0;
    const float* mu = p->in[13];
    for (int half = 0; half < 2; ++half) {
        const int ko = half * 1024;
        for (int i = 0; i < 3; ++i) { const int mi = (i == 0) ? 0 : (i == 1 ? 2 : 3);
            conv_job(ConvJob{p->in[14] + (size_t)i * D * D, D, D, W + W_BTP, 2048, ko, 1024, 1024, i * 1024, half ? mu + mi * D : nullptr}, tile, rot, tx); }
        for (int d = 0; d < 2; ++d) {
            conv_job(ConvJob{p->in[16] + (size_t)d * D * 64, D, 64, W + W_BTP, 2048, ko, 64, 64, 3072 + 64 * d, half ? mu + 1 * D : nullptr}, tile, rot, tx);
            conv_job(ConvJob{p->in[19] + (size_t)d * D * 64, D, 64, W + W_BTP, 2048, ko, 64, 64, 3200 + 64 * d, half ? mu + 4 * D : nullptr}, tile, rot, tx); }
        conv_job(ConvJob{p->in[21], D, 128, W + W_BTP, 2048, ko, 128, 128, 3328, half ? mu + 5 * D : nullptr}, tile, rot, tx);
    }
    conv_job(ConvJob{p->in[22], 128, D, W + W_BTG, 384, 256, 1024, 1024, 0, nullptr}, tile, rot, tx);
    for (int idx = tx.bid * 512 + tx.tid; idx < 1024 * 32; idx += tx.gd * 512) { const int n = idx >> 5, k8 = idx & 31; *(u32x4*)(W + W_BTG + (size_t)n * 384 + 8 * k8) = (u32x4){0u, 0u, 0u, 0u}; }
    conv_job(ConvJob{p->in[28], D, D, W + W_WOT, 1024, 0, 1024, 1024, 0, nullptr}, tile, rot, tx);
    for (int d = 0; d < 2; ++d) {
        conv_job(ConvJob{p->in[17] + (size_t)d * 64 * D, 64, D, W + W_W2L + (size_t)d * 65536, 64, 0, 1024, 1024, 0, nullptr}, tile, rot, tx);
        conv_job(ConvJob{p->in[20] + (size_t)d * 64 * D, 64, D, W + W_A2L + (size_t)d * 65536, 64, 0, 1024, 1024, 0, nullptr}, tile, rot, tx); }
}
__device__ void conv_pool(CP p, bf16_t* W, const Tix tx) {
    const float* pw = p->in[29]; const float* ps = p->in[30];
    for (int idx = tx.bid * 512 + tx.tid; idx < 1024 * 128; idx += tx.gd * 512) {
        const int k8 = idx >> 10, n = idx & 1023, g = n >> 8; u32x4 w = (u32x4){0u, 0u, 0u, 0u};
        if ((k8 >> 5) == g) { const float s = ps[n]; float v[8];
#pragma unroll
            for (int i = 0; i < 8; ++i) v[i] = pw[((size_t)g * 256 + ((8 * k8 + i) & 255)) * 256 + (n & 255)] * s;
            w.x = cvt_pk_bf16(v[0], v[1]); w.y = cvt_pk_bf16(v[2], v[3]); w.z = cvt_pk_bf16(v[4], v[5]); w.w = cvt_pk_bf16(v[6], v[7]); }
        *(u32x4*)(W + (size_t)n * 1024 + 8 * k8) = w; }
}

__device__ void mod_phase(CP p, LAS float* lf, const Tix tx) {
    LAS float* sc = lf; LAS float* red = lf + 9216;
    const int tid = tx.tid;
    if (tx.bid >= 288) return;
    for (int o = tid; o < 9216; o += 512) { const int c = o >> 10, k = o & 1023; const float v = (c == 0) ? p->in[5][k] : p->in[2][(c - 1) * 1024 + k]; sc[o] = v * fast_sigmoid(v); }
    __syncthreads();
    float* mod = (float*)(p->ws + OFF_MOD);
    for (int item = tx.bid; item < 288; item += tx.gd) {
        const int i = item / 144, n0 = (item % 144) * 64, col = tid & 63, ks = tid >> 6;
        float acc[9];
#pragma unroll
        for (int c = 0; c < 9; ++c) acc[c] = 0.f;
        const float* wp = p->in[6] + ((size_t)i * 1024 + ks * 128) * 9216 + n0 + col;
#pragma unroll 8
        for (int k = 0; k < 128; ++k) { const float w = wp[(size_t)k * 9216];
#pragma unroll
            for (int c = 0; c < 9; ++c) acc[c] += sc[c * 1024 + ks * 128 + k] * w; }
#pragma unroll
        for (int c = 0; c < 9; ++c) red[(ks * 9 + c) * 64 + col] = acc[c];
        __syncthreads();
        for (int o = tid; o < 576; o += 512) { const int c = o >> 6, cl = o & 63; float s = p->in[7][i * 9216 + n0 + cl];
#pragma unroll
            for (int k2 = 0; k2 < 8; ++k2) s += red[(k2 * 9 + c) * 64 + cl];
            mod[((size_t)c * 2 + i) * 9216 + n0 + cl] = s; }
        __syncthreads();
    }
}

struct RowCfg {
    int src_input;
    int pending;
    int lg, gidx; float coef; const float* npost;
    int has_next;
    int lh, shidx, scidx; const float* npre;
    int write_x;
    int fsplit;
};
__device__ __forceinline__ const float* xrow_in(CP p, int m) { return m < MP ? p->in[0] + (size_t)m * D : p->in[1] + (size_t)(m - MP) * D; }
__device__ __forceinline__ int cond_of(int m) { return m < MP ? 0 : 1 + ((m - MP) >> 11); }
__device__ __forceinline__ void row_update(CP p, const RowCfg& c, int m, int lane, f32x4 (&x)[4]) {
    const float* xr = c.src_input ? xrow_in(p, m) : p->out + (size_t)m * D;
    const float* mod = (const float*)(p->ws + OFF_MOD);
    const int cd = cond_of(m);
#pragma unroll
    for (int q = 0; q < 4; ++q) x[q] = *(const f32x4*)(xr + 4 * lane + 256 * q);
    if (c.pending) {
        const bf16_t* fr = (const bf16_t*)(p->ws + OFF_E) + (size_t)m * D; f32x4 f[4]; float ss = 0.f;
#pragma unroll
        for (int q = 0; q < 4; ++q) { const u32x2 w = *(const u32x2*)(fr + 4 * lane + 256 * q); f[q] = (f32x4){bflo(w.x), bfhi(w.x), bflo(w.y), bfhi(w.y)}; }
        if (c.fsplit && m >= 16384) {
            const bf16_t* fr2 = (const bf16_t*)(p->ws + OFF_FB) + (size_t)(m - 16384) * D;
#pragma unroll
            for (int q = 0; q < 4; ++q) { const u32x2 w = *(const u32x2*)(fr2 + 4 * lane + 256 * q); f[q] += (f32x4){bflo(w.x), bfhi(w.x), bflo(w.y), bfhi(w.y)}; } }
#pragma unroll
        for (int q = 0; q < 4; ++q) ss += f[q][0] * f[q][0] + f[q][1] * f[q][1] + f[q][2] * f[q][2] + f[q][3] * f[q][3];
        ss = wave_sum(ss); const float rs = rsqrtf(ss * (1.0f / 1024.0f) + RMS_EPS) * c.coef;
        const float* gate = mod + ((size_t)(cd * 2 + c.lg) * 9 + c.gidx) * D;
#pragma unroll
        for (int q = 0; q < 4; ++q) { const f32x4 g = *(const f32x4*)(gate + 4 * lane + 256 * q), np = *(const f32x4*)(c.npost + 4 * lane + 256 * q); x[q] += g * (f[q] * np) * rs; }
    }
}
__device__ __forceinline__ void row_premod(CP p, const RowCfg& c, int m, int lane, const f32x4 (&x)[4], f32x4 (&h)[4]) {
    const float* mod = (const float*)(p->ws + OFF_MOD);
    const int cd = cond_of(m);
    float ss = 0.f;
#pragma unroll
    for (int q = 0; q < 4; ++q) ss += x[q][0] * x[q][0] + x[q][1] * x[q][1] + x[q][2] * x[q][2] + x[q][3] * x[q][3];
    ss = wave_sum(ss); const float rs = rsqrtf(ss * (1.0f / 1024.0f) + RMS_EPS);
    const float* sh = mod + ((size_t)(cd * 2 + c.lh) * 9 + c.shidx) * D; const float* scl = mod + ((size_t)(cd * 2 + c.lh) * 9 + c.scidx) * D;
#pragma unroll
    for (int q = 0; q < 4; ++q) { const f32x4 g = *(const f32x4*)(c.npre + 4 * lane + 256 * q), s1 = *(const f32x4*)(scl + 4 * lane + 256 * q), s0 = *(const f32x4*)(sh + 4 * lane + 256 * q);
        h[q] = (x[q] * rs * g) * (1.0f + s1) + s0; }
}
__device__ __forceinline__ void store_bf16_row(bf16_t* dst, int lane, const f32x4 (&h)[4]) {
#pragma unroll
    for (int q = 0; q < 4; ++q) { u32x2 w; w.x = cvt_pk_bf16(h[q][0], h[q][1]); w.y = cvt_pk_bf16(h[q][2], h[q][3]); *(u32x2*)(dst + 4 * lane + 256 * q) = w; }
}
__device__ void rowpass_simple(CP p, const RowCfg c, const Tix tx) {
    const int lane = tx.tid & 63, wid = tx.tid >> 6, nw = tx.gd * 8;
    bf16_t* hdst = (bf16_t*)(p->ws + OFF_A);
    for (int m = tx.bid * 8 + wid; m < MT; m += nw) {
        f32x4 x[4]; row_update(p, c, m, lane, x);
        if (c.write_x) {
#pragma unroll
            for (int q = 0; q < 4; ++q) *(f32x4*)(p->out + (size_t)m * D + 4 * lane + 256 * q) = x[q]; }
        if (c.has_next) { f32x4 h[4]; row_premod(p, c, m, lane, x, h); store_bf16_row(hdst + (size_t)m * D, lane, h); }
    }
}
__device__ void rowpass_shift(CP p, const RowCfg c, LAS float* lf, const Tix tx) {
    const int lane = tx.tid & 63, wid = tx.tid >> 6;
    bf16_t* adst = (bf16_t*)(p->ws + OFF_A);
    constexpr int RUN = 12;
    for (int run = tx.bid * 8 + wid; run < MT / RUN; run += tx.gd * 8) {
        const int m0 = run * RUN;
        f32x4 hA[4], hB[4], xB[4];
#pragma unroll
        for (int q = 0; q < 4; ++q) { hA[q] = (f32x4){0.f, 0.f, 0.f, 0.f}; hB[q] = hA[q]; xB[q] = hA[q]; }
#pragma unroll 1
        for (int j = -1; j <= RUN; ++j) {
            const int m = m0 + j;
            f32x4 xC[4], hC[4];
#pragma unroll
            for (int q = 0; q < 4; ++q) { xC[q] = (f32x4){0.f, 0.f, 0.f, 0.f}; hC[q] = xC[q]; }
            if (m >= 0 && m < MT) { row_update(p, c, m, lane, xC); row_premod(p, c, m, lane, xC, hC); }
            if (j >= 1) {
                const int mo = m - 1; const int T = mo < MP ? 256 : 2048, t = mo < MP ? (mo & 255) : ((mo - MP) & 2047);
                f32x4 hs[4];
#pragma unroll
                for (int q = 0; q < 4; ++q) { *(f32x4*)(p->out + (size_t)mo * D + 4 * lane + 256 * q) = xB[q];
                    hs[q] = (f32x4){0.f, 0.f, 0.f, 0.f};
                    if (t > 0) hs[q] += hA[q];
                    if (t < T - 1) hs[q] += hC[q];
                    hs[q] = 0.5f * hs[q] - hB[q]; }
                store_bf16_row(adst + (size_t)mo * 2048, lane, hB);
                store_bf16_row(adst + (size_t)mo * 2048 + 1024, lane, hs);
            }
#pragma unroll
            for (int q = 0; q < 4; ++q) { hA[q] = hB[q]; hB[q] = hC[q]; xB[q] = xC[q]; }
        }
    }
}
__device__ void rowpass_gn(CP p, const Tix tx) {
    const int lane = tx.tid & 63, wid = tx.tid >> 6, nw = tx.gd * 8;
    const bf16_t* yf = (const bf16_t*)(p->ws + OFF_A); const bf16_t* yb = (const bf16_t*)(p->ws + OFF_B);
    const bf16_t* gb = (const bf16_t*)(p->ws + OFF_C); const bf16_t* vb = (const bf16_t*)(p->ws + OFF_E);
    bf16_t* ob = (bf16_t*)(p->ws + OFF_D); const float* cbp = (const float*)(p->ws + OFF_CBP);
    const float* gnw = p->in[26]; const float* gnb = p->in[27];
    for (int m = tx.bid * 8 + wid; m < MT; m += nw) {
#pragma unroll
        for (int q = 0; q < 2; ++q) {
            const int col = 8 * lane + 512 * q, hd = (lane >> 3) + 8 * q;
            const u32x4 a = *(const u32x4*)(yf + (size_t)m * D + col), b = *(const u32x4*)(yb + (size_t)m * D + col);
            const u32x4 vw = *(const u32x4*)(vb + (size_t)m * D + col), gw = *(const u32x4*)(gb + (size_t)m * D + col);
            const f32x4 c0 = *(const f32x4*)(cbp + ((size_t)m * 16 + hd) * 4), c1 = *(const f32x4*)(cbp + ((size_t)(MT + m) * 16 + hd) * 4);
            const f32x4 w0 = *(const f32x4*)(gnw + col), w1 = *(const f32x4*)(gnw + col + 4), b0 = *(const f32x4*)(gnb + col), b1 = *(const f32x4*)(gnb + col + 4);
            float y[8] = {bflo(a.x) + bflo(b.x), bfhi(a.x) + bfhi(b.x), bflo(a.y) + bflo(b.y), bfhi(a.y) + bfhi(b.y), bflo(a.z) + bflo(b.z), bfhi(a.z) + bfhi(b.z), bflo(a.w) + bflo(b.w), bfhi(a.w) + bfhi(b.w)};
            float s = ((y[0] + y[1]) + (y[2] + y[3])) + ((y[4] + y[5]) + (y[6] + y[7]));
            s = reduce8(s);
            const float mean = s * (1.0f / 64.0f); float vs = 0.f;
#pragma unroll
            for (int i = 0; i < 8; ++i) { y[i] -= mean; vs += y[i] * y[i]; }
            vs = reduce8(vs);
            const float rstd = rsqrtf(vs * (1.0f / 64.0f) + GN_EPS);
            const float cb = ((c0[0] + c0[1]) + (c0[2] + c0[3])) + ((c1[0] + c1[1]) + (c1[2] + c1[3]));
            const float vv[8] = {bflo(vw.x), bfhi(vw.x), bflo(vw.y), bfhi(vw.y), bflo(vw.z), bfhi(vw.z), bflo(vw.w), bfhi(vw.w)};
            const float gg[8] = {bflo(gw.x), bfhi(gw.x), bflo(gw.y), bfhi(gw.y), bflo(gw.z), bfhi(gw.z), bflo(gw.w), bfhi(gw.w)};
            const float ww[8] = {w0[0], w0[1], w0[2], w0[3], w1[0], w1[1], w1[2], w1[3]}, bb[8] = {b0[0], b0[1], b0[2], b0[3], b1[0], b1[1], b1[2], b1[3]};
            float o[8];
#pragma unroll
            for (int i = 0; i < 8; ++i) o[i] = (y[i] * rstd * ww[i] + bb[i] + cb * vv[i]) * gg[i];
            u32x4 ow; ow.x = cvt_pk_bf16(o[0], o[1]); ow.y = cvt_pk_bf16(o[2], o[3]); ow.z = cvt_pk_bf16(o[4], o[5]); ow.w = cvt_pk_bf16(o[6], o[7]);
            *(u32x4*)(ob + (size_t)m * D + col) = ow;
        }
    }
}

__device__ __forceinline__ void pool_add(float (&s)[8], const u32x4 w, const float sg) {
    s[0] += sg * bflo(w.x); s[1] += sg * bfhi(w.x); s[2] += sg * bflo(w.y); s[3] += sg * bfhi(w.y); s[4] += sg * bflo(w.z); s[5] += sg * bfhi(w.z); s[6] += sg * bflo(w.w); s[7] += sg * bfhi(w.w);
}
template <int WIN> __device__ __forceinline__ void pool_blk(const bf16_t* src, const int sb, const int stride, const int L, const int a0, const int ch, const int mode,
                                                            bf16_t* dst, const int db, const bf16_t* hsrc, const int hb) {
    constexpr int HW = WIN / 2, NT = WIN + 7;
    u32x4 tap[NT];
#pragma unroll
    for (int j = 0; j < NT; ++j) { const int pp = a0 - HW + j; const int pc = min(max(pp, 0), L - 1);
        const u32x4 w = *(const u32x4*)(src + (size_t)(sb + pc * stride) * D + ch);
        tap[j] = (pp >= 0 && pp < L) ? w : (u32x4){0u, 0u, 0u, 0u}; }
    float s[8];
#pragma unroll
    for (int i = 0; i < 8; ++i) s[i] = 0.f;
#pragma unroll
    for (int j = 0; j < WIN; ++j) pool_add(s, tap[j], 1.0f);
#pragma unroll
    for (int i = 0; i < 8; ++i) {
        const int a = a0 + i;
        const float inv = __builtin_amdgcn_rcpf((float)(min(a + HW, L) - max(a - HW, 0)));
        float c8[8];
        if (mode == 1) {
#pragma unroll
            for (int k = 0; k < 8; ++k) c8[k] = 0.f; }
        else { const u32x4 cw = (mode == 0) ? tap[i + HW] : *(const u32x4*)(hsrc + (size_t)(hb + a * stride) * D + ch);
            c8[0] = bflo(cw.x); c8[1] = bfhi(cw.x); c8[2] = bflo(cw.y); c8[3] = bfhi(cw.y); c8[4] = bflo(cw.z); c8[5] = bfhi(cw.z); c8[6] = bflo(cw.w); c8[7] = bfhi(cw.w); }
        u32x4 o; o.x = cvt_pk_bf16(s[0] * inv - c8[0], s[1] * inv - c8[1]); o.y = cvt_pk_bf16(s[2] * inv - c8[2], s[3] * inv - c8[3]);
        o.z = cvt_pk_bf16(s[4] * inv - c8[4], s[5] * inv - c8[5]); o.w = cvt_pk_bf16(s[6] * inv - c8[6], s[7] * inv - c8[7]);
        *(u32x4*)(dst + (size_t)(db + a * stride) * D + ch) = o;
        if (i < 7) { pool_add(s, tap[i + WIN], 1.0f); pool_add(s, tap[i], -1.0f); }
    }
}
template <int WIN> __device__ __forceinline__ void pool_unit(CP p, const int pass, const int v, const int gi, const int lane) {
    const bf16_t* h = (const bf16_t*)(p->ws + OFF_A); bf16_t* t1 = (bf16_t*)(p->ws + OFF_B); bf16_t* dl = (bf16_t*)(p->ws + OFF_D);
    const int ch = gi * 256 + 8 * (lane & 31), sub = (lane >> 5) * 8;
    if (pass == 0) {
        if (v < 512) { const int seq = v >> 4, k = v & 15; pool_blk<WIN>(h, seq * 256, 1, 256, 16 * k + sub, ch, 0, dl, seq * 256, h, 0); }
        else { const int w = v - 512, b = w >> 7, cc = (w >> 1) & 63, k = w & 1;
            pool_blk<WIN>(h, MP + b * 2048 + cc, 64, 32, 16 * k + sub, ch, 1, t1, b * 2048 + cc, h, 0); }
    } else { const int b = v >> 7, r = (v >> 2) & 31, k = v & 3;
        pool_blk<WIN>(t1, b * 2048 + r * 64, 1, 64, 16 * k + sub, ch, 2, dl, MP + b * 2048 + r * 64, h, MP + b * 2048 + r * 64); }
}
__device__ void pool_pass(CP p, int pass, const Tix tx) {
    const int lane = tx.tid & 63, wid = tx.tid >> 6;
    const int total = (pass == 0 ? 1536 : 1024) * 4;
    for (int u = tx.bid * 8 + wid; u < total; u += tx.gd * 8) {
        const int gi = u & 3, v = u >> 2;
        if (gi == 0) pool_unit<2>(p, pass, v, 0, lane); else if (gi == 1) pool_unit<4>(p, pass, v, 1, lane);
        else if (gi == 2) pool_unit<8>(p, pass, v, 2, lane); else pool_unit<16>(p, pass, v, 3, lane);
    }
}

constexpr int SST = 324;
constexpr int SBUF = 16 * SST + 64;
template <int VAR> __device__ void scan_phase(CP p, const bf16_t* W, LAS float* lf, const Tix tx, const int skipmask) {
    const int tid = tx.tid, lane = tid & 63, wid = tid >> 6, grp = wid >> 2, q = wid & 3;
    const int l15 = lane & 15, quad = lane >> 4, rl = lane >> 3, cg8 = lane & 7, i0 = 16 * q + 2 * rl;
    const bf16_t* rb = (const bf16_t*)(p->ws + OFF_C); const bf16_t* kb = (const bf16_t*)(p->ws + OFF_D); const bf16_t* vb = (const bf16_t*)(p->ws + OFF_E);
    const bf16_t* lb = (const bf16_t*)(p->ws + OFF_S);
    bf16_t* yout = (bf16_t*)(p->ws + OFF_A);
    float* cbp = (float*)(p->ws + OFF_CBP);
    const int tch = grp == 0 ? 128 : 16, nsub = grp == 0 ? 1 : ((skipmask & 8) ? 0 : 4);
    for (int it = tx.bid; it < 256; it += tx.gd) {
        f32x2 Sa[4], Sb[4];
        bf16x8 W2f[2], A2f[2];
        LAS float* ystage = lf + 4 * SBUF + 8 * 144 + wid * 1024;
        LAS float* wcst = lf + 4 * SBUF + wid * 144;
#pragma unroll
        for (int i = 0; i < 4; ++i) { Sa[i] = (f32x2){0.f, 0.f}; Sb[i] = (f32x2){0.f, 0.f}; }
        W2f[0] = W2f[1] = A2f[0] = A2f[1] = (bf16x8){0, 0, 0, 0, 0, 0, 0, 0};
        u32x2 pr = (u32x2){0u, 0u}, pk = pr, pv = pr; u32x4 pkf0 = (u32x4){0u, 0u, 0u, 0u}, pkf1 = pkf0; bf16x8 plw0 = (bf16x8){0, 0, 0, 0, 0, 0, 0, 0}, plw1 = plw0, pla0 = plw0, pla1 = plw0;
        int mn = 0, dn = 0, hhn = 0, scn = 0, slg = 0; bool sact = false;
        for (int c = -2; c < 128; ++c) {
#pragma unroll 1
          for (int slot = 0; slot < 2; ++slot) {
            if ((slot == 0) == (grp == 1)) {
                if (sact && !(skipmask & 2)) {
                    f32x4 aw = (f32x4){0.f, 0.f, 0.f, 0.f}, aa = aw;
                    aw = __builtin_amdgcn_mfma_f32_16x16x32_bf16(W2f[0], plw0, aw, 0, 0, 0); aw = __builtin_amdgcn_mfma_f32_16x16x32_bf16(W2f[1], plw1, aw, 0, 0, 0);
                    aa = __builtin_amdgcn_mfma_f32_16x16x32_bf16(A2f[0], pla0, aa, 0, 0, 0); aa = __builtin_amdgcn_mfma_f32_16x16x32_bf16(A2f[1], pla1, aa, 0, 0, 0);
                    const f32x4 cw0 = *(const LAS f32x4*)(wcst + 4 * quad), ca0 = *(const LAS f32x4*)(wcst + 16 + 4 * quad), ckk = *(const LAS f32x4*)(wcst + 32 + 4 * quad), cka = *(const LAS f32x4*)(wcst + 48 + 4 * quad), crk = *(const LAS f32x4*)(wcst + 64 + 4 * quad);
                    f32x4 kn[4];
    #pragma unroll
                    for (int i = 0; i < 4; ++i) kn[i] = *(const LAS f32x4*)(wcst + 80 + 16 * quad + 4 * i);
                    float ssq = 0.f;
                    { const unsigned kw[8] = {pkf0.x, pkf0.y, pkf0.z, pkf0.w, pkf1.x, pkf1.y, pkf1.z, pkf1.w};
    #pragma unroll
                      for (int i = 0; i < 8; ++i) { const float a = bflo(kw[i]) * kn[i >> 1][(i & 1) * 2], b2 = bfhi(kw[i]) * kn[i >> 1][(i & 1) * 2 + 1]; ssq += a * a + b2 * b2; } }
                    { auto s1 = __builtin_amdgcn_permlane16_swap(__float_as_uint(ssq), __float_as_uint(ssq), false, false); ssq = __uint_as_float(s1[0]) + __uint_as_float(s1[1]);
                      auto s2 = __builtin_amdgcn_permlane32_swap(__float_as_uint(ssq), __float_as_uint(ssq), false, false); ssq = __uint_as_float(s2[0]) + __uint_as_float(s2[1]); }
                    const float rn = fminf(__builtin_amdgcn_rsqf(ssq), 1e12f);
                    const f32x4 r4 = (f32x4){bflo(pr.x), bfhi(pr.x), bflo(pr.y), bfhi(pr.y)}, k4 = (f32x4){bflo(pk.x), bfhi(pk.x), bflo(pk.y), bfhi(pk.y)}, v4 = (f32x4){bflo(pv.x), bfhi(pv.x), bflo(pv.y), bfhi(pv.y)};
                    f32x4 e4, E4, kk4, b4, kd4, rh4, cs4; float cbs = 0.f;
    #pragma unroll
                    for (int j = 0; j < 4; ++j) { e4[j] = 0.60653066f * fast_sigmoid(cw0[j] + aw[j]);
                        float t = e4[j];
                        t += __builtin_bit_cast(float, __builtin_amdgcn_update_dpp(0, __builtin_bit_cast(int, t), 0x111, 0xf, 0xf, true));
                        t += __builtin_bit_cast(float, __builtin_amdgcn_update_dpp(0, __builtin_bit_cast(int, t), 0x112, 0xf, 0xf, true));
                        t += __builtin_bit_cast(float, __builtin_amdgcn_update_dpp(0, __builtin_bit_cast(int, t), 0x114, 0xf, 0xf, true));
                        t += __builtin_bit_cast(float, __builtin_amdgcn_update_dpp(0, __builtin_bit_cast(int, t), 0x118, 0xf, 0xf, true));
                        E4[j] = t; }
    #pragma unroll
                    for (int j = 0; j < 4; ++j) {
                        const float a = fast_sigmoid(ca0[j] + aa[j]);
                        const float kkn = k4[j] * ckk[j] * rn, bq = kkn * a, kd = k4[j] * (1.0f + (a - 1.0f) * cka[j]);
                        cbs += r4[j] * kd * crk[j];
                        const float cs = __expf(-E4[j]), cinv = __builtin_amdgcn_rcpf(cs);
                        const float cp = __builtin_bit_cast(float, __builtin_amdgcn_update_dpp(0x3f800000, __builtin_bit_cast(int, cs), 0x111, 0xf, 0xf, false));
                        kk4[j] = kkn * cp; b4[j] = bq * cinv; kd4[j] = kd * cinv; rh4[j] = r4[j] * cs; cs4[j] = cs; }
                    LAS float* wb = lf + (slg * 2 + (scn & 1)) * SBUF;
                    LAS float* wp = wb + l15 * SST + 16 * q + 4 * quad;
                    *(LAS f32x4*)(wp) = kk4; *(LAS f32x4*)(wp + 64) = b4; *(LAS f32x4*)(wp + 128) = kd4; *(LAS f32x4*)(wp + 192) = rh4; *(LAS f32x4*)(wp + 256) = v4;
                    if (l15 == 15) *(LAS f32x4*)(wb + 16 * SST + 16 * q + 4 * quad) = cs4;
                    { auto s1 = __builtin_amdgcn_permlane16_swap(__float_as_uint(cbs), __float_as_uint(cbs), false, false); cbs = __uint_as_float(s1[0]) + __uint_as_float(s1[1]);
                      auto s2 = __builtin_amdgcn_permlane32_swap(__float_as_uint(cbs), __float_as_uint(cbs), false, false); cbs = __uint_as_float(s2[0]) + __uint_as_float(s2[1]); }
                    if (quad == 0) cbp[(((size_t)dn * MT + mn) * 16 + hhn) * 4 + q] = cbs;
                }
            }
            if (slot == 0) {
                const int cn = c + 1 + grp; const int g1len = ((skipmask & 8) ? 0 : 4) * 16;
                const int lg = (grp == 1 && cn >= g1len) ? 0 : grp;
                const int ltch = lg == 0 ? 128 : 16; const int subn = cn / ltch, ccn = cn % ltch;
                const bool actn = (cn >= 0) && (cn < 128) && (grp == 1 || cn < g1len);
                sact = actn; scn = cn; slg = lg;
                if (actn && !(skipmask & 4)) {
                    const int pid = lg == 0 ? it : 4 * it + subn; dn = pid & 1; hhn = (pid >> 1) & 15; const int b = pid >> 5;
                    const int T = lg == 0 ? 2048 : 256, mb = lg == 0 ? MP + b * 2048 : b * 256;
                    const int pos = ccn * 16 + l15; mn = mb + (dn == 0 ? pos : T - 1 - pos);
                    const int col4 = 64 * hhn + 16 * q + 4 * quad;
                    pr = *(const u32x2*)(rb + (size_t)mn * D + col4); pk = *(const u32x2*)(kb + (size_t)mn * D + col4); pv = *(const u32x2*)(vb + (size_t)mn * D + col4);
                    pkf0 = *(const u32x4*)(kb + (size_t)mn * D + 64 * hhn + 16 * quad); pkf1 = *(const u32x4*)(kb + (size_t)mn * D + 64 * hhn + 16 * quad + 8);
                    plw0 = *(const bf16x8*)(lb + (size_t)mn * 384 + dn * 64 + 8 * quad); plw1 = *(const bf16x8*)(lb + (size_t)mn * 384 + dn * 64 + 32 + 8 * quad);
                    pla0 = *(const bf16x8*)(lb + (size_t)mn * 384 + 128 + dn * 64 + 8 * quad); pla1 = *(const bf16x8*)(lb + (size_t)mn * 384 + 128 + dn * 64 + 32 + 8 * quad);
                    if (ccn == 0 || (grp == 1 && lg == 0 && cn == g1len)) {
                        const bf16_t* w2r = W + W_W2L + ((size_t)dn * 1024 + 64 * hhn + 16 * q + l15) * 64 + 8 * quad;
                        const bf16_t* a2r = W + W_A2L + ((size_t)dn * 1024 + 64 * hhn + 16 * q + l15) * 64 + 8 * quad;
                        W2f[0] = *(const bf16x8*)w2r; W2f[1] = *(const bf16x8*)(w2r + 32); A2f[0] = *(const bf16x8*)a2r; A2f[1] = *(const bf16x8*)(a2r + 32);
                        const int cw = 64 * hhn + 16 * q + l15;
                        if (lane < 16) { wcst[lane] = p->in[15][dn * D + cw]; wcst[16 + lane] = p->in[18][dn * D + cw]; wcst[32 + lane] = p->in[23][cw]; wcst[48 + lane] = p->in[24][cw]; wcst[64 + lane] = p->in[25][cw]; }
                        wcst[80 + lane] = p->in[23][64 * hhn + lane];
                    }
                }
                const int sub = c < 0 ? 0 : c / tch, cc = c < 0 ? 0 : c % tch; const bool act = (c >= 0) && (sub < nsub);
                if (act && !(skipmask & 1)) {
                    const int pid = grp == 0 ? it : 4 * it + sub; const int d = pid & 1, hh = (pid >> 1) & 15, b = pid >> 5;
                    const int T = grp == 0 ? 2048 : 256, mb = grp == 0 ? MP + b * 2048 : b * 256;
                    if (cc == 0) {
                        if (grp == 0) { const float* s0 = (d == 0 ? p->in[3] : p->in[4]) + ((size_t)(b * 16 + hh) * 64 + i0) * 64 + 8 * cg8;
                            const f32x4 a0 = *(const f32x4*)s0, a1 = *(const f32x4*)(s0 + 4), b0 = *(const f32x4*)(s0 + 64), b1 = *(const f32x4*)(s0 + 68);
                            Sa[0] = a0.lo; Sa[1] = a0.hi; Sa[2] = a1.lo; Sa[3] = a1.hi; Sb[0] = b0.lo; Sb[1] = b0.hi; Sb[2] = b1.lo; Sb[3] = b1.hi; }
                        else {
    #pragma unroll
                            for (int i = 0; i < 4; ++i) { Sa[i] = (f32x2){0.f, 0.f}; Sb[i] = (f32x2){0.f, 0.f}; } }
                    }
                    const LAS float* bp0 = lf + (grp * 2 + (c & 1)) * SBUF;
                    bf16_t* yo = yout + (size_t)d * MT * D + 64 * hh + i0;
                    f32x4 nk0, nk1, nb0, nb1, nd0, nd1; f32x2 nv; f32x2 rp[4];
    #define SCAN_LOAD_K(s_) do { const LAS float* bp_ = bp0 + (s_) * SST + 8 * cg8; nk0 = *(const LAS f32x4*)(bp_); nk1 = *(const LAS f32x4*)(bp_ + 4); } while (0)
    #define SCAN_LOAD_R(s_) do { const LAS float* bp_ = bp0 + (s_) * SST + 8 * cg8; const f32x4 r0_ = *(const LAS f32x4*)(bp_ + 192), r1_ = *(const LAS f32x4*)(bp_ + 196); rp[0] = r0_.lo; rp[1] = r0_.hi; rp[2] = r1_.lo; rp[3] = r1_.hi; } while (0)
    #define SCAN_LOAD_B(s_) do { const LAS float* bp_ = bp0 + (s_) * SST + 8 * cg8; nb0 = *(const LAS f32x4*)(bp_ + 64); nb1 = *(const LAS f32x4*)(bp_ + 68); \
                        nd0 = *(const LAS f32x4*)(bp_ + 128); nd1 = *(const LAS f32x4*)(bp_ + 132); nv = *(const LAS f32x2*)(bp0 + (s_) * SST + 256 + i0); } while (0)
                    SCAN_LOAD_K(0); SCAN_LOAD_B(0);
    #pragma unroll
                    for (int i = 0; i < 4; ++i) rp[i] = (f32x2){0.f, 0.f};
    #define SCAN_YFLUSH(b_) do { const LAS float* ys_ = ystage + cg8 * 128 + 16 * rl; const f32x4 q0_ = *(const LAS f32x4*)(ys_), q1_ = *(const LAS f32x4*)(ys_ + 4), q2_ = *(const LAS f32x4*)(ys_ + 8), q3_ = *(const LAS f32x4*)(ys_ + 12); \
                        const float ye_ = ((q0_[0] + q0_[2]) + (q1_[0] + q1_[2])) + ((q2_[0] + q2_[2]) + (q3_[0] + q3_[2])), yo_ = ((q0_[1] + q0_[3]) + (q1_[1] + q1_[3])) + ((q2_[1] + q2_[3]) + (q3_[1] + q3_[3])); \
                        const int pos_ = cc * 16 + 8 * (b_) + cg8; const int m_ = mb + (d == 0 ? pos_ : T - 1 - pos_); *(unsigned*)(yo + (size_t)m_ * D) = cvt_pk_bf16(ye_, yo_); } while (0)
    #pragma unroll
                    for (int s = 0; s < 16; ++s) {
                        const f32x2 kk[4] = {nk0.lo, nk0.hi, nk1.lo, nk1.hi};
                        f32x2 pa = Sa[0] * kk[0], pb = Sb[0] * kk[0], ya = Sa[0] * rp[0], yb = Sb[0] * rp[0];
    #pragma unroll
                        for (int i = 1; i < 4; ++i) { pa = Sa[i] * kk[i] + pa; pb = Sb[i] * kk[i] + pb; ya = Sa[i] * rp[i] + ya; yb = Sb[i] * rp[i] + yb; }
                        if (s < 15 && !(VAR & 2)) SCAN_LOAD_K(s + 1);
                        if (!(VAR & 2)) SCAN_LOAD_R(s);
                        float sa0 = pa.x + pa.y, sa1 = pb.x + pb.y;
                        if (s > 0) *(LAS f32x2*)(ystage + ((s - 1) & 7) * 128 + 2 * lane) = (f32x2){ya.x + ya.y, yb.x + yb.y};
                        sa0 += dpp_f<0xB1>(sa0); sa1 += dpp_f<0xB1>(sa1);
                        sa0 += dpp_f<0x4E>(sa0); sa1 += dpp_f<0x4E>(sa1);
                        sa0 += dpp_f<0x141>(sa0); sa1 += dpp_f<0x141>(sa1);
                        const f32x2 bb[4] = {nb0.lo, nb0.hi, nb1.lo, nb1.hi}, dd[4] = {nd0.lo, nd0.hi, nd1.lo, nd1.hi};
                        const f32x2 n0 = (f32x2){-sa0, -sa0}, n1 = (f32x2){-sa1, -sa1}, v0 = (f32x2){nv.x, nv.x}, v1 = (f32x2){nv.y, nv.y};
    #pragma unroll
                        for (int i = 0; i < 4; ++i) { Sa[i] = n0 * bb[i] + Sa[i]; Sb[i] = n1 * bb[i] + Sb[i]; Sa[i] = v0 * dd[i] + Sa[i]; Sb[i] = v1 * dd[i] + Sb[i]; }
                        if (s < 15 && !(VAR & 1)) SCAN_LOAD_B(s + 1);
                        if (s == 8) SCAN_YFLUSH(0);
                    }
                    {
                        f32x2 ya = Sa[0] * rp[0], yb = Sb[0] * rp[0];
    #pragma unroll
                        for (int i = 1; i < 4; ++i) { ya = Sa[i] * rp[i] + ya; yb = Sb[i] * rp[i] + yb; }
                        *(LAS f32x2*)(ystage + 7 * 128 + 2 * lane) = (f32x2){ya.x + ya.y, yb.x + yb.y};
                        const f32x4 c0 = *(const LAS f32x4*)(bp0 + 16 * SST + 8 * cg8), c1 = *(const LAS f32x4*)(bp0 + 16 * SST + 8 * cg8 + 4);
                        Sa[0] *= c0.lo; Sa[1] *= c0.hi; Sa[2] *= c1.lo; Sa[3] *= c1.hi; Sb[0] *= c0.lo; Sb[1] *= c0.hi; Sb[2] *= c1.lo; Sb[3] *= c1.hi;
                        SCAN_YFLUSH(1);
                    }
    #undef SCAN_YFLUSH
    #undef SCAN_LOAD_K
    #undef SCAN_LOAD_R
    #undef SCAN_LOAD_B
                    if (grp == 1 && cc == tch - 1) {
                        float* sf = p->out + (size_t)MT * D + (size_t)d * (32 * 16 * 4096) + ((size_t)(b * 16 + hh) * 64 + i0) * 64 + 8 * cg8;
                        *(f32x4*)sf = (f32x4){Sa[0].x, Sa[0].y, Sa[1].x, Sa[1].y}; *(f32x4*)(sf + 4) = (f32x4){Sa[2].x, Sa[2].y, Sa[3].x, Sa[3].y};
                        *(f32x4*)(sf + 64) = (f32x4){Sb[0].x, Sb[0].y, Sb[1].x, Sb[1].y}; *(f32x4*)(sf + 68) = (f32x4){Sb[2].x, Sb[2].y, Sb[3].x, Sb[3].y};
                    }
                }
            }
          }
            asm volatile("s_waitcnt lgkmcnt(0)" ::: "memory"); __builtin_amdgcn_s_barrier(); asm volatile("" ::: "memory");
        }
    }
}

#define XB_TMO      128
#define XB_XCNT(j)  (256  + 64 * (j))
#define XB_XSUB(j)  (1280 + 64 * (j))
#define XB_XGEN(j)  (2304 + 64 * (j))
#define XB_TOP      3328
#define XB_TOPGEN   3392
#define XCD_BAR_WORDS 3456
#define XB_SPIN_CAP (1u << 18)

__device__ __forceinline__ unsigned xb_ld(unsigned* p)              { return __hip_atomic_load(p, __ATOMIC_RELAXED, __HIP_MEMORY_SCOPE_AGENT); }
__device__ __forceinline__ unsigned xb_add(unsigned* p, unsigned v) { return __hip_atomic_fetch_add(p, v, __ATOMIC_RELAXED, __HIP_MEMORY_SCOPE_AGENT); }
__device__ __forceinline__ unsigned xb_xcc_id() { return (unsigned)__builtin_amdgcn_s_getreg((3 << 11) | 20) & 0xFu; }
#define XB_SPIN(cond, bar) do { unsigned _sp = 0; while (cond) { __builtin_amdgcn_s_sleep(1); \
    if ((++_sp & 255u) == 0u) { if (xb_ld(&(bar)[XB_TMO])) break; if (_sp > XB_SPIN_CAP) { atomicAdd(&(bar)[XB_TMO], 1u); break; } } } } while (0)

struct XcdBarrier {
    unsigned* bar; unsigned x;
    volatile LAS unsigned* st;
};

__device__ __forceinline__ XcdBarrier xcd_barrier_post(unsigned* bar, volatile LAS unsigned* st) {
    XcdBarrier b; b.bar = bar; b.x = xb_xcc_id(); b.st = st;
    if (threadIdx.x == 0) (void)xb_add(&bar[XB_XCNT(b.x)], 1u);
    return b;
}
__device__ __forceinline__ void xcd_barrier_complete(unsigned* bar, unsigned x, unsigned& nloc, unsigned& nx) {
    const unsigned G = gridDim.x * gridDim.y * gridDim.z;
    unsigned sum, cnt, mine, sp = 0u;
    for (;;) {
        sum = 0u; cnt = 0u; mine = 0u;
#pragma unroll
        for (unsigned j = 0; j < 16; ++j) { const unsigned c = xb_ld(&bar[XB_XCNT(j)]); sum += c; cnt += (c > 0u) ? 1u : 0u; mine = (j == x) ? c : mine; }
        if (sum == G) break;
        __builtin_amdgcn_s_sleep(1);
        if ((++sp & 255u) == 0u) { if (xb_ld(&bar[XB_TMO])) break; if (sp > XB_SPIN_CAP) { atomicAdd(&bar[XB_TMO], 1u); break; } }
    }
    nloc = mine > 0u ? mine : 1u; nx = cnt > 0u ? cnt : 1u;
}

__device__ __forceinline__ void xcd_barrier(const XcdBarrier& b) {
    asm volatile("s_waitcnt vmcnt(0)" ::: "memory");
    __syncthreads();
    if (threadIdx.x == 0) {
        unsigned* bar = b.bar;
        __builtin_amdgcn_s_waitcnt(0);
        unsigned nloc = b.st[0], nx = b.st[1];
        if (nloc == 0u) { xcd_barrier_complete(bar, b.x, nloc, nx); b.st[0] = nloc; b.st[1] = nx; }
        const unsigned old = xb_add(&bar[XB_XSUB(b.x)], 1u);
        const unsigned gen = old / nloc;
        if (old + 1u == (gen + 1u) * nloc) {
            __builtin_amdgcn_fence(__ATOMIC_RELEASE, "agent");
            asm volatile("s_waitcnt vmcnt(0)" ::: "memory");
            const unsigned og = xb_add(&bar[XB_TOP], 1u);
            const unsigned tg = og / nx;
            if (og + 1u == (tg + 1u) * nx) xb_add(&bar[XB_TOPGEN], 1u);
            else XB_SPIN(xb_ld(&bar[XB_TOPGEN]) == tg, bar);
            __builtin_amdgcn_fence(__ATOMIC_ACQUIRE, "agent");
            xb_add(&bar[XB_XGEN(b.x)], 1u);
            asm volatile("s_waitcnt vmcnt(0)" ::: "memory");
        } else {
            XB_SPIN(xb_ld(&bar[XB_XGEN(b.x)]) == gen, bar);
            __builtin_amdgcn_fence(__ATOMIC_ACQUIRE, "agent");
            asm volatile("s_waitcnt vmcnt(0)" ::: "memory");
        }
    }
    __syncthreads();
}


constexpr int NPHASE = 24;
#ifndef SPLITK
#define SPLITK 1
#endif
#ifndef ONLYMASK
#define ONLYMASK 0x1ff
#endif
#define EN(k) ((ONLYMASK >> (k)) & 1)
constexpr int LDS_BYTES = 131072 + 16;
__global__ void __launch_bounds__(512, 2) mega(Params kp) {
    extern __shared__ __attribute__((aligned(16))) unsigned char shm[];
    PG8_LAS unsigned char* lds = (PG8_LAS unsigned char*)shm;
    LAS float* lf = (LAS float*)shm;
    cg::grid_group grid = cg::this_grid();
    const int pb = kp.pb, pe = kp.pe;
    volatile LAS unsigned* xst = (volatile LAS unsigned*)(lds + 131072);
    if (threadIdx.x < 2) xst[threadIdx.x] = 0u;
    __syncthreads();
    XcdBarrier xb = xcd_barrier_post((unsigned*)(kp.ws + OFF_BAR), xst);
#ifdef PROBE_SYNC
#pragma unroll 1
    for (int i = 0; i < PROBE_SYNC; ++i) grid.sync();
#endif
#pragma unroll 1
    for (int ph = pb; ph < pe; ++ph) {
        CP p = (CP)__builtin_amdgcn_kernarg_segment_ptr();
        asm volatile("" : "+s"(p));
        Tix tx; { int t_ = threadIdx.x, b_ = blockIdx.x, g_ = gridDim.x; asm volatile("" : "+v"(t_)); asm volatile("" : "+s"(b_), "+s"(g_)); tx.tid = t_; tx.bid = b_; tx.gd = g_; }
        bf16_t* rA = (bf16_t*)(p->ws + OFF_A); bf16_t* rB = (bf16_t*)(p->ws + OFF_B); bf16_t* rC = (bf16_t*)(p->ws + OFF_C); bf16_t* rD = (bf16_t*)(p->ws + OFF_D); bf16_t* rE = (bf16_t*)(p->ws + OFF_E);
        bf16_t* rS = (bf16_t*)(p->ws + OFF_S);
        const int wsel = (ph <= 3) ? 0 : (ph <= 9) ? 1 : (ph <= 12) ? 0 : (ph <= 15) ? 1 : (ph <= 19) ? 0 : 1;
        bf16_t* W = (bf16_t*)(p->ws + (wsel ? OFF_W2 : OFF_W)); bf16_t* Wn = (bf16_t*)(p->ws + (wsel ? OFF_W : OFF_W2));
        const float* npre = p->in[8]; const float* npost = p->in[9];
        int kind = 0;
        RowCfg rc{}; int conv = -1;
        const bf16_t* gA = nullptr; const bf16_t* gB = nullptr; bf16_t* gO = nullptr; int gN = 0, gK = 0, pool_pass_id = 0;
        switch (ph) {
            case 0: kind = 0; break;
            case 1: kind = 1; rc = RowCfg{1, 0, 0, 0, 0.f, npost, 1, 0, 0, 1, npre + 0 * D, 0, SPLITK}; break;
            case 2: case 11: case 14: case 21: kind = 2; conv = (ph == 2) ? 4 : (ph == 11) ? 2 : (ph == 14) ? 5 : -1; break;
            case 3: case 12: case 15: case 22: kind = 3; gA = rB; gB = W + W_W2T; gO = rE; gN = 1024; gK = 2816; break;
            case 4: kind = 4; rc = RowCfg{1, 1, 0, 2, 0.5f, npost + 0 * D, 1, 0, 3, 4, npre + 1 * D, 1, SPLITK}; break;
            case 5: kind = 5; conv = 1; break;
            case 6: kind = 6; break;
            case 7: kind = 3; gA = rS; gB = W + W_BTG; gO = rC; gN = 1024; gK = 384; break;
            case 8: kind = 7; break;
            case 9: kind = 3; gA = rD; gB = W + W_WOT; gO = rE; gN = 1024; gK = 1024; break;
            case 10: kind = 1; rc = RowCfg{0, 1, 0, 5, 1.0f, npost + 1 * D, 1, 0, 6, 7, npre + 2 * D, 1, SPLITK}; break;
            case 13: kind = 1; rc = RowCfg{0, 1, 0, 8, 0.5f, npost + 2 * D, 1, 1, 0, 1, npre + 3 * D, 1, SPLITK}; break;
            case 16: kind = 1; rc = RowCfg{0, 1, 1, 2, 0.5f, npost + 3 * D, 1, 1, 3, 4, npre + 4 * D, 1, SPLITK}; break;
            case 17: kind = 8; pool_pass_id = 0; break;
            case 18: kind = 8; pool_pass_id = 1; break;
            case 19: kind = 3; gA = rD; gB = W; gO = rE; gN = 1024; gK = 1024; conv = 3; break;
            case 20: kind = 1; rc = RowCfg{0, 1, 1, 5, 1.0f, npost + 4 * D, 1, 1, 6, 7, npre + 5 * D, 1, SPLITK}; break;
            case 23: kind = 1; rc = RowCfg{0, 1, 1, 8, 0.5f, npost + 5 * D, 0, 0, 0, 0, npre, 1, SPLITK}; break;
            default: break;
        }
        rc.fsplit = (SPLITK && tx.gd == 256 && ph != 20) ? 1 : 0;
#ifdef PROBE_PH
        const int reps = (ph == PROBE_PH) ? PROBE_N : 1;
#else
        const int reps = 1;
#endif
#pragma unroll 1
        for (int rep = 0; rep < reps; ++rep) {
        if (rep > 0) xcd_barrier(xb);
        asm volatile("" : "+v"(tx.tid)); asm volatile("" : "+s"(tx.bid), "+s"(tx.gd)); asm volatile("" : "+s"(p));
        if (EN(0) && kind == 0) { mod_phase(p, lf, tx); __syncthreads();
            if (tx.gd > 64) { if (tx.bid >= 32) { const Tix tv{tx.tid, tx.bid - 32, tx.gd - 32}; conv_ffn(p, W, 0, lf + 16384, tv); } }
            else conv_ffn(p, W, 0, lf + 16384, tx); }
        else if (EN(1) && kind == 1) { rowpass_simple(p, rc, tx); }
        else if (EN(4) && kind == 4) { rowpass_shift(p, rc, lf, tx); }
        else if (EN(2) && (kind == 2 || kind == 3 || kind == 5)) {
            if (kind == 2) { gA = rA; gB = W + W_W13; gO = rB; gN = 5632; gK = 1024; } else if (kind == 5) { gA = rA; gB = W + W_BTP; gO = rC; gN = 3584; gK = 2048; }
            const int diag = (ph == 19) ? 1 : 0;
            const int bal = (!diag && SPLITK && kind == 3 && gK >= 1024 && tx.gd == 256) ? 1 : 0;
            pg8::Gemm g{gA, gB, MT, gN, gK}; pg8::FwdOrder S; S.init(MT, gN, gK, tx.gd, tx.bid, diag ? 2 : (ph == 7 ? 3 : bal));
            pg8::EpiAll E{kind == 3 ? 0 : (kind == 2 ? 1 : 2), gO, kind == 2 ? DFF : 1024, rS, (bf16_t*)(p->ws + OFF_FB) - (size_t)16384 * 1024};
#ifdef PROBE_NOEPI
            if (rep + 1 < reps) E.kind = 7;
#endif
            pg8::gemm_phase<pg8::EpiAll, pg8::FwdOrder, false>(lds, g, S, E, nullptr, tx.tid);
            if (conv >= 0) { const int nunit = (MT / 256) * (gN / 256), extra = nunit % tx.gd;
                const int half = (bal || extra == 0 || extra > tx.gd / 2) ? 0 : extra; if (tx.bid >= half) { const Tix tv{tx.tid, tx.bid - half, tx.gd - half};
                if (conv < 4) conv_ffn(p, Wn, conv, lf, tv); else if (conv == 4) conv_rwkv(p, Wn, lf, tv); else conv_pool(p, Wn, tv); } } }
        else if (EN(6) && kind == 6) {
#ifdef PROBE_VAR
            if (rep + 1 < reps) scan_phase<PROBE_VAR>(p, W, lf, tx, 0); else scan_phase<0>(p, W, lf, tx, 0);
#elif defined(PROBE_MASK)
            scan_phase<0>(p, W, lf, tx, (rep + 1 < reps) ? PROBE_MASK : 0);
#else
            scan_phase<0>(p, W, lf, tx, 0);
#endif
        }
        else if (EN(7) && kind == 7) rowpass_gn(p, tx);
        else if (EN(8) && kind == 8) pool_pass(p, pool_pass_id, tx);
        }
        if (ph + 1 < pe) { if (pb > pe) grid.sync(); else xcd_barrier(xb); }
    }
}

#include <cstdio>
#ifndef USE_COOP
#define USE_COOP 1
#endif
extern "C" void kernel_launch(void* const* d_in, const int* in_sizes, int n_in, void* d_out, int out_size, void* d_ws, size_t ws_size, hipStream_t stream) {
    static int grid = 0;
    if (grid == 0) {
        if (n_in != NIN || ws_size < WS_NEED) { fprintf(stderr, "kernel_launch: n_in %d ws %zu (need %zu)\n", n_in, ws_size, (size_t)WS_NEED); grid = -1; return; }
        int dev = 0, cus = 0, per_cu = 0;
        hipGetDevice(&dev); hipDeviceGetAttribute(&cus, hipDeviceAttributeMultiprocessorCount, dev);
        if (hipFuncSetAttribute((const void*)mega, hipFuncAttributeMaxDynamicSharedMemorySize, LDS_BYTES) != hipSuccess) { fprintf(stderr, "kernel_launch: hipFuncSetAttribute failed\n"); grid = -1; return; }
        if (hipOccupancyMaxActiveBlocksPerMultiprocessor(&per_cu, (const void*)mega, 512, LDS_BYTES) != hipSuccess || per_cu < 1) { fprintf(stderr, "kernel_launch: occupancy query says %d\n", per_cu); per_cu = 1; }
        (void)hipGetLastError();
        grid = cus * 1;
        if (grid <= 0) grid = 256;
    }
    if (grid < 0) return;
    if (hipMemsetAsync((unsigned char*)d_ws + OFF_BAR, 0, 16384, stream) != hipSuccess) { fprintf(stderr, "kernel_launch: memset of the barrier words failed\n"); return; }
    Params p{};
    for (int i = 0; i < NIN; ++i) p.in[i] = (const float*)d_in[i];
    p.out = (float*)d_out; p.ws = (unsigned char*)d_ws;
#if USE_COOP
    p.pb = 0; p.pe = NPHASE;
    void* args[] = {&p};
    hipError_t e = hipLaunchCooperativeKernel((const void*)mega, dim3(grid), dim3(512), args, LDS_BYTES, stream);
    if (e != hipSuccess) fprintf(stderr, "cooperative launch failed: %s (grid %d)\n", hipGetErrorString(e), grid);
#else
    for (int ph = 0; ph < NPHASE; ++ph) { p.pb = ph; p.pe = ph + 1; hipLaunchKernelGGL(mega, dim3(grid), dim3(512), LDS_BYTES, stream, p); }
#endif
}
```

```cpp
#include <hip/hip_runtime.h>
#include <hip/hip_cooperative_groups.h>
namespace pg8 {
#define PG8_LAS __attribute__((address_space(3)))
typedef unsigned short bf16_t;
typedef short bf16x8 __attribute__((ext_vector_type(8)));
typedef float f32x4 __attribute__((ext_vector_type(4)));
typedef unsigned u32x4 __attribute__((ext_vector_type(4)));
constexpr int BM = 256, BK = 64, HALF = 128, HTB = HALF * BK * 2  , STAGE_BYTES = 8 * HTB, NXCD = 8, WGM = 8;

__host__ __device__ __forceinline__ int lds_byte(int r, int c) { const int st = (r >> 4) * 2 + (c >> 5), rr = r & 15, cc = c & 31, ob = rr * 64 + cc * 2; return st * 1024 + (ob ^ (((ob >> 9) & 1) << 5)); }
__host__ __device__ __forceinline__ void stage_rc(int b, int& R, int& C) { const int st = b / 1024, sb = b % 1024, swz = sb ^ (((sb >> 9) & 1) << 5); R = (st >> 1) * 16 + swz / 64; C = (st & 1) * 32 + (swz % 64) / 2; }
__host__ __device__ __forceinline__ int perm32(int rho) { const int n = rho >> 4, i = rho & 15; return 8 * (i >> 2) + 4 * n + (i & 3); }

struct Unit { int pm, pn, part; };
struct Gemm { const bf16_t* A; const bf16_t* Bt; int M, N, K; };

struct StaticOrder {
    int nM, nN, nwg, G, c;
    __host__ __device__ void init(int M, int N, int G_, int c_) { nM = M / BM; nN = N / BM; nwg = nM * nN; G = G_; c = c_; }
    __host__ __device__ bool next(int i, Unit& u) const {
        const long L = (long)i * G + c; if (L >= nwg) return false;
        int wgid = (int)L; { const int q = nwg / NXCD, r = nwg % NXCD, xcd = wgid % NXCD, off = wgid / NXCD; wgid = (xcd < r ? xcd * (q + 1) : r * (q + 1) + (xcd - r) * q) + off; }
        const int nig = WGM * nN, gid = wgid / nig, fm = gid * WGM, gsz = (nM - fm) < WGM ? (nM - fm) : WGM;
        u.pm = fm + ((wgid % nig) % gsz); u.pn = (wgid % nig) / gsz; u.part = 0; return true;
    }
    __device__ __forceinline__ void a_ready(const Unit&) const {}
    __device__ __forceinline__ void done(const Unit&) const {}
};
struct FwdOrder {
    StaticOrder so; int mode;
    __host__ __device__ void init(int M, int N, int K, int G_, int c_, int mode_) { so.init(M, N, G_, c_); mode = mode_; }
    __host__ __device__ bool next(int i, Unit& u) const {
        if (mode == 0) return so.next(i, u);
        if (mode == 2) { const bool ok = so.next(i, u); u.part = 3; return ok; }
        if (mode == 3) { const bool ok = so.next(i, u); u.part = 4; return ok; }
        if (i >= 2) return false;
        const int w = (so.c & 7) * 32 + (so.c >> 3);
        if (i == 0) { u.pm = w >> 2; u.pn = w & 3; u.part = 0; }
        else { u.pm = 64 + (w >> 3); u.pn = (w >> 1) & 3; u.part = 1 + (w & 1); }
        return true;
    }
    __device__ __forceinline__ void a_ready(const Unit&) const {}
    __device__ __forceinline__ void done(const Unit&) const {}
};
__device__ __forceinline__ unsigned cvt_pk_bf16(float lo, float hi) { unsigned r; asm volatile("v_cvt_pk_bf16_f32 %0, %1, %2" : "=v"(r) : "v"(lo), "v"(hi)); return r; }
typedef float f32x2 __attribute__((ext_vector_type(2)));
__device__ __forceinline__ float fast_sigmoid(float x) { return __builtin_amdgcn_rcpf(1.0f + __expf(-x)); }
__device__ __forceinline__ float fast_tanh(float x) { return 1.0f - 2.0f * __builtin_amdgcn_rcpf(1.0f + __expf(2.0f * x)); }
struct EpiStore {
    static constexpr bool PERM = true, AFTER_DRAIN = false;
    bf16_t* O; int ldc;
    __device__ __forceinline__ void operator()(const f32x4 (&acc)[2][2][4][2], const Unit& u, int wr, int wc, int fr, int fq) const {
        const int row0 = u.pm * BM + wr * 64 + fr, col0 = u.pn * BM + wc * 32 + 8 * fq;
#pragma unroll
        for (int ai = 0; ai < 2; ++ai)
#pragma unroll
            for (int m = 0; m < 4; ++m) { bf16_t* rowp = O + (size_t)(row0 + ai * HALF + m * 16) * ldc + col0;
#pragma unroll
                for (int bj = 0; bj < 2; ++bj) { const f32x4 v0 = acc[ai][bj][m][0], v1 = acc[ai][bj][m][1];
                    u32x4 w; w.x = cvt_pk_bf16(v0[0], v0[1]); w.y = cvt_pk_bf16(v0[2], v0[3]); w.z = cvt_pk_bf16(v1[0], v1[1]); w.w = cvt_pk_bf16(v1[2], v1[3]);
                    *(u32x4*)(rowp + bj * HALF) = w; } }
    }
};
struct EpiSwiglu {
    static constexpr bool PERM = true, AFTER_DRAIN = false;
    bf16_t* O; int ldc;
    __device__ __forceinline__ void operator()(const f32x4 (&acc)[2][2][4][2], const Unit& u, int wr, int wc, int fr, int fq) const {
        const int row0 = u.pm * BM + wr * 64 + fr, col0 = u.pn * HALF + wc * 32 + 8 * fq;
#pragma unroll
        for (int ai = 0; ai < 2; ++ai)
#pragma unroll
            for (int m = 0; m < 4; ++m) { bf16_t* rowp = O + (size_t)(row0 + ai * HALF + m * 16) * ldc + col0;
                float o[8];
#pragma unroll
                for (int n = 0; n < 2; ++n)
#pragma unroll
                    for (int j = 0; j < 4; ++j) { const float a = acc[ai][0][m][n][j], b = acc[ai][1][m][n][j]; o[n * 4 + j] = a * fast_sigmoid(a) * b; }
                u32x4 w; w.x = cvt_pk_bf16(o[0], o[1]); w.y = cvt_pk_bf16(o[2], o[3]); w.z = cvt_pk_bf16(o[4], o[5]); w.w = cvt_pk_bf16(o[6], o[7]);
                *(u32x4*)rowp = w; }
    }
};
struct EpiRkv {
    static constexpr bool PERM = true, AFTER_DRAIN = false;
    bf16_t* O; size_t tstride; bf16_t* L;
    __device__ __forceinline__ void operator()(const f32x4 (&acc)[2][2][4][2], const Unit& u, int wr, int wc, int fr, int fq) const {
        const int row0 = u.pm * BM + wr * 64 + fr;
        if (u.pn < 12) {
            bf16_t* base = O + (size_t)(u.pn >> 2) * tstride; const int col0 = (u.pn & 3) * BM + wc * 32 + 8 * fq;
#pragma unroll
            for (int ai = 0; ai < 2; ++ai)
#pragma unroll
                for (int m = 0; m < 4; ++m) { bf16_t* rowp = base + (size_t)(row0 + ai * HALF + m * 16) * 1024 + col0;
#pragma unroll
                    for (int bj = 0; bj < 2; ++bj) { const f32x4 v0 = acc[ai][bj][m][0], v1 = acc[ai][bj][m][1];
                        u32x4 w; w.x = cvt_pk_bf16(v0[0], v0[1]); w.y = cvt_pk_bf16(v0[2], v0[3]); w.z = cvt_pk_bf16(v1[0], v1[1]); w.w = cvt_pk_bf16(v1[2], v1[3]);
                        *(u32x4*)(rowp + bj * HALF) = w; } }
        } else {
            const int t13 = (u.pn == 13); const int col0 = (u.pn - 12) * BM + wc * 32 + 8 * fq;
#pragma unroll
            for (int ai = 0; ai < 2; ++ai)
#pragma unroll
                for (int m = 0; m < 4; ++m) { bf16_t* rowp = L + (size_t)(row0 + ai * HALF + m * 16) * 384 + col0;
#pragma unroll
                    for (int bj = 0; bj < 2; ++bj) { if (t13 && bj == 1) continue;
                        float o[8];
#pragma unroll
                        for (int n = 0; n < 2; ++n)
#pragma unroll
                            for (int j = 0; j < 4; ++j) { const float a = acc[ai][bj][m][n][j]; o[n * 4 + j] = t13 ? fast_sigmoid(a) : (bj == 0 ? fast_tanh(a) : a); }
                        u32x4 w; w.x = cvt_pk_bf16(o[0], o[1]); w.y = cvt_pk_bf16(o[2], o[3]); w.z = cvt_pk_bf16(o[4], o[5]); w.w = cvt_pk_bf16(o[6], o[7]);
                        *(u32x4*)(rowp + bj * HALF) = w; } }
        }
    }
};

struct EpiAll {
    static constexpr bool PERM = true, AFTER_DRAIN = false;
    int kind; bf16_t* O; int ldc; bf16_t* L; bf16_t* O2;
    __device__ __forceinline__ void operator()(const f32x4 (&acc)[2][2][4][2], const Unit& u, int wr, int wc, int fr, int fq) const {
        if (kind == 0) { EpiStore e{u.part == 2 ? O2 : O, ldc}; e(acc, u, wr, wc, fr, fq); }
        else if (kind == 1) { EpiSwiglu e{O, ldc}; e(acc, u, wr, wc, fr, fq); }
        else if (kind == 2) { EpiRkv e{O, (size_t)24576 * 1024, L}; e(acc, u, wr, wc, fr, fq); }
    }
};
template <class Epi, class Sched, bool STAMP = false>
__device__ __forceinline__ void gemm_phase(PG8_LAS unsigned char* lds, const Gemm g, const Sched& S, const Epi& E, unsigned long long* stamps, const int tid_in) {
    const int tid = tid_in, wid = __builtin_amdgcn_readfirstlane(tid >> 6), lane = tid & 63, wr = wid >> 2, wc = wid & 3, fr = lane & 15, fq = lane >> 4;
    const int K = g.K; int nt = K / BK;
    int ts_lo = 0, ts_hi = 0, nts = 0; const unsigned long long rt_entry = STAMP ? (unsigned long long)wall_clock64() : 0ull;
#define PG8_STAMP() do { if (STAMP && wid == 0 && nts < 64) { const unsigned long long _c = (unsigned long long)clock64(); \
        ts_lo = (lane == nts) ? (int)(unsigned)_c : ts_lo; ts_hi = (lane == nts) ? (int)(unsigned)(_c >> 32) : ts_hi; ++nts; } } while (0)
    PG8_STAMP();
    unsigned voffA[2], voffB[2];
#pragma unroll
    for (int i = 0; i < 2; ++i) { int R, C; stage_rc(tid * 16 + i * 8192, R, C); const int Rb = Epi::PERM ? ((R & ~31) + perm32(R & 31)) : R;
        voffA[i] = (unsigned)(R * K + C) * 2u; voffB[i] = (unsigned)(Rb * K + C) * 2u; }
    const size_t kstep = (size_t)(BK * 2);
    const size_t hstep = (size_t)HALF * K * 2;
    const size_t tstep = 2 * hstep;
    const unsigned ldsw = (unsigned)wid * 1024u;
    const int aoff = lds_byte(wr * 64 + fr, fq * 8), boff = lds_byte(wc * 32 + fr, fq * 8);
#define PG8_SA(b, h) (((b) * 2 + (h)) * HTB)
#define PG8_SB(b, h) ((4 + (b) * 2 + (h)) * HTB)
#define PG8_STAGE(bufoff, gbase, voff) do { _Pragma("unroll") for (int _i = 0; _i < 2; ++_i) \
        __builtin_amdgcn_global_load_lds((const unsigned*)((const char*)(gbase) + (voff)[_i]), (PG8_LAS unsigned*)(lds + (bufoff) + ldsw + _i * 8192), 16, 0, 0); } while (0)
#define PG8_LDA(dst, b, h) do { _Pragma("unroll") for (int m = 0; m < 4; ++m) _Pragma("unroll") for (int k = 0; k < 2; ++k) dst[m][k] = *(const PG8_LAS bf16x8*)(lds + PG8_SA(b, h) + aoff + m * 2048 + k * 1024); } while (0)
#define PG8_LDB(dst, b, h) do { _Pragma("unroll") for (int n = 0; n < 2; ++n) _Pragma("unroll") for (int k = 0; k < 2; ++k) dst[n][k] = *(const PG8_LAS bf16x8*)(lds + PG8_SB(b, h) + boff + n * 2048 + k * 1024); } while (0)
#define PG8_MMA(ai, bj, At, Bt) do { __builtin_amdgcn_s_setprio(1); _Pragma("unroll") for (int m = 0; m < 4; ++m) _Pragma("unroll") for (int n = 0; n < 2; ++n) _Pragma("unroll") for (int k = 0; k < 2; ++k) \
        acc[ai][bj][m][n] = __builtin_amdgcn_mfma_f32_16x16x32_bf16(Bt[n][k], At[m][k], acc[ai][bj][m][n], 0, 0, 0); __builtin_amdgcn_s_setprio(0); } while (0)
#define PG8_WAIT_V(n) asm volatile("s_waitcnt vmcnt(" #n ")" ::: "memory")
#define PG8_WAIT_L(n) asm volatile("s_waitcnt lgkmcnt(" #n ")" ::: "memory")
#define PG8_BAR __builtin_amdgcn_s_barrier()
#define PG8_SCHED __builtin_amdgcn_sched_barrier(0)
    Unit cur, nxt; int ui = 0;
    if (!S.next(0, cur)) return;
    f32x4 acc[2][2][4][2];
#pragma unroll
    for (int a = 0; a < 2; ++a)
#pragma unroll
        for (int b = 0; b < 2; ++b)
#pragma unroll
            for (int m = 0; m < 4; ++m)
#pragma unroll
                for (int n = 0; n < 2; ++n) acc[a][b][m][n] = (f32x4){0.f, 0.f, 0.f, 0.f};
    bf16x8 At[4][2], B0[2][2], B1[2][2];
    const char* cA = (const char*)g.A + (size_t)cur.pm * tstep + (cur.part == 2 ? (size_t)K : cur.part == 3 ? (size_t)cur.pn * 512 : cur.part == 4 ? (size_t)512 : (size_t)0); const char* cB = (const char*)g.Bt + (size_t)cur.pn * tstep + (cur.part == 2 ? (size_t)K : cur.part == 3 ? (size_t)cur.pn * 512 : cur.part == 4 ? (size_t)512 : (size_t)0);
    nt = cur.part == 3 ? 4 : cur.part == 4 ? 2 : cur.part ? K / (2 * BK) : K / BK;
    S.a_ready(cur);
    PG8_STAGE(PG8_SB(0, 0), cB, voffB); PG8_STAGE(PG8_SA(0, 0), cA, voffA); PG8_STAGE(PG8_SB(0, 1), cB + hstep, voffB); PG8_STAGE(PG8_SA(0, 1), cA + hstep, voffA);
    if (wr == 1) PG8_BAR;
    PG8_WAIT_V(4); PG8_BAR;
    PG8_STAGE(PG8_SB(1, 0), cB + kstep, voffB); PG8_STAGE(PG8_SA(1, 0), cA + kstep, voffA); PG8_STAGE(PG8_SB(1, 1), cB + hstep + kstep, voffB);
    PG8_WAIT_V(6); PG8_BAR;
    PG8_STAMP();
    for (;;) {
        const bool has_next = S.next(ui + 1, nxt);
        const char* nA = has_next ? (const char*)g.A + (size_t)nxt.pm * tstep + (nxt.part == 2 ? (size_t)K : nxt.part == 3 ? (size_t)nxt.pn * 512 : nxt.part == 4 ? (size_t)512 : (size_t)0) : cA; const char* nB = has_next ? (const char*)g.Bt + (size_t)nxt.pn * tstep + (nxt.part == 2 ? (size_t)K : nxt.part == 3 ? (size_t)nxt.pn * 512 : nxt.part == 4 ? (size_t)512 : (size_t)0) : cB;
        for (int t = 0; t < nt; t += 2) {
            const bool last = (t == nt - 2);
            const char* a1 = cA + (size_t)(t + 1) * kstep;
            const char* a2 = last ? nA : cA + (size_t)(t + 2) * kstep; const char* b2 = last ? nB : cB + (size_t)(t + 2) * kstep;
            const char* a3 = a2 + kstep; const char* b3 = b2 + kstep;
            if (last && has_next) S.a_ready(nxt);
            PG8_LDB(B0, 0, 0); PG8_SCHED; PG8_LDA(At, 0, 0); PG8_STAGE(PG8_SA(1, 1), a1 + hstep, voffA);
            PG8_WAIT_L(8); PG8_BAR; PG8_WAIT_L(0); PG8_MMA(0, 0, At, B0); PG8_BAR; PG8_SCHED;
            PG8_LDB(B1, 0, 1); PG8_STAGE(PG8_SB(0, 0), b2, voffB);
            PG8_BAR; PG8_WAIT_L(0); PG8_MMA(0, 1, At, B1); PG8_BAR;
            PG8_LDA(At, 0, 1); PG8_STAGE(PG8_SA(0, 0), a2, voffA);
            PG8_BAR; PG8_WAIT_L(0); PG8_MMA(1, 0, At, B0); PG8_BAR; PG8_SCHED;
            PG8_STAGE(PG8_SB(0, 1), b2 + hstep, voffB);
            PG8_WAIT_V(6); PG8_BAR; PG8_MMA(1, 1, At, B1); PG8_BAR;
            PG8_LDB(B0, 1, 0); PG8_SCHED; PG8_LDA(At, 1, 0); PG8_STAGE(PG8_SA(0, 1), a2 + hstep, voffA);
            PG8_WAIT_L(8); PG8_BAR; PG8_WAIT_L(0); PG8_MMA(0, 0, At, B0); PG8_BAR; PG8_SCHED;
            PG8_LDB(B1, 1, 1); PG8_STAGE(PG8_SB(1, 0), b3, voffB);
            PG8_BAR; PG8_WAIT_L(0); PG8_MMA(0, 1, At, B1); PG8_BAR;
            PG8_LDA(At, 1, 1); PG8_STAGE(PG8_SA(1, 0), a3, voffA);
            PG8_BAR; PG8_WAIT_L(0); PG8_MMA(1, 0, At, B0); PG8_BAR; PG8_SCHED;
            PG8_STAGE(PG8_SB(1, 1), b3 + hstep, voffB);
            PG8_WAIT_V(6); PG8_BAR; PG8_MMA(1, 1, At, B1); PG8_BAR;
        }
        PG8_STAMP();
        if constexpr (!Epi::AFTER_DRAIN) { E(acc, cur, wr, wc, fr, fq); S.done(cur); }
        PG8_STAMP();
        if (!has_next) break;
#pragma unroll
        for (int a = 0; a < 2; ++a)
#pragma unroll
            for (int b = 0; b < 2; ++b)
#pragma unroll
                for (int m = 0; m < 4; ++m)
#pragma unroll
                    for (int n = 0; n < 2; ++n) acc[a][b][m][n] = (f32x4){0.f, 0.f, 0.f, 0.f};
        cur = nxt; cA = nA; cB = nB; ++ui; nt = cur.part == 3 ? 4 : cur.part == 4 ? 2 : cur.part ? K / (2 * BK) : K / BK;
    }
    PG8_WAIT_V(0);
    if (wr == 0) PG8_BAR;
    PG8_BAR;
    if constexpr (Epi::AFTER_DRAIN) { E.fused(acc, cur, wr, wc, fr, fq, lds, wid, lane); S.done(cur); }
    PG8_STAMP();
    if (STAMP && wid == 0) { stamps[lane] = lane < nts ? (((unsigned long long)(unsigned)ts_hi << 32) | (unsigned)ts_lo) : 0ull;
        if (lane == 62) stamps[62] = rt_entry; if (lane == 63) stamps[63] = (unsigned long long)wall_clock64(); }
#undef PG8_STAMP
#undef PG8_SA
#undef PG8_SB
#undef PG8_STAGE
#undef PG8_LDA
#undef PG8_LDB
#undef PG8_MMA
#undef PG8_WAIT_V
#undef PG8_WAIT_L
#undef PG8_BAR
#undef PG8_SCHED
}
}

namespace cg = cooperative_groups;
using pg8::bf16_t; using pg8::bf16x8; using pg8::f32x4; using pg8::u32x4; using pg8::cvt_pk_bf16; using pg8::fast_sigmoid;
#define LAS __attribute__((address_space(3)))
typedef float f32x2 __attribute__((ext_vector_type(2)));
typedef unsigned u32x2 __attribute__((ext_vector_type(2)));

constexpr int D = 1024, DFF = 2816, MP = 8192, MS = 16384, MT = 24576;
constexpr int NIN = 31;
constexpr size_t R48 = (size_t)MT * 1024 * 2;
constexpr size_t OFF_A = 0, OFF_B = R48, OFF_C = 2 * R48, OFF_D = 3 * R48, OFF_E = 4 * R48;
constexpr size_t OFF_S = 5 * R48;
constexpr size_t OFF_W = OFF_S + (size_t)MT * 384 * 2;
constexpr size_t W_ELEMS = 9043968;
constexpr size_t OFF_MOD = OFF_W + W_ELEMS * 2;
constexpr size_t OFF_CBP = OFF_MOD + (size_t)9 * 2 * 9216 * 4;
constexpr size_t OFF_BAR = OFF_CBP + (size_t)2 * MT * 64 * 4;
constexpr size_t OFF_W2 = OFF_BAR + 16384;
constexpr size_t OFF_FB = OFF_W2 + W_ELEMS * 2;
constexpr size_t WS_NEED = OFF_FB + (size_t)8192 * 1024 * 2;
constexpr size_t W_W13 = 0, W_W2T = (size_t)5632 * 1024;
constexpr size_t W_BTP = 0, W_BTG = (size_t)3584 * 2048, W_WOT = W_BTG + (size_t)1024 * 384, W_W2L = W_WOT + (size_t)1024 * 1024, W_A2L = W_W2L + 131072;
constexpr float RMS_EPS = 1e-6f, GN_EPS = 64e-5f;

struct Tix { int tid, bid, gd; };
struct Params { const float* in[NIN]; float* out; unsigned char* ws; int pb, pe; };
typedef const Params __attribute__((address_space(4)))* CP;

__device__ __forceinline__ float bf2f(unsigned short b) { return __uint_as_float(((unsigned)b) << 16); }
__device__ __forceinline__ float bflo(unsigned w) { return __uint_as_float(w << 16); }
__device__ __forceinline__ float bfhi(unsigned w) { return __uint_as_float(w & 0xffff0000u); }
template <int CTRL> __device__ __forceinline__ float dpp_f(float x) { return __builtin_bit_cast(float, __builtin_amdgcn_mov_dpp(__builtin_bit_cast(int, x), CTRL, 0xf, 0xf, true)); }
__device__ __forceinline__ float row16_sum(float v) { v += dpp_f<0xB1>(v); v += dpp_f<0x4E>(v); v += dpp_f<0x141>(v); v += dpp_f<0x128>(v); return v; }
__device__ __forceinline__ float wave_sum(float v) {
    v = row16_sum(v);
    auto s1 = __builtin_amdgcn_permlane16_swap(__float_as_uint(v), __float_as_uint(v), false, false); v = __uint_as_float(s1[0]) + __uint_as_float(s1[1]);
    auto s2 = __builtin_amdgcn_permlane32_swap(__float_as_uint(v), __float_as_uint(v), false, false); v = __uint_as_float(s2[0]) + __uint_as_float(s2[1]);
    return v;
}
__device__ __forceinline__ float reduce8(float x) { x += dpp_f<0xB1>(x); x += dpp_f<0x4E>(x); x += dpp_f<0x141>(x); return x; }

struct ConvJob { const float* src; int K, N; bf16_t* dst; int dld, kofs, blk, blk_stride, row_off; const float* ksc; };
__device__ __forceinline__ void conv_job(const ConvJob j, LAS float* tile, int& rot, const Tix tx) {
    const int tid = tx.tid, G = tx.gd;
    const int tn = j.N >> 6, nt = (j.K >> 6) * tn;
    int t0 = (tx.bid - (rot % G) + G) % G;
    for (int t = t0; t < nt; t += G) {
        const int k0 = (t / tn) << 6, n0 = (t % tn) << 6;
        { const int r = tid >> 4, c4 = tid & 15;
#pragma unroll
          for (int it = 0; it < 2; ++it) { const int k = r + 32 * it; const float4 v = *(const float4*)(j.src + (size_t)(k0 + k) * j.N + n0 + 4 * c4);
              LAS float* tp = tile + k * 65 + 4 * c4; tp[0] = v.x; tp[1] = v.y; tp[2] = v.z; tp[3] = v.w; } }
        __syncthreads();
        { const int n = tid >> 3, kg = tid & 7; float v[8];
#pragma unroll
          for (int i = 0; i < 8; ++i) { v[i] = tile[(8 * kg + i) * 65 + n]; if (j.ksc) v[i] *= j.ksc[k0 + 8 * kg + i]; }
          u32x4 w; w.x = cvt_pk_bf16(v[0], v[1]); w.y = cvt_pk_bf16(v[2], v[3]); w.z = cvt_pk_bf16(v[4], v[5]); w.w = cvt_pk_bf16(v[6], v[7]);
          const int gn = n0 + n; const int drow = (gn / j.blk) * j.blk_stride + (gn % j.blk) + j.row_off;
          *(u32x4*)(j.dst + (size_t)drow * j.dld + j.kofs + k0 + 8 * kg) = w; }
        __syncthreads();
    }
    rot += nt;
}
__device__ void conv_ffn(CP p, bf16_t* W, int fi, LAS float* tile, const Tix tx) {
    int rot = 0;
    conv_job(ConvJob{p->in[10] + (size_t)fi * D * DFF, D, DFF, W + W_W13, 1024, 0, 128, 256, 0, nullptr}, tile, rot, tx);
    conv_job(ConvJob{p->in[11] + (size_t)fi * D * DFF, D, DFF, W + W_W13, 1024, 0, 128, 256, 128, nullptr}, tile, rot, tx);
    conv_job(ConvJob{p->in[12] + (size_t)fi * D * DFF, DFF, D, W + W_W2T, 2816, 0, 1024, 1024, 0, nullptr}, tile, rot, tx);
}
__device__ void conv_rwkv(CP p, bf16_t* W, LAS float* tile, const Tix tx) {
    int rot = 0;
    const float* mu = p->in[13];
    for (int half = 0; half < 2; ++half) {
        const int ko = half * 1024;
        for (int i = 0; i < 3; ++i) { const int mi = (i == 0) ? 0 : (i == 1 ? 2 : 3);
            conv_job(ConvJob{p->in[14] + (size_t)i * D * D, D, D, W + W_BTP, 2048, ko, 1024, 1024, i * 1024, half ? mu + mi * D : nullptr}, tile, rot, tx); }
        for (int d = 0; d < 2; ++d) {
            conv_job(ConvJob{p->in[16] + (size_t)d * D * 64, D, 64, W + W_BTP, 2048, ko, 64, 64, 3072 + 64 * d, half ? mu + 1 * D : nullptr}, tile, rot, tx);
            conv_job(ConvJob{p->in[19] + (size_t)d * D * 64, D, 64, W + W_BTP, 2048, ko, 64, 64, 3200 + 64 * d, half ? mu + 4 * D : nullptr}, tile, rot, tx); }
        conv_job(ConvJob{p->in[21], D, 128, W + W_BTP, 2048, ko, 128, 128, 3328, half ? mu + 5 * D : nullptr}, tile, rot, tx);
    }
    conv_job(ConvJob{p->in[22], 128, D, W + W_BTG, 384, 256, 1024, 1024, 0, nullptr}, tile, rot, tx);
    for (int idx = tx.bid * 512 + tx.tid; idx < 1024 * 32; idx += tx.gd * 512) { const int n = idx >> 5, k8 = idx & 31; *(u32x4*)(W + W_BTG + (size_t)n * 384 + 8 * k8) = (u32x4){0u, 0u, 0u, 0u}; }
    conv_job(ConvJob{p->in[28], D, D, W + W_WOT, 1024, 0, 1024, 1024, 0, nullptr}, tile, rot, tx);
    for (int d = 0; d < 2; ++d) {
        conv_job(ConvJob{p->in[17] + (size_t)d * 64 * D, 64, D, W + W_W2L + (size_t)d * 65536, 64, 0, 1024, 1024, 0, nullptr}, tile, rot, tx);
        conv_job(ConvJob{p->in[20] + (size_t)d * 64 * D, 64, D, W + W_A2L + (size_t)d * 65536, 64, 0, 1024, 1024, 0, nullptr}, tile, rot, tx); }
}
__device__ void conv_pool(CP p, bf16_t* W, const Tix tx) {
    const float* pw = p->in[29]; const float* ps = p->in[30];
    for (int idx = tx.bid * 512 + tx.tid; idx < 1024 * 128; idx += tx.gd * 512) {
        const int k8 = idx >> 10, n = idx & 1023, g = n >> 8; u32x4 w = (u32x4){0u, 0u, 0u, 0u};
        if ((k8 >> 5) == g) { const float s = ps[n]; float v[8];
#pragma unroll
            for (int i = 0; i < 8; ++i) v[i] = pw[((size_t)g * 256 + ((8 * k8 + i) & 255)) * 256 + (n & 255)] * s;
            w.x = cvt_pk_bf16(v[0], v[1]); w.y = cvt_pk_bf16(v[2], v[3]); w.z = cvt_pk_bf16(v[4], v[5]); w.w = cvt_pk_bf16(v[6], v[7]); }
        *(u32x4*)(W + (size_t)n * 1024 + 8 * k8) = w; }
}

__device__ void mod_phase(CP p, LAS float* lf, const Tix tx) {
    LAS float* sc = lf; LAS float* red = lf + 9216;
    const int tid = tx.tid;
    if (tx.bid >= 288) return;
    for (int o = tid; o < 9216; o += 512) { const int c = o >> 10, k = o & 1023; const float v = (c == 0) ? p->in[5][k] : p->in[2][(c - 1) * 1024 + k]; sc[o] = v * fast_sigmoid(v); }
    __syncthreads();
    float* mod = (float*)(p->ws + OFF_MOD);
    for (int item = tx.bid; item < 288; item += tx.gd) {
        const int i = item / 144, n0 = (item % 144) * 64, col = tid & 63, ks = tid >> 6;
        float acc[9];
#pragma unroll
        for (int c = 0; c < 9; ++c) acc[c] = 0.f;
        const float* wp = p->in[6] + ((size_t)i * 1024 + ks * 128) * 9216 + n0 + col;
#pragma unroll 8
        for (int k = 0; k < 128; ++k) { const float w = wp[(size_t)k * 9216];
#pragma unroll
            for (int c = 0; c < 9; ++c) acc[c] += sc[c * 1024 + ks * 128 + k] * w; }
#pragma unroll
        for (int c = 0; c < 9; ++c) red[(ks * 9 + c) * 64 + col] = acc[c];
        __syncthreads();
        for (int o = tid; o < 576; o += 512) { const int c = o >> 6, cl = o & 63; float s = p->in[7][i * 9216 + n0 + cl];
#pragma unroll
            for (int k2 = 0; k2 < 8; ++k2) s += red[(k2 * 9 + c) * 64 + cl];
            mod[((size_t)c * 2 + i) * 9216 + n0 + cl] = s; }
        __syncthreads();
    }
}

struct RowCfg {
    int src_input;
    int pending;
    int lg, gidx; float coef; const float* npost;
    int has_next;
    int lh, shidx, scidx; const float* npre;
    int write_x;
    int fsplit;
};
__device__ __forceinline__ const float* xrow_in(CP p, int m) { return m < MP ? p->in[0] + (size_t)m * D : p->in[1] + (size_t)(m - MP) * D; }
__device__ __forceinline__ int cond_of(int m) { return m < MP ? 0 : 1 + ((m - MP) >> 11); }
__device__ __forceinline__ void row_update(CP p, const RowCfg& c, int m, int lane, f32x4 (&x)[4]) {
    const float* xr = c.src_input ? xrow_in(p, m) : p->out + (size_t)m * D;
    const float* mod = (const float*)(p->ws + OFF_MOD);
    const int cd = cond_of(m);
#pragma unroll
    for (int q = 0; q < 4; ++q) x[q] = *(const f32x4*)(xr + 4 * lane + 256 * q);
    if (c.pending) {
        const bf16_t* fr = (const bf16_t*)(p->ws + OFF_E) + (size_t)m * D; f32x4 f[4]; float ss = 0.f;
#pragma unroll
        for (int q = 0; q < 4; ++q) { const u32x2 w = *(const u32x2*)(fr + 4 * lane + 256 * q); f[q] = (f32x4){bflo(w.x), bfhi(w.x), bflo(w.y), bfhi(w.y)}; }
        if (c.fsplit && m >= 16384) {
            const bf16_t* fr2 = (const bf16_t*)(p->ws + OFF_FB) + (size_t)(m - 16384) * D;
#pragma unroll
            for (int q = 0; q < 4; ++q) { const u32x2 w = *(const u32x2*)(fr2 + 4 * lane + 256 * q); f[q] += (f32x4){bflo(w.x), bfhi(w.x), bflo(w.y), bfhi(w.y)}; } }
#pragma unroll
        for (int q = 0; q < 4; ++q) ss += f[q][0] * f[q][0] + f[q][1] * f[q][1] + f[q][2] * f[q][2] + f[q][3] * f[q][3];
        ss = wave_sum(ss); const float rs = rsqrtf(ss * (1.0f / 1024.0f) + RMS_EPS) * c.coef;
        const float* gate = mod + ((size_t)(cd * 2 + c.lg) * 9 + c.gidx) * D;
#pragma unroll
        for (int q = 0; q < 4; ++q) { const f32x4 g = *(const f32x4*)(gate + 4 * lane + 256 * q), np = *(const f32x4*)(c.npost + 4 * lane + 256 * q); x[q] += g * (f[q] * np) * rs; }
    }
}
__device__ __forceinline__ void row_premod(CP p, const RowCfg& c, int m, int lane, const f32x4 (&x)[4], f32x4 (&h)[4]) {
    const float* mod = (const float*)(p->ws + OFF_MOD);
    const int cd = cond_of(m);
    float ss = 0.f;
#pragma unroll
    for (int q = 0; q < 4; ++q) ss += x[q][0] * x[q][0] + x[q][1] * x[q][1] + x[q][2] * x[q][2] + x[q][3] * x[q][3];
    ss = wave_sum(ss); const float rs = rsqrtf(ss * (1.0f / 1024.0f) + RMS_EPS);
    const float* sh = mod + ((size_t)(cd * 2 + c.lh) * 9 + c.shidx) * D; const float* scl = mod + ((size_t)(cd * 2 + c.lh) * 9 + c.scidx) * D;
#pragma unroll
    for (int q = 0; q < 4; ++q) { const f32x4 g = *(const f32x4*)(c.npre + 4 * lane + 256 * q), s1 = *(const f32x4*)(scl + 4 * lane + 256 * q), s0 = *(const f32x4*)(sh + 4 * lane + 256 * q);
        h[q] = (x[q] * rs * g) * (1.0f + s1) + s0; }
}
__device__ __forceinline__ void store_bf16_row(bf16_t* dst, int lane, const f32x4 (&h)[4]) {
#pragma unroll
    for (int q = 0; q < 4; ++q) { u32x2 w; w.x = cvt_pk_bf16(h[q][0], h[q][1]); w.y = cvt_pk_bf16(h[q][2], h[q][3]); *(u32x2*)(dst + 4 * lane + 256 * q) = w; }
}
__device__ void rowpass_simple(CP p, const RowCfg c, const Tix tx) {
    const int lane = tx.tid & 63, wid = tx.tid >> 6, nw = tx.gd * 8;
    bf16_t* hdst = (bf16_t*)(p->ws + OFF_A);
    for (int m = tx.bid * 8 + wid; m < MT; m += nw) {
        f32x4 x[4]; row_update(p, c, m, lane, x);
        if (c.write_x) {
#pragma unroll
            for (int q = 0; q < 4; ++q) *(f32x4*)(p->out + (size_t)m * D + 4 * lane + 256 * q) = x[q]; }
        if (c.has_next) { f32x4 h[4]; row_premod(p, c, m, lane, x, h); store_bf16_row(hdst + (size_t)m * D, lane, h); }
    }
}
__device__ void rowpass_shift(CP p, const RowCfg c, LAS float* lf, const Tix tx) {
    const int lane = tx.tid & 63, wid = tx.tid >> 6;
    bf16_t* adst = (bf16_t*)(p->ws + OFF_A);
    constexpr int RUN = 12;
    for (int run = tx.bid * 8 + wid; run < MT / RUN; run += tx.gd * 8) {
        const int m0 = run * RUN;
        f32x4 hA[4], hB[4], xB[4];
#pragma unroll
        for (int q = 0; q < 4; ++q) { hA[q] = (f32x4){0.f, 0.f, 0.f, 0.f}; hB[q] = hA[q]; xB[q] = hA[q]; }
#pragma unroll 1
        for (int j = -1; j <= RUN; ++j) {
            const int m = m0 + j;
            f32x4 xC[4], hC[4];
#pragma unroll
            for (int q = 0; q < 4; ++q) { xC[q] = (f32x4){0.f, 0.f, 0.f, 0.f}; hC[q] = xC[q]; }
            if (m >= 0 && m < MT) { row_update(p, c, m, lane, xC); row_premod(p, c, m, lane, xC, hC); }
            if (j >= 1) {
                const int mo = m - 1; const int T = mo < MP ? 256 : 2048, t = mo < MP ? (mo & 255) : ((mo - MP) & 2047);
                f32x4 hs[4];
#pragma unroll
                for (int q = 0; q < 4; ++q) { *(f32x4*)(p->out + (size_t)mo * D + 4 * lane + 256 * q) = xB[q];
                    hs[q] = (f32x4){0.f, 0.f, 0.f, 0.f};
                    if (t > 0) hs[q] += hA[q];
                    if (t < T - 1) hs[q] += hC[q];
                    hs[q] = 0.5f * hs[q] - hB[q]; }
                store_bf16_row(adst + (size_t)mo * 2048, lane, hB);
                store_bf16_row(adst + (size_t)mo * 2048 + 1024, lane, hs);
            }
#pragma unroll
            for (int q = 0; q < 4; ++q) { hA[q] = hB[q]; hB[q] = hC[q]; xB[q] = xC[q]; }
        }
    }
}
__device__ void rowpass_gn(CP p, const Tix tx) {
    const int lane = tx.tid & 63, wid = tx.tid >> 6, nw = tx.gd * 8;
    const bf16_t* yf = (const bf16_t*)(p->ws + OFF_A); const bf16_t* yb = (const bf16_t*)(p->ws + OFF_B);
    const bf16_t* gb = (const bf16_t*)(p->ws + OFF_C); const bf16_t* vb = (const bf16_t*)(p->ws + OFF_E);
    bf16_t* ob = (bf16_t*)(p->ws + OFF_D); const float* cbp = (const float*)(p->ws + OFF_CBP);
    const float* gnw = p->in[26]; const float* gnb = p->in[27];
    for (int m = tx.bid * 8 + wid; m < MT; m += nw) {
#pragma unroll
        for (int q = 0; q < 2; ++q) {
            const int col = 8 * lane + 512 * q, hd = (lane >> 3) + 8 * q;
            const u32x4 a = *(const u32x4*)(yf + (size_t)m * D + col), b = *(const u32x4*)(yb + (size_t)m * D + col);
            const u32x4 vw = *(const u32x4*)(vb + (size_t)m * D + col), gw = *(const u32x4*)(gb + (size_t)m * D + col);
            const f32x4 c0 = *(const f32x4*)(cbp + ((size_t)m * 16 + hd) * 4), c1 = *(const f32x4*)(cbp + ((size_t)(MT + m) * 16 + hd) * 4);
            const f32x4 w0 = *(const f32x4*)(gnw + col), w1 = *(const f32x4*)(gnw + col + 4), b0 = *(const f32x4*)(gnb + col), b1 = *(const f32x4*)(gnb + col + 4);
            float y[8] = {bflo(a.x) + bflo(b.x), bfhi(a.x) + bfhi(b.x), bflo(a.y) + bflo(b.y), bfhi(a.y) + bfhi(b.y), bflo(a.z) + bflo(b.z), bfhi(a.z) + bfhi(b.z), bflo(a.w) + bflo(b.w), bfhi(a.w) + bfhi(b.w)};
            float s = ((y[0] + y[1]) + (y[2] + y[3])) + ((y[4] + y[5]) + (y[6] + y[7]));
            s = reduce8(s);
            const float mean = s * (1.0f / 64.0f); float vs = 0.f;
#pragma unroll
            for (int i = 0; i < 8; ++i) { y[i] -= mean; vs += y[i] * y[i]; }
            vs = reduce8(vs);
            const float rstd = rsqrtf(vs * (1.0f / 64.0f) + GN_EPS);
            const float cb = ((c0[0] + c0[1]) + (c0[2] + c0[3])) + ((c1[0] + c1[1]) + (c1[2] + c1[3]));
            const float vv[8] = {bflo(vw.x), bfhi(vw.x), bflo(vw.y), bfhi(vw.y), bflo(vw.z), bfhi(vw.z), bflo(vw.w), bfhi(vw.w)};
            const float gg[8] = {bflo(gw.x), bfhi(gw.x), bflo(gw.y), bfhi(gw.y), bflo(gw.z), bfhi(gw.z), bflo(gw.w), bfhi(gw.w)};
            const float ww[8] = {w0[0], w0[1], w0[2], w0[3], w1[0], w1[1], w1[2], w1[3]}, bb[8] = {b0[0], b0[1], b0[2], b0[3], b1[0], b1[1], b1[2], b1[3]};
            float o[8];
#pragma unroll
            for (int i = 0; i < 8; ++i) o[i] = (y[i] * rstd * ww[i] + bb[i] + cb * vv[i]) * gg[i];
            u32x4 ow; ow.x = cvt_pk_bf16(o[0], o[1]); ow.y = cvt_pk_bf16(o[2], o[3]); ow.z = cvt_pk_bf16(o[4], o[5]); ow.w = cvt_pk_bf16(o[6], o[7]);
            *(u32x4*)(ob + (size_t)m * D + col) = ow;
        }
    }
}

__device__ __forceinline__ void pool_add(float (&s)[8], const u32x4 w, const float sg) {
    s[0] += sg * bflo(w.x); s[1] += sg * bfhi(w.x); s[2] += sg * bflo(w.y); s[3] += sg * bfhi(w.y); s[4] += sg * bflo(w.z); s[5] += sg * bfhi(w.z); s[6] += sg * bflo(w.w); s[7] += sg * bfhi(w.w);
}
template <int WIN> __device__ __forceinline__ void pool_blk(const bf16_t* src, const int sb, const int stride, const int L, const int a0, const int ch, const int mode,
                                                            bf16_t* dst, const int db, const bf16_t* hsrc, const int hb) {
    constexpr int HW = WIN / 2, NT = WIN + 7;
    u32x4 tap[NT];
#pragma unroll
    for (int j = 0; j < NT; ++j) { const int pp = a0 - HW + j; const int pc = min(max(pp, 0), L - 1);
        const u32x4 w = *(const u32x4*)(src + (size_t)(sb + pc * stride) * D + ch);
        tap[j] = (pp >= 0 && pp < L) ? w : (u32x4){0u, 0u, 0u, 0u}; }
    float s[8];
#pragma unroll
    for (int i = 0; i < 8; ++i) s[i] = 0.f;
#pragma unroll
    for (int j = 0; j < WIN; ++j) pool_add(s, tap[j], 1.0f);
#pragma unroll
    for (int i = 0; i < 8; ++i) {
        const int a = a0 + i;
        const float inv = __builtin_amdgcn_rcpf((float)(min(a + HW, L) - max(a - HW, 0)));
        float c8[8];
        if (mode == 1) {
#pragma unroll
            for (int k = 0; k < 8; ++k) c8[k] = 0.f; }
        else { const u32x4 cw = (mode == 0) ? tap[i + HW] : *(const u32x4*)(hsrc + (size_t)(hb + a * stride) * D + ch);
            c8[0] = bflo(cw.x); c8[1] = bfhi(cw.x); c8[2] = bflo(cw.y); c8[3] = bfhi(cw.y); c8[4] = bflo(cw.z); c8[5] = bfhi(cw.z); c8[6] = bflo(cw.w); c8[7] = bfhi(cw.w); }
        u32x4 o; o.x = cvt_pk_bf16(s[0] * inv - c8[0], s[1] * inv - c8[1]); o.y = cvt_pk_bf16(s[2] * inv - c8[2], s[3] * inv - c8[3]);
        o.z = cvt_pk_bf16(s[4] * inv - c8[4], s[5] * inv - c8[5]); o.w = cvt_pk_bf16(s[6] * inv - c8[6], s[7] * inv - c8[7]);
        *(u32x4*)(dst + (size_t)(db + a * stride) * D + ch) = o;
        if (i < 7) { pool_add(s, tap[i + WIN], 1.0f); pool_add(s, tap[i], -1.0f); }
    }
}
template <int WIN> __device__ __forceinline__ void pool_unit(CP p, const int pass, const int v, const int gi, const int lane) {
    const bf16_t* h = (const bf16_t*)(p->ws + OFF_A); bf16_t* t1 = (bf16_t*)(p->ws + OFF_B); bf16_t* dl = (bf16_t*)(p->ws + OFF_D);
    const int ch = gi * 256 + 8 * (lane & 31), sub = (lane >> 5) * 8;
    if (pass == 0) {
        if (v < 512) { const int seq = v >> 4, k = v & 15; pool_blk<WIN>(h, seq * 256, 1, 256, 16 * k + sub, ch, 0, dl, seq * 256, h, 0); }
        else { const int w = v - 512, b = w >> 7, cc = (w >> 1) & 63, k = w & 1;
            pool_blk<WIN>(h, MP + b * 2048 + cc, 64, 32, 16 * k + sub, ch, 1, t1, b * 2048 + cc, h, 0); }
    } else { const int b = v >> 7, r = (v >> 2) & 31, k = v & 3;
        pool_blk<WIN>(t1, b * 2048 + r * 64, 1, 64, 16 * k + sub, ch, 2, dl, MP + b * 2048 + r * 64, h, MP + b * 2048 + r * 64); }
}
__device__ void pool_pass(CP p, int pass, const Tix tx) {
    const int lane = tx.tid & 63, wid = tx.tid >> 6;
    const int total = (pass == 0 ? 1536 : 1024) * 4;
    for (int u = tx.bid * 8 + wid; u < total; u += tx.gd * 8) {
        const int gi = u & 3, v = u >> 2;
        if (gi == 0) pool_unit<2>(p, pass, v, 0, lane); else if (gi == 1) pool_unit<4>(p, pass, v, 1, lane);
        else if (gi == 2) pool_unit<8>(p, pass, v, 2, lane); else pool_unit<16>(p, pass, v, 3, lane);
    }
}

constexpr int SST = 324;
constexpr int SBUF = 16 * SST + 64;
template <int VAR> __device__ void scan_phase(CP p, const bf16_t* W, LAS float* lf, const Tix tx, const int skipmask) {
    const int tid = tx.tid, lane = tid & 63, wid = tid >> 6, grp = wid >> 2, q = wid & 3;
    const int l15 = lane & 15, quad = lane >> 4, rl = lane >> 3, cg8 = lane & 7, i0 = 16 * q + 2 * rl;
    const bf16_t* rb = (const bf16_t*)(p->ws + OFF_C); const bf16_t* kb = (const bf16_t*)(p->ws + OFF_D); const bf16_t* vb = (const bf16_t*)(p->ws + OFF_E);
    const bf16_t* lb = (const bf16_t*)(p->ws + OFF_S);
    bf16_t* yout = (bf16_t*)(p->ws + OFF_A);
    float* cbp = (float*)(p->ws + OFF_CBP);
    const int tch = grp == 0 ? 128 : 16, nsub = grp == 0 ? 1 : ((skipmask & 8) ? 0 : 4);
    for (int it = tx.bid; it < 256; it += tx.gd) {
        f32x2 Sa[4], Sb[4];
        bf16x8 W2f[2], A2f[2];
        LAS float* ystage = lf + 4 * SBUF + 8 * 144 + wid * 1024;
        LAS float* wcst = lf + 4 * SBUF + wid * 144;
#pragma unroll
        for (int i = 0; i < 4; ++i) { Sa[i] = (f32x2){0.f, 0.f}; Sb[i] = (f32x2){0.f, 0.f}; }
        W2f[0] = W2f[1] = A2f[0] = A2f[1] = (bf16x8){0, 0, 0, 0, 0, 0, 0, 0};
        u32x2 pr = (u32x2){0u, 0u}, pk = pr, pv = pr; u32x4 pkf0 = (u32x4){0u, 0u, 0u, 0u}, pkf1 = pkf0; bf16x8 plw0 = (bf16x8){0, 0, 0, 0, 0, 0, 0, 0}, plw1 = plw0, pla0 = plw0, pla1 = plw0;
        int mn = 0, dn = 0, hhn = 0, scn = 0, slg = 0; bool sact = false;
        for (int c = -2; c < 128; ++c) {
#pragma unroll 1
          for (int slot = 0; slot < 2; ++slot) {
            if ((slot == 0) == (grp == 1)) {
                if (sact && !(skipmask & 2)) {
                    f32x4 aw = (f32x4){0.f, 0.f, 0.f, 0.f}, aa = aw;
                    aw = __builtin_amdgcn_mfma_f32_16x16x32_bf16(W2f[0], plw0, aw, 0, 0, 0); aw = __builtin_amdgcn_mfma_f32_16x16x32_bf16(W2f[1], plw1, aw, 0, 0, 0);
                    aa = __builtin_amdgcn_mfma_f32_16x16x32_bf16(A2f[0], pla0, aa, 0, 0, 0); aa = __builtin_amdgcn_mfma_f32_16x16x32_bf16(A2f[1], pla1, aa, 0, 0, 0);
                    const f32x4 cw0 = *(const LAS f32x4*)(wcst + 4 * quad), ca0 = *(const LAS f32x4*)(wcst + 16 + 4 * quad), ckk = *(const LAS f32x4*)(wcst + 32 + 4 * quad), cka = *(const LAS f32x4*)(wcst + 48 + 4 * quad), crk = *(const LAS f32x4*)(wcst + 64 + 4 * quad);
                    f32x4 kn[4];
    #pragma unroll
                    for (int i = 0; i < 4; ++i) kn[i] = *(const LAS f32x4*)(wcst + 80 + 16 * quad + 4 * i);
                    float ssq = 0.f;
                    { const unsigned kw[8] = {pkf0.x, pkf0.y, pkf0.z, pkf0.w, pkf1.x, pkf1.y, pkf1.z, pkf1.w};
    #pragma unroll
                      for (int i = 0; i < 8; ++i) { const float a = bflo(kw[i]) * kn[i >> 1][(i & 1) * 2], b2 = bfhi(kw[i]) * kn[i >> 1][(i & 1) * 2 + 1]; ssq += a * a + b2 * b2; } }
                    { auto s1 = __builtin_amdgcn_permlane16_swap(__float_as_uint(ssq), __float_as_uint(ssq), false, false); ssq = __uint_as_float(s1[0]) + __uint_as_float(s1[1]);
                      auto s2 = __builtin_amdgcn_permlane32_swap(__float_as_uint(ssq), __float_as_uint(ssq), false, false); ssq = __uint_as_float(s2[0]) + __uint_as_float(s2[1]); }
                    const float rn = fminf(__builtin_amdgcn_rsqf(ssq), 1e12f);
                    const f32x4 r4 = (f32x4){bflo(pr.x), bfhi(pr.x), bflo(pr.y), bfhi(pr.y)}, k4 = (f32x4){bflo(pk.x), bfhi(pk.x), bflo(pk.y), bfhi(pk.y)}, v4 = (f32x4){bflo(pv.x), bfhi(pv.x), bflo(pv.y), bfhi(pv.y)};
                    f32x4 e4, E4, kk4, b4, kd4, rh4, cs4; float cbs = 0.f;
    #pragma unroll
                    for (int j = 0; j < 4; ++j) { e4[j] = 0.60653066f * fast_sigmoid(cw0[j] + aw[j]);
                        float t = e4[j];
                        t += __builtin_bit_cast(float, __builtin_amdgcn_update_dpp(0, __builtin_bit_cast(int, t), 0x111, 0xf, 0xf, true));
                        t += __builtin_bit_cast(float, __builtin_amdgcn_update_dpp(0, __builtin_bit_cast(int, t), 0x112, 0xf, 0xf, true));
                        t += __builtin_bit_cast(float, __builtin_amdgcn_update_dpp(0, __builtin_bit_cast(int, t), 0x114, 0xf, 0xf, true));
                        t += __builtin_bit_cast(float, __builtin_amdgcn_update_dpp(0, __builtin_bit_cast(int, t), 0x118, 0xf, 0xf, true));
                        E4[j] = t; }
    #pragma unroll
                    for (int j = 0; j < 4; ++j) {
                        const float a = fast_sigmoid(ca0[j] + aa[j]);
                        const float kkn = k4[j] * ckk[j] * rn, bq = kkn * a, kd = k4[j] * (1.0f + (a - 1.0f) * cka[j]);
                        cbs += r4[j] * kd * crk[j];
                        const float cs = __expf(-E4[j]), cinv = __builtin_amdgcn_rcpf(cs);
                        const float cp = __builtin_bit_cast(float, __builtin_amdgcn_update_dpp(0x3f800000, __builtin_bit_cast(int, cs), 0x111, 0xf, 0xf, false));
                        kk4[j] = kkn * cp; b4[j] = bq * cinv; kd4[j] = kd * cinv; rh4[j] = r4[j] * cs; cs4[j] = cs; }
                    LAS float* wb = lf + (slg * 2 + (scn & 1)) * SBUF;
                    LAS float* wp = wb + l15 * SST + 16 * q + 4 * quad;
                    *(LAS f32x4*)(wp) = kk4; *(LAS f32x4*)(wp + 64) = b4; *(LAS f32x4*)(wp + 128) = kd4; *(LAS f32x4*)(wp + 192) = rh4; *(LAS f32x4*)(wp + 256) = v4;
                    if (l15 == 15) *(LAS f32x4*)(wb + 16 * SST + 16 * q + 4 * quad) = cs4;
                    { auto s1 = __builtin_amdgcn_permlane16_swap(__float_as_uint(cbs), __float_as_uint(cbs), false, false); cbs = __uint_as_float(s1[0]) + __uint_as_float(s1[1]);
                      auto s2 = __builtin_amdgcn_permlane32_swap(__float_as_uint(cbs), __float_as_uint(cbs), false, false); cbs = __uint_as_float(s2[0]) + __uint_as_float(s2[1]); }
                    if (quad == 0) cbp[(((size_t)dn * MT + mn) * 16 + hhn) * 4 + q] = cbs;
                }
            }
            if (slot == 0) {
                const int cn = c + 1 + grp; const int g1len = ((skipmask & 8) ? 0 : 4) * 16;
                const int lg = (grp == 1 && cn >= g1len) ? 0 : grp;
                const int ltch = lg == 0 ? 128 : 16; const int subn = cn / ltch, ccn = cn % ltch;
                const bool actn = (cn >= 0) && (cn < 128) && (grp == 1 || cn < g1len);
                sact = actn; scn = cn; slg = lg;
                if (actn && !(skipmask & 4)) {
                    const int pid = lg == 0 ? it : 4 * it + subn; dn = pid & 1; hhn = (pid >> 1) & 15; const int b = pid >> 5;
                    const int T = lg == 0 ? 2048 : 256, mb = lg == 0 ? MP + b * 2048 : b * 256;
                    const int pos = ccn * 16 + l15; mn = mb + (dn == 0 ? pos : T - 1 - pos);
                    const int col4 = 64 * hhn + 16 * q + 4 * quad;
                    pr = *(const u32x2*)(rb + (size_t)mn * D + col4); pk = *(const u32x2*)(kb + (size_t)mn * D + col4); pv = *(const u32x2*)(vb + (size_t)mn * D + col4);
                    pkf0 = *(const u32x4*)(kb + (size_t)mn * D + 64 * hhn + 16 * quad); pkf1 = *(const u32x4*)(kb + (size_t)mn * D + 64 * hhn + 16 * quad + 8);
                    plw0 = *(const bf16x8*)(lb + (size_t)mn * 384 + dn * 64 + 8 * quad); plw1 = *(const bf16x8*)(lb + (size_t)mn * 384 + dn * 64 + 32 + 8 * quad);
                    pla0 = *(const bf16x8*)(lb + (size_t)mn * 384 + 128 + dn * 64 + 8 * quad); pla1 = *(const bf16x8*)(lb + (size_t)mn * 384 + 128 + dn * 64 + 32 + 8 * quad);
                    if (ccn == 0 || (grp == 1 && lg == 0 && cn == g1len)) {
                        const bf16_t* w2r = W + W_W2L + ((size_t)dn * 1024 + 64 * hhn + 16 * q + l15) * 64 + 8 * quad;
                        const bf16_t* a2r = W + W_A2L + ((size_t)dn * 1024 + 64 * hhn + 16 * q + l15) * 64 + 8 * quad;
                        W2f[0] = *(const bf16x8*)w2r; W2f[1] = *(const bf16x8*)(w2r + 32); A2f[0] = *(const bf16x8*)a2r; A2f[1] = *(const bf16x8*)(a2r + 32);
                        const int cw = 64 * hhn + 16 * q + l15;
                        if (lane < 16) { wcst[lane] = p->in[15][dn * D + cw]; wcst[16 + lane] = p->in[18][dn * D + cw]; wcst[32 + lane] = p->in[23][cw]; wcst[48 + lane] = p->in[24][cw]; wcst[64 + lane] = p->in[25][cw]; }
                        wcst[80 + lane] = p->in[23][64 * hhn + lane];
                    }
                }
                const int sub = c < 0 ? 0 : c / tch, cc = c < 0 ? 0 : c % tch; const bool act = (c >= 0) && (sub < nsub);
                if (act && !(skipmask & 1)) {
                    const int pid = grp == 0 ? it : 4 * it + sub; const int d = pid & 1, hh = (pid >> 1) & 15, b = pid >> 5;
                    const int T = grp == 0 ? 2048 : 256, mb = grp == 0 ? MP + b * 2048 : b * 256;
                    if (cc == 0) {
                        if (grp == 0) { const float* s0 = (d == 0 ? p->in[3] : p->in[4]) + ((size_t)(b * 16 + hh) * 64 + i0) * 64 + 8 * cg8;
                            const f32x4 a0 = *(const f32x4*)s0, a1 = *(const f32x4*)(s0 + 4), b0 = *(const f32x4*)(s0 + 64), b1 = *(const f32x4*)(s0 + 68);
                            Sa[0] = a0.lo; Sa[1] = a0.hi; Sa[2] = a1.lo; Sa[3] = a1.hi; Sb[0] = b0.lo; Sb[1] = b0.hi; Sb[2] = b1.lo; Sb[3] = b1.hi; }
                        else {
    #pragma unroll
                            for (int i = 0; i < 4; ++i) { Sa[i] = (f32x2){0.f, 0.f}; Sb[i] = (f32x2){0.f, 0.f}; } }
                    }
                    const LAS float* bp0 = lf + (grp * 2 + (c & 1)) * SBUF;
                    bf16_t* yo = yout + (size_t)d * MT * D + 64 * hh + i0;
                    f32x4 nk0, nk1, nb0, nb1, nd0, nd1; f32x2 nv; f32x2 rp[4];
    #define SCAN_LOAD_K(s_) do { const LAS float* bp_ = bp0 + (s_) * SST + 8 * cg8; nk0 = *(const LAS f32x4*)(bp_); nk1 = *(const LAS f32x4*)(bp_ + 4); } while (0)
    #define SCAN_LOAD_R(s_) do { const LAS float* bp_ = bp0 + (s_) * SST + 8 * cg8; const f32x4 r0_ = *(const LAS f32x4*)(bp_ + 192), r1_ = *(const LAS f32x4*)(bp_ + 196); rp[0] = r0_.lo; rp[1] = r0_.hi; rp[2] = r1_.lo; rp[3] = r1_.hi; } while (0)
    #define SCAN_LOAD_B(s_) do { const LAS float* bp_ = bp0 + (s_) * SST + 8 * cg8; nb0 = *(const LAS f32x4*)(bp_ + 64); nb1 = *(const LAS f32x4*)(bp_ + 68); \
                        nd0 = *(const LAS f32x4*)(bp_ + 128); nd1 = *(const LAS f32x4*)(bp_ + 132); nv = *(const LAS f32x2*)(bp0 + (s_) * SST + 256 + i0); } while (0)
                    SCAN_LOAD_K(0); SCAN_LOAD_B(0);
    #pragma unroll
                    for (int i = 0; i < 4; ++i) rp[i] = (f32x2){0.f, 0.f};
    #define SCAN_YFLUSH(b_) do { const LAS float* ys_ = ystage + cg8 * 128 + 16 * rl; const f32x4 q0_ = *(const LAS f32x4*)(ys_), q1_ = *(const LAS f32x4*)(ys_ + 4), q2_ = *(const LAS f32x4*)(ys_ + 8), q3_ = *(const LAS f32x4*)(ys_ + 12); \
                        const float ye_ = ((q0_[0] + q0_[2]) + (q1_[0] + q1_[2])) + ((q2_[0] + q2_[2]) + (q3_[0] + q3_[2])), yo_ = ((q0_[1] + q0_[3]) + (q1_[1] + q1_[3])) + ((q2_[1] + q2_[3]) + (q3_[1] + q3_[3])); \
                        const int pos_ = cc * 16 + 8 * (b_) + cg8; const int m_ = mb + (d == 0 ? pos_ : T - 1 - pos_); *(unsigned*)(yo + (size_t)m_ * D) = cvt_pk_bf16(ye_, yo_); } while (0)
    #pragma unroll
                    for (int s = 0; s < 16; ++s) {
                        const f32x2 kk[4] = {nk0.lo, nk0.hi, nk1.lo, nk1.hi};
                        f32x2 pa = Sa[0] * kk[0], pb = Sb[0] * kk[0], ya = Sa[0] * rp[0], yb = Sb[0] * rp[0];
    #pragma unroll
                        for (int i = 1; i < 4; ++i) { pa = Sa[i] * kk[i] + pa; pb = Sb[i] * kk[i] + pb; ya = Sa[i] * rp[i] + ya; yb = Sb[i] * rp[i] + yb; }
                        if (s < 15 && !(VAR & 2)) SCAN_LOAD_K(s + 1);
                        if (!(VAR & 2)) SCAN_LOAD_R(s);
                        float sa0 = pa.x + pa.y, sa1 = pb.x + pb.y;
                        if (s > 0) { LAS float* yp_ = ystage + ((s - 1) & 7) * 128 + 2 * lane; float y0s_, y1s_; asm("v_add_f32 %0, %1, %2" : "=v"(y0s_) : "v"(ya.x), "v"(ya.y)); asm("v_add_f32 %0, %1, %2" : "=v"(y1s_) : "v"(yb.x), "v"(yb.y));
                        asm volatile("ds_write2_b32 %0, %1, %2 offset1:1" :: "v"(yp_), "v"(y0s_), "v"(y1s_) : "memory"); }
                        sa0 += dpp_f<0xB1>(sa0); sa1 += dpp_f<0xB1>(sa1);
                        sa0 += dpp_f<0x4E>(sa0); sa1 += dpp_f<0x4E>(sa1);
                        sa0 += dpp_f<0x141>(sa0); sa1 += dpp_f<0x141>(sa1);
                        const f32x2 bb[4] = {nb0.lo, nb0.hi, nb1.lo, nb1.hi}, dd[4] = {nd0.lo, nd0.hi, nd1.lo, nd1.hi};
                        const f32x2 n0 = (f32x2){-sa0, -sa0}, n1 = (f32x2){-sa1, -sa1}, v0 = (f32x2){nv.x, nv.x}, v1 = (f32x2){nv.y, nv.y};
    #pragma unroll
                        for (int i = 0; i < 4; ++i) { Sa[i] = n0 * bb[i] + Sa[i]; Sb[i] = n1 * bb[i] + Sb[i]; Sa[i] = v0 * dd[i] + Sa[i]; Sb[i] = v1 * dd[i] + Sb[i]; }
                        if (s < 15 && !(VAR & 1)) SCAN_LOAD_B(s + 1);
                        if (s == 8) SCAN_YFLUSH(0);
                    }
                    {
                        f32x2 ya = Sa[0] * rp[0], yb = Sb[0] * rp[0];
    #pragma unroll
                        for (int i = 1; i < 4; ++i) { ya = Sa[i] * rp[i] + ya; yb = Sb[i] * rp[i] + yb; }
                        { LAS float* yp_ = ystage + 7 * 128 + 2 * lane; yp_[0] = ya.x + ya.y; yp_[1] = yb.x + yb.y; }
                        const f32x4 c0 = *(const LAS f32x4*)(bp0 + 16 * SST + 8 * cg8), c1 = *(const LAS f32x4*)(bp0 + 16 * SST + 8 * cg8 + 4);
                        Sa[0] *= c0.lo; Sa[1] *= c0.hi; Sa[2] *= c1.lo; Sa[3] *= c1.hi; Sb[0] *= c0.lo; Sb[1] *= c0.hi; Sb[2] *= c1.lo; Sb[3] *= c1.hi;
                        SCAN_YFLUSH(1);
                    }
    #undef SCAN_YFLUSH
    #undef SCAN_LOAD_K
    #undef SCAN_LOAD_R
    #undef SCAN_LOAD_B
                    if (grp == 1 && cc == tch - 1) {
                        float* sf = p->out + (size_t)MT * D + (size_t)d * (32 * 16 * 4096) + ((size_t)(b * 16 + hh) * 64 + i0) * 64 + 8 * cg8;
                        *(f32x4*)sf = (f32x4){Sa[0].x, Sa[0].y, Sa[1].x, Sa[1].y}; *(f32x4*)(sf + 4) = (f32x4){Sa[2].x, Sa[2].y, Sa[3].x, Sa[3].y};
                        *(f32x4*)(sf + 64) = (f32x4){Sb[0].x, Sb[0].y, Sb[1].x, Sb[1].y}; *(f32x4*)(sf + 68) = (f32x4){Sb[2].x, Sb[2].y, Sb[3].x, Sb[3].y};
                    }
                }
            }
          }
            asm volatile("s_waitcnt lgkmcnt(0)" ::: "memory"); __builtin_amdgcn_s_barrier(); asm volatile("" ::: "memory");
        }
    }
}

#define XB_TMO      128
#define XB_XCNT(j)  (256  + 64 * (j))
#define XB_XSUB(j)  (1280 + 64 * (j))
#define XB_XGEN(j)  (2304 + 64 * (j))
#define XB_TOP      3328
#define XB_TOPGEN   3392
#define XCD_BAR_WORDS 3456
#define XB_SPIN_CAP (1u << 18)

__device__ __forceinline__ unsigned xb_ld(unsigned* p)              { return __hip_atomic_load(p, __ATOMIC_RELAXED, __HIP_MEMORY_SCOPE_AGENT); }
__device__ __forceinline__ unsigned xb_add(unsigned* p, unsigned v) { return __hip_atomic_fetch_add(p, v, __ATOMIC_RELAXED, __HIP_MEMORY_SCOPE_AGENT); }
__device__ __forceinline__ unsigned xb_xcc_id() { return (unsigned)__builtin_amdgcn_s_getreg((3 << 11) | 20) & 0xFu; }
#define XB_SPIN(cond, bar) do { unsigned _sp = 0; while (cond) { __builtin_amdgcn_s_sleep(1); \
    if ((++_sp & 255u) == 0u) { if (xb_ld(&(bar)[XB_TMO])) break; if (_sp > XB_SPIN_CAP) { atomicAdd(&(bar)[XB_TMO], 1u); break; } } } } while (0)

struct XcdBarrier {
    unsigned* bar; unsigned x;
    volatile LAS unsigned* st;
};

__device__ __forceinline__ XcdBarrier xcd_barrier_post(unsigned* bar, volatile LAS unsigned* st) {
    XcdBarrier b; b.bar = bar; b.x = xb_xcc_id(); b.st = st;
    if (threadIdx.x == 0) (void)xb_add(&bar[XB_XCNT(b.x)], 1u);
    return b;
}
__device__ __forceinline__ void xcd_barrier_complete(unsigned* bar, unsigned x, unsigned& nloc, unsigned& nx) {
    const unsigned G = gridDim.x * gridDim.y * gridDim.z;
    unsigned sum, cnt, mine, sp = 0u;
    for (;;) {
        sum = 0u; cnt = 0u; mine = 0u;
#pragma unroll
        for (unsigned j = 0; j < 16; ++j) { const unsigned c = xb_ld(&bar[XB_XCNT(j)]); sum += c; cnt += (c > 0u) ? 1u : 0u; mine = (j == x) ? c : mine; }
        if (sum == G) break;
        __builtin_amdgcn_s_sleep(1);
        if ((++sp & 255u) == 0u) { if (xb_ld(&bar[XB_TMO])) break; if (sp > XB_SPIN_CAP) { atomicAdd(&bar[XB_TMO], 1u); break; } }
    }
    nloc = mine > 0u ? mine : 1u; nx = cnt > 0u ? cnt : 1u;
}

__device__ __forceinline__ void xcd_barrier(const XcdBarrier& b) {
    asm volatile("s_waitcnt vmcnt(0)" ::: "memory");
    __syncthreads();
    if (threadIdx.x == 0) {
        unsigned* bar = b.bar;
        __builtin_amdgcn_s_waitcnt(0);
        unsigned nloc = b.st[0], nx = b.st[1];
        if (nloc == 0u) { xcd_barrier_complete(bar, b.x, nloc, nx); b.st[0] = nloc; b.st[1] = nx; }
        const unsigned old = xb_add(&bar[XB_XSUB(b.x)], 1u);
        const unsigned gen = old / nloc;
        if (old + 1u == (gen + 1u) * nloc) {
            __builtin_amdgcn_fence(__ATOMIC_RELEASE, "agent");
            asm volatile("s_waitcnt vmcnt(0)" ::: "memory");
            const unsigned og = xb_add(&bar[XB_TOP], 1u);
            const unsigned tg = og / nx;
            if (og + 1u == (tg + 1u) * nx) xb_add(&bar[XB_TOPGEN], 1u);
            else XB_SPIN(xb_ld(&bar[XB_TOPGEN]) == tg, bar);
            __builtin_amdgcn_fence(__ATOMIC_ACQUIRE, "agent");
            xb_add(&bar[XB_XGEN(b.x)], 1u);
            asm volatile("s_waitcnt vmcnt(0)" ::: "memory");
        } else {
            XB_SPIN(xb_ld(&bar[XB_XGEN(b.x)]) == gen, bar);
            __builtin_amdgcn_fence(__ATOMIC_ACQUIRE, "agent");
            asm volatile("s_waitcnt vmcnt(0)" ::: "memory");
        }
    }
    __syncthreads();
}


constexpr int NPHASE = 24;
#ifndef SPLITK
#define SPLITK 1
#endif
#ifndef ONLYMASK
#define ONLYMASK 0x1ff
#endif
#define EN(k) ((ONLYMASK >> (k)) & 1)
constexpr int LDS_BYTES = 131072 + 16;
__global__ void __launch_bounds__(512, 2) mega(Params kp) {
    extern __shared__ __attribute__((aligned(16))) unsigned char shm[];
    PG8_LAS unsigned char* lds = (PG8_LAS unsigned char*)shm;
    LAS float* lf = (LAS float*)shm;
    cg::grid_group grid = cg::this_grid();
    const int pb = kp.pb, pe = kp.pe;
    volatile LAS unsigned* xst = (volatile LAS unsigned*)(lds + 131072);
    if (threadIdx.x < 2) xst[threadIdx.x] = 0u;
    __syncthreads();
    XcdBarrier xb = xcd_barrier_post((unsigned*)(kp.ws + OFF_BAR), xst);
#ifdef PROBE_SYNC
#pragma unroll 1
    for (int i = 0; i < PROBE_SYNC; ++i) grid.sync();
#endif
#pragma unroll 1
    for (int ph = pb; ph < pe; ++ph) {
        CP p = (CP)__builtin_amdgcn_kernarg_segment_ptr();
        asm volatile("" : "+s"(p));
        Tix tx; { int t_ = threadIdx.x, b_ = blockIdx.x, g_ = gridDim.x; asm volatile("" : "+v"(t_)); asm volatile("" : "+s"(b_), "+s"(g_)); tx.tid = t_; tx.bid = b_; tx.gd = g_; }
        bf16_t* rA = (bf16_t*)(p->ws + OFF_A); bf16_t* rB = (bf16_t*)(p->ws + OFF_B); bf16_t* rC = (bf16_t*)(p->ws + OFF_C); bf16_t* rD = (bf16_t*)(p->ws + OFF_D); bf16_t* rE = (bf16_t*)(p->ws + OFF_E);
        bf16_t* rS = (bf16_t*)(p->ws + OFF_S);
        const int wsel = (ph <= 3) ? 0 : (ph <= 9) ? 1 : (ph <= 12) ? 0 : (ph <= 15) ? 1 : (ph <= 19) ? 0 : 1;
        bf16_t* W = (bf16_t*)(p->ws + (wsel ? OFF_W2 : OFF_W)); bf16_t* Wn = (bf16_t*)(p->ws + (wsel ? OFF_W : OFF_W2));
        const float* npre = p->in[8]; const float* npost = p->in[9];
        int kind = 0;
        RowCfg rc{}; int conv = -1;
        const bf16_t* gA = nullptr; const bf16_t* gB = nullptr; bf16_t* gO = nullptr; int gN = 0, gK = 0, pool_pass_id = 0;
        switch (ph) {
            case 0: kind = 0; break;
            case 1: kind = 1; rc = RowCfg{1, 0, 0, 0, 0.f, npost, 1, 0, 0, 1, npre + 0 * D, 0, SPLITK}; break;
            case 2: case 11: case 14: case 21: kind = 2; conv = (ph == 2) ? 4 : (ph == 11) ? 2 : (ph == 14) ? 5 : -1; break;
            case 3: case 12: case 15: case 22: kind = 3; gA = rB; gB = W + W_W2T; gO = rE; gN = 1024; gK = 2816; break;
            case 4: kind = 4; rc = RowCfg{1, 1, 0, 2, 0.5f, npost + 0 * D, 1, 0, 3, 4, npre + 1 * D, 1, SPLITK}; break;
            case 5: kind = 5; conv = 1; break;
            case 6: kind = 6; break;
            case 7: kind = 3; gA = rS; gB = W + W_BTG; gO = rC; gN = 1024; gK = 384; break;
            case 8: kind = 7; break;
            case 9: kind = 3; gA = rD; gB = W + W_WOT; gO = rE; gN = 1024; gK = 1024; break;
            case 10: kind = 1; rc = RowCfg{0, 1, 0, 5, 1.0f, npost + 1 * D, 1, 0, 6, 7, npre + 2 * D, 1, SPLITK}; break;
            case 13: kind = 1; rc = RowCfg{0, 1, 0, 8, 0.5f, npost + 2 * D, 1, 1, 0, 1, npre + 3 * D, 1, SPLITK}; break;
            case 16: kind = 1; rc = RowCfg{0, 1, 1, 2, 0.5f, npost + 3 * D, 1, 1, 3, 4, npre + 4 * D, 1, SPLITK}; break;
            case 17: kind = 8; pool_pass_id = 0; break;
            case 18: kind = 8; pool_pass_id = 1; break;
            case 19: kind = 3; gA = rD; gB = W; gO = rE; gN = 1024; gK = 1024; conv = 3; break;
            case 20: kind = 1; rc = RowCfg{0, 1, 1, 5, 1.0f, npost + 4 * D, 1, 1, 6, 7, npre + 5 * D, 1, SPLITK}; break;
            case 23: kind = 1; rc = RowCfg{0, 1, 1, 8, 0.5f, npost + 5 * D, 0, 0, 0, 0, npre, 1, SPLITK}; break;
            default: break;
        }
        rc.fsplit = (SPLITK && tx.gd == 256 && ph != 20) ? 1 : 0;
#ifdef PROBE_PH
        const int reps = (ph == PROBE_PH) ? PROBE_N : 1;
#else
        const int reps = 1;
#endif
#pragma unroll 1
        for (int rep = 0; rep < reps; ++rep) {
        if (rep > 0) xcd_barrier(xb);
        asm volatile("" : "+v"(tx.tid)); asm volatile("" : "+s"(tx.bid), "+s"(tx.gd)); asm volatile("" : "+s"(p));
        if (EN(0) && kind == 0) { mod_phase(p, lf, tx); __syncthreads();
            if (tx.gd > 64) { if (tx.bid >= 32) { const Tix tv{tx.tid, tx.bid - 32, tx.gd - 32}; conv_ffn(p, W, 0, lf + 16384, tv); } }
            else conv_ffn(p, W, 0, lf + 16384, tx); }
        else if (EN(1) && kind == 1) { rowpass_simple(p, rc, tx); }
        else if (EN(4) && kind == 4) { rowpass_shift(p, rc, lf, tx); }
        else if (EN(2) && (kind == 2 || kind == 3 || kind == 5)) {
            if (kind == 2) { gA = rA; gB = W + W_W13; gO = rB; gN = 5632; gK = 1024; } else if (kind == 5) { gA = rA; gB = W + W_BTP; gO = rC; gN = 3584; gK = 2048; }
            const int diag = (ph == 19) ? 1 : 0;
            const int bal = (!diag && SPLITK && kind == 3 && gK >= 1024 && tx.gd == 256) ? 1 : 0;
            pg8::Gemm g{gA, gB, MT, gN, gK}; pg8::FwdOrder S; S.init(MT, gN, gK, tx.gd, tx.bid, diag ? 2 : (ph == 7 ? 3 : bal));
            pg8::EpiAll E{kind == 3 ? 0 : (kind == 2 ? 1 : 2), gO, kind == 2 ? DFF : 1024, rS, (bf16_t*)(p->ws + OFF_FB) - (size_t)16384 * 1024};
#ifdef PROBE_NOEPI
            if (rep + 1 < reps) E.kind = 7;
#endif
            pg8::gemm_phase<pg8::EpiAll, pg8::FwdOrder, false>(lds, g, S, E, nullptr, tx.tid);
            if (conv >= 0) { const int nunit = (MT / 256) * (gN / 256), extra = nunit % tx.gd;
                const int half = (bal || extra == 0 || extra > tx.gd / 2) ? 0 : extra; if (tx.bid >= half) { const Tix tv{tx.tid, tx.bid - half, tx.gd - half};
                if (conv < 4) conv_ffn(p, Wn, conv, lf, tv); else if (conv == 4) conv_rwkv(p, Wn, lf, tv); else conv_pool(p, Wn, tv); } } }
        else if (EN(6) && kind == 6) {
#ifdef PROBE_VAR
            if (rep + 1 < reps) scan_phase<PROBE_VAR>(p, W, lf, tx, 0); else scan_phase<0>(p, W, lf, tx, 0);
#elif defined(PROBE_MASK)
            scan_phase<0>(p, W, lf, tx, (rep + 1 < reps) ? PROBE_MASK : 0);
#else
            scan_phase<0>(p, W, lf, tx, 0);
#endif
        }
        else if (EN(7) && kind == 7) rowpass_gn(p, tx);
        else if (EN(8) && kind == 8) pool_pass(p, pool_pass_id, tx);
        }
        if (ph + 1 < pe) { if (pb > pe) grid.sync(); else xcd_barrier(xb); }
    }
}

#include <cstdio>
#ifndef USE_COOP
#define USE_COOP 1
#endif
extern "C" void kernel_launch(void* const* d_in, const int* in_sizes, int n_in, void* d_out, int out_size, void* d_ws, size_t ws_size, hipStream_t stream) {
    static int grid = 0;
    if (grid == 0) {
        if (n_in != NIN || ws_size < WS_NEED) { fprintf(stderr, "kernel_launch: n_in %d ws %zu (need %zu)\n", n_in, ws_size, (size_t)WS_NEED); grid = -1; return; }
        int dev = 0, cus = 0, per_cu = 0;
        hipGetDevice(&dev); hipDeviceGetAttribute(&cus, hipDeviceAttributeMultiprocessorCount, dev);
        if (hipFuncSetAttribute((const void*)mega, hipFuncAttributeMaxDynamicSharedMemorySize, LDS_BYTES) != hipSuccess) { fprintf(stderr, "kernel_launch: hipFuncSetAttribute failed\n"); grid = -1; return; }
        if (hipOccupancyMaxActiveBlocksPerMultiprocessor(&per_cu, (const void*)mega, 512, LDS_BYTES) != hipSuccess || per_cu < 1) { fprintf(stderr, "kernel_launch: occupancy query says %d\n", per_cu); per_cu = 1; }
        (void)hipGetLastError();
        grid = cus * 1;
        if (grid <= 0) grid = 256;
    }
    if (grid < 0) return;
    if (hipMemsetAsync((unsigned char*)d_ws + OFF_BAR, 0, 16384, stream) != hipSuccess) { fprintf(stderr, "kernel_launch: memset of the barrier words failed\n"); return; }
    Params p{};
    for (int i = 0; i < NIN; ++i) p.in[i] = (const float*)d_in[i];
    p.out = (float*)d_out; p.ws = (unsigned char*)d_ws;
#if USE_COOP
    p.pb = 0; p.pe = NPHASE;
    void* args[] = {&p};
    hipError_t e = hipLaunchCooperativeKernel((const void*)mega, dim3(grid), dim3(512), args, LDS_BYTES, stream);
    if (e != hipSuccess) fprintf(stderr, "cooperative launch failed: %s (grid %d)\n", hipGetErrorString(e), grid);
#else
    for (int ph = 0; ph < NPHASE; ++ph) { p.pb = ph; p.pe = ph + 1; hipLaunchKernelGGL(mega, dim3(grid), dim3(512), LDS_BYTES, stream, p); }
#endif
}
```
